# Optimizing an MI355X kernel written in HIP

```python
import math
import jax, jax.numpy as jnp
from jax import lax
import numpy as np

D_MODEL = 1024
BATCH = 8
SEQ = 2048
DEPTH = 4
DEC_BATCH = 128
DEC_SEQ = 4
PAST_LEN = 16384
PAGE_SIZE = 128

M_MIXERS = 2
N_A = (DEPTH + M_MIXERS - 1) // M_MIXERS
N_B = DEPTH // M_MIXERS
SC_DIM = 768
SC_W = 3
GDN_H = 6
GDN_DK = 128
GDN_DV = 128
GDN_DIM = GDN_H * GDN_DK
GDN_CONV_W = 4
GDN_CHUNK = 64
N_MEM = 256
XH = 4
XD = 64
XDIM = XH * XD
D_FF = 2816
FFN_W = 3
ALPHA = (2.0 * DEPTH) ** 0.25
BETA_DN = (8.0 * DEPTH) ** -0.25
LN_EPS = 1e-5
RMS_EPS = 1e-6

kernel_name = "hybrid_shortconv_gdn_memxattn_convffn_step"


def layer_norm(x, g, b):
    xf = x.astype(jnp.float32)
    mu = jnp.mean(xf, -1, keepdims=True)
    var = jnp.mean(jnp.square(xf - mu), -1, keepdims=True)
    y = (xf - mu) * lax.rsqrt(var + LN_EPS)
    return (y * g.astype(jnp.float32) + b.astype(jnp.float32)).astype(x.dtype)


def l2norm(x):
    return x * lax.rsqrt(jnp.sum(jnp.square(x), -1, keepdims=True) + RMS_EPS)


def causal_dwconv(x_full, w):
    width = w.shape[0]
    t = x_full.shape[1] - (width - 1)
    out = x_full[:, 0:t] * w[0]
    for j in range(1, width):
        out = out + x_full[:, j:j + t] * w[j]
    return out


def mem_attention(qm, mem_k, mem_v):
    bsz, t, _ = qm.shape
    q = qm.reshape(bsz, t, XH, XD)
    s = jnp.einsum('bthd,bmhd->bhtm', q, mem_k).astype(jnp.float32) * (XD ** -0.5)
    p = jax.nn.softmax(s, axis=-1)
    o = jnp.einsum('bhtm,bmhd->bthd', p.astype(mem_v.dtype), mem_v)
    return o.reshape(bsz, t, XDIM).astype(qm.dtype)


def gated_delta_chunked(q, k, v, g, beta, s0):
    bsz, t, h, dk = q.shape
    dv = v.shape[-1]
    c = GDN_CHUNK if t % GDN_CHUNK == 0 else t
    n = t // c

    def blocks(a):
        a = jnp.moveaxis(a, 2, 1)
        return a.reshape(bsz, h, n, c, *a.shape[3:])

    q = blocks(q * (dk ** -0.5))
    k = blocks(k)
    v = blocks(v)
    g = blocks(g)
    beta = blocks(beta)
    gc = jnp.cumsum(g, axis=-1)
    tril = jnp.tril(jnp.ones((c, c), dtype=bool))
    strict = jnp.tril(jnp.ones((c, c), dtype=bool), -1)
    diff = gc[..., :, None] - gc[..., None, :]
    decay = jnp.exp(jnp.where(tril, diff, -jnp.inf))
    kb = k * beta[..., None]
    a = jnp.einsum('bhnid,bhnjd->bhnij', kb, k) * decay
    a = jnp.where(strict, a, 0.0) + jnp.eye(c, dtype=a.dtype)
    rhs = jnp.concatenate([v * beta[..., None], kb * jnp.exp(gc)[..., None]], axis=-1)
    sol = lax.linalg.triangular_solve(a, rhs, left_side=True, lower=True, unit_diagonal=True)
    u, w = sol[..., :dv], sol[..., dv:]
    qk = jnp.einsum('bhnid,bhnjd->bhnij', q, k) * decay
    q_dec = q * jnp.exp(gc)[..., None]
    k_dec = k * jnp.exp(gc[..., -1:] - gc)[..., None]
    g_last = gc[..., -1]

    def step(s, inp):
        qk_i, qd_i, kd_i, u_i, w_i, gl_i = inp
        v_new = u_i - jnp.einsum('bhcd,bhde->bhce', w_i, s)
        o = jnp.einsum('bhcd,bhde->bhce', qd_i, s) + jnp.einsum('bhcj,bhje->bhce', qk_i, v_new)
        s = s * jnp.exp(gl_i)[..., None, None] + jnp.einsum('bhcd,bhce->bhde', kd_i, v_new)
        return s, o

    xs = tuple(jnp.moveaxis(a_, 2, 0) for a_ in (qk, q_dec, k_dec, u, w, g_last))
    s_fin, o = lax.scan(step, s0, xs)
    o = jnp.transpose(o, (1, 0, 3, 2, 4)).reshape(bsz, t, h, dv)
    return o, s_fin


def shortconv_mixer(x, hist, w_in, w_conv, w_out, mem_k, mem_v):
    h = x @ w_in
    xin, bg, cg, qm = jnp.split(h, [SC_DIM, 2 * SC_DIM, 3 * SC_DIM], axis=-1)
    u_full = jnp.concatenate([hist.astype(x.dtype), cg * xin], axis=1)
    y = bg * causal_dwconv(u_full, w_conv)
    o_mem = mem_attention(qm, mem_k, mem_v)
    out = jnp.concatenate([y, o_mem], axis=-1) @ w_out
    return out, u_full[:, -(SC_W - 1):]


def gdn_mixer(x, hist, s0, w_in, w_conv, a_log, dt_bias, norm_w, w_out, mem_k, mem_v):
    bsz, t, _ = x.shape
    h = x @ w_in
    qkv, z, b, a, qm = jnp.split(
        h, [3 * GDN_DIM, 4 * GDN_DIM, 4 * GDN_DIM + GDN_H, 4 * GDN_DIM + 2 * GDN_H], axis=-1)
    qkv_full = jnp.concatenate([hist.astype(x.dtype), qkv], axis=1)
    qkv_c = jax.nn.silu(causal_dwconv(qkv_full, w_conv)).astype(jnp.float32)
    q, k, v = jnp.split(qkv_c, 3, axis=-1)
    q = l2norm(q.reshape(bsz, t, GDN_H, GDN_DK))
    k = l2norm(k.reshape(bsz, t, GDN_H, GDN_DK))
    v = v.reshape(bsz, t, GDN_H, GDN_DV)
    beta = jax.nn.sigmoid(b.astype(jnp.float32))
    g = -jnp.exp(a_log.astype(jnp.float32)) * jax.nn.softplus(
        a.astype(jnp.float32) + dt_bias.astype(jnp.float32))
    o, s_new = gated_delta_chunked(q, k, v, g, beta, s0.astype(jnp.float32))
    o = o * lax.rsqrt(jnp.mean(jnp.square(o), -1, keepdims=True) + RMS_EPS)
    o = o * norm_w.astype(jnp.float32) * jax.nn.silu(z.astype(jnp.float32).reshape(bsz, t, GDN_H, GDN_DV))
    o = o.reshape(bsz, t, GDN_DIM).astype(x.dtype)
    o_mem = mem_attention(qm, mem_k, mem_v)
    out = jnp.concatenate([o, o_mem], axis=-1) @ w_out
    return out, qkv_full[:, -(GDN_CONV_W - 1):], s_new.astype(s0.dtype)


def channel_mixer(x, hist, w_up, w_conv, w_down):
    h_full = jnp.concatenate([hist.astype(x.dtype), x @ w_up], axis=1)
    hc = causal_dwconv(h_full, w_conv)
    gate, up = jnp.split(hc, 2, axis=-1)
    return (jax.nn.silu(gate) * up) @ w_down, h_full[:, -(FFN_W - 1):]


def trunk(x, mem_k, mem_v, sc_hist, gdn_hist, gdn_s, ffn_hist,
          w_in_a, conv_a, w_out_a, w_in_b, conv_b, a_log, dt_bias, gdn_norm_w, w_out_b,
          ln1_g, ln1_b, ln2_g, ln2_b, w_up, w_conv_ffn, w_down):
    new_sc, new_gc, new_gs, new_ffn = [], [], [], []
    for i in range(DEPTH):
        j = i // M_MIXERS
        if i % M_MIXERS == 0:
            mix, hs = shortconv_mixer(x, sc_hist[j], w_in_a[j], conv_a[j], w_out_a[j], mem_k[i], mem_v[i])
            new_sc.append(hs)
        else:
            mix, hg, sg = gdn_mixer(x, gdn_hist[j], gdn_s[j], w_in_b[j], conv_b[j], a_log[j], dt_bias[j],
                                    gdn_norm_w[j], w_out_b[j], mem_k[i], mem_v[i])
            new_gc.append(hg)
            new_gs.append(sg)
        x = layer_norm(ALPHA * x + mix, ln1_g[i], ln1_b[i])
        f, hf = channel_mixer(x, ffn_hist[i], w_up[i], w_conv_ffn[i], w_down[i])
        new_ffn.append(hf)
        x = layer_norm(ALPHA * x + f, ln2_g[i], ln2_b[i])
    return x, jnp.stack(new_sc), jnp.stack(new_gc), jnp.stack(new_gs), jnp.stack(new_ffn)


def setup_inputs(seed: int = 0) -> dict:
    key = jax.random.key(seed)
    ks = jax.random.split(key, 32)
    nrm = jax.random.normal
    f32 = jnp.float32
    w_in_b_cols = 4 * GDN_DIM + 2 * GDN_H + XDIM
    dt = jnp.exp(jax.random.uniform(ks[15], (N_B, GDN_H), f32, math.log(1e-3), math.log(1e-1)))
    return {
        "x_prompt": nrm(ks[0], (BATCH, SEQ, D_MODEL), f32),
        "x_sample": nrm(ks[1], (DEC_BATCH, DEC_SEQ, D_MODEL), f32),
        "mem_prompt": nrm(ks[2], (BATCH, N_MEM, D_MODEL), f32),
        "cache_mem_k": nrm(ks[3], (DEPTH, DEC_BATCH, N_MEM, XH, XD), f32),
        "cache_mem_v": nrm(ks[4], (DEPTH, DEC_BATCH, N_MEM, XH, XD), f32),
        "state_shortconv": nrm(ks[5], (N_A, DEC_BATCH, SC_W - 1, SC_DIM), f32),
        "state_gdn_conv": nrm(ks[6], (N_B, DEC_BATCH, GDN_CONV_W - 1, 3 * GDN_DIM), f32),
        "state_gdn": 0.1 * nrm(ks[7], (N_B, DEC_BATCH, GDN_H, GDN_DK, GDN_DV), f32),
        "state_ffn_conv": nrm(ks[8], (DEPTH, DEC_BATCH, FFN_W - 1, 2 * D_FF), f32),
        "w_in_a": nrm(ks[9], (N_A, D_MODEL, 3 * SC_DIM + XDIM), f32) * D_MODEL ** -0.5,
        "conv_a": nrm(ks[10], (N_A, SC_W, SC_DIM), f32) * SC_W ** -0.5,
        "w_out_a": nrm(ks[11], (N_A, SC_DIM + XDIM, D_MODEL), f32) * (SC_DIM + XDIM) ** -0.5 * BETA_DN,
        "w_in_b": nrm(ks[12], (N_B, D_MODEL, w_in_b_cols), f32) * D_MODEL ** -0.5,
        "conv_b": nrm(ks[13], (N_B, GDN_CONV_W, 3 * GDN_DIM), f32) * GDN_CONV_W ** -0.5,
        "a_log": jnp.log(jax.random.uniform(ks[14], (N_B, GDN_H), f32, 1.0, 16.0)),
        "dt_bias": dt + jnp.log(-jnp.expm1(-dt)),
        "gdn_norm_w": 1.0 + 0.02 * nrm(ks[16], (N_B, GDN_DV), f32),
        "w_out_b": nrm(ks[17], (N_B, GDN_DIM + XDIM, D_MODEL), f32) * (GDN_DIM + XDIM) ** -0.5 * BETA_DN,
        "w_mem_kv": nrm(ks[18], (DEPTH, D_MODEL, 2 * XDIM), f32) * D_MODEL ** -0.5,
        "ln1_g": 1.0 + 0.02 * nrm(ks[19], (DEPTH, D_MODEL), f32),
        "ln1_b": 0.02 * nrm(ks[20], (DEPTH, D_MODEL), f32),
        "ln2_g": 1.0 + 0.02 * nrm(ks[21], (DEPTH, D_MODEL), f32),
        "ln2_b": 0.02 * nrm(ks[22], (DEPTH, D_MODEL), f32),
        "w_up": nrm(ks[23], (DEPTH, D_MODEL, 2 * D_FF), f32) * D_MODEL ** -0.5,
        "w_conv_ffn": nrm(ks[24], (DEPTH, FFN_W, 2 * D_FF), f32) * FFN_W ** -0.5,
        "w_down": nrm(ks[25], (DEPTH, D_FF, D_MODEL), f32) * D_FF ** -0.5 * BETA_DN,
    }


def reference(x_prompt, x_sample, mem_prompt, cache_mem_k, cache_mem_v, state_shortconv, state_gdn_conv,
              state_gdn, state_ffn_conv, w_in_a, conv_a, w_out_a, w_in_b, conv_b, a_log, dt_bias,
              gdn_norm_w, w_out_b, w_mem_kv, ln1_g, ln1_b, ln2_g, ln2_b, w_up, w_conv_ffn, w_down):
    weights = (w_in_a, conv_a, w_out_a, w_in_b, conv_b, a_log, dt_bias, gdn_norm_w, w_out_b,
               ln1_g, ln1_b, ln2_g, ln2_b, w_up, w_conv_ffn, w_down)
    bsz = x_prompt.shape[0]
    dtp = x_prompt.dtype
    kv = jnp.einsum('bmd,lde->lbme', mem_prompt, w_mem_kv)
    mem_k_prompt = kv[..., :XDIM].reshape(DEPTH, bsz, N_MEM, XH, XD)
    mem_v_prompt = kv[..., XDIM:].reshape(DEPTH, bsz, N_MEM, XH, XD)
    z_sc = jnp.zeros((N_A, bsz, SC_W - 1, SC_DIM), dtp)
    z_gc = jnp.zeros((N_B, bsz, GDN_CONV_W - 1, 3 * GDN_DIM), dtp)
    z_gs = jnp.zeros((N_B, bsz, GDN_H, GDN_DK, GDN_DV), dtp)
    z_ffn = jnp.zeros((DEPTH, bsz, FFN_W - 1, 2 * D_FF), dtp)
    y_prompt, sc_p, gc_p, gs_p, ffn_p = trunk(x_prompt, mem_k_prompt, mem_v_prompt, z_sc, z_gc, z_gs, z_ffn,
                                              *weights)
    y_sample, sc_s, gc_s, gs_s, ffn_s = trunk(x_sample, cache_mem_k, cache_mem_v, state_shortconv,
                                              state_gdn_conv, state_gdn, state_ffn_conv, *weights)
    return (y_prompt, y_sample, mem_k_prompt, mem_v_prompt, sc_p, gc_p, gs_p, ffn_p, sc_s, gc_s, gs_s, ffn_s)
```

```cpp
#include <hip/hip_runtime.h>
#include <hip/hip_cooperative_groups.h>
#include <cstdio>
namespace cg = cooperative_groups;
#define NAIVE_ATTN 1
#define NAIVE_GDN 1
namespace pg8 {
#define PG8_LAS __attribute__((address_space(3)))
typedef unsigned short bf16_t;
typedef short bf16x8 __attribute__((ext_vector_type(8)));
typedef float f32x4 __attribute__((ext_vector_type(4)));
typedef unsigned u32x4 __attribute__((ext_vector_type(4)));
constexpr int BM = 256, BK = 64, HALF = 128, HTB = HALF * BK * 2  , STAGE_BYTES = 8 * HTB, NXCD = 8, WGM = 8;

__host__ __device__ __forceinline__ int lds_byte(int r, int c) { const int st = (r >> 4) * 2 + (c >> 5), rr = r & 15, cc = c & 31, ob = rr * 64 + cc * 2; return st * 1024 + (ob ^ (((ob >> 9) & 1) << 5)); }
__host__ __device__ __forceinline__ void stage_rc(int b, int& R, int& C) { const int st = b / 1024, sb = b % 1024, swz = sb ^ (((sb >> 9) & 1) << 5); R = (st >> 1) * 16 + swz / 64; C = (st & 1) * 32 + (swz % 64) / 2; }
__host__ __device__ __forceinline__ int perm32(int rho) { const int n = rho >> 4, i = rho & 15; return 8 * (i >> 2) + 4 * n + (i & 3); }

struct Unit { int pm, pn; };
struct Gemm { const bf16_t* A; const bf16_t* Bt; int M, N, K; };

struct StaticOrder {
    int nM, nN, nwg, G, c;
    __host__ __device__ void init(int M, int N, int G_, int c_) { nM = M / BM; nN = N / BM; nwg = nM * nN; G = G_; c = c_; }
    __host__ __device__ bool next(int i, Unit& u) const {
        const long L = (long)i * G + c; if (L >= nwg) return false;
        int wgid = (int)L; { const int q = nwg / NXCD, r = nwg % NXCD, xcd = wgid % NXCD, off = wgid / NXCD; wgid = (xcd < r ? xcd * (q + 1) : r * (q + 1) + (xcd - r) * q) + off; }
        const int nig = WGM * nN, gid = wgid / nig, fm = gid * WGM, gsz = (nM - fm) < WGM ? (nM - fm) : WGM;
        u.pm = fm + ((wgid % nig) % gsz); u.pn = (wgid % nig) / gsz; return true;
    }
    __device__ __forceinline__ void a_ready(const Unit&) const {}
    __device__ __forceinline__ void done(const Unit&) const {}
};
__device__ __forceinline__ unsigned cvt_pk_bf16(float lo, float hi) { unsigned r; asm volatile("v_cvt_pk_bf16_f32 %0, %1, %2" : "=v"(r) : "v"(lo), "v"(hi)); return r; }
typedef float f32x2 __attribute__((ext_vector_type(2)));
template <class Epi, class Sched, bool STAMP = false>
__device__ __forceinline__ void gemm_phase(PG8_LAS unsigned char* lds, const Gemm g, const Sched& S, const Epi& E, unsigned long long* stamps) {
    int tid = threadIdx.x; asm volatile("" : "+v"(tid)); const int wid = __builtin_amdgcn_readfirstlane(tid >> 6), lane = tid & 63, wr = wid >> 2, wc = wid & 3, fr = lane & 15, fq = lane >> 4;
    const int K = g.K, nt = K / BK;
    int ts_lo = 0, ts_hi = 0, nts = 0; const unsigned long long rt_entry = STAMP ? (unsigned long long)wall_clock64() : 0ull;
#define PG8_STAMP() do { if (STAMP && wid == 0 && nts < 64) { const unsigned long long _c = (unsigned long long)clock64(); \
        ts_lo = (lane == nts) ? (int)(unsigned)_c : ts_lo; ts_hi = (lane == nts) ? (int)(unsigned)(_c >> 32) : ts_hi; ++nts; } } while (0)
    PG8_STAMP();
    unsigned voffA[2], voffB[2];
#pragma unroll
    for (int i = 0; i < 2; ++i) { int R, C; stage_rc(tid * 16 + i * 8192, R, C); const int Rb = Epi::PERM ? ((R & ~31) + perm32(R & 31)) : R;
        voffA[i] = (unsigned)(R * K + C) * 2u; voffB[i] = (unsigned)(Rb * K + C) * 2u; }
    const size_t kstep = (size_t)(BK * 2);
    const size_t hstep = (size_t)HALF * K * 2;
    const size_t tstep = 2 * hstep;
    const unsigned ldsw = (unsigned)wid * 1024u;
    const int aoff = lds_byte(wr * 64 + fr, fq * 8), boff = lds_byte(wc * 32 + fr, fq * 8);
#define PG8_SA(b, h) (((b) * 2 + (h)) * HTB)
#define PG8_SB(b, h) ((4 + (b) * 2 + (h)) * HTB)
#define PG8_STAGE(bufoff, gbase, voff) do { _Pragma("unroll") for (int _i = 0; _i < 2; ++_i) \
        __builtin_amdgcn_global_load_lds((const unsigned*)((const char*)(gbase) + (voff)[_i]), (PG8_LAS unsigned*)(lds + (bufoff) + ldsw + _i * 8192), 16, 0, 0); } while (0)
#define PG8_LDA(dst, b, h) do { _Pragma("unroll") for (int m = 0; m < 4; ++m) _Pragma("unroll") for (int k = 0; k < 2; ++k) dst[m][k] = *(const PG8_LAS bf16x8*)(lds + PG8_SA(b, h) + aoff + m * 2048 + k * 1024); } while (0)
#define PG8_LDB(dst, b, h) do { _Pragma("unroll") for (int n = 0; n < 2; ++n) _Pragma("unroll") for (int k = 0; k < 2; ++k) dst[n][k] = *(const PG8_LAS bf16x8*)(lds + PG8_SB(b, h) + boff + n * 2048 + k * 1024); } while (0)
#define PG8_MMA(ai, bj, At, Bt) do { __builtin_amdgcn_s_setprio(1); _Pragma("unroll") for (int m = 0; m < 4; ++m) _Pragma("unroll") for (int n = 0; n < 2; ++n) _Pragma("unroll") for (int k = 0; k < 2; ++k) \
        acc[ai][bj][m][n] = __builtin_amdgcn_mfma_f32_16x16x32_bf16(Bt[n][k], At[m][k], acc[ai][bj][m][n], 0, 0, 0); __builtin_amdgcn_s_setprio(0); } while (0)
#define PG8_WAIT_V(n) asm volatile("s_waitcnt vmcnt(" #n ")" ::: "memory")
#define PG8_WAIT_L(n) asm volatile("s_waitcnt lgkmcnt(" #n ")" ::: "memory")
#define PG8_BAR __builtin_amdgcn_s_barrier()
#define PG8_SCHED __builtin_amdgcn_sched_barrier(0)
    Unit cur, nxt; int ui = 0;
    if (!S.next(0, cur)) return;
    f32x4 acc[2][2][4][2];
#pragma unroll
    for (int a = 0; a < 2; ++a)
#pragma unroll
        for (int b = 0; b < 2; ++b)
#pragma unroll
            for (int m = 0; m < 4; ++m)
#pragma unroll
                for (int n = 0; n < 2; ++n) acc[a][b][m][n] = (f32x4){0.f, 0.f, 0.f, 0.f};
    bf16x8 At[4][2], B0[2][2], B1[2][2];
    const char* cA = (const char*)g.A + (size_t)cur.pm * tstep; const char* cB = (const char*)g.Bt + (size_t)cur.pn * tstep;
    S.a_ready(cur);
    PG8_STAGE(PG8_SB(0, 0), cB, voffB); PG8_STAGE(PG8_SA(0, 0), cA, voffA); PG8_STAGE(PG8_SB(0, 1), cB + hstep, voffB); PG8_STAGE(PG8_SA(0, 1), cA + hstep, voffA);
    if (wr == 1) PG8_BAR;
    PG8_WAIT_V(4); PG8_BAR;
    PG8_STAGE(PG8_SB(1, 0), cB + kstep, voffB); PG8_STAGE(PG8_SA(1, 0), cA + kstep, voffA); PG8_STAGE(PG8_SB(1, 1), cB + hstep + kstep, voffB);
    PG8_WAIT_V(6); PG8_BAR;
    PG8_STAMP();
    for (;;) {
        const bool has_next = S.next(ui + 1, nxt);
        const char* nA = has_next ? (const char*)g.A + (size_t)nxt.pm * tstep : cA; const char* nB = has_next ? (const char*)g.Bt + (size_t)nxt.pn * tstep : cB;
        for (int t = 0; t < nt; t += 2) {
            const bool last = (t == nt - 2);
            const char* a1 = cA + (size_t)(t + 1) * kstep;
            const char* a2 = last ? nA : cA + (size_t)(t + 2) * kstep; const char* b2 = last ? nB : cB + (size_t)(t + 2) * kstep;
            const char* a3 = a2 + kstep; const char* b3 = b2 + kstep;
            if (last && has_next) S.a_ready(nxt);
            PG8_LDB(B0, 0, 0); PG8_SCHED; PG8_LDA(At, 0, 0); PG8_STAGE(PG8_SA(1, 1), a1 + hstep, voffA);
            PG8_WAIT_L(8); PG8_BAR; PG8_WAIT_L(0); PG8_MMA(0, 0, At, B0); PG8_BAR; PG8_SCHED;
            PG8_LDB(B1, 0, 1); PG8_STAGE(PG8_SB(0, 0), b2, voffB);
            PG8_BAR; PG8_WAIT_L(0); PG8_MMA(0, 1, At, B1); PG8_BAR;
            PG8_LDA(At, 0, 1); PG8_STAGE(PG8_SA(0, 0), a2, voffA);
            PG8_BAR; PG8_WAIT_L(0); PG8_MMA(1, 0, At, B0); PG8_BAR; PG8_SCHED;
            PG8_STAGE(PG8_SB(0, 1), b2 + hstep, voffB);
            PG8_WAIT_V(6); PG8_BAR; PG8_MMA(1, 1, At, B1); PG8_BAR;
            PG8_LDB(B0, 1, 0); PG8_SCHED; PG8_LDA(At, 1, 0); PG8_STAGE(PG8_SA(0, 1), a2 + hstep, voffA);
            PG8_WAIT_L(8); PG8_BAR; PG8_WAIT_L(0); PG8_MMA(0, 0, At, B0); PG8_BAR; PG8_SCHED;
            PG8_LDB(B1, 1, 1); PG8_STAGE(PG8_SB(1, 0), b3, voffB);
            PG8_BAR; PG8_WAIT_L(0); PG8_MMA(0, 1, At, B1); PG8_BAR;
            PG8_LDA(At, 1, 1); PG8_STAGE(PG8_SA(1, 0), a3, voffA);
            PG8_BAR; PG8_WAIT_L(0); PG8_MMA(1, 0, At, B0); PG8_BAR; PG8_SCHED;
            PG8_STAGE(PG8_SB(1, 1), b3 + hstep, voffB);
            PG8_WAIT_V(6); PG8_BAR; PG8_MMA(1, 1, At, B1); PG8_BAR;
        }
        PG8_STAMP();
        if constexpr (!Epi::AFTER_DRAIN) { E(acc, cur, wr, wc, fr, fq); S.done(cur); }
        PG8_STAMP();
        if (!has_next) break;
#pragma unroll
        for (int a = 0; a < 2; ++a)
#pragma unroll
            for (int b = 0; b < 2; ++b)
#pragma unroll
                for (int m = 0; m < 4; ++m)
#pragma unroll
                    for (int n = 0; n < 2; ++n) acc[a][b][m][n] = (f32x4){0.f, 0.f, 0.f, 0.f};
        cur = nxt; cA = nA; cB = nB; ++ui;
    }
    PG8_WAIT_V(0);
    if (wr == 0) PG8_BAR;
    PG8_BAR;
    if constexpr (Epi::AFTER_DRAIN) { E.fused(acc, cur, wr, wc, fr, fq, lds, wid, lane); S.done(cur); }
    PG8_STAMP();
    if (STAMP && wid == 0) { stamps[lane] = lane < nts ? (((unsigned long long)(unsigned)ts_hi << 32) | (unsigned)ts_lo) : 0ull;
        if (lane == 62) stamps[62] = rt_entry; if (lane == 63) stamps[63] = (unsigned long long)wall_clock64(); }
#undef PG8_STAMP
#undef PG8_SA
#undef PG8_SB
#undef PG8_STAGE
#undef PG8_LDA
#undef PG8_LDB
#undef PG8_MMA
#undef PG8_WAIT_V
#undef PG8_WAIT_L
#undef PG8_BAR
#undef PG8_SCHED
}
}

#define LAS __attribute__((address_space(3)))
using pg8::bf16_t; using pg8::bf16x8; using pg8::f32x4; using pg8::u32x4; using pg8::cvt_pk_bf16;
typedef unsigned u32x2 __attribute__((ext_vector_type(2)));
typedef float f32x2 __attribute__((ext_vector_type(2)));

constexpr int TP = 16384, TS = 512, TT = 16896, DM = 1024;
constexpr int NHA = 2560, NHB = 3584, DFF = 2816, NUP = 5632;
constexpr float ALPHA = 1.6817928305074292f;
constexpr int LDS_BYTES = 139264;

constexpr size_t WS_WINA = 0;
constexpr size_t WS_WOUTA = WS_WINA + (size_t)2 * NHA * DM * 2;
constexpr size_t WS_WINB = WS_WOUTA + (size_t)2 * DM * DM * 2;
constexpr size_t WS_WOUTB = WS_WINB + (size_t)2 * NHB * DM * 2;
constexpr size_t WS_WKV = WS_WOUTB + (size_t)2 * DM * DM * 2;
constexpr size_t WS_WUP = WS_WKV + (size_t)2048 * DM * 2;
constexpr size_t WS_WDOWN = WS_WUP + (size_t)4 * NUP * DM * 2;
constexpr size_t WS_XF = WS_WDOWN + (size_t)4 * DM * DFF * 2;
constexpr size_t WS_XB = WS_XF + (size_t)TT * DM * 4;
constexpr size_t WS_MEMB = WS_XB + (size_t)TT * DM * 2;
constexpr size_t WS_KB = WS_MEMB + (size_t)2048 * DM * 2;
constexpr size_t WS_VT = WS_KB + (size_t)4 * 8 * 4 * 256 * 64 * 2;
constexpr size_t WS_R = WS_VT + (size_t)4 * 8 * 4 * 256 * 64 * 2;
constexpr size_t WS_H = WS_R;
constexpr size_t WS_CAT = WS_H + (size_t)TT * NHB * 2;
constexpr size_t WS_QKVN = WS_CAT + (size_t)TT * DM * 2;
constexpr size_t WS_GB = WS_QKVN + (size_t)TT * 2304 * 2;
constexpr size_t WS_WC = WS_GB + (size_t)TT * 12 * 4;
constexpr size_t WS_QDC = WS_WC + (size_t)1536 * 16384;
constexpr size_t WS_KDT = WS_QDC + (size_t)1536 * 16384;
constexpr size_t WS_QKC = WS_KDT + (size_t)1536 * 16384;
constexpr size_t WS_UT = WS_QKC + (size_t)1536 * 8192;
constexpr size_t WS_GL = WS_UT + (size_t)1536 * 32768;
constexpr size_t WS_O = WS_GL + (size_t)1536 * 4 + 2048;
constexpr size_t WS_MIX_END = WS_O + (size_t)TT * 768 * 4;
constexpr size_t WS_HU = WS_R;
constexpr size_t WS_GACT = WS_HU + (size_t)TT * NUP * 2;
constexpr size_t WS_FFN_END = WS_GACT + (size_t)TT * DFF * 2;
constexpr size_t WS_END = WS_MIX_END > WS_FFN_END ? WS_MIX_END : WS_FFN_END;

constexpr size_t O_Y = 0;
constexpr size_t O_MK = O_Y + (size_t)TT * DM;
constexpr size_t O_MV = O_MK + (size_t)4 * 8 * 256 * 256;
constexpr size_t O_SCP = O_MV + (size_t)4 * 8 * 256 * 256;
constexpr size_t O_GCP = O_SCP + (size_t)2 * 8 * 2 * 768;
constexpr size_t O_GSP = O_GCP + (size_t)2 * 8 * 3 * 2304;
constexpr size_t O_FFP = O_GSP + (size_t)2 * 8 * 6 * 16384;
constexpr size_t O_SCS = O_FFP + (size_t)4 * 8 * 2 * NUP;
constexpr size_t O_GCS = O_SCS + (size_t)2 * 128 * 2 * 768;
constexpr size_t O_GSS = O_GCS + (size_t)2 * 128 * 3 * 2304;
constexpr size_t O_FFS = O_GSS + (size_t)2 * 128 * 6 * 16384;
constexpr size_t O_END = O_FFS + (size_t)4 * 128 * 2 * NUP;

struct Params { const float* in[26]; float* out; unsigned char* ws; };
__device__ __forceinline__ int otid() { int t = threadIdx.x; asm volatile("" : "+v"(t)); return t; }

__device__ __forceinline__ float bflo(unsigned w) { return __uint_as_float(w << 16); }
__device__ __forceinline__ float bfhi(unsigned w) { return __uint_as_float(w & 0xffff0000u); }
__device__ __forceinline__ float bf1(bf16_t v) { return __uint_as_float((unsigned)v << 16); }
__device__ __forceinline__ float silu_f(float x) { return x / (1.f + __expf(-x)); }
__device__ __forceinline__ float wave_sum(float v) {
#pragma unroll
    for (int o = 1; o < 64; o <<= 1) v += __shfl_xor(v, o);
    return v;
}
__device__ __forceinline__ bf16x8 as_bf16x8(u32x4 v) { union { u32x4 u; bf16x8 b; } x; x.u = v; return x.b; }
__device__ __forceinline__ bf16x8 pack8(f32x4 a, f32x4 b) {
    u32x4 w; w.x = cvt_pk_bf16(a[0], a[1]); w.y = cvt_pk_bf16(a[2], a[3]); w.z = cvt_pk_bf16(b[0], b[1]); w.w = cvt_pk_bf16(b[2], b[3]);
    return as_bf16x8(w);
}
__device__ __forceinline__ int invperm32(int a) { return 8 * ((a & 15) >> 2) + (a & 3) + ((a >> 4) << 2); }
__device__ __forceinline__ int perm32k(int p) { const int g = p >> 3, jj = p & 7; return jj < 4 ? 4 * g + jj : 16 + 4 * g + (jj - 4); }

struct EpiStoreBf16 {
    static constexpr bool PERM = true, AFTER_DRAIN = false;
    bf16_t* O; int ldc;
    __device__ __forceinline__ void operator()(const f32x4 (&acc)[2][2][4][2], const pg8::Unit& u, int wr, int wc, int fr, int fq) const {
        const int row0 = u.pm * 256 + wr * 64 + fr, col0 = u.pn * 256 + wc * 32 + 8 * fq;
#pragma unroll
        for (int ai = 0; ai < 2; ++ai)
#pragma unroll
            for (int m = 0; m < 4; ++m) { bf16_t* rowp = O + (size_t)(row0 + ai * 128 + m * 16) * ldc + col0;
#pragma unroll
                for (int bj = 0; bj < 2; ++bj) { const f32x4 v0 = acc[ai][bj][m][0], v1 = acc[ai][bj][m][1];
                    u32x4 w; w.x = cvt_pk_bf16(v0[0], v0[1]); w.y = cvt_pk_bf16(v0[2], v0[3]); w.z = cvt_pk_bf16(v1[0], v1[1]); w.w = cvt_pk_bf16(v1[2], v1[3]);
                    *(u32x4*)(rowp + bj * 128) = w; } }
    }
};
struct EpiResid {
    static constexpr bool PERM = false, AFTER_DRAIN = false;
    float* X; int ldc;
    __device__ __forceinline__ void operator()(const f32x4 (&acc)[2][2][4][2], const pg8::Unit& u, int wr, int wc, int fr, int fq) const {
        const int row0 = u.pm * 256 + wr * 64 + fr, col0 = u.pn * 256 + wc * 32 + 4 * fq;
#pragma unroll
        for (int ai = 0; ai < 2; ++ai)
#pragma unroll
            for (int m = 0; m < 4; ++m) { float* rowp = X + (size_t)(row0 + ai * 128 + m * 16) * ldc + col0;
#pragma unroll
                for (int bj = 0; bj < 2; ++bj)
#pragma unroll
                    for (int n = 0; n < 2; ++n) { f32x4* p = (f32x4*)(rowp + bj * 128 + n * 16); const f32x4 x = *p; *p = x * ALPHA + acc[ai][bj][m][n]; } }
    }
};
struct EpiKV {
    static constexpr bool PERM = false, AFTER_DRAIN = false;
    float* outK; float* outV; bf16_t* Kb; bf16_t* Vt;
    __device__ __forceinline__ void operator()(const f32x4 (&acc)[2][2][4][2], const pg8::Unit& u, int wr, int wc, int fr, int fq) const {
        const int row0 = u.pm * 256 + wr * 64 + fr, col0 = u.pn * 256 + wc * 32 + 4 * fq;
#pragma unroll
        for (int ai = 0; ai < 2; ++ai)
#pragma unroll
            for (int m = 0; m < 4; ++m) { const int row = row0 + ai * 128 + m * 16; const int b = row >> 8, mm = row & 255;
#pragma unroll
                for (int bj = 0; bj < 2; ++bj)
#pragma unroll
                    for (int n = 0; n < 2; ++n) { const int col = col0 + bj * 128 + n * 16; const int l = col >> 9, e = col & 511; const f32x4 v = acc[ai][bj][m][n];
                        if (e < 256) { *(f32x4*)(outK + ((size_t)((l * 8 + b) * 256 + mm)) * 256 + e) = v;
                            u32x2 w; w.x = cvt_pk_bf16(v[0], v[1]); w.y = cvt_pk_bf16(v[2], v[3]);
                            *(u32x2*)(Kb + ((size_t)(((l * 8 + b) * 4 + (e >> 6)) * 256 + mm)) * 64 + (e & 63)) = w; }
                        else { const int e2 = e - 256; *(f32x4*)(outV + ((size_t)((l * 8 + b) * 256 + mm)) * 256 + e2) = v;
                            const unsigned w0 = cvt_pk_bf16(v[0], v[1]), w1 = cvt_pk_bf16(v[2], v[3]);
                            bf16_t* vp = Vt + ((size_t)(((l * 8 + b) * 4 + (e2 >> 6)) * 64 + (e2 & 63))) * 256 + mm;
                            vp[0] = (bf16_t)(w0 & 0xffffu); vp[256] = (bf16_t)(w0 >> 16); vp[512] = (bf16_t)(w1 & 0xffffu); vp[768] = (bf16_t)(w1 >> 16); } } }
    }
};

template <class Epi>
__device__ __forceinline__ void run_gemm(LAS unsigned char* lds, const bf16_t* A, const bf16_t* Bt, int M, int N, int K, const Epi& E, int c) {
    pg8::Gemm g{A, Bt, M, N, K}; pg8::StaticOrder S; S.init(M, N, (int)gridDim.x, c);
    pg8::gemm_phase<Epi, pg8::StaticOrder, false>(lds, g, S, E, nullptr);
}

__device__ __forceinline__ void p0_transpose_item(const float* W, int K, int Ns, int Nd, bool remap, bf16_t* WT, LAS float* scr, int item, int lane) {
    const int nblk = Nd / 32, kb = item / nblk, nb = item % nblk, k0 = 64 * kb, n0 = 32 * nb;
    const int n = n0 + (lane & 31); int sn = n;
    if (remap) sn = n < 3072 ? n : (n < 3328 ? n + 12 : (n < 3340 ? n - 256 : -1));
#pragma unroll 8
    for (int i = 0; i < 32; ++i) { const int kk = 2 * i + (lane >> 5); scr[kk * 33 + (lane & 31)] = sn >= 0 ? W[(size_t)(k0 + kk) * Ns + sn] : 0.f; }
    asm volatile("s_waitcnt lgkmcnt(0)" ::: "memory");
    const int c = lane & 7;
#pragma unroll
    for (int j = 0; j < 4; ++j) { const int nn = (lane >> 3) + 8 * j; const LAS float* s = scr + (8 * c) * 33 + nn;
        u32x4 o; o.x = cvt_pk_bf16(s[0 * 33], s[1 * 33]); o.y = cvt_pk_bf16(s[2 * 33], s[3 * 33]); o.z = cvt_pk_bf16(s[4 * 33], s[5 * 33]); o.w = cvt_pk_bf16(s[6 * 33], s[7 * 33]);
        *(u32x4*)(WT + (size_t)(n0 + nn) * K + k0 + 8 * c) = o; }
    asm volatile("s_waitcnt lgkmcnt(0)" ::: "memory");
}

__device__ __forceinline__ void phase_prep(const Params& p, LAS unsigned char* lds) {
    const int tid = otid(), lane = tid & 63, wave = __builtin_amdgcn_readfirstlane(tid >> 6);
    const int gw = blockIdx.x * 8 + wave, NGW = gridDim.x * 8;
    LAS float* scr = (LAS float*)(lds + wave * 16384);
    unsigned char* ws = p.ws;
    constexpr int I_INA = 16 * 80, I_OUT = 16 * 32, I_INB = 16 * 112, I_KV = 16 * 16, I_UP = 16 * 176, I_DN = 44 * 32;
    constexpr int NIT = 2 * I_INA + 2 * I_OUT + 2 * I_INB + 2 * I_OUT + 4 * I_KV + 4 * I_UP + 4 * I_DN;
    for (int it = gw; it < NIT; it += NGW) {
        int r = it;
        if (r < 2 * I_INA) { const int l = r / I_INA; r -= l * I_INA; p0_transpose_item(p.in[9] + (size_t)l * DM * NHA, DM, NHA, NHA, false, (bf16_t*)(ws + WS_WINA) + (size_t)l * NHA * DM, scr, r, lane); continue; } r -= 2 * I_INA;
        if (r < 2 * I_OUT) { const int l = r / I_OUT; r -= l * I_OUT; p0_transpose_item(p.in[11] + (size_t)l * DM * DM, DM, DM, DM, false, (bf16_t*)(ws + WS_WOUTA) + (size_t)l * DM * DM, scr, r, lane); continue; } r -= 2 * I_OUT;
        if (r < 2 * I_INB) { const int l = r / I_INB; r -= l * I_INB; p0_transpose_item(p.in[12] + (size_t)l * DM * 3340, DM, 3340, NHB, true, (bf16_t*)(ws + WS_WINB) + (size_t)l * NHB * DM, scr, r, lane); continue; } r -= 2 * I_INB;
        if (r < 2 * I_OUT) { const int l = r / I_OUT; r -= l * I_OUT; p0_transpose_item(p.in[17] + (size_t)l * DM * DM, DM, DM, DM, false, (bf16_t*)(ws + WS_WOUTB) + (size_t)l * DM * DM, scr, r, lane); continue; } r -= 2 * I_OUT;
        if (r < 4 * I_KV) { const int l = r / I_KV; r -= l * I_KV; p0_transpose_item(p.in[18] + (size_t)l * DM * 512, DM, 512, 512, false, (bf16_t*)(ws + WS_WKV) + (size_t)l * 512 * DM, scr, r, lane); continue; } r -= 4 * I_KV;
        if (r < 4 * I_UP) { const int l = r / I_UP; r -= l * I_UP; p0_transpose_item(p.in[23] + (size_t)l * DM * NUP, DM, NUP, NUP, false, (bf16_t*)(ws + WS_WUP) + (size_t)l * NUP * DM, scr, r, lane); continue; } r -= 4 * I_UP;
        { const int l = r / I_DN; r -= l * I_DN; p0_transpose_item(p.in[25] + (size_t)l * DFF * DM, DFF, DM, DM, false, (bf16_t*)(ws + WS_WDOWN) + (size_t)l * DM * DFF, scr, r, lane); }
    }
    const size_t gt = (size_t)blockIdx.x * 512 + tid, NT = (size_t)gridDim.x * 512;
    float* xf = (float*)(ws + WS_XF); bf16_t* xb = (bf16_t*)(ws + WS_XB); bf16_t* memb = (bf16_t*)(ws + WS_MEMB);
    for (size_t i = gt; i < (size_t)TT * 256; i += NT) {
        const f32x4 v = i < (size_t)TP * 256 ? ((const f32x4*)p.in[0])[i] : ((const f32x4*)p.in[1])[i - (size_t)TP * 256];
        ((f32x4*)xf)[i] = v; u32x2 w; w.x = cvt_pk_bf16(v[0], v[1]); w.y = cvt_pk_bf16(v[2], v[3]); ((u32x2*)xb)[i] = w;
    }
    for (size_t i = gt; i < (size_t)2048 * 256; i += NT) {
        const f32x4 v = ((const f32x4*)p.in[2])[i]; u32x2 w; w.x = cvt_pk_bf16(v[0], v[1]); w.y = cvt_pk_bf16(v[2], v[3]); ((u32x2*)memb)[i] = w;
    }
}

__device__ __forceinline__ void phase_ln(float* xf, bf16_t* xb, const float* gam, const float* bet, float* yout) {
    const int tid_ = otid(); const int lane = tid_ & 63, wave = __builtin_amdgcn_readfirstlane(tid_ >> 6);
    const int gw = blockIdx.x * 8 + wave, NGW = gridDim.x * 8;
    f32x4 gg[4], bb[4];
#pragma unroll
    for (int j = 0; j < 4; ++j) { gg[j] = ((const f32x4*)gam)[lane + 64 * j]; bb[j] = ((const f32x4*)bet)[lane + 64 * j]; }
    for (int row = gw; row < TT; row += NGW) {
        f32x4* xr = (f32x4*)(xf + (size_t)row * DM) + lane;
        f32x4 v[4]; float s = 0.f;
#pragma unroll
        for (int j = 0; j < 4; ++j) { v[j] = xr[64 * j]; s += (v[j][0] + v[j][1]) + (v[j][2] + v[j][3]); }
        const float mean = wave_sum(s) * (1.f / DM); float s2 = 0.f;
#pragma unroll
        for (int j = 0; j < 4; ++j) { v[j] = v[j] - mean; s2 += (v[j][0] * v[j][0] + v[j][1] * v[j][1]) + (v[j][2] * v[j][2] + v[j][3] * v[j][3]); }
        const float rstd = 1.f / sqrtf(wave_sum(s2) * (1.f / DM) + 1e-5f);
#pragma unroll
        for (int j = 0; j < 4; ++j) { const f32x4 o = v[j] * rstd * gg[j] + bb[j];
            if (yout) ((f32x4*)(yout + (size_t)row * DM))[lane + 64 * j] = o;
            else { xr[64 * j] = o; u32x2 w; w.x = cvt_pk_bf16(o[0], o[1]); w.y = cvt_pk_bf16(o[2], o[3]); ((u32x2*)(xb + (size_t)row * DM))[lane + 64 * j] = w; } }
    }
}

__device__ __forceinline__ void attn_prompt_item(LAS unsigned char* lds, const bf16_t* h, int ldh, int qoff, const bf16_t* Kb, const bf16_t* Vt, bf16_t* cat, int layer, int item) {
    const int tid = otid(), lane = tid & 63, wave = __builtin_amdgcn_readfirstlane(tid >> 6), c16 = lane & 15, g = lane >> 4;
    const int qc = item & 7, hd = (item >> 3) & 3, b = item >> 5;
    const size_t kvbase = ((size_t)((layer * 8 + b) * 4 + hd)) * 16384;
    constexpr int VOFF = 256 * 144;
#pragma unroll
    for (int i = 0; i < 4; ++i) { const int q = tid + 512 * i;
        const u32x4 kv = *(const u32x4*)(Kb + kvbase + (size_t)q * 8); *(LAS u32x4*)(lds + (q >> 3) * 144 + (q & 7) * 16) = kv;
        const u32x4 vv = *(const u32x4*)(Vt + kvbase + (size_t)q * 8); *(LAS u32x4*)(lds + VOFF + (q >> 5) * 528 + (q & 31) * 16) = vv; }
    __syncthreads();
#pragma unroll 1
    for (int qt = wave; qt < 16; qt += 8) {
        const int row = b * 2048 + qc * 256 + qt * 16 + c16;
        const bf16_t* qp = h + (size_t)row * ldh + qoff + hd * 64 + g * 8;
        const bf16x8 qf0 = *(const bf16x8*)qp, qf1 = *(const bf16x8*)(qp + 32);
        f32x4 acc[16];
#pragma unroll
        for (int kt = 0; kt < 16; ++kt) { acc[kt] = (f32x4){0.f, 0.f, 0.f, 0.f};
            const LAS unsigned char* kp = lds + (16 * kt + c16) * 144 + g * 16;
            const bf16x8 k0 = *(const LAS bf16x8*)kp, k1 = *(const LAS bf16x8*)(kp + 64);
            acc[kt] = __builtin_amdgcn_mfma_f32_16x16x32_bf16(k0, qf0, acc[kt], 0, 0, 0);
            acc[kt] = __builtin_amdgcn_mfma_f32_16x16x32_bf16(k1, qf1, acc[kt], 0, 0, 0); }
        float mx = -3.0e38f;
#pragma unroll
        for (int kt = 0; kt < 16; ++kt) mx = fmaxf(mx, fmaxf(fmaxf(acc[kt][0], acc[kt][1]), fmaxf(acc[kt][2], acc[kt][3])));
        mx = fmaxf(mx, __shfl_xor(mx, 16)); mx = fmaxf(mx, __shfl_xor(mx, 32));
        const float sc = 0.125f * 1.44269504089f; float sum = 0.f;
#pragma unroll
        for (int kt = 0; kt < 16; ++kt)
#pragma unroll
            for (int r = 0; r < 4; ++r) { const float e = __builtin_amdgcn_exp2f((acc[kt][r] - mx) * sc); acc[kt][r] = e; sum += e; }
        sum += __shfl_xor(sum, 16); sum += __shfl_xor(sum, 32);
        const float inv = 1.f / sum;
        f32x4 o[4];
#pragma unroll
        for (int dt = 0; dt < 4; ++dt) o[dt] = (f32x4){0.f, 0.f, 0.f, 0.f};
#pragma unroll
        for (int s = 0; s < 8; ++s) { const bf16x8 pf = pack8(acc[2 * s], acc[2 * s + 1]);
#pragma unroll
            for (int dt = 0; dt < 4; ++dt) { const LAS unsigned char* vp = lds + VOFF + (16 * dt + c16) * 528 + (32 * s + 4 * g) * 2;
                const u32x2 a0 = *(const LAS u32x2*)vp, a1 = *(const LAS u32x2*)(vp + 32);
                u32x4 av; av.x = a0.x; av.y = a0.y; av.z = a1.x; av.w = a1.y;
                o[dt] = __builtin_amdgcn_mfma_f32_16x16x32_bf16(as_bf16x8(av), pf, o[dt], 0, 0, 0); } }
#pragma unroll
        for (int dt = 0; dt < 4; ++dt) { u32x2 w; w.x = cvt_pk_bf16(o[dt][0] * inv, o[dt][1] * inv); w.y = cvt_pk_bf16(o[dt][2] * inv, o[dt][3] * inv);
            *(u32x2*)(cat + (size_t)row * DM + 768 + hd * 64 + 16 * dt + 4 * g) = w; }
    }
    __syncthreads();
}

__device__ __forceinline__ void attn_prompt_item_naive(LAS unsigned char* lds, const bf16_t* h, int ldh, int qoff, const float* outK, const float* outV, bf16_t* cat, int layer, int item) {
    const int tid = otid();
    const int qc = item & 7, hd = (item >> 3) & 3, b = item >> 5;
    LAS float* Ks = (LAS float*)lds; LAS float* Vs = Ks + 256 * 64;
    for (int i = tid; i < 256 * 64; i += 512) { const int m = i >> 6, d = i & 63; const size_t src = ((size_t)((layer * 8 + b) * 256 + m)) * 256 + hd * 64 + d; Ks[i] = outK[src]; Vs[i] = outV[src]; }
    __syncthreads();
    const int ql = tid & 255, half = tid >> 8;
    const int row = b * 2048 + qc * 256 + ql;
    float q[64];
#pragma unroll
    for (int d = 0; d < 64; ++d) q[d] = bf1(h[(size_t)row * ldh + qoff + hd * 64 + d]);
    float mx = -3.0e38f, l = 0.f; float acc[64];
#pragma unroll
    for (int d = 0; d < 64; ++d) acc[d] = 0.f;
#pragma unroll 1
    for (int m = half * 128; m < half * 128 + 128; ++m) {
        float sdot = 0.f;
#pragma unroll
        for (int d = 0; d < 64; ++d) sdot += q[d] * Ks[m * 64 + d];
        sdot *= 0.125f;
        const float nm = fmaxf(mx, sdot); const float corr = __expf(mx - nm), pe = __expf(sdot - nm);
        l = l * corr + pe;
#pragma unroll
        for (int d = 0; d < 64; ++d) acc[d] = acc[d] * corr + pe * Vs[m * 64 + d];
        mx = nm;
    }
    __syncthreads();
    LAS float* ex = (LAS float*)lds;
    if (half == 1) { ex[ql * 66 + 64] = mx; ex[ql * 66 + 65] = l;
#pragma unroll
        for (int d = 0; d < 64; ++d) ex[ql * 66 + d] = acc[d]; }
    __syncthreads();
    if (half == 0) { const float m2 = ex[ql * 66 + 64], l2 = ex[ql * 66 + 65]; const float nm = fmaxf(mx, m2); const float c1 = __expf(mx - nm), c2 = __expf(m2 - nm); const float inv = 1.f / (l * c1 + l2 * c2);
#pragma unroll
        for (int d = 0; d < 64; ++d) { const float o = (acc[d] * c1 + ex[ql * 66 + d] * c2) * inv; cat[(size_t)row * DM + 768 + hd * 64 + d] = (bf16_t)(cvt_pk_bf16(o, 0.f) & 0xffffu); } }
    __syncthreads();
}
__device__ __forceinline__ void attn_sample_item(LAS unsigned char* lds, const bf16_t* h, int ldh, int qoff, const float* ck, const float* cv, bf16_t* cat, int layer, int item) {
    const int tid = otid(), lane = tid & 63, wave = __builtin_amdgcn_readfirstlane(tid >> 6);
    const int hp = item & 1, sb = item >> 1;
    LAS float* qs = (LAS float*)lds;
    LAS float* scs = qs + 512;
    LAS float* red = scs + 2048;
    { const int t = tid >> 7, hh = (tid >> 6) & 1, d = tid & 63;
      qs[tid] = bf1(h[(size_t)(TP + sb * 4 + t) * ldh + qoff + (2 * hp + hh) * 64 + d]); }
    __syncthreads();
    { const int m = tid & 255, hh = tid >> 8;
      const f32x4* kp = (const f32x4*)(ck + (((size_t)(layer * 128 + sb) * 256 + m) * 4 + (2 * hp + hh)) * 64);
      float a0 = 0.f, a1 = 0.f, a2 = 0.f, a3 = 0.f;
#pragma unroll
      for (int i = 0; i < 16; ++i) { const f32x4 kv = kp[i];
#pragma unroll
          for (int e = 0; e < 4; ++e) { const int d = 4 * i + e; a0 += kv[e] * qs[(0 * 2 + hh) * 64 + d]; a1 += kv[e] * qs[(1 * 2 + hh) * 64 + d]; a2 += kv[e] * qs[(2 * 2 + hh) * 64 + d]; a3 += kv[e] * qs[(3 * 2 + hh) * 64 + d]; } }
      scs[(0 * 2 + hh) * 256 + m] = a0 * 0.125f; scs[(1 * 2 + hh) * 256 + m] = a1 * 0.125f; scs[(2 * 2 + hh) * 256 + m] = a2 * 0.125f; scs[(3 * 2 + hh) * 256 + m] = a3 * 0.125f; }
    __syncthreads();
    { LAS float* sp = scs + wave * 256; float v[4]; float mx = -3.0e38f;
#pragma unroll
      for (int i = 0; i < 4; ++i) { v[i] = sp[lane + 64 * i]; mx = fmaxf(mx, v[i]); }
#pragma unroll
      for (int o = 1; o < 64; o <<= 1) mx = fmaxf(mx, __shfl_xor(mx, o));
      float s = 0.f;
#pragma unroll
      for (int i = 0; i < 4; ++i) { v[i] = __expf(v[i] - mx); s += v[i]; }
      s = wave_sum(s); const float inv = 1.f / s;
#pragma unroll
      for (int i = 0; i < 4; ++i) sp[lane + 64 * i] = v[i] * inv; }
    __syncthreads();
    { const int d = tid & 63, hh = (tid >> 6) & 1, mp = tid >> 7;
      float a0 = 0.f, a1 = 0.f, a2 = 0.f, a3 = 0.f;
      const float* vp = cv + (((size_t)(layer * 128 + sb) * 256 + mp * 64) * 4 + (2 * hp + hh)) * 64 + d;
#pragma unroll 8
      for (int m = 0; m < 64; ++m) { const float vv = vp[(size_t)m * 256]; const int mm = mp * 64 + m;
          a0 += scs[(0 * 2 + hh) * 256 + mm] * vv; a1 += scs[(1 * 2 + hh) * 256 + mm] * vv; a2 += scs[(2 * 2 + hh) * 256 + mm] * vv; a3 += scs[(3 * 2 + hh) * 256 + mm] * vv; }
      red[(mp * 8 + 0 * 2 + hh) * 64 + d] = a0; red[(mp * 8 + 1 * 2 + hh) * 64 + d] = a1; red[(mp * 8 + 2 * 2 + hh) * 64 + d] = a2; red[(mp * 8 + 3 * 2 + hh) * 64 + d] = a3; }
    __syncthreads();
    { const int t = tid >> 7, hh = (tid >> 6) & 1, d = tid & 63; const int idx = (t * 2 + hh) * 64 + d;
      const float o = red[idx] + red[512 + idx] + red[1024 + idx] + red[1536 + idx];
      cat[(size_t)(TP + sb * 4 + t) * DM + 768 + (2 * hp + hh) * 64 + d] = (bf16_t)(cvt_pk_bf16(o, 0.f) & 0xffffu); }
    __syncthreads();
}

__device__ __forceinline__ void load_u8(const bf16_t* h, size_t row, int c, float* u) {
    const u32x4 xi = *(const u32x4*)(h + row * NHA + c), cg = *(const u32x4*)(h + row * NHA + 1536 + c);
#pragma unroll
    for (int i = 0; i < 4; ++i) { u[2 * i] = bflo(xi[i]) * bflo(cg[i]); u[2 * i + 1] = bfhi(xi[i]) * bfhi(cg[i]); }
}
__device__ __forceinline__ void phase_mixA_elem(const Params& p, int j) {
    const bf16_t* h = (const bf16_t*)(p.ws + WS_H); bf16_t* cat = (bf16_t*)(p.ws + WS_CAT);
    const float* cw = p.in[10] + (size_t)j * 3 * 768; const float* hist = p.in[5] + (size_t)j * 128 * 2 * 768;
    const size_t gt = (size_t)blockIdx.x * 512 + otid(), NT = (size_t)gridDim.x * 512;
    for (size_t idx = gt; idx < (size_t)TT * 96; idx += NT) {
        const int row = (int)(idx / 96), c = (int)(idx % 96) * 8;
        const bool smp = row >= TP; const int t = smp ? ((row - TP) & 3) : (row & 2047); const int bb = smp ? ((row - TP) >> 2) : (row >> 11);
        float u0[8], u1[8], u2[8];
        load_u8(h, row, c, u2);
        if (t >= 1) load_u8(h, row - 1, c, u1);
        else if (smp) { const f32x4* hp = (const f32x4*)(hist + ((size_t)bb * 2 + 1) * 768 + c); const f32x4 a = hp[0], b2 = hp[1];
#pragma unroll
            for (int i = 0; i < 4; ++i) { u1[i] = a[i]; u1[4 + i] = b2[i]; } }
        else {
#pragma unroll
            for (int i = 0; i < 8; ++i) u1[i] = 0.f; }
        if (t >= 2) load_u8(h, row - 2, c, u0);
        else if (smp) { const f32x4* hp = (const f32x4*)(hist + ((size_t)bb * 2 + t) * 768 + c); const f32x4 a = hp[0], b2 = hp[1];
#pragma unroll
            for (int i = 0; i < 4; ++i) { u0[i] = a[i]; u0[4 + i] = b2[i]; } }
        else {
#pragma unroll
            for (int i = 0; i < 8; ++i) u0[i] = 0.f; }
        const u32x4 bg = *(const u32x4*)(h + (size_t)row * NHA + 768 + c);
        float y[8];
#pragma unroll
        for (int i = 0; i < 8; ++i) { const float w0 = cw[c + i], w1 = cw[768 + c + i], w2 = cw[1536 + c + i];
            const float bgv = (i & 1) ? bfhi(bg[i >> 1]) : bflo(bg[i >> 1]);
            y[i] = bgv * (w0 * u0[i] + w1 * u1[i] + w2 * u2[i]); }
        u32x4 w; w.x = cvt_pk_bf16(y[0], y[1]); w.y = cvt_pk_bf16(y[2], y[3]); w.z = cvt_pk_bf16(y[4], y[5]); w.w = cvt_pk_bf16(y[6], y[7]);
        *(u32x4*)(cat + (size_t)row * DM + c) = w;
        const int T = smp ? 4 : 2048;
        if (t >= T - 2) { float* op = p.out + (smp ? O_SCS : O_SCP) + (((size_t)j * (smp ? 128 : 8) + bb) * 2 + (t - (T - 2))) * 768 + c;
            ((f32x4*)op)[0] = (f32x4){u2[0], u2[1], u2[2], u2[3]}; ((f32x4*)op)[1] = (f32x4){u2[4], u2[5], u2[6], u2[7]}; }
    }
}

__device__ __forceinline__ void load_h8(const bf16_t* hu, size_t row, int c, float* v) {
    const u32x4 x = *(const u32x4*)(hu + row * NUP + c);
#pragma unroll
    for (int i = 0; i < 4; ++i) { v[2 * i] = bflo(x[i]); v[2 * i + 1] = bfhi(x[i]); }
}
__device__ __forceinline__ void load_f8(const float* src, float* v) {
    const f32x4 a = ((const f32x4*)src)[0], b = ((const f32x4*)src)[1];
#pragma unroll
    for (int i = 0; i < 4; ++i) { v[i] = a[i]; v[4 + i] = b[i]; }
}
__device__ __forceinline__ void phase_convgate(const Params& p, int l) {
    const bf16_t* hu = (const bf16_t*)(p.ws + WS_HU); bf16_t* gact = (bf16_t*)(p.ws + WS_GACT);
    const float* cw = p.in[24] + (size_t)l * 3 * NUP; const float* hist = p.in[8] + (size_t)l * 128 * 2 * NUP;
    const size_t gt = (size_t)blockIdx.x * 512 + otid(), NT = (size_t)gridDim.x * 512;
    for (size_t idx = gt; idx < (size_t)TT * 352; idx += NT) {
        const int row = (int)(idx / 352), c = (int)(idx % 352) * 8;
        const bool smp = row >= TP; const int t = smp ? ((row - TP) & 3) : (row & 2047); const int bb = smp ? ((row - TP) >> 2) : (row >> 11);
        float res[2][8];
#pragma unroll
        for (int half = 0; half < 2; ++half) {
            const int cc = c + half * DFF;
            float v0[8], v1[8], v2[8];
            load_h8(hu, row, cc, v2);
            if (t >= 1) load_h8(hu, row - 1, cc, v1);
            else if (smp) load_f8(hist + ((size_t)bb * 2 + 1) * NUP + cc, v1);
            else {
#pragma unroll
                for (int i = 0; i < 8; ++i) v1[i] = 0.f; }
            if (t >= 2) load_h8(hu, row - 2, cc, v0);
            else if (smp) load_f8(hist + ((size_t)bb * 2 + t) * NUP + cc, v0);
            else {
#pragma unroll
                for (int i = 0; i < 8; ++i) v0[i] = 0.f; }
#pragma unroll
            for (int i = 0; i < 8; ++i) res[half][i] = cw[cc + i] * v0[i] + cw[NUP + cc + i] * v1[i] + cw[2 * NUP + cc + i] * v2[i];
        }
        float y[8];
#pragma unroll
        for (int i = 0; i < 8; ++i) y[i] = silu_f(res[0][i]) * res[1][i];
        u32x4 w; w.x = cvt_pk_bf16(y[0], y[1]); w.y = cvt_pk_bf16(y[2], y[3]); w.z = cvt_pk_bf16(y[4], y[5]); w.w = cvt_pk_bf16(y[6], y[7]);
        *(u32x4*)(gact + (size_t)row * DFF + c) = w;
    }
    for (size_t idx = gt; idx < (size_t)(8 + 128) * 2 * (NUP / 8); idx += NT) {
        const int c = (int)(idx % (NUP / 8)) * 8; const int rr = (int)(idx / (NUP / 8)); const int k = rr & 1, bq = rr >> 1;
        const bool smp = bq >= 8; const int bb = smp ? bq - 8 : bq;
        const size_t row = smp ? (size_t)TP + bb * 4 + 2 + k : (size_t)bb * 2048 + 2046 + k;
        float v[8]; load_h8(hu, row, c, v);
        float* op = p.out + (smp ? O_FFS : O_FFP) + (((size_t)l * (smp ? 128 : 8) + bb) * 2 + k) * NUP + c;
        ((f32x4*)op)[0] = (f32x4){v[0], v[1], v[2], v[3]}; ((f32x4*)op)[1] = (f32x4){v[4], v[5], v[6], v[7]};
    }
}

__device__ __forceinline__ void phase_gdn_pre(const Params& p, int j) {
    const bf16_t* h = (const bf16_t*)(p.ws + WS_H); bf16_t* qkvn = (bf16_t*)(p.ws + WS_QKVN); float* gb = (float*)(p.ws + WS_GB);
    const float* cw = p.in[13] + (size_t)j * 4 * 2304; const float* hist = p.in[6] + (size_t)j * 128 * 3 * 2304;
    const int tid_ = otid(); const int lane = tid_ & 63, wave = __builtin_amdgcn_readfirstlane(tid_ >> 6);
    const int gw = blockIdx.x * 8 + wave, NGW = gridDim.x * 8;
    for (int it = gw; it < TT * 6; it += NGW) {
        const int row = it / 6, hd = it % 6;
        const bool smp = row >= TP; const int t = smp ? ((row - TP) & 3) : (row & 2047); const int bb = smp ? ((row - TP) >> 2) : (row >> 11);
        const int T = smp ? 4 : 2048;
        float val[3][2];
#pragma unroll
        for (int sec = 0; sec < 3; ++sec) {
            const int col = sec * 768 + hd * 128 + 2 * lane;
            float a0 = 0.f, a1 = 0.f;
#pragma unroll
            for (int k = 0; k < 4; ++k) { const int tt = t - 3 + k; float x0, x1;
                if (tt >= 0) { const unsigned w = *(const unsigned*)(h + (size_t)(row - 3 + k) * NHB + col); x0 = bflo(w); x1 = bfhi(w); }
                else if (smp) { const f32x2 hv = *(const f32x2*)(hist + ((size_t)bb * 3 + (tt + 3)) * 2304 + col); x0 = hv[0]; x1 = hv[1]; }
                else { x0 = 0.f; x1 = 0.f; }
                const f32x2 wv = *(const f32x2*)(cw + (size_t)k * 2304 + col);
                a0 += wv[0] * x0; a1 += wv[1] * x1;
                if (k == 3 && t >= T - 3) { float* op = p.out + (smp ? O_GCS : O_GCP) + (((size_t)j * (smp ? 128 : 8) + bb) * 3 + (t - (T - 3))) * 2304 + col; *(f32x2*)op = (f32x2){x0, x1}; }
            }
            val[sec][0] = silu_f(a0); val[sec][1] = silu_f(a1);
        }
#pragma unroll
        for (int sec = 0; sec < 2; ++sec) { const float ss = wave_sum(val[sec][0] * val[sec][0] + val[sec][1] * val[sec][1]); const float r = 1.f / sqrtf(ss + 1e-6f); val[sec][0] *= r; val[sec][1] *= r; }
#pragma unroll
        for (int sec = 0; sec < 3; ++sec) *(unsigned*)(qkvn + (size_t)row * 2304 + sec * 768 + hd * 128 + 2 * lane) = cvt_pk_bf16(val[sec][0], val[sec][1]);
        if (lane == 0) {
            const float bv = bf1(h[(size_t)row * NHB + 3328 + hd]), av = bf1(h[(size_t)row * NHB + 3334 + hd]);
            const float x = av + p.in[15][j * 6 + hd];
            const float sp = fmaxf(x, 0.f) + log1pf(__expf(-fabsf(x)));
            gb[(size_t)row * 12 + hd] = -__expf(p.in[14][j * 6 + hd]) * sp;
            gb[(size_t)row * 12 + 6 + hd] = 1.f / (1.f + __expf(-bv));
        }
    }
}

__device__ __forceinline__ void solve_lds(LAS float* sol, const LAS float* A, int lane) {
#pragma unroll 1
    for (int i = 1; i < 64; ++i) {
        float r0 = sol[i * 64 + lane], r1 = 0.f;
        const int n4 = (i + 3) >> 2;
#pragma unroll 2
        for (int j4 = 0; j4 < n4; ++j4) {
            const f32x4 a = *(const LAS f32x4*)(A + i * 64 + 4 * j4);
            const LAS float* sp = sol + (4 * j4) * 64 + lane;
            r0 -= a[0] * sp[0]; r1 -= a[1] * sp[64]; r0 -= a[2] * sp[128]; r1 -= a[3] * sp[192];
        }
        sol[i * 64 + lane] = r0 + r1;
    }
}
__device__ __forceinline__ void phase_gdn_prep(const Params& p, LAS unsigned char* lds) {
    const bf16_t* qkvn = (const bf16_t*)(p.ws + WS_QKVN); const float* gb = (const float*)(p.ws + WS_GB);
    bf16_t* Wc = (bf16_t*)(p.ws + WS_WC); bf16_t* QDc = (bf16_t*)(p.ws + WS_QDC); bf16_t* KDT = (bf16_t*)(p.ws + WS_KDT); bf16_t* QKc = (bf16_t*)(p.ws + WS_QKC);
    float* UT = (float*)(p.ws + WS_UT); float* GL = (float*)(p.ws + WS_GL);
    const int tid_ = otid(); const int lane0 = tid_ & 63, wave = __builtin_amdgcn_readfirstlane(tid_ >> 6);
    if (wave >= 4) return;
    const int gw = blockIdx.x * 4 + wave, NGW = gridDim.x * 4;
#pragma unroll 1
    for (int ci = gw; ci < 1536; ci += NGW) {
        int lane = lane0; unsigned aoff = (unsigned)wave * 32768u;
        asm volatile("" : "+v"(lane), "+v"(aoff));
        const int c16 = lane & 15, g = lane >> 4;
        LAS float* A = (LAS float*)(lds + aoff);
        const int n = ci & 31, hd = (ci >> 5) % 6, b = ci / 192;
        const int tok0 = b * 2048 + n * 64;
        const float gi = gb[(size_t)(tok0 + lane) * 12 + hd], beta = gb[(size_t)(tok0 + lane) * 12 + 6 + hd];
        float gc = gi;
#pragma unroll
        for (int o = 1; o < 64; o <<= 1) { const float tv = __shfl_up(gc, o); if (lane >= o) gc += tv; }
        const float gl = __shfl(gc, 63);
        const float egc = __expf(gc), edl = __expf(gl - gc);
        if (lane == 0) GL[ci] = __expf(gl);
        {
            bf16x8 kf[4][4];
#pragma unroll
            for (int t = 0; t < 4; ++t)
#pragma unroll
                for (int ks = 0; ks < 4; ++ks) kf[t][ks] = *(const bf16x8*)(qkvn + (size_t)(tok0 + 16 * t + c16) * 2304 + 768 + hd * 128 + 32 * ks + 8 * g);
#pragma unroll
            for (int it = 0; it < 4; ++it)
#pragma unroll
                for (int jt = 0; jt <= it; ++jt) {
                    f32x4 acc = (f32x4){0.f, 0.f, 0.f, 0.f};
#pragma unroll
                    for (int ks = 0; ks < 4; ++ks) acc = __builtin_amdgcn_mfma_f32_16x16x32_bf16(kf[it][ks], kf[jt][ks], acc, 0, 0, 0);
                    const int jj = 16 * jt + c16; const float gcj = __shfl(gc, jj);
#pragma unroll
                    for (int r = 0; r < 4; ++r) { const int ii = 16 * it + 4 * g + r; const float gci = __shfl(gc, ii), bi = __shfl(beta, ii);
                        A[ii * 64 + jj] = ii > jj ? bi * acc[r] * __expf(gci - gcj) : 0.f; }
                }
#pragma unroll
            for (int it = 0; it < 4; ++it) {
                bf16x8 qf[4];
#pragma unroll
                for (int ks = 0; ks < 4; ++ks) qf[ks] = *(const bf16x8*)(qkvn + (size_t)(tok0 + 16 * it + c16) * 2304 + hd * 128 + 32 * ks + 8 * g);
#pragma unroll
                for (int jt = 0; jt < 4; ++jt) {
                    f32x4 acc = (f32x4){0.f, 0.f, 0.f, 0.f};
                    if (jt <= it) {
#pragma unroll
                        for (int ks = 0; ks < 4; ++ks) acc = __builtin_amdgcn_mfma_f32_16x16x32_bf16(qf[ks], kf[jt][ks], acc, 0, 0, 0);
                    }
                    const int jj = 16 * jt + c16; const float gcj = __shfl(gc, jj);
                    const int pos = (jj & 32) + invperm32(jj & 31);
#pragma unroll
                    for (int r = 0; r < 4; ++r) { const int ii = 16 * it + 4 * g + r; const float gci = __shfl(gc, ii);
                        const float v = ii >= jj ? acc[r] * 0.08838834764831845f * __expf(gci - gcj) : 0.f;
                        QKc[(size_t)ci * 4096 + ii * 64 + pos] = (bf16_t)(cvt_pk_bf16(v, 0.f) & 0xffffu); }
                }
            }
        }
        asm volatile("s_waitcnt lgkmcnt(0)" ::: "memory");
        LAS float* sol = A + 4096;
#pragma unroll 1
        for (int pass = 0; pass < 4; ++pass) {
            const int half = pass & 1, isw = pass >> 1;
            const int c = lane + 64 * half; const int posc = (c & ~31) + invperm32(c & 31);
            const bf16_t* src = qkvn + (size_t)tok0 * 2304 + (isw ? 768 : 1536) + hd * 128 + c;
#pragma unroll 8
            for (int i = 0; i < 64; ++i) { float f = __shfl(beta, i); if (isw) f *= __shfl(egc, i); sol[i * 64 + lane] = bf1(src[(size_t)i * 2304]) * f; }
            asm volatile("s_waitcnt lgkmcnt(0)" ::: "memory");
            solve_lds(sol, A, lane);
            asm volatile("s_waitcnt lgkmcnt(0)" ::: "memory");
            if (!isw) { float* up = UT + (size_t)ci * 8192 + (size_t)c * 64;
#pragma unroll 4
                for (int i = 0; i < 64; i += 4) *(f32x4*)(up + i) = (f32x4){sol[i * 64 + lane], sol[(i + 1) * 64 + lane], sol[(i + 2) * 64 + lane], sol[(i + 3) * 64 + lane]}; }
            else {
#pragma unroll 8
                for (int i = 0; i < 64; ++i) Wc[(size_t)ci * 8192 + i * 128 + posc] = (bf16_t)(cvt_pk_bf16(sol[i * 64 + lane], 0.f) & 0xffffu); }
            asm volatile("s_waitcnt lgkmcnt(0)" ::: "memory");
        }
        const int c0 = 2 * lane; const int pos0 = (c0 & ~31) + invperm32(c0 & 31);
#pragma unroll 8
        for (int i = 0; i < 64; ++i) { const unsigned w = *(const unsigned*)(qkvn + (size_t)(tok0 + i) * 2304 + hd * 128 + 2 * lane);
            const float s = __shfl(egc, i) * 0.08838834764831845f;
            *(unsigned*)(QDc + (size_t)ci * 8192 + i * 128 + pos0) = cvt_pk_bf16(bflo(w) * s, bfhi(w) * s); }
        asm volatile("s_waitcnt lgkmcnt(0)" ::: "memory");
        {
            LAS bf16_t* kt = (LAS bf16_t*)A;
#pragma unroll 8
            for (int i = 0; i < 64; ++i) { const unsigned w = *(const unsigned*)(qkvn + (size_t)(tok0 + i) * 2304 + 768 + hd * 128 + 2 * lane);
                *(LAS unsigned*)(kt + i * 128 + 2 * lane) = w; }
            asm volatile("s_waitcnt lgkmcnt(0)" ::: "memory");
#pragma unroll
            for (int hh = 0; hh < 2; ++hh) { const int dk = lane + 64 * hh;
#pragma unroll
                for (int p8 = 0; p8 < 8; ++p8) { float v[8];
#pragma unroll
                    for (int e = 0; e < 8; ++e) { const int pp = p8 * 8 + e; const int c = (pp & 32) + perm32k(pp & 31);
                        v[e] = bf1(kt[c * 128 + dk]) * __builtin_amdgcn_readlane(edl, c); }
                    u32x4 w; w.x = cvt_pk_bf16(v[0], v[1]); w.y = cvt_pk_bf16(v[2], v[3]); w.z = cvt_pk_bf16(v[4], v[5]); w.w = cvt_pk_bf16(v[6], v[7]);
                    *(u32x4*)(KDT + (size_t)ci * 8192 + dk * 64 + p8 * 8) = w; } }
            asm volatile("s_waitcnt lgkmcnt(0)" ::: "memory");
        }
    }
}

constexpr int RB_W = 0, RB_QD = 17408, RB_KD = 34816, RB_QK = 34816 + 18432, RB_SZ = 62464;
__device__ __forceinline__ void rec_load(u32x4 (&r)[7], const bf16_t* Wc, const bf16_t* QDc, const bf16_t* KDT, const bf16_t* QKc, int ci, int tid) {
    r[0] = *(const u32x4*)(Wc + (size_t)ci * 8192 + (size_t)tid * 8); r[1] = *(const u32x4*)(Wc + (size_t)ci * 8192 + (size_t)(512 + tid) * 8);
    r[2] = *(const u32x4*)(QDc + (size_t)ci * 8192 + (size_t)tid * 8); r[3] = *(const u32x4*)(QDc + (size_t)ci * 8192 + (size_t)(512 + tid) * 8);
    r[4] = *(const u32x4*)(KDT + (size_t)ci * 8192 + (size_t)tid * 8); r[5] = *(const u32x4*)(KDT + (size_t)ci * 8192 + (size_t)(512 + tid) * 8);
    r[6] = *(const u32x4*)(QKc + (size_t)ci * 4096 + (size_t)tid * 8);
}
__device__ __forceinline__ void rec_store(const u32x4 (&r)[7], LAS unsigned char* buf, int tid) {
#pragma unroll
    for (int k = 0; k < 2; ++k) { const int q = tid + 512 * k;
        *(LAS u32x4*)(buf + RB_W + (q >> 4) * 272 + (q & 15) * 16) = r[k];
        *(LAS u32x4*)(buf + RB_QD + (q >> 4) * 272 + (q & 15) * 16) = r[2 + k];
        *(LAS u32x4*)(buf + RB_KD + (q >> 3) * 144 + (q & 7) * 16) = r[4 + k]; }
    *(LAS u32x4*)(buf + RB_QK + (tid >> 3) * 144 + (tid & 7) * 16) = r[6];
}
__device__ __forceinline__ void gdn_recur_prompt(const Params& p, LAS unsigned char* lds, int j, int bh) {
    const bf16_t* Wc = (const bf16_t*)(p.ws + WS_WC); const bf16_t* QDc = (const bf16_t*)(p.ws + WS_QDC); const bf16_t* KDT = (const bf16_t*)(p.ws + WS_KDT); const bf16_t* QKc = (const bf16_t*)(p.ws + WS_QKC);
    const float* UT = (const float*)(p.ws + WS_UT); const float* GL = (const float*)(p.ws + WS_GL); float* ob = (float*)(p.ws + WS_O);
    const int tid = otid(), lane = tid & 63, wave = __builtin_amdgcn_readfirstlane(tid >> 6), c16 = lane & 15, g = lane >> 4;
    const int b = bh / 6, hd = bh % 6, dv0 = wave * 16;
    f32x4 S[8];
#pragma unroll
    for (int i = 0; i < 8; ++i) S[i] = (f32x4){0.f, 0.f, 0.f, 0.f};
    u32x4 rg[7];
    rec_load(rg, Wc, QDc, KDT, QKc, bh * 32, tid);
    rec_store(rg, lds, tid);
    __syncthreads();
#pragma unroll 1
    for (int n = 0; n < 32; ++n) {
        const int ci = bh * 32 + n;
        LAS unsigned char* buf = lds + (n & 1) * RB_SZ;
        if (n + 1 < 32) rec_load(rg, Wc, QDc, KDT, QKc, ci + 1, tid);
        f32x4 u[4];
#pragma unroll
        for (int ct = 0; ct < 4; ++ct) u[ct] = *(const f32x4*)(UT + (size_t)ci * 8192 + (size_t)(dv0 + c16) * 64 + 16 * ct + 4 * g);
        const float egl = GL[ci];
        bf16x8 bS[4];
#pragma unroll
        for (int ks = 0; ks < 4; ++ks) bS[ks] = pack8(S[2 * ks], S[2 * ks + 1]);
        f32x4 vn[4], o[4];
#pragma unroll
        for (int ct = 0; ct < 4; ++ct) {
            f32x4 ws = (f32x4){0.f, 0.f, 0.f, 0.f}, oo = (f32x4){0.f, 0.f, 0.f, 0.f};
#pragma unroll
            for (int ks = 0; ks < 4; ++ks) {
                const bf16x8 wf = *(const LAS bf16x8*)(buf + RB_W + (16 * ct + c16) * 272 + ks * 64 + g * 16);
                const bf16x8 qf = *(const LAS bf16x8*)(buf + RB_QD + (16 * ct + c16) * 272 + ks * 64 + g * 16);
                ws = __builtin_amdgcn_mfma_f32_16x16x32_bf16(wf, bS[ks], ws, 0, 0, 0);
                oo = __builtin_amdgcn_mfma_f32_16x16x32_bf16(qf, bS[ks], oo, 0, 0, 0);
            }
            vn[ct] = u[ct] - ws; o[ct] = oo;
        }
        bf16x8 bV[2];
#pragma unroll
        for (int k2 = 0; k2 < 2; ++k2) bV[k2] = pack8(vn[2 * k2], vn[2 * k2 + 1]);
#pragma unroll
        for (int ct = 0; ct < 4; ++ct) {
#pragma unroll
            for (int k2 = 0; k2 < 2; ++k2) { const bf16x8 af = *(const LAS bf16x8*)(buf + RB_QK + (16 * ct + c16) * 144 + k2 * 64 + g * 16);
                o[ct] = __builtin_amdgcn_mfma_f32_16x16x32_bf16(af, bV[k2], o[ct], 0, 0, 0); }
#pragma unroll
            for (int r = 0; r < 4; ++r) ob[(size_t)(b * 2048 + n * 64 + 16 * ct + 4 * g + r) * 768 + hd * 128 + dv0 + c16] = o[ct][r];
        }
#pragma unroll
        for (int dt = 0; dt < 8; ++dt) { f32x4 s = S[dt] * egl;
#pragma unroll
            for (int k2 = 0; k2 < 2; ++k2) { const bf16x8 af = *(const LAS bf16x8*)(buf + RB_KD + (16 * dt + c16) * 144 + k2 * 64 + g * 16);
                s = __builtin_amdgcn_mfma_f32_16x16x32_bf16(af, bV[k2], s, 0, 0, 0); }
            S[dt] = s; }
        if (n + 1 < 32) rec_store(rg, lds + ((n + 1) & 1) * RB_SZ, tid);
        __syncthreads();
    }
    float* so = p.out + O_GSP + ((size_t)(j * 8 + b) * 6 + hd) * 16384;
#pragma unroll
    for (int dt = 0; dt < 8; ++dt)
#pragma unroll
        for (int r = 0; r < 4; ++r) so[(size_t)(16 * dt + 4 * g + r) * 128 + dv0 + c16] = S[dt][r];
}
__device__ __forceinline__ void gdn_naive_item(const Params& p, LAS unsigned char* lds, int row0, int T, int hd, const float* s0, float* sout) {
    const bf16_t* qkvn = (const bf16_t*)(p.ws + WS_QKVN); const float* gb = (const float*)(p.ws + WS_GB); float* ob = (float*)(p.ws + WS_O);
    const int tid = otid(), e = tid & 127, part = tid >> 7;
    LAS float* kq = (LAS float*)lds;
    LAS float* red = kq + 1024;
    LAS float* red2 = red + 512;
    float S[32];
#pragma unroll
    for (int i = 0; i < 32; ++i) S[i] = s0 ? s0[(size_t)(part * 32 + i) * 128 + e] : 0.f;
#pragma unroll 1
    for (int tb = 0; tb < T; tb += 4) {
        __syncthreads();
        for (int i = tid; i < 1024; i += 512) { const int t = i >> 8, s = (i >> 7) & 1, d = i & 127;
            kq[i] = bf1(qkvn[(size_t)(row0 + tb + t) * 2304 + (s == 0 ? 768 : 0) + hd * 128 + d]); }
        __syncthreads();
#pragma unroll 1
        for (int t = 0; t < 4; ++t) {
            const int row = row0 + tb + t;
            const float a = __expf(gb[(size_t)row * 12 + hd]), bt = gb[(size_t)row * 12 + 6 + hd];
            const float v = bf1(qkvn[(size_t)row * 2304 + 1536 + hd * 128 + e]);
            float ps = 0.f;
#pragma unroll
            for (int i = 0; i < 32; ++i) ps += S[i] * kq[(t * 2 + 0) * 128 + part * 32 + i];
            red[part * 128 + e] = ps;
            __syncthreads();
            const float kS = red[e] + red[128 + e] + red[256 + e] + red[384 + e];
            const float vnew = bt * (v - a * kS);
            float po = 0.f;
#pragma unroll
            for (int i = 0; i < 32; ++i) { S[i] = a * S[i] + kq[(t * 2 + 0) * 128 + part * 32 + i] * vnew; po += S[i] * kq[(t * 2 + 1) * 128 + part * 32 + i]; }
            red2[part * 128 + e] = po;
            __syncthreads();
            if (part == 0) ob[(size_t)row * 768 + hd * 128 + e] = (red2[e] + red2[128 + e] + red2[256 + e] + red2[384 + e]) * 0.08838834764831845f;
        }
    }
#pragma unroll
    for (int i = 0; i < 32; ++i) sout[(size_t)(part * 32 + i) * 128 + e] = S[i];
    __syncthreads();
}
__device__ __forceinline__ void gdn_sample_item(const Params& p, LAS unsigned char* lds, int j, int item) {
    const int sb = item / 6, hd = item % 6;
    gdn_naive_item(p, lds, TP + sb * 4, 4, hd, p.in[7] + ((size_t)(j * 128 + sb) * 6 + hd) * 16384, p.out + O_GSS + ((size_t)(j * 128 + sb) * 6 + hd) * 16384);
}
__device__ __forceinline__ void phase_gdn_post(const Params& p, int j) {
    const bf16_t* h = (const bf16_t*)(p.ws + WS_H); const float* ob = (const float*)(p.ws + WS_O); bf16_t* cat = (bf16_t*)(p.ws + WS_CAT);
    const int tid_ = otid(); const int lane = tid_ & 63, wave = __builtin_amdgcn_readfirstlane(tid_ >> 6);
    const int gw = blockIdx.x * 8 + wave, NGW = gridDim.x * 8;
    const f32x2 nw = *(const f32x2*)(p.in[16] + j * 128 + 2 * lane);
    for (int it = gw; it < TT * 6; it += NGW) {
        const int row = it / 6, hd = it % 6;
        const f32x2 o = *(const f32x2*)(ob + (size_t)row * 768 + hd * 128 + 2 * lane);
        const float ss = wave_sum(o[0] * o[0] + o[1] * o[1]);
        const float r = 1.f / sqrtf(ss * (1.f / 128.f) + 1e-6f);
        const unsigned zw = *(const unsigned*)(h + (size_t)row * NHB + 2304 + hd * 128 + 2 * lane);
        const float y0 = o[0] * r * nw[0] * silu_f(bflo(zw)), y1 = o[1] * r * nw[1] * silu_f(bfhi(zw));
        *(unsigned*)(cat + (size_t)row * DM + hd * 128 + 2 * lane) = cvt_pk_bf16(y0, y1);
    }
}

__global__ void __launch_bounds__(512, 2) fwd_megakernel(Params p) {
    extern __shared__ __attribute__((aligned(16))) unsigned char lds_raw[];
    LAS unsigned char* lds = (LAS unsigned char*)lds_raw;
    cg::grid_group grid = cg::this_grid();
    unsigned char* ws = p.ws;
    float* xf = (float*)(ws + WS_XF); bf16_t* xb = (bf16_t*)(ws + WS_XB);
    bf16_t* hbuf = (bf16_t*)(ws + WS_H); bf16_t* cat = (bf16_t*)(ws + WS_CAT);
    bf16_t* hu = (bf16_t*)(ws + WS_HU); bf16_t* gact = (bf16_t*)(ws + WS_GACT);
    const bf16_t* Kb = (const bf16_t*)(ws + WS_KB); const bf16_t* Vt = (const bf16_t*)(ws + WS_VT);
    const int bid = blockIdx.x, G = gridDim.x;

    phase_prep(p, lds);
    grid.sync();
    {
        EpiKV E{p.out + O_MK, p.out + O_MV, (bf16_t*)(ws + WS_KB), (bf16_t*)(ws + WS_VT)};
        run_gemm(lds, (const bf16_t*)(ws + WS_MEMB), (const bf16_t*)(ws + WS_WKV), 2048, 2048, DM, E, (bid + 64) % G);
    }
#pragma unroll 1
    for (int l = 0; l < 4; ++l) {
        const int j = l >> 1; const bool isB = (l & 1) != 0;
        if (!isB) {
            { EpiStoreBf16 E{hbuf, NHA}; run_gemm(lds, xb, (const bf16_t*)(ws + WS_WINA) + (size_t)j * NHA * DM, TT, NHA, DM, E, bid); }
            grid.sync();
            phase_mixA_elem(p, j);
#ifdef NAIVE_ATTN
            for (int it = bid; it < 256; it += G) attn_prompt_item_naive(lds, hbuf, NHA, 2304, p.out + O_MK, p.out + O_MV, cat, l, it);
#else
            for (int it = bid; it < 256; it += G) attn_prompt_item(lds, hbuf, NHA, 2304, Kb, Vt, cat, l, it);
#endif
            for (int it = bid; it < 256; it += G) attn_sample_item(lds, hbuf, NHA, 2304, p.in[3], p.in[4], cat, l, it);
            grid.sync();
            { EpiResid E{xf, DM}; run_gemm(lds, cat, (const bf16_t*)(ws + WS_WOUTA) + (size_t)j * DM * DM, TT, DM, DM, E, bid); }
        } else {
            { EpiStoreBf16 E{hbuf, NHB}; run_gemm(lds, xb, (const bf16_t*)(ws + WS_WINB) + (size_t)j * NHB * DM, TT, NHB, DM, E, bid); }
            grid.sync();
            phase_gdn_pre(p, j);
            grid.sync();
#ifndef NAIVE_GDN
            phase_gdn_prep(p, lds);
            grid.sync();
#endif
#ifdef NAIVE_GDN
            if (bid < 48) gdn_naive_item(p, lds, (bid / 6) * 2048, 2048, bid % 6, nullptr, p.out + O_GSP + ((size_t)(j * 8 + bid / 6) * 6 + bid % 6) * 16384);
#else
            if (bid < 48) gdn_recur_prompt(p, lds, j, bid);
#endif
            else {
                const int nb = G - 48;
                for (int it = bid - 48; it < 768; it += nb) gdn_sample_item(p, lds, j, it);
#ifdef NAIVE_ATTN
                for (int it = bid - 48; it < 256; it += nb) attn_prompt_item_naive(lds, hbuf, NHB, 3072, p.out + O_MK, p.out + O_MV, cat, l, it);
#else
                for (int it = bid - 48; it < 256; it += nb) attn_prompt_item(lds, hbuf, NHB, 3072, Kb, Vt, cat, l, it);
#endif
                for (int it = bid - 48; it < 256; it += nb) attn_sample_item(lds, hbuf, NHB, 3072, p.in[3], p.in[4], cat, l, it);
            }
            grid.sync();
            phase_gdn_post(p, j);
            grid.sync();
            { EpiResid E{xf, DM}; run_gemm(lds, cat, (const bf16_t*)(ws + WS_WOUTB) + (size_t)j * DM * DM, TT, DM, DM, E, bid); }
        }
        grid.sync();
        phase_ln(xf, xb, p.in[19] + l * DM, p.in[20] + l * DM, nullptr);
        grid.sync();
        { EpiStoreBf16 E{hu, NUP}; run_gemm(lds, xb, (const bf16_t*)(ws + WS_WUP) + (size_t)l * NUP * DM, TT, NUP, DM, E, bid); }
        grid.sync();
        phase_convgate(p, l);
        grid.sync();
        { EpiResid E{xf, DM}; run_gemm(lds, gact, (const bf16_t*)(ws + WS_WDOWN) + (size_t)l * DM * DFF, TT, DM, DFF, E, bid); }
        grid.sync();
        phase_ln(xf, xb, p.in[21] + l * DM, p.in[22] + l * DM, l == 3 ? p.out + O_Y : nullptr);
        if (l < 3) grid.sync();
    }
}

extern "C" void kernel_launch(void* const* d_in, const int* in_sizes, int n_in, void* d_out, int out_size, void* d_ws, size_t ws_size, hipStream_t stream) {
    static int grid_blocks = 0;
    if (grid_blocks == 0) {
        if (n_in != 26 || (size_t)out_size != O_END || ws_size < WS_END) { fprintf(stderr, "kernel_launch: unexpected shapes n_in %d out %d (want %zu) ws %zu (need %zu)\n", n_in, out_size, (size_t)O_END, ws_size, (size_t)WS_END); grid_blocks = -1; return; }
        int dev = 0, cus = 0, per_cu = 0;
        hipGetDevice(&dev);
        hipDeviceGetAttribute(&cus, hipDeviceAttributeMultiprocessorCount, dev);
        if (hipFuncSetAttribute((const void*)fwd_megakernel, hipFuncAttributeMaxDynamicSharedMemorySize, LDS_BYTES) != hipSuccess) { fprintf(stderr, "kernel_launch: hipFuncSetAttribute failed\n"); grid_blocks = -1; return; }
        hipOccupancyMaxActiveBlocksPerMultiprocessor(&per_cu, (const void*)fwd_megakernel, 512, LDS_BYTES);
        if (per_cu < 1) { fprintf(stderr, "kernel_launch: occupancy query says %d blocks/CU\n", per_cu); grid_blocks = -1; return; }
        grid_blocks = cus;
        if (grid_blocks > 256) grid_blocks = 256;
    }
    if (grid_blocks < 0) return;
    Params p{};
    for (int i = 0; i < 26; ++i) p.in[i] = (const float*)d_in[i];
    p.out = (float*)d_out; p.ws = (unsigned char*)d_ws;
    void* args[] = {&p};
    hipError_t e = hipLaunchCooperativeKernel((const void*)fwd_megakernel, dim3(grid_blocks), dim3(512), args, LDS_BYTES, stream);
    if (e != hipSuccess) fprintf(stderr, "cooperative launch failed: %s (grid %d)\n", hipGetErrorString(e), grid_blocks);
}
```

```cpp
#include <hip/hip_runtime.h>
#include <hip/hip_cooperative_groups.h>
#include <cstdio>
namespace cg = cooperative_groups;
#define NAIVE_GDN 1
namespace pg8 {
#define PG8_LAS __attribute__((address_space(3)))
typedef unsigned short bf16_t;
typedef short bf16x8 __attribute__((ext_vector_type(8)));
typedef float f32x4 __attribute__((ext_vector_type(4)));
typedef unsigned u32x4 __attribute__((ext_vector_type(4)));
constexpr int BM = 256, BK = 64, HALF = 128, HTB = HALF * BK * 2  , STAGE_BYTES = 8 * HTB, NXCD = 8, WGM = 8;

__host__ __device__ __forceinline__ int lds_byte(int r, int c) { const int st = (r >> 4) * 2 + (c >> 5), rr = r & 15, cc = c & 31, ob = rr * 64 + cc * 2; return st * 1024 + (ob ^ (((ob >> 9) & 1) << 5)); }
__host__ __device__ __forceinline__ void stage_rc(int b, int& R, int& C) { const int st = b / 1024, sb = b % 1024, swz = sb ^ (((sb >> 9) & 1) << 5); R = (st >> 1) * 16 + swz / 64; C = (st & 1) * 32 + (swz % 64) / 2; }
__host__ __device__ __forceinline__ int perm32(int rho) { const int n = rho >> 4, i = rho & 15; return 8 * (i >> 2) + 4 * n + (i & 3); }

struct Unit { int pm, pn; };
struct Gemm { const bf16_t* A; const bf16_t* Bt; int M, N, K; };

struct StaticOrder {
    int nM, nN, nwg, G, c;
    __host__ __device__ void init(int M, int N, int G_, int c_) { nM = M / BM; nN = N / BM; nwg = nM * nN; G = G_; c = c_; }
    __host__ __device__ bool next(int i, Unit& u) const {
        const long L = (long)i * G + c; if (L >= nwg) return false;
        int wgid = (int)L; { const int q = nwg / NXCD, r = nwg % NXCD, xcd = wgid % NXCD, off = wgid / NXCD; wgid = (xcd < r ? xcd * (q + 1) : r * (q + 1) + (xcd - r) * q) + off; }
        const int nig = WGM * nN, gid = wgid / nig, fm = gid * WGM, gsz = (nM - fm) < WGM ? (nM - fm) : WGM;
        u.pm = fm + ((wgid % nig) % gsz); u.pn = (wgid % nig) / gsz; return true;
    }
    __device__ __forceinline__ void a_ready(const Unit&) const {}
    __device__ __forceinline__ void done(const Unit&) const {}
};
__device__ __forceinline__ unsigned cvt_pk_bf16(float lo, float hi) { unsigned r; asm volatile("v_cvt_pk_bf16_f32 %0, %1, %2" : "=v"(r) : "v"(lo), "v"(hi)); return r; }
typedef float f32x2 __attribute__((ext_vector_type(2)));
template <class Epi, class Sched, bool STAMP = false>
__device__ __forceinline__ void gemm_phase(PG8_LAS unsigned char* lds, const Gemm g, const Sched& S, const Epi& E, unsigned long long* stamps) {
    int tid = threadIdx.x; asm volatile("" : "+v"(tid)); const int wid = __builtin_amdgcn_readfirstlane(tid >> 6), lane = tid & 63, wr = wid >> 2, wc = wid & 3, fr = lane & 15, fq = lane >> 4;
    const int K = g.K, nt = K / BK;
    int ts_lo = 0, ts_hi = 0, nts = 0; const unsigned long long rt_entry = STAMP ? (unsigned long long)wall_clock64() : 0ull;
#define PG8_STAMP() do { if (STAMP && wid == 0 && nts < 64) { const unsigned long long _c = (unsigned long long)clock64(); \
        ts_lo = (lane == nts) ? (int)(unsigned)_c : ts_lo; ts_hi = (lane == nts) ? (int)(unsigned)(_c >> 32) : ts_hi; ++nts; } } while (0)
    PG8_STAMP();
    unsigned voffA[2], voffB[2];
#pragma unroll
    for (int i = 0; i < 2; ++i) { int R, C; stage_rc(tid * 16 + i * 8192, R, C); const int Rb = Epi::PERM ? ((R & ~31) + perm32(R & 31)) : R;
        voffA[i] = (unsigned)(R * K + C) * 2u; voffB[i] = (unsigned)(Rb * K + C) * 2u; }
    const size_t kstep = (size_t)(BK * 2);
    const size_t hstep = (size_t)HALF * K * 2;
    const size_t tstep = 2 * hstep;
    const unsigned ldsw = (unsigned)wid * 1024u;
    const int aoff = lds_byte(wr * 64 + fr, fq * 8), boff = lds_byte(wc * 32 + fr, fq * 8);
#define PG8_SA(b, h) (((b) * 2 + (h)) * HTB)
#define PG8_SB(b, h) ((4 + (b) * 2 + (h)) * HTB)
#define PG8_STAGE(bufoff, gbase, voff) do { _Pragma("unroll") for (int _i = 0; _i < 2; ++_i) \
        __builtin_amdgcn_global_load_lds((const unsigned*)((const char*)(gbase) + (voff)[_i]), (PG8_LAS unsigned*)(lds + (bufoff) + ldsw + _i * 8192), 16, 0, 0); } while (0)
#define PG8_LDA(dst, b, h) do { _Pragma("unroll") for (int m = 0; m < 4; ++m) _Pragma("unroll") for (int k = 0; k < 2; ++k) dst[m][k] = *(const PG8_LAS bf16x8*)(lds + PG8_SA(b, h) + aoff + m * 2048 + k * 1024); } while (0)
#define PG8_LDB(dst, b, h) do { _Pragma("unroll") for (int n = 0; n < 2; ++n) _Pragma("unroll") for (int k = 0; k < 2; ++k) dst[n][k] = *(const PG8_LAS bf16x8*)(lds + PG8_SB(b, h) + boff + n * 2048 + k * 1024); } while (0)
#define PG8_MMA(ai, bj, At, Bt) do { __builtin_amdgcn_s_setprio(1); _Pragma("unroll") for (int m = 0; m < 4; ++m) _Pragma("unroll") for (int n = 0; n < 2; ++n) _Pragma("unroll") for (int k = 0; k < 2; ++k) \
        acc[ai][bj][m][n] = __builtin_amdgcn_mfma_f32_16x16x32_bf16(Bt[n][k], At[m][k], acc[ai][bj][m][n], 0, 0, 0); __builtin_amdgcn_s_setprio(0); } while (0)
#define PG8_WAIT_V(n) asm volatile("s_waitcnt vmcnt(" #n ")" ::: "memory")
#define PG8_WAIT_L(n) asm volatile("s_waitcnt lgkmcnt(" #n ")" ::: "memory")
#define PG8_BAR __builtin_amdgcn_s_barrier()
#define PG8_SCHED __builtin_amdgcn_sched_barrier(0)
    Unit cur, nxt; int ui = 0;
    if (!S.next(0, cur)) return;
    f32x4 acc[2][2][4][2];
#pragma unroll
    for (int a = 0; a < 2; ++a)
#pragma unroll
        for (int b = 0; b < 2; ++b)
#pragma unroll
            for (int m = 0; m < 4; ++m)
#pragma unroll
                for (int n = 0; n < 2; ++n) acc[a][b][m][n] = (f32x4){0.f, 0.f, 0.f, 0.f};
    bf16x8 At[4][2], B0[2][2], B1[2][2];
    const char* cA = (const char*)g.A + (size_t)cur.pm * tstep; const char* cB = (const char*)g.Bt + (size_t)cur.pn * tstep;
    S.a_ready(cur);
    PG8_STAGE(PG8_SB(0, 0), cB, voffB); PG8_STAGE(PG8_SA(0, 0), cA, voffA); PG8_STAGE(PG8_SB(0, 1), cB + hstep, voffB); PG8_STAGE(PG8_SA(0, 1), cA + hstep, voffA);
    if (wr == 1) PG8_BAR;
    PG8_WAIT_V(4); PG8_BAR;
    PG8_STAGE(PG8_SB(1, 0), cB + kstep, voffB); PG8_STAGE(PG8_SA(1, 0), cA + kstep, voffA); PG8_STAGE(PG8_SB(1, 1), cB + hstep + kstep, voffB);
    PG8_WAIT_V(6); PG8_BAR;
    PG8_STAMP();
    for (;;) {
        const bool has_next = S.next(ui + 1, nxt);
        const char* nA = has_next ? (const char*)g.A + (size_t)nxt.pm * tstep : cA; const char* nB = has_next ? (const char*)g.Bt + (size_t)nxt.pn * tstep : cB;
        for (int t = 0; t < nt; t += 2) {
            const bool last = (t == nt - 2);
            const char* a1 = cA + (size_t)(t + 1) * kstep;
            const char* a2 = last ? nA : cA + (size_t)(t + 2) * kstep; const char* b2 = last ? nB : cB + (size_t)(t + 2) * kstep;
            const char* a3 = a2 + kstep; const char* b3 = b2 + kstep;
            if (last && has_next) S.a_ready(nxt);
            PG8_LDB(B0, 0, 0); PG8_SCHED; PG8_LDA(At, 0, 0); PG8_STAGE(PG8_SA(1, 1), a1 + hstep, voffA);
            PG8_WAIT_L(8); PG8_BAR; PG8_WAIT_L(0); PG8_MMA(0, 0, At, B0); PG8_BAR; PG8_SCHED;
            PG8_LDB(B1, 0, 1); PG8_STAGE(PG8_SB(0, 0), b2, voffB);
            PG8_BAR; PG8_WAIT_L(0); PG8_MMA(0, 1, At, B1); PG8_BAR;
            PG8_LDA(At, 0, 1); PG8_STAGE(PG8_SA(0, 0), a2, voffA);
            PG8_BAR; PG8_WAIT_L(0); PG8_MMA(1, 0, At, B0); PG8_BAR; PG8_SCHED;
            PG8_STAGE(PG8_SB(0, 1), b2 + hstep, voffB);
            PG8_WAIT_V(6); PG8_BAR; PG8_MMA(1, 1, At, B1); PG8_BAR;
            PG8_LDB(B0, 1, 0); PG8_SCHED; PG8_LDA(At, 1, 0); PG8_STAGE(PG8_SA(0, 1), a2 + hstep, voffA);
            PG8_WAIT_L(8); PG8_BAR; PG8_WAIT_L(0); PG8_MMA(0, 0, At, B0); PG8_BAR; PG8_SCHED;
            PG8_LDB(B1, 1, 1); PG8_STAGE(PG8_SB(1, 0), b3, voffB);
            PG8_BAR; PG8_WAIT_L(0); PG8_MMA(0, 1, At, B1); PG8_BAR;
            PG8_LDA(At, 1, 1); PG8_STAGE(PG8_SA(1, 0), a3, voffA);
            PG8_BAR; PG8_WAIT_L(0); PG8_MMA(1, 0, At, B0); PG8_BAR; PG8_SCHED;
            PG8_STAGE(PG8_SB(1, 1), b3 + hstep, voffB);
            PG8_WAIT_V(6); PG8_BAR; PG8_MMA(1, 1, At, B1); PG8_BAR;
        }
        PG8_STAMP();
        if constexpr (!Epi::AFTER_DRAIN) { E(acc, cur, wr, wc, fr, fq); S.done(cur); }
        PG8_STAMP();
        if (!has_next) break;
#pragma unroll
        for (int a = 0; a < 2; ++a)
#pragma unroll
            for (int b = 0; b < 2; ++b)
#pragma unroll
                for (int m = 0; m < 4; ++m)
#pragma unroll
                    for (int n = 0; n < 2; ++n) acc[a][b][m][n] = (f32x4){0.f, 0.f, 0.f, 0.f};
        cur = nxt; cA = nA; cB = nB; ++ui;
    }
    PG8_WAIT_V(0);
    if (wr == 0) PG8_BAR;
    PG8_BAR;
    if constexpr (Epi::AFTER_DRAIN) { E.fused(acc, cur, wr, wc, fr, fq, lds, wid, lane); S.done(cur); }
    PG8_STAMP();
    if (STAMP && wid == 0) { stamps[lane] = lane < nts ? (((unsigned long long)(unsigned)ts_hi << 32) | (unsigned)ts_lo) : 0ull;
        if (lane == 62) stamps[62] = rt_entry; if (lane == 63) stamps[63] = (unsigned long long)wall_clock64(); }
#undef PG8_STAMP
#undef PG8_SA
#undef PG8_SB
#undef PG8_STAGE
#undef PG8_LDA
#undef PG8_LDB
#undef PG8_MMA
#undef PG8_WAIT_V
#undef PG8_WAIT_L
#undef PG8_BAR
#undef PG8_SCHED
}
}

#define LAS __attribute__((address_space(3)))
using pg8::bf16_t; using pg8::bf16x8; using pg8::f32x4; using pg8::u32x4; using pg8::cvt_pk_bf16;
typedef unsigned u32x2 __attribute__((ext_vector_type(2)));
typedef float f32x2 __attribute__((ext_vector_type(2)));

constexpr int TP = 16384, TS = 512, TT = 16896, DM = 1024;
constexpr int NHA = 2560, NHB = 3584, DFF = 2816, NUP = 5632;
constexpr float ALPHA = 1.6817928305074292f;
constexpr int LDS_BYTES = 139264;

constexpr size_t WS_WINA = 0;
constexpr size_t WS_WOUTA = WS_WINA + (size_t)2 * NHA * DM * 2;
constexpr size_t WS_WINB = WS_WOUTA + (size_t)2 * DM * DM * 2;
constexpr size_t WS_WOUTB = WS_WINB + (size_t)2 * NHB * DM * 2;
constexpr size_t WS_WKV = WS_WOUTB + (size_t)2 * DM * DM * 2;
constexpr size_t WS_WUP = WS_WKV + (size_t)2048 * DM * 2;
constexpr size_t WS_WDOWN = WS_WUP + (size_t)4 * NUP * DM * 2;
constexpr size_t WS_XF = WS_WDOWN + (size_t)4 * DM * DFF * 2;
constexpr size_t WS_XB = WS_XF + (size_t)TT * DM * 4;
constexpr size_t WS_MEMB = WS_XB + (size_t)TT * DM * 2;
constexpr size_t WS_KB = WS_MEMB + (size_t)2048 * DM * 2;
constexpr size_t WS_VT = WS_KB + (size_t)4 * 8 * 4 * 256 * 64 * 2;
constexpr size_t WS_R = WS_VT + (size_t)4 * 8 * 4 * 256 * 64 * 2;
constexpr size_t WS_H = WS_R;
constexpr size_t WS_CAT = WS_H + (size_t)TT * NHB * 2;
constexpr size_t WS_QKVN = WS_CAT + (size_t)TT * DM * 2;
constexpr size_t WS_GB = WS_QKVN + (size_t)TT * 2304 * 2;
constexpr size_t WS_WC = WS_GB + (size_t)TT * 12 * 4;
constexpr size_t WS_QDC = WS_WC + (size_t)1536 * 16384;
constexpr size_t WS_KDT = WS_QDC + (size_t)1536 * 16384;
constexpr size_t WS_QKC = WS_KDT + (size_t)1536 * 16384;
constexpr size_t WS_UT = WS_QKC + (size_t)1536 * 8192;
constexpr size_t WS_GL = WS_UT + (size_t)1536 * 32768;
constexpr size_t WS_O = WS_GL + (size_t)1536 * 4 + 2048;
constexpr size_t WS_MIX_END = WS_O + (size_t)TT * 768 * 4;
constexpr size_t WS_HU = WS_R;
constexpr size_t WS_GACT = WS_HU + (size_t)TT * NUP * 2;
constexpr size_t WS_FFN_END = WS_GACT + (size_t)TT * DFF * 2;
constexpr size_t WS_END = WS_MIX_END > WS_FFN_END ? WS_MIX_END : WS_FFN_END;

constexpr size_t O_Y = 0;
constexpr size_t O_MK = O_Y + (size_t)TT * DM;
constexpr size_t O_MV = O_MK + (size_t)4 * 8 * 256 * 256;
constexpr size_t O_SCP = O_MV + (size_t)4 * 8 * 256 * 256;
constexpr size_t O_GCP = O_SCP + (size_t)2 * 8 * 2 * 768;
constexpr size_t O_GSP = O_GCP + (size_t)2 * 8 * 3 * 2304;
constexpr size_t O_FFP = O_GSP + (size_t)2 * 8 * 6 * 16384;
constexpr size_t O_SCS = O_FFP + (size_t)4 * 8 * 2 * NUP;
constexpr size_t O_GCS = O_SCS + (size_t)2 * 128 * 2 * 768;
constexpr size_t O_GSS = O_GCS + (size_t)2 * 128 * 3 * 2304;
constexpr size_t O_FFS = O_GSS + (size_t)2 * 128 * 6 * 16384;
constexpr size_t O_END = O_FFS + (size_t)4 * 128 * 2 * NUP;

struct Params { const float* in[26]; float* out; unsigned char* ws; };
__device__ __forceinline__ int otid() { int t = threadIdx.x; asm volatile("" : "+v"(t)); return t; }

__device__ __forceinline__ float bflo(unsigned w) { return __uint_as_float(w << 16); }
__device__ __forceinline__ float bfhi(unsigned w) { return __uint_as_float(w & 0xffff0000u); }
__device__ __forceinline__ float bf1(bf16_t v) { return __uint_as_float((unsigned)v << 16); }
__device__ __forceinline__ float silu_f(float x) { return x / (1.f + __expf(-x)); }
__device__ __forceinline__ float wave_sum(float v) {
#pragma unroll
    for (int o = 1; o < 64; o <<= 1) v += __shfl_xor(v, o);
    return v;
}
__device__ __forceinline__ bf16x8 as_bf16x8(u32x4 v) { union { u32x4 u; bf16x8 b; } x; x.u = v; return x.b; }
__device__ __forceinline__ bf16x8 pack8(f32x4 a, f32x4 b) {
    u32x4 w; w.x = cvt_pk_bf16(a[0], a[1]); w.y = cvt_pk_bf16(a[2], a[3]); w.z = cvt_pk_bf16(b[0], b[1]); w.w = cvt_pk_bf16(b[2], b[3]);
    return as_bf16x8(w);
}
__device__ __forceinline__ int invperm32(int a) { return 8 * ((a & 15) >> 2) + (a & 3) + ((a >> 4) << 2); }
__device__ __forceinline__ int perm32k(int p) { const int g = p >> 3, jj = p & 7; return jj < 4 ? 4 * g + jj : 16 + 4 * g + (jj - 4); }

struct EpiStoreBf16 {
    static constexpr bool PERM = true, AFTER_DRAIN = false;
    bf16_t* O; int ldc;
    __device__ __forceinline__ void operator()(const f32x4 (&acc)[2][2][4][2], const pg8::Unit& u, int wr, int wc, int fr, int fq) const {
        const int row0 = u.pm * 256 + wr * 64 + fr, col0 = u.pn * 256 + wc * 32 + 8 * fq;
#pragma unroll
        for (int ai = 0; ai < 2; ++ai)
#pragma unroll
            for (int m = 0; m < 4; ++m) { bf16_t* rowp = O + (size_t)(row0 + ai * 128 + m * 16) * ldc + col0;
#pragma unroll
                for (int bj = 0; bj < 2; ++bj) { const f32x4 v0 = acc[ai][bj][m][0], v1 = acc[ai][bj][m][1];
                    u32x4 w; w.x = cvt_pk_bf16(v0[0], v0[1]); w.y = cvt_pk_bf16(v0[2], v0[3]); w.z = cvt_pk_bf16(v1[0], v1[1]); w.w = cvt_pk_bf16(v1[2], v1[3]);
                    *(u32x4*)(rowp + bj * 128) = w; } }
    }
};
struct EpiResid {
    static constexpr bool PERM = false, AFTER_DRAIN = false;
    float* X; int ldc;
    __device__ __forceinline__ void operator()(const f32x4 (&acc)[2][2][4][2], const pg8::Unit& u, int wr, int wc, int fr, int fq) const {
        const int row0 = u.pm * 256 + wr * 64 + fr, col0 = u.pn * 256 + wc * 32 + 4 * fq;
#pragma unroll
        for (int ai = 0; ai < 2; ++ai)
#pragma unroll
            for (int m = 0; m < 4; ++m) { float* rowp = X + (size_t)(row0 + ai * 128 + m * 16) * ldc + col0;
#pragma unroll
                for (int bj = 0; bj < 2; ++bj)
#pragma unroll
                    for (int n = 0; n < 2; ++n) { f32x4* p = (f32x4*)(rowp + bj * 128 + n * 16); const f32x4 x = *p; *p = x * ALPHA + acc[ai][bj][m][n]; } }
    }
};
struct EpiKV {
    static constexpr bool PERM = false, AFTER_DRAIN = false;
    float* outK; float* outV; bf16_t* Kb; bf16_t* Vt;
    __device__ __forceinline__ void operator()(const f32x4 (&acc)[2][2][4][2], const pg8::Unit& u, int wr, int wc, int fr, int fq) const {
        const int row0 = u.pm * 256 + wr * 64 + fr, col0 = u.pn * 256 + wc * 32 + 4 * fq;
#pragma unroll
        for (int ai = 0; ai < 2; ++ai)
#pragma unroll
            for (int m = 0; m < 4; ++m) { const int row = row0 + ai * 128 + m * 16; const int b = row >> 8, mm = row & 255;
#pragma unroll
                for (int bj = 0; bj < 2; ++bj)
#pragma unroll
                    for (int n = 0; n < 2; ++n) { const int col = col0 + bj * 128 + n * 16; const int l = col >> 9, e = col & 511; const f32x4 v = acc[ai][bj][m][n];
                        if (e < 256) { *(f32x4*)(outK + ((size_t)((l * 8 + b) * 256 + mm)) * 256 + e) = v;
                            u32x2 w; w.x = cvt_pk_bf16(v[0], v[1]); w.y = cvt_pk_bf16(v[2], v[3]);
                            *(u32x2*)(Kb + ((size_t)(((l * 8 + b) * 4 + (e >> 6)) * 256 + mm)) * 64 + (e & 63)) = w; }
                        else { const int e2 = e - 256; *(f32x4*)(outV + ((size_t)((l * 8 + b) * 256 + mm)) * 256 + e2) = v;
                            const unsigned w0 = cvt_pk_bf16(v[0], v[1]), w1 = cvt_pk_bf16(v[2], v[3]);
                            bf16_t* vp = Vt + ((size_t)(((l * 8 + b) * 4 + (e2 >> 6)) * 64 + (e2 & 63))) * 256 + mm;
                            vp[0] = (bf16_t)(w0 & 0xffffu); vp[256] = (bf16_t)(w0 >> 16); vp[512] = (bf16_t)(w1 & 0xffffu); vp[768] = (bf16_t)(w1 >> 16); } } }
    }
};

template <class Epi>
__device__ __forceinline__ void run_gemm(LAS unsigned char* lds, const bf16_t* A, const bf16_t* Bt, int M, int N, int K, const Epi& E, int c) {
    pg8::Gemm g{A, Bt, M, N, K}; pg8::StaticOrder S; S.init(M, N, (int)gridDim.x, c);
    pg8::gemm_phase<Epi, pg8::StaticOrder, false>(lds, g, S, E, nullptr);
}

__device__ __forceinline__ void p0_transpose_item(const float* W, int K, int Ns, int Nd, bool remap, bf16_t* WT, LAS float* scr, int item, int lane) {
    const int nblk = Nd / 32, kb = item / nblk, nb = item % nblk, k0 = 64 * kb, n0 = 32 * nb;
    const int n = n0 + (lane & 31); int sn = n;
    if (remap) sn = n < 3072 ? n : (n < 3328 ? n + 12 : (n < 3340 ? n - 256 : -1));
#pragma unroll 8
    for (int i = 0; i < 32; ++i) { const int kk = 2 * i + (lane >> 5); scr[kk * 33 + (lane & 31)] = sn >= 0 ? W[(size_t)(k0 + kk) * Ns + sn] : 0.f; }
    asm volatile("s_waitcnt lgkmcnt(0)" ::: "memory");
    const int c = lane & 7;
#pragma unroll
    for (int j = 0; j < 4; ++j) { const int nn = (lane >> 3) + 8 * j; const LAS float* s = scr + (8 * c) * 33 + nn;
        u32x4 o; o.x = cvt_pk_bf16(s[0 * 33], s[1 * 33]); o.y = cvt_pk_bf16(s[2 * 33], s[3 * 33]); o.z = cvt_pk_bf16(s[4 * 33], s[5 * 33]); o.w = cvt_pk_bf16(s[6 * 33], s[7 * 33]);
        *(u32x4*)(WT + (size_t)(n0 + nn) * K + k0 + 8 * c) = o; }
    asm volatile("s_waitcnt lgkmcnt(0)" ::: "memory");
}

__device__ __forceinline__ void phase_prep(const Params& p, LAS unsigned char* lds) {
    const int tid = otid(), lane = tid & 63, wave = __builtin_amdgcn_readfirstlane(tid >> 6);
    const int gw = blockIdx.x * 8 + wave, NGW = gridDim.x * 8;
    LAS float* scr = (LAS float*)(lds + wave * 16384);
    unsigned char* ws = p.ws;
    constexpr int I_INA = 16 * 80, I_OUT = 16 * 32, I_INB = 16 * 112, I_KV = 16 * 16, I_UP = 16 * 176, I_DN = 44 * 32;
    constexpr int NIT = 2 * I_INA + 2 * I_OUT + 2 * I_INB + 2 * I_OUT + 4 * I_KV + 4 * I_UP + 4 * I_DN;
    for (int it = gw; it < NIT; it += NGW) {
        int r = it;
        if (r < 2 * I_INA) { const int l = r / I_INA; r -= l * I_INA; p0_transpose_item(p.in[9] + (size_t)l * DM * NHA, DM, NHA, NHA, false, (bf16_t*)(ws + WS_WINA) + (size_t)l * NHA * DM, scr, r, lane); continue; } r -= 2 * I_INA;
        if (r < 2 * I_OUT) { const int l = r / I_OUT; r -= l * I_OUT; p0_transpose_item(p.in[11] + (size_t)l * DM * DM, DM, DM, DM, false, (bf16_t*)(ws + WS_WOUTA) + (size_t)l * DM * DM, scr, r, lane); continue; } r -= 2 * I_OUT;
        if (r < 2 * I_INB) { const int l = r / I_INB; r -= l * I_INB; p0_transpose_item(p.in[12] + (size_t)l * DM * 3340, DM, 3340, NHB, true, (bf16_t*)(ws + WS_WINB) + (size_t)l * NHB * DM, scr, r, lane); continue; } r -= 2 * I_INB;
        if (r < 2 * I_OUT) { const int l = r / I_OUT; r -= l * I_OUT; p0_transpose_item(p.in[17] + (size_t)l * DM * DM, DM, DM, DM, false, (bf16_t*)(ws + WS_WOUTB) + (size_t)l * DM * DM, scr, r, lane); continue; } r -= 2 * I_OUT;
        if (r < 4 * I_KV) { const int l = r / I_KV; r -= l * I_KV; p0_transpose_item(p.in[18] + (size_t)l * DM * 512, DM, 512, 512, false, (bf16_t*)(ws + WS_WKV) + (size_t)l * 512 * DM, scr, r, lane); continue; } r -= 4 * I_KV;
        if (r < 4 * I_UP) { const int l = r / I_UP; r -= l * I_UP; p0_transpose_item(p.in[23] + (size_t)l * DM * NUP, DM, NUP, NUP, false, (bf16_t*)(ws + WS_WUP) + (size_t)l * NUP * DM, scr, r, lane); continue; } r -= 4 * I_UP;
        { const int l = r / I_DN; r -= l * I_DN; p0_transpose_item(p.in[25] + (size_t)l * DFF * DM, DFF, DM, DM, false, (bf16_t*)(ws + WS_WDOWN) + (size_t)l * DM * DFF, scr, r, lane); }
    }
    const size_t gt = (size_t)blockIdx.x * 512 + tid, NT = (size_t)gridDim.x * 512;
    float* xf = (float*)(ws + WS_XF); bf16_t* xb = (bf16_t*)(ws + WS_XB); bf16_t* memb = (bf16_t*)(ws + WS_MEMB);
    for (size_t i = gt; i < (size_t)TT * 256; i += NT) {
        const f32x4 v = i < (size_t)TP * 256 ? ((const f32x4*)p.in[0])[i] : ((const f32x4*)p.in[1])[i - (size_t)TP * 256];
        ((f32x4*)xf)[i] = v; u32x2 w; w.x = cvt_pk_bf16(v[0], v[1]); w.y = cvt_pk_bf16(v[2], v[3]); ((u32x2*)xb)[i] = w;
    }
    for (size_t i = gt; i < (size_t)2048 * 256; i += NT) {
        const f32x4 v = ((const f32x4*)p.in[2])[i]; u32x2 w; w.x = cvt_pk_bf16(v[0], v[1]); w.y = cvt_pk_bf16(v[2], v[3]); ((u32x2*)memb)[i] = w;
    }
}

__device__ __forceinline__ void phase_ln(float* xf, bf16_t* xb, const float* gam, const float* bet, float* yout) {
    const int tid_ = otid(); const int lane = tid_ & 63, wave = __builtin_amdgcn_readfirstlane(tid_ >> 6);
    const int gw = blockIdx.x * 8 + wave, NGW = gridDim.x * 8;
    f32x4 gg[4], bb[4];
#pragma unroll
    for (int j = 0; j < 4; ++j) { gg[j] = ((const f32x4*)gam)[lane + 64 * j]; bb[j] = ((const f32x4*)bet)[lane + 64 * j]; }
    for (int row = gw; row < TT; row += NGW) {
        f32x4* xr = (f32x4*)(xf + (size_t)row * DM) + lane;
        f32x4 v[4]; float s = 0.f;
#pragma unroll
        for (int j = 0; j < 4; ++j) { v[j] = xr[64 * j]; s += (v[j][0] + v[j][1]) + (v[j][2] + v[j][3]); }
        const float mean = wave_sum(s) * (1.f / DM); float s2 = 0.f;
#pragma unroll
        for (int j = 0; j < 4; ++j) { v[j] = v[j] - mean; s2 += (v[j][0] * v[j][0] + v[j][1] * v[j][1]) + (v[j][2] * v[j][2] + v[j][3] * v[j][3]); }
        const float rstd = 1.f / sqrtf(wave_sum(s2) * (1.f / DM) + 1e-5f);
#pragma unroll
        for (int j = 0; j < 4; ++j) { const f32x4 o = v[j] * rstd * gg[j] + bb[j];
            if (yout) ((f32x4*)(yout + (size_t)row * DM))[lane + 64 * j] = o;
            else { xr[64 * j] = o; u32x2 w; w.x = cvt_pk_bf16(o[0], o[1]); w.y = cvt_pk_bf16(o[2], o[3]); ((u32x2*)(xb + (size_t)row * DM))[lane + 64 * j] = w; } }
    }
}

__device__ __forceinline__ void attn_prompt_item(LAS unsigned char* lds, const bf16_t* h, int ldh, int qoff, const bf16_t* Kb, const bf16_t* Vt, bf16_t* cat, int layer, int item) {
    const int tid = otid(), lane = tid & 63, wave = __builtin_amdgcn_readfirstlane(tid >> 6), c16 = lane & 15, g = lane >> 4;
    const int qc = item & 7, hd = (item >> 3) & 3, b = item >> 5;
    const size_t kvbase = ((size_t)((layer * 8 + b) * 4 + hd)) * 16384;
    constexpr int VOFF = 256 * 144;
#pragma unroll
    for (int i = 0; i < 4; ++i) { const int q = tid + 512 * i;
        const u32x4 kv = *(const u32x4*)(Kb + kvbase + (size_t)q * 8); *(LAS u32x4*)(lds + (q >> 3) * 144 + (q & 7) * 16) = kv;
        const u32x4 vv = *(const u32x4*)(Vt + kvbase + (size_t)q * 8); *(LAS u32x4*)(lds + VOFF + (q >> 5) * 528 + (q & 31) * 16) = vv; }
    __syncthreads();
#pragma unroll 1
    for (int qt = wave; qt < 16; qt += 8) {
        const int row = b * 2048 + qc * 256 + qt * 16 + c16;
        const bf16_t* qp = h + (size_t)row * ldh + qoff + hd * 64 + g * 8;
        const bf16x8 qf0 = *(const bf16x8*)qp, qf1 = *(const bf16x8*)(qp + 32);
        f32x4 acc[16];
#pragma unroll
        for (int kt = 0; kt < 16; ++kt) { acc[kt] = (f32x4){0.f, 0.f, 0.f, 0.f};
            const LAS unsigned char* kp = lds + (16 * kt + c16) * 144 + g * 16;
            const bf16x8 k0 = *(const LAS bf16x8*)kp, k1 = *(const LAS bf16x8*)(kp + 64);
            acc[kt] = __builtin_amdgcn_mfma_f32_16x16x32_bf16(k0, qf0, acc[kt], 0, 0, 0);
            acc[kt] = __builtin_amdgcn_mfma_f32_16x16x32_bf16(k1, qf1, acc[kt], 0, 0, 0); }
        float mx = -3.0e38f;
#pragma unroll
        for (int kt = 0; kt < 16; ++kt) mx = fmaxf(mx, fmaxf(fmaxf(acc[kt][0], acc[kt][1]), fmaxf(acc[kt][2], acc[kt][3])));
        mx = fmaxf(mx, __shfl_xor(mx, 16)); mx = fmaxf(mx, __shfl_xor(mx, 32));
        const float sc = 0.125f * 1.44269504089f; float sum = 0.f;
#pragma unroll
        for (int kt = 0; kt < 16; ++kt)
#pragma unroll
            for (int r = 0; r < 4; ++r) { const float e = __builtin_amdgcn_exp2f((acc[kt][r] - mx) * sc); acc[kt][r] = e; sum += e; }
        sum += __shfl_xor(sum, 16); sum += __shfl_xor(sum, 32);
        const float inv = 1.f / sum;
        f32x4 o[4];
#pragma unroll
        for (int dt = 0; dt < 4; ++dt) o[dt] = (f32x4){0.f, 0.f, 0.f, 0.f};
#pragma unroll
        for (int s = 0; s < 8; ++s) { const bf16x8 pf = pack8(acc[2 * s], acc[2 * s + 1]);
#pragma unroll
            for (int dt = 0; dt < 4; ++dt) { const LAS unsigned char* vp = lds + VOFF + (16 * dt + c16) * 528 + (32 * s + 4 * g) * 2;
                const u32x2 a0 = *(const LAS u32x2*)vp, a1 = *(const LAS u32x2*)(vp + 32);
                u32x4 av; av.x = a0.x; av.y = a0.y; av.z = a1.x; av.w = a1.y;
                o[dt] = __builtin_amdgcn_mfma_f32_16x16x32_bf16(as_bf16x8(av), pf, o[dt], 0, 0, 0); } }
#pragma unroll
        for (int dt = 0; dt < 4; ++dt) { u32x2 w; w.x = cvt_pk_bf16(o[dt][0] * inv, o[dt][1] * inv); w.y = cvt_pk_bf16(o[dt][2] * inv, o[dt][3] * inv);
            *(u32x2*)(cat + (size_t)row * DM + 768 + hd * 64 + 16 * dt + 4 * g) = w; }
    }
    __syncthreads();
}

__device__ __forceinline__ void attn_prompt_item_naive(LAS unsigned char* lds, const bf16_t* h, int ldh, int qoff, const float* outK, const float* outV, bf16_t* cat, int layer, int item) {
    const int tid = otid();
    const int qc = item & 7, hd = (item >> 3) & 3, b = item >> 5;
    LAS float* Ks = (LAS float*)lds; LAS float* Vs = Ks + 256 * 64;
    for (int i = tid; i < 256 * 64; i += 512) { const int m = i >> 6, d = i & 63; const size_t src = ((size_t)((layer * 8 + b) * 256 + m)) * 256 + hd * 64 + d; Ks[i] = outK[src]; Vs[i] = outV[src]; }
    __syncthreads();
    const int ql = tid & 255, half = tid >> 8;
    const int row = b * 2048 + qc * 256 + ql;
    float q[64];
#pragma unroll
    for (int d = 0; d < 64; ++d) q[d] = bf1(h[(size_t)row * ldh + qoff + hd * 64 + d]);
    float mx = -3.0e38f, l = 0.f; float acc[64];
#pragma unroll
    for (int d = 0; d < 64; ++d) acc[d] = 0.f;
#pragma unroll 1
    for (int m = half * 128; m < half * 128 + 128; ++m) {
        float sdot = 0.f;
#pragma unroll
        for (int d = 0; d < 64; ++d) sdot += q[d] * Ks[m * 64 + d];
        sdot *= 0.125f;
        const float nm = fmaxf(mx, sdot); const float corr = __expf(mx - nm), pe = __expf(sdot - nm);
        l = l * corr + pe;
#pragma unroll
        for (int d = 0; d < 64; ++d) acc[d] = acc[d] * corr + pe * Vs[m * 64 + d];
        mx = nm;
    }
    __syncthreads();
    LAS float* ex = (LAS float*)lds;
    if (half == 1) { ex[ql * 66 + 64] = mx; ex[ql * 66 + 65] = l;
#pragma unroll
        for (int d = 0; d < 64; ++d) ex[ql * 66 + d] = acc[d]; }
    __syncthreads();
    if (half == 0) { const float m2 = ex[ql * 66 + 64], l2 = ex[ql * 66 + 65]; const float nm = fmaxf(mx, m2); const float c1 = __expf(mx - nm), c2 = __expf(m2 - nm); const float inv = 1.f / (l * c1 + l2 * c2);
#pragma unroll
        for (int d = 0; d < 64; ++d) { const float o = (acc[d] * c1 + ex[ql * 66 + d] * c2) * inv; cat[(size_t)row * DM + 768 + hd * 64 + d] = (bf16_t)(cvt_pk_bf16(o, 0.f) & 0xffffu); } }
    __syncthreads();
}
__device__ __forceinline__ void attn_sample_item(LAS unsigned char* lds, const bf16_t* h, int ldh, int qoff, const float* ck, const float* cv, bf16_t* cat, int layer, int item) {
    const int tid = otid(), lane = tid & 63, wave = __builtin_amdgcn_readfirstlane(tid >> 6);
    const int hp = item & 1, sb = item >> 1;
    LAS float* qs = (LAS float*)lds;
    LAS float* scs = qs + 512;
    LAS float* red = scs + 2048;
    { const int t = tid >> 7, hh = (tid >> 6) & 1, d = tid & 63;
      qs[tid] = bf1(h[(size_t)(TP + sb * 4 + t) * ldh + qoff + (2 * hp + hh) * 64 + d]); }
    __syncthreads();
    { const int m = tid & 255, hh = tid >> 8;
      const f32x4* kp = (const f32x4*)(ck + (((size_t)(layer * 128 + sb) * 256 + m) * 4 + (2 * hp + hh)) * 64);
      float a0 = 0.f, a1 = 0.f, a2 = 0.f, a3 = 0.f;
#pragma unroll
      for (int i = 0; i < 16; ++i) { const f32x4 kv = kp[i];
#pragma unroll
          for (int e = 0; e < 4; ++e) { const int d = 4 * i + e; a0 += kv[e] * qs[(0 * 2 + hh) * 64 + d]; a1 += kv[e] * qs[(1 * 2 + hh) * 64 + d]; a2 += kv[e] * qs[(2 * 2 + hh) * 64 + d]; a3 += kv[e] * qs[(3 * 2 + hh) * 64 + d]; } }
      scs[(0 * 2 + hh) * 256 + m] = a0 * 0.125f; scs[(1 * 2 + hh) * 256 + m] = a1 * 0.125f; scs[(2 * 2 + hh) * 256 + m] = a2 * 0.125f; scs[(3 * 2 + hh) * 256 + m] = a3 * 0.125f; }
    __syncthreads();
    { LAS float* sp = scs + wave * 256; float v[4]; float mx = -3.0e38f;
#pragma unroll
      for (int i = 0; i < 4; ++i) { v[i] = sp[lane + 64 * i]; mx = fmaxf(mx, v[i]); }
#pragma unroll
      for (int o = 1; o < 64; o <<= 1) mx = fmaxf(mx, __shfl_xor(mx, o));
      float s = 0.f;
#pragma unroll
      for (int i = 0; i < 4; ++i) { v[i] = __expf(v[i] - mx); s += v[i]; }
      s = wave_sum(s); const float inv = 1.f / s;
#pragma unroll
      for (int i = 0; i < 4; ++i) sp[lane + 64 * i] = v[i] * inv; }
    __syncthreads();
    { const int d = tid & 63, hh = (tid >> 6) & 1, mp = tid >> 7;
      float a0 = 0.f, a1 = 0.f, a2 = 0.f, a3 = 0.f;
      const float* vp = cv + (((size_t)(layer * 128 + sb) * 256 + mp * 64) * 4 + (2 * hp + hh)) * 64 + d;
#pragma unroll 8
      for (int m = 0; m < 64; ++m) { const float vv = vp[(size_t)m * 256]; const int mm = mp * 64 + m;
          a0 += scs[(0 * 2 + hh) * 256 + mm] * vv; a1 += scs[(1 * 2 + hh) * 256 + mm] * vv; a2 += scs[(2 * 2 + hh) * 256 + mm] * vv; a3 += scs[(3 * 2 + hh) * 256 + mm] * vv; }
      red[(mp * 8 + 0 * 2 + hh) * 64 + d] = a0; red[(mp * 8 + 1 * 2 + hh) * 64 + d] = a1; red[(mp * 8 + 2 * 2 + hh) * 64 + d] = a2; red[(mp * 8 + 3 * 2 + hh) * 64 + d] = a3; }
    __syncthreads();
    { const int t = tid >> 7, hh = (tid >> 6) & 1, d = tid & 63; const int idx = (t * 2 + hh) * 64 + d;
      const float o = red[idx] + red[512 + idx] + red[1024 + idx] + red[1536 + idx];
      cat[(size_t)(TP + sb * 4 + t) * DM + 768 + (2 * hp + hh) * 64 + d] = (bf16_t)(cvt_pk_bf16(o, 0.f) & 0xffffu); }
    __syncthreads();
}

__device__ __forceinline__ void load_u8(const bf16_t* h, size_t row, int c, float* u) {
    const u32x4 xi = *(const u32x4*)(h + row * NHA + c), cg = *(const u32x4*)(h + row * NHA + 1536 + c);
#pragma unroll
    for (int i = 0; i < 4; ++i) { u[2 * i] = bflo(xi[i]) * bflo(cg[i]); u[2 * i + 1] = bfhi(xi[i]) * bfhi(cg[i]); }
}
__device__ __forceinline__ void phase_mixA_elem(const Params& p, int j) {
    const bf16_t* h = (const bf16_t*)(p.ws + WS_H); bf16_t* cat = (bf16_t*)(p.ws + WS_CAT);
    const float* cw = p.in[10] + (size_t)j * 3 * 768; const float* hist = p.in[5] + (size_t)j * 128 * 2 * 768;
    const size_t gt = (size_t)blockIdx.x * 512 + otid(), NT = (size_t)gridDim.x * 512;
    for (size_t idx = gt; idx < (size_t)TT * 96; idx += NT) {
        const int row = (int)(idx / 96), c = (int)(idx % 96) * 8;
        const bool smp = row >= TP; const int t = smp ? ((row - TP) & 3) : (row & 2047); const int bb = smp ? ((row - TP) >> 2) : (row >> 11);
        float u0[8], u1[8], u2[8];
        load_u8(h, row, c, u2);
        if (t >= 1) load_u8(h, row - 1, c, u1);
        else if (smp) { const f32x4* hp = (const f32x4*)(hist + ((size_t)bb * 2 + 1) * 768 + c); const f32x4 a = hp[0], b2 = hp[1];
#pragma unroll
            for (int i = 0; i < 4; ++i) { u1[i] = a[i]; u1[4 + i] = b2[i]; } }
        else {
#pragma unroll
            for (int i = 0; i < 8; ++i) u1[i] = 0.f; }
        if (t >= 2) load_u8(h, row - 2, c, u0);
        else if (smp) { const f32x4* hp = (const f32x4*)(hist + ((size_t)bb * 2 + t) * 768 + c); const f32x4 a = hp[0], b2 = hp[1];
#pragma unroll
            for (int i = 0; i < 4; ++i) { u0[i] = a[i]; u0[4 + i] = b2[i]; } }
        else {
#pragma unroll
            for (int i = 0; i < 8; ++i) u0[i] = 0.f; }
        const u32x4 bg = *(const u32x4*)(h + (size_t)row * NHA + 768 + c);
        float y[8];
#pragma unroll
        for (int i = 0; i < 8; ++i) { const float w0 = cw[c + i], w1 = cw[768 + c + i], w2 = cw[1536 + c + i];
            const float bgv = (i & 1) ? bfhi(bg[i >> 1]) : bflo(bg[i >> 1]);
            y[i] = bgv * (w0 * u0[i] + w1 * u1[i] + w2 * u2[i]); }
        u32x4 w; w.x = cvt_pk_bf16(y[0], y[1]); w.y = cvt_pk_bf16(y[2], y[3]); w.z = cvt_pk_bf16(y[4], y[5]); w.w = cvt_pk_bf16(y[6], y[7]);
        *(u32x4*)(cat + (size_t)row * DM + c) = w;
        const int T = smp ? 4 : 2048;
        if (t >= T - 2) { float* op = p.out + (smp ? O_SCS : O_SCP) + (((size_t)j * (smp ? 128 : 8) + bb) * 2 + (t - (T - 2))) * 768 + c;
            ((f32x4*)op)[0] = (f32x4){u2[0], u2[1], u2[2], u2[3]}; ((f32x4*)op)[1] = (f32x4){u2[4], u2[5], u2[6], u2[7]}; }
    }
}

__device__ __forceinline__ void load_h8(const bf16_t* hu, size_t row, int c, float* v) {
    const u32x4 x = *(const u32x4*)(hu + row * NUP + c);
#pragma unroll
    for (int i = 0; i < 4; ++i) { v[2 * i] = bflo(x[i]); v[2 * i + 1] = bfhi(x[i]); }
}
__device__ __forceinline__ void load_f8(const float* src, float* v) {
    const f32x4 a = ((const f32x4*)src)[0], b = ((const f32x4*)src)[1];
#pragma unroll
    for (int i = 0; i < 4; ++i) { v[i] = a[i]; v[4 + i] = b[i]; }
}
__device__ __forceinline__ void phase_convgate(const Params& p, int l) {
    const bf16_t* hu = (const bf16_t*)(p.ws + WS_HU); bf16_t* gact = (bf16_t*)(p.ws + WS_GACT);
    const float* cw = p.in[24] + (size_t)l * 3 * NUP; const float* hist = p.in[8] + (size_t)l * 128 * 2 * NUP;
    const size_t gt = (size_t)blockIdx.x * 512 + otid(), NT = (size_t)gridDim.x * 512;
    for (size_t idx = gt; idx < (size_t)TT * 352; idx += NT) {
        const int row = (int)(idx / 352), c = (int)(idx % 352) * 8;
        const bool smp = row >= TP; const int t = smp ? ((row - TP) & 3) : (row & 2047); const int bb = smp ? ((row - TP) >> 2) : (row >> 11);
        float res[2][8];
#pragma unroll
        for (int half = 0; half < 2; ++half) {
            const int cc = c + half * DFF;
            float v0[8], v1[8], v2[8];
            load_h8(hu, row, cc, v2);
            if (t >= 1) load_h8(hu, row - 1, cc, v1);
            else if (smp) load_f8(hist + ((size_t)bb * 2 + 1) * NUP + cc, v1);
            else {
#pragma unroll
                for (int i = 0; i < 8; ++i) v1[i] = 0.f; }
            if (t >= 2) load_h8(hu, row - 2, cc, v0);
            else if (smp) load_f8(hist + ((size_t)bb * 2 + t) * NUP + cc, v0);
            else {
#pragma unroll
                for (int i = 0; i < 8; ++i) v0[i] = 0.f; }
#pragma unroll
            for (int i = 0; i < 8; ++i) res[half][i] = cw[cc + i] * v0[i] + cw[NUP + cc + i] * v1[i] + cw[2 * NUP + cc + i] * v2[i];
        }
        float y[8];
#pragma unroll
        for (int i = 0; i < 8; ++i) y[i] = silu_f(res[0][i]) * res[1][i];
        u32x4 w; w.x = cvt_pk_bf16(y[0], y[1]); w.y = cvt_pk_bf16(y[2], y[3]); w.z = cvt_pk_bf16(y[4], y[5]); w.w = cvt_pk_bf16(y[6], y[7]);
        *(u32x4*)(gact + (size_t)row * DFF + c) = w;
    }
    for (size_t idx = gt; idx < (size_t)(8 + 128) * 2 * (NUP / 8); idx += NT) {
        const int c = (int)(idx % (NUP / 8)) * 8; const int rr = (int)(idx / (NUP / 8)); const int k = rr & 1, bq = rr >> 1;
        const bool smp = bq >= 8; const int bb = smp ? bq - 8 : bq;
        const size_t row = smp ? (size_t)TP + bb * 4 + 2 + k : (size_t)bb * 2048 + 2046 + k;
        float v[8]; load_h8(hu, row, c, v);
        float* op = p.out + (smp ? O_FFS : O_FFP) + (((size_t)l * (smp ? 128 : 8) + bb) * 2 + k) * NUP + c;
        ((f32x4*)op)[0] = (f32x4){v[0], v[1], v[2], v[3]}; ((f32x4*)op)[1] = (f32x4){v[4], v[5], v[6], v[7]};
    }
}

__device__ __forceinline__ void phase_gdn_pre(const Params& p, int j) {
    const bf16_t* h = (const bf16_t*)(p.ws + WS_H); bf16_t* qkvn = (bf16_t*)(p.ws + WS_QKVN); float* gb = (float*)(p.ws + WS_GB);
    const float* cw = p.in[13] + (size_t)j * 4 * 2304; const float* hist = p.in[6] + (size_t)j * 128 * 3 * 2304;
    const int tid_ = otid(); const int lane = tid_ & 63, wave = __builtin_amdgcn_readfirstlane(tid_ >> 6);
    const int gw = blockIdx.x * 8 + wave, NGW = gridDim.x * 8;
    for (int it = gw; it < TT * 6; it += NGW) {
        const int row = it / 6, hd = it % 6;
        const bool smp = row >= TP; const int t = smp ? ((row - TP) & 3) : (row & 2047); const int bb = smp ? ((row - TP) >> 2) : (row >> 11);
        const int T = smp ? 4 : 2048;
        float val[3][2];
#pragma unroll
        for (int sec = 0; sec < 3; ++sec) {
            const int col = sec * 768 + hd * 128 + 2 * lane;
            float a0 = 0.f, a1 = 0.f;
#pragma unroll
            for (int k = 0; k < 4; ++k) { const int tt = t - 3 + k; float x0, x1;
                if (tt >= 0) { const unsigned w = *(const unsigned*)(h + (size_t)(row - 3 + k) * NHB + col); x0 = bflo(w); x1 = bfhi(w); }
                else if (smp) { const f32x2 hv = *(const f32x2*)(hist + ((size_t)bb * 3 + (tt + 3)) * 2304 + col); x0 = hv[0]; x1 = hv[1]; }
                else { x0 = 0.f; x1 = 0.f; }
                const f32x2 wv = *(const f32x2*)(cw + (size_t)k * 2304 + col);
                a0 += wv[0] * x0; a1 += wv[1] * x1;
                if (k == 3 && t >= T - 3) { float* op = p.out + (smp ? O_GCS : O_GCP) + (((size_t)j * (smp ? 128 : 8) + bb) * 3 + (t - (T - 3))) * 2304 + col; *(f32x2*)op = (f32x2){x0, x1}; }
            }
            val[sec][0] = silu_f(a0); val[sec][1] = silu_f(a1);
        }
#pragma unroll
        for (int sec = 0; sec < 2; ++sec) { const float ss = wave_sum(val[sec][0] * val[sec][0] + val[sec][1] * val[sec][1]); const float r = 1.f / sqrtf(ss + 1e-6f); val[sec][0] *= r; val[sec][1] *= r; }
#pragma unroll
        for (int sec = 0; sec < 3; ++sec) *(unsigned*)(qkvn + (size_t)row * 2304 + sec * 768 + hd * 128 + 2 * lane) = cvt_pk_bf16(val[sec][0], val[sec][1]);
        if (lane == 0) {
            const float bv = bf1(h[(size_t)row * NHB + 3328 + hd]), av = bf1(h[(size_t)row * NHB + 3334 + hd]);
            const float x = av + p.in[15][j * 6 + hd];
            const float sp = fmaxf(x, 0.f) + log1pf(__expf(-fabsf(x)));
            gb[(size_t)row * 12 + hd] = -__expf(p.in[14][j * 6 + hd]) * sp;
            gb[(size_t)row * 12 + 6 + hd] = 1.f / (1.f + __expf(-bv));
        }
    }
}

__device__ __forceinline__ void solve_lds(LAS float* sol, const LAS float* A, int lane) {
#pragma unroll 1
    for (int i = 1; i < 64; ++i) {
        float r0 = sol[i * 64 + lane], r1 = 0.f;
        const int n4 = (i + 3) >> 2;
#pragma unroll 2
        for (int j4 = 0; j4 < n4; ++j4) {
            const f32x4 a = *(const LAS f32x4*)(A + i * 64 + 4 * j4);
            const LAS float* sp = sol + (4 * j4) * 64 + lane;
            r0 -= a[0] * sp[0]; r1 -= a[1] * sp[64]; r0 -= a[2] * sp[128]; r1 -= a[3] * sp[192];
        }
        sol[i * 64 + lane] = r0 + r1;
    }
}
__device__ __forceinline__ void phase_gdn_prep(const Params& p, LAS unsigned char* lds) {
    const bf16_t* qkvn = (const bf16_t*)(p.ws + WS_QKVN); const float* gb = (const float*)(p.ws + WS_GB);
    bf16_t* Wc = (bf16_t*)(p.ws + WS_WC); bf16_t* QDc = (bf16_t*)(p.ws + WS_QDC); bf16_t* KDT = (bf16_t*)(p.ws + WS_KDT); bf16_t* QKc = (bf16_t*)(p.ws + WS_QKC);
    float* UT = (float*)(p.ws + WS_UT); float* GL = (float*)(p.ws + WS_GL);
    const int tid_ = otid(); const int lane0 = tid_ & 63, wave = __builtin_amdgcn_readfirstlane(tid_ >> 6);
    if (wave >= 4) return;
    const int gw = blockIdx.x * 4 + wave, NGW = gridDim.x * 4;
#pragma unroll 1
    for (int ci = gw; ci < 1536; ci += NGW) {
        int lane = lane0; unsigned aoff = (unsigned)wave * 32768u;
        asm volatile("" : "+v"(lane), "+v"(aoff));
        const int c16 = lane & 15, g = lane >> 4;
        LAS float* A = (LAS float*)(lds + aoff);
        const int n = ci & 31, hd = (ci >> 5) % 6, b = ci / 192;
        const int tok0 = b * 2048 + n * 64;
        const float gi = gb[(size_t)(tok0 + lane) * 12 + hd], beta = gb[(size_t)(tok0 + lane) * 12 + 6 + hd];
        float gc = gi;
#pragma unroll
        for (int o = 1; o < 64; o <<= 1) { const float tv = __shfl_up(gc, o); if (lane >= o) gc += tv; }
        const float gl = __shfl(gc, 63);
        const float egc = __expf(gc), edl = __expf(gl - gc);
        if (lane == 0) GL[ci] = __expf(gl);
        {
            bf16x8 kf[4][4];
#pragma unroll
            for (int t = 0; t < 4; ++t)
#pragma unroll
                for (int ks = 0; ks < 4; ++ks) kf[t][ks] = *(const bf16x8*)(qkvn + (size_t)(tok0 + 16 * t + c16) * 2304 + 768 + hd * 128 + 32 * ks + 8 * g);
#pragma unroll
            for (int it = 0; it < 4; ++it)
#pragma unroll
                for (int jt = 0; jt <= it; ++jt) {
                    f32x4 acc = (f32x4){0.f, 0.f, 0.f, 0.f};
#pragma unroll
                    for (int ks = 0; ks < 4; ++ks) acc = __builtin_amdgcn_mfma_f32_16x16x32_bf16(kf[it][ks], kf[jt][ks], acc, 0, 0, 0);
                    const int jj = 16 * jt + c16; const float gcj = __shfl(gc, jj);
#pragma unroll
                    for (int r = 0; r < 4; ++r) { const int ii = 16 * it + 4 * g + r; const float gci = __shfl(gc, ii), bi = __shfl(beta, ii);
                        A[ii * 64 + jj] = ii > jj ? bi * acc[r] * __expf(gci - gcj) : 0.f; }
                }
#pragma unroll
            for (int it = 0; it < 4; ++it) {
                bf16x8 qf[4];
#pragma unroll
                for (int ks = 0; ks < 4; ++ks) qf[ks] = *(const bf16x8*)(qkvn + (size_t)(tok0 + 16 * it + c16) * 2304 + hd * 128 + 32 * ks + 8 * g);
#pragma unroll
                for (int jt = 0; jt < 4; ++jt) {
                    f32x4 acc = (f32x4){0.f, 0.f, 0.f, 0.f};
                    if (jt <= it) {
#pragma unroll
                        for (int ks = 0; ks < 4; ++ks) acc = __builtin_amdgcn_mfma_f32_16x16x32_bf16(qf[ks], kf[jt][ks], acc, 0, 0, 0);
                    }
                    const int jj = 16 * jt + c16; const float gcj = __shfl(gc, jj);
                    const int pos = (jj & 32) + invperm32(jj & 31);
#pragma unroll
                    for (int r = 0; r < 4; ++r) { const int ii = 16 * it + 4 * g + r; const float gci = __shfl(gc, ii);
                        const float v = ii >= jj ? acc[r] * 0.08838834764831845f * __expf(gci - gcj) : 0.f;
                        QKc[(size_t)ci * 4096 + ii * 64 + pos] = (bf16_t)(cvt_pk_bf16(v, 0.f) & 0xffffu); }
                }
            }
        }
        asm volatile("s_waitcnt lgkmcnt(0)" ::: "memory");
        LAS float* sol = A + 4096;
#pragma unroll 1
        for (int pass = 0; pass < 4; ++pass) {
            const int half = pass & 1, isw = pass >> 1;
            const int c = lane + 64 * half; const int posc = (c & ~31) + invperm32(c & 31);
            const bf16_t* src = qkvn + (size_t)tok0 * 2304 + (isw ? 768 : 1536) + hd * 128 + c;
#pragma unroll 8
            for (int i = 0; i < 64; ++i) { float f = __shfl(beta, i); if (isw) f *= __shfl(egc, i); sol[i * 64 + lane] = bf1(src[(size_t)i * 2304]) * f; }
            asm volatile("s_waitcnt lgkmcnt(0)" ::: "memory");
            solve_lds(sol, A, lane);
            asm volatile("s_waitcnt lgkmcnt(0)" ::: "memory");
            if (!isw) { float* up = UT + (size_t)ci * 8192 + (size_t)c * 64;
#pragma unroll 4
                for (int i = 0; i < 64; i += 4) *(f32x4*)(up + i) = (f32x4){sol[i * 64 + lane], sol[(i + 1) * 64 + lane], sol[(i + 2) * 64 + lane], sol[(i + 3) * 64 + lane]}; }
            else {
#pragma unroll 8
                for (int i = 0; i < 64; ++i) Wc[(size_t)ci * 8192 + i * 128 + posc] = (bf16_t)(cvt_pk_bf16(sol[i * 64 + lane], 0.f) & 0xffffu); }
            asm volatile("s_waitcnt lgkmcnt(0)" ::: "memory");
        }
        const int c0 = 2 * lane; const int pos0 = (c0 & ~31) + invperm32(c0 & 31);
#pragma unroll 8
        for (int i = 0; i < 64; ++i) { const unsigned w = *(const unsigned*)(qkvn + (size_t)(tok0 + i) * 2304 + hd * 128 + 2 * lane);
            const float s = __shfl(egc, i) * 0.08838834764831845f;
            *(unsigned*)(QDc + (size_t)ci * 8192 + i * 128 + pos0) = cvt_pk_bf16(bflo(w) * s, bfhi(w) * s); }
        asm volatile("s_waitcnt lgkmcnt(0)" ::: "memory");
        {
            LAS bf16_t* kt = (LAS bf16_t*)A;
#pragma unroll 8
            for (int i = 0; i < 64; ++i) { const unsigned w = *(const unsigned*)(qkvn + (size_t)(tok0 + i) * 2304 + 768 + hd * 128 + 2 * lane);
                *(LAS unsigned*)(kt + i * 128 + 2 * lane) = w; }
            asm volatile("s_waitcnt lgkmcnt(0)" ::: "memory");
#pragma unroll
            for (int hh = 0; hh < 2; ++hh) { const int dk = lane + 64 * hh;
#pragma unroll
                for (int p8 = 0; p8 < 8; ++p8) { float v[8];
#pragma unroll
                    for (int e = 0; e < 8; ++e) { const int pp = p8 * 8 + e; const int c = (pp & 32) + perm32k(pp & 31);
                        v[e] = bf1(kt[c * 128 + dk]) * __builtin_amdgcn_readlane(edl, c); }
                    u32x4 w; w.x = cvt_pk_bf16(v[0], v[1]); w.y = cvt_pk_bf16(v[2], v[3]); w.z = cvt_pk_bf16(v[4], v[5]); w.w = cvt_pk_bf16(v[6], v[7]);
                    *(u32x4*)(KDT + (size_t)ci * 8192 + dk * 64 + p8 * 8) = w; } }
            asm volatile("s_waitcnt lgkmcnt(0)" ::: "memory");
        }
    }
}

constexpr int RB_W = 0, RB_QD = 17408, RB_KD = 34816, RB_QK = 34816 + 18432, RB_SZ = 62464;
__device__ __forceinline__ void rec_load(u32x4 (&r)[7], const bf16_t* Wc, const bf16_t* QDc, const bf16_t* KDT, const bf16_t* QKc, int ci, int tid) {
    r[0] = *(const u32x4*)(Wc + (size_t)ci * 8192 + (size_t)tid * 8); r[1] = *(const u32x4*)(Wc + (size_t)ci * 8192 + (size_t)(512 + tid) * 8);
    r[2] = *(const u32x4*)(QDc + (size_t)ci * 8192 + (size_t)tid * 8); r[3] = *(const u32x4*)(QDc + (size_t)ci * 8192 + (size_t)(512 + tid) * 8);
    r[4] = *(const u32x4*)(KDT + (size_t)ci * 8192 + (size_t)tid * 8); r[5] = *(const u32x4*)(KDT + (size_t)ci * 8192 + (size_t)(512 + tid) * 8);
    r[6] = *(const u32x4*)(QKc + (size_t)ci * 4096 + (size_t)tid * 8);
}
__device__ __forceinline__ void rec_store(const u32x4 (&r)[7], LAS unsigned char* buf, int tid) {
#pragma unroll
    for (int k = 0; k < 2; ++k) { const int q = tid + 512 * k;
        *(LAS u32x4*)(buf + RB_W + (q >> 4) * 272 + (q & 15) * 16) = r[k];
        *(LAS u32x4*)(buf + RB_QD + (q >> 4) * 272 + (q & 15) * 16) = r[2 + k];
        *(LAS u32x4*)(buf + RB_KD + (q >> 3) * 144 + (q & 7) * 16) = r[4 + k]; }
    *(LAS u32x4*)(buf + RB_QK + (tid >> 3) * 144 + (tid & 7) * 16) = r[6];
}
__device__ __forceinline__ void gdn_recur_prompt(const Params& p, LAS unsigned char* lds, int j, int bh) {
    const bf16_t* Wc = (const bf16_t*)(p.ws + WS_WC); const bf16_t* QDc = (const bf16_t*)(p.ws + WS_QDC); const bf16_t* KDT = (const bf16_t*)(p.ws + WS_KDT); const bf16_t* QKc = (const bf16_t*)(p.ws + WS_QKC);
    const float* UT = (const float*)(p.ws + WS_UT); const float* GL = (const float*)(p.ws + WS_GL); float* ob = (float*)(p.ws + WS_O);
    const int tid = otid(), lane = tid & 63, wave = __builtin_amdgcn_readfirstlane(tid >> 6), c16 = lane & 15, g = lane >> 4;
    const int b = bh / 6, hd = bh % 6, dv0 = wave * 16;
    f32x4 S[8];
#pragma unroll
    for (int i = 0; i < 8; ++i) S[i] = (f32x4){0.f, 0.f, 0.f, 0.f};
    u32x4 rg[7];
    rec_load(rg, Wc, QDc, KDT, QKc, bh * 32, tid);
    rec_store(rg, lds, tid);
    __syncthreads();
#pragma unroll 1
    for (int n = 0; n < 32; ++n) {
        const int ci = bh * 32 + n;
        LAS unsigned char* buf = lds + (n & 1) * RB_SZ;
        if (n + 1 < 32) rec_load(rg, Wc, QDc, KDT, QKc, ci + 1, tid);
        f32x4 u[4];
#pragma unroll
        for (int ct = 0; ct < 4; ++ct) u[ct] = *(const f32x4*)(UT + (size_t)ci * 8192 + (size_t)(dv0 + c16) * 64 + 16 * ct + 4 * g);
        const float egl = GL[ci];
        bf16x8 bS[4];
#pragma unroll
        for (int ks = 0; ks < 4; ++ks) bS[ks] = pack8(S[2 * ks], S[2 * ks + 1]);
        f32x4 vn[4], o[4];
#pragma unroll
        for (int ct = 0; ct < 4; ++ct) {
            f32x4 ws = (f32x4){0.f, 0.f, 0.f, 0.f}, oo = (f32x4){0.f, 0.f, 0.f, 0.f};
#pragma unroll
            for (int ks = 0; ks < 4; ++ks) {
                const bf16x8 wf = *(const LAS bf16x8*)(buf + RB_W + (16 * ct + c16) * 272 + ks * 64 + g * 16);
                const bf16x8 qf = *(const LAS bf16x8*)(buf + RB_QD + (16 * ct + c16) * 272 + ks * 64 + g * 16);
                ws = __builtin_amdgcn_mfma_f32_16x16x32_bf16(wf, bS[ks], ws, 0, 0, 0);
                oo = __builtin_amdgcn_mfma_f32_16x16x32_bf16(qf, bS[ks], oo, 0, 0, 0);
            }
            vn[ct] = u[ct] - ws; o[ct] = oo;
        }
        bf16x8 bV[2];
#pragma unroll
        for (int k2 = 0; k2 < 2; ++k2) bV[k2] = pack8(vn[2 * k2], vn[2 * k2 + 1]);
#pragma unroll
        for (int ct = 0; ct < 4; ++ct) {
#pragma unroll
            for (int k2 = 0; k2 < 2; ++k2) { const bf16x8 af = *(const LAS bf16x8*)(buf + RB_QK + (16 * ct + c16) * 144 + k2 * 64 + g * 16);
                o[ct] = __builtin_amdgcn_mfma_f32_16x16x32_bf16(af, bV[k2], o[ct], 0, 0, 0); }
#pragma unroll
            for (int r = 0; r < 4; ++r) ob[(size_t)(b * 2048 + n * 64 + 16 * ct + 4 * g + r) * 768 + hd * 128 + dv0 + c16] = o[ct][r];
        }
#pragma unroll
        for (int dt = 0; dt < 8; ++dt) { f32x4 s = S[dt] * egl;
#pragma unroll
            for (int k2 = 0; k2 < 2; ++k2) { const bf16x8 af = *(const LAS bf16x8*)(buf + RB_KD + (16 * dt + c16) * 144 + k2 * 64 + g * 16);
                s = __builtin_amdgcn_mfma_f32_16x16x32_bf16(af, bV[k2], s, 0, 0, 0); }
            S[dt] = s; }
        if (n + 1 < 32) rec_store(rg, lds + ((n + 1) & 1) * RB_SZ, tid);
        __syncthreads();
    }
    float* so = p.out + O_GSP + ((size_t)(j * 8 + b) * 6 + hd) * 16384;
#pragma unroll
    for (int dt = 0; dt < 8; ++dt)
#pragma unroll
        for (int r = 0; r < 4; ++r) so[(size_t)(16 * dt + 4 * g + r) * 128 + dv0 + c16] = S[dt][r];
}
__device__ __forceinline__ void gdn_naive_item(const Params& p, LAS unsigned char* lds, int row0, int T, int hd, const float* s0, float* sout) {
    const bf16_t* qkvn = (const bf16_t*)(p.ws + WS_QKVN); const float* gb = (const float*)(p.ws + WS_GB); float* ob = (float*)(p.ws + WS_O);
    const int tid = otid(), e = tid & 127, part = tid >> 7;
    LAS float* kq = (LAS float*)lds;
    LAS float* red = kq + 1024;
    LAS float* red2 = red + 512;
    float S[32];
#pragma unroll
    for (int i = 0; i < 32; ++i) S[i] = s0 ? s0[(size_t)(part * 32 + i) * 128 + e] : 0.f;
#pragma unroll 1
    for (int tb = 0; tb < T; tb += 4) {
        __syncthreads();
        for (int i = tid; i < 1024; i += 512) { const int t = i >> 8, s = (i >> 7) & 1, d = i & 127;
            kq[i] = bf1(qkvn[(size_t)(row0 + tb + t) * 2304 + (s == 0 ? 768 : 0) + hd * 128 + d]); }
        __syncthreads();
#pragma unroll 1
        for (int t = 0; t < 4; ++t) {
            const int row = row0 + tb + t;
            const float a = __expf(gb[(size_t)row * 12 + hd]), bt = gb[(size_t)row * 12 + 6 + hd];
            const float v = bf1(qkvn[(size_t)row * 2304 + 1536 + hd * 128 + e]);
            float ps = 0.f;
#pragma unroll
            for (int i = 0; i < 32; ++i) ps += S[i] * kq[(t * 2 + 0) * 128 + part * 32 + i];
            red[part * 128 + e] = ps;
            __syncthreads();
            const float kS = red[e] + red[128 + e] + red[256 + e] + red[384 + e];
            const float vnew = bt * (v - a * kS);
            float po = 0.f;
#pragma unroll
            for (int i = 0; i < 32; ++i) { S[i] = a * S[i] + kq[(t * 2 + 0) * 128 + part * 32 + i] * vnew; po += S[i] * kq[(t * 2 + 1) * 128 + part * 32 + i]; }
            red2[part * 128 + e] = po;
            __syncthreads();
            if (part == 0) ob[(size_t)row * 768 + hd * 128 + e] = (red2[e] + red2[128 + e] + red2[256 + e] + red2[384 + e]) * 0.08838834764831845f;
        }
    }
#pragma unroll
    for (int i = 0; i < 32; ++i) sout[(size_t)(part * 32 + i) * 128 + e] = S[i];
    __syncthreads();
}
__device__ __forceinline__ void gdn_sample_item(const Params& p, LAS unsigned char* lds, int j, int item) {
    const int sb = item / 6, hd = item % 6;
    gdn_naive_item(p, lds, TP + sb * 4, 4, hd, p.in[7] + ((size_t)(j * 128 + sb) * 6 + hd) * 16384, p.out + O_GSS + ((size_t)(j * 128 + sb) * 6 + hd) * 16384);
}
__device__ __forceinline__ void phase_gdn_post(const Params& p, int j) {
    const bf16_t* h = (const bf16_t*)(p.ws + WS_H); const float* ob = (const float*)(p.ws + WS_O); bf16_t* cat = (bf16_t*)(p.ws + WS_CAT);
    const int tid_ = otid(); const int lane = tid_ & 63, wave = __builtin_amdgcn_readfirstlane(tid_ >> 6);
    const int gw = blockIdx.x * 8 + wave, NGW = gridDim.x * 8;
    const f32x2 nw = *(const f32x2*)(p.in[16] + j * 128 + 2 * lane);
    for (int it = gw; it < TT * 6; it += NGW) {
        const int row = it / 6, hd = it % 6;
        const f32x2 o = *(const f32x2*)(ob + (size_t)row * 768 + hd * 128 + 2 * lane);
        const float ss = wave_sum(o[0] * o[0] + o[1] * o[1]);
        const float r = 1.f / sqrtf(ss * (1.f / 128.f) + 1e-6f);
        const unsigned zw = *(const unsigned*)(h + (size_t)row * NHB + 2304 + hd * 128 + 2 * lane);
        const float y0 = o[0] * r * nw[0] * silu_f(bflo(zw)), y1 = o[1] * r * nw[1] * silu_f(bfhi(zw));
        *(unsigned*)(cat + (size_t)row * DM + hd * 128 + 2 * lane) = cvt_pk_bf16(y0, y1);
    }
}

__global__ void __launch_bounds__(512, 2) fwd_megakernel(Params p) {
    extern __shared__ __attribute__((aligned(16))) unsigned char lds_raw[];
    LAS unsigned char* lds = (LAS unsigned char*)lds_raw;
    cg::grid_group grid = cg::this_grid();
    unsigned char* ws = p.ws;
    float* xf = (float*)(ws + WS_XF); bf16_t* xb = (bf16_t*)(ws + WS_XB);
    bf16_t* hbuf = (bf16_t*)(ws + WS_H); bf16_t* cat = (bf16_t*)(ws + WS_CAT);
    bf16_t* hu = (bf16_t*)(ws + WS_HU); bf16_t* gact = (bf16_t*)(ws + WS_GACT);
    const bf16_t* Kb = (const bf16_t*)(ws + WS_KB); const bf16_t* Vt = (const bf16_t*)(ws + WS_VT);
    const int bid = blockIdx.x, G = gridDim.x;

    phase_prep(p, lds);
    grid.sync();
    {
        EpiKV E{p.out + O_MK, p.out + O_MV, (bf16_t*)(ws + WS_KB), (bf16_t*)(ws + WS_VT)};
        run_gemm(lds, (const bf16_t*)(ws + WS_MEMB), (const bf16_t*)(ws + WS_WKV), 2048, 2048, DM, E, (bid + 64) % G);
    }
#pragma unroll 1
    for (int l = 0; l < 4; ++l) {
        const int j = l >> 1; const bool isB = (l & 1) != 0;
        if (!isB) {
            { EpiStoreBf16 E{hbuf, NHA}; run_gemm(lds, xb, (const bf16_t*)(ws + WS_WINA) + (size_t)j * NHA * DM, TT, NHA, DM, E, bid); }
            grid.sync();
            phase_mixA_elem(p, j);
#ifdef NAIVE_ATTN
            for (int it = bid; it < 256; it += G) attn_prompt_item_naive(lds, hbuf, NHA, 2304, p.out + O_MK, p.out + O_MV, cat, l, it);
#else
            for (int it = bid; it < 256; it += G) attn_prompt_item(lds, hbuf, NHA, 2304, Kb, Vt, cat, l, it);
#endif
            for (int it = bid; it < 256; it += G) attn_sample_item(lds, hbuf, NHA, 2304, p.in[3], p.in[4], cat, l, it);
            grid.sync();
            { EpiResid E{xf, DM}; run_gemm(lds, cat, (const bf16_t*)(ws + WS_WOUTA) + (size_t)j * DM * DM, TT, DM, DM, E, bid); }
        } else {
            { EpiStoreBf16 E{hbuf, NHB}; run_gemm(lds, xb, (const bf16_t*)(ws + WS_WINB) + (size_t)j * NHB * DM, TT, NHB, DM, E, bid); }
            grid.sync();
            phase_gdn_pre(p, j);
            grid.sync();
#ifndef NAIVE_GDN
            phase_gdn_prep(p, lds);
            grid.sync();
#endif
#ifdef NAIVE_GDN
            if (bid < 48) gdn_naive_item(p, lds, (bid / 6) * 2048, 2048, bid % 6, nullptr, p.out + O_GSP + ((size_t)(j * 8 + bid / 6) * 6 + bid % 6) * 16384);
#else
            if (bid < 48) gdn_recur_prompt(p, lds, j, bid);
#endif
            else {
                const int nb = G - 48;
                for (int it = bid - 48; it < 768; it += nb) gdn_sample_item(p, lds, j, it);
#ifdef NAIVE_ATTN
                for (int it = bid - 48; it < 256; it += nb) attn_prompt_item_naive(lds, hbuf, NHB, 3072, p.out + O_MK, p.out + O_MV, cat, l, it);
#else
                for (int it = bid - 48; it < 256; it += nb) attn_prompt_item(lds, hbuf, NHB, 3072, Kb, Vt, cat, l, it);
#endif
                for (int it = bid - 48; it < 256; it += nb) attn_sample_item(lds, hbuf, NHB, 3072, p.in[3], p.in[4], cat, l, it);
            }
            grid.sync();
            phase_gdn_post(p, j);
            grid.sync();
            { EpiResid E{xf, DM}; run_gemm(lds, cat, (const bf16_t*)(ws + WS_WOUTB) + (size_t)j * DM * DM, TT, DM, DM, E, bid); }
        }
        grid.sync();
        phase_ln(xf, xb, p.in[19] + l * DM, p.in[20] + l * DM, nullptr);
        grid.sync();
        { EpiStoreBf16 E{hu, NUP}; run_gemm(lds, xb, (const bf16_t*)(ws + WS_WUP) + (size_t)l * NUP * DM, TT, NUP, DM, E, bid); }
        grid.sync();
        phase_convgate(p, l);
        grid.sync();
        { EpiResid E{xf, DM}; run_gemm(lds, gact, (const bf16_t*)(ws + WS_WDOWN) + (size_t)l * DM * DFF, TT, DM, DFF, E, bid); }
        grid.sync();
        phase_ln(xf, xb, p.in[21] + l * DM, p.in[22] + l * DM, l == 3 ? p.out + O_Y : nullptr);
        if (l < 3) grid.sync();
    }
}

extern "C" void kernel_launch(void* const* d_in, const int* in_sizes, int n_in, void* d_out, int out_size, void* d_ws, size_t ws_size, hipStream_t stream) {
    static int grid_blocks = 0;
    if (grid_blocks == 0) {
        if (n_in != 26 || (size_t)out_size != O_END || ws_size < WS_END) { fprintf(stderr, "kernel_launch: unexpected shapes n_in %d out %d (want %zu) ws %zu (need %zu)\n", n_in, out_size, (size_t)O_END, ws_size, (size_t)WS_END); grid_blocks = -1; return; }
        int dev = 0, cus = 0, per_cu = 0;
        hipGetDevice(&dev);
        hipDeviceGetAttribute(&cus, hipDeviceAttributeMultiprocessorCount, dev);
        if (hipFuncSetAttribute((const void*)fwd_megakernel, hipFuncAttributeMaxDynamicSharedMemorySize, LDS_BYTES) != hipSuccess) { fprintf(stderr, "kernel_launch: hipFuncSetAttribute failed\n"); grid_blocks = -1; return; }
        hipOccupancyMaxActiveBlocksPerMultiprocessor(&per_cu, (const void*)fwd_megakernel, 512, LDS_BYTES);
        if (per_cu < 1) { fprintf(stderr, "kernel_launch: occupancy query says %d blocks/CU\n", per_cu); grid_blocks = -1; return; }
        grid_blocks = cus;
        if (grid_blocks > 256) grid_blocks = 256;
    }
    if (grid_blocks < 0) return;
    Params p{};
    for (int i = 0; i < 26; ++i) p.in[i] = (const float*)d_in[i];
    p.out = (float*)d_out; p.ws = (unsigned char*)d_ws;
    void* args[] = {&p};
    hipError_t e = hipLaunchCooperativeKernel((const void*)fwd_megakernel, dim3(grid_blocks), dim3(512), args, LDS_BYTES, stream);
    if (e != hipSuccess) fprintf(stderr, "cooperative launch failed: %s (grid %d)\n", hipGetErrorString(e), grid_blocks);
}
```

```cpp
#include <hip/hip_runtime.h>
#include <hip/hip_cooperative_groups.h>
#include <cstdio>
namespace cg = cooperative_groups;
namespace pg8 {
#define PG8_LAS __attribute__((address_space(3)))
typedef unsigned short bf16_t;
typedef short bf16x8 __attribute__((ext_vector_type(8)));
typedef float f32x4 __attribute__((ext_vector_type(4)));
typedef unsigned u32x4 __attribute__((ext_vector_type(4)));
constexpr int BM = 256, BK = 64, HALF = 128, HTB = HALF * BK * 2  , STAGE_BYTES = 8 * HTB, NXCD = 8, WGM = 8;

__host__ __device__ __forceinline__ int lds_byte(int r, int c) { const int st = (r >> 4) * 2 + (c >> 5), rr = r & 15, cc = c & 31, ob = rr * 64 + cc * 2; return st * 1024 + (ob ^ (((ob >> 9) & 1) << 5)); }
__host__ __device__ __forceinline__ void stage_rc(int b, int& R, int& C) { const int st = b / 1024, sb = b % 1024, swz = sb ^ (((sb >> 9) & 1) << 5); R = (st >> 1) * 16 + swz / 64; C = (st & 1) * 32 + (swz % 64) / 2; }
__host__ __device__ __forceinline__ int perm32(int rho) { const int n = rho >> 4, i = rho & 15; return 8 * (i >> 2) + 4 * n + (i & 3); }

struct Unit { int pm, pn; };
struct Gemm { const bf16_t* A; const bf16_t* Bt; int M, N, K; };

struct StaticOrder {
    int nM, nN, nwg, G, c;
    __host__ __device__ void init(int M, int N, int G_, int c_) { nM = M / BM; nN = N / BM; nwg = nM * nN; G = G_; c = c_; }
    __host__ __device__ bool next(int i, Unit& u) const {
        const long L = (long)i * G + c; if (L >= nwg) return false;
        int wgid = (int)L; { const int q = nwg / NXCD, r = nwg % NXCD, xcd = wgid % NXCD, off = wgid / NXCD; wgid = (xcd < r ? xcd * (q + 1) : r * (q + 1) + (xcd - r) * q) + off; }
        const int nig = WGM * nN, gid = wgid / nig, fm = gid * WGM, gsz = (nM - fm) < WGM ? (nM - fm) : WGM;
        u.pm = fm + ((wgid % nig) % gsz); u.pn = (wgid % nig) / gsz; return true;
    }
    __device__ __forceinline__ void a_ready(const Unit&) const {}
    __device__ __forceinline__ void done(const Unit&) const {}
};
__device__ __forceinline__ unsigned cvt_pk_bf16(float lo, float hi) { unsigned r; asm volatile("v_cvt_pk_bf16_f32 %0, %1, %2" : "=v"(r) : "v"(lo), "v"(hi)); return r; }
typedef float f32x2 __attribute__((ext_vector_type(2)));
template <class Epi, class Sched, bool STAMP = false>
__device__ __forceinline__ void gemm_phase(PG8_LAS unsigned char* lds, const Gemm g, const Sched& S, const Epi& E, unsigned long long* stamps) {
    int tid = threadIdx.x; asm volatile("" : "+v"(tid)); const int wid = __builtin_amdgcn_readfirstlane(tid >> 6), lane = tid & 63, wr = wid >> 2, wc = wid & 3, fr = lane & 15, fq = lane >> 4;
    const int K = g.K, nt = K / BK;
    int ts_lo = 0, ts_hi = 0, nts = 0; const unsigned long long rt_entry = STAMP ? (unsigned long long)wall_clock64() : 0ull;
#define PG8_STAMP() do { if (STAMP && wid == 0 && nts < 64) { const unsigned long long _c = (unsigned long long)clock64(); \
        ts_lo = (lane == nts) ? (int)(unsigned)_c : ts_lo; ts_hi = (lane == nts) ? (int)(unsigned)(_c >> 32) : ts_hi; ++nts; } } while (0)
    PG8_STAMP();
    unsigned voffA[2], voffB[2];
#pragma unroll
    for (int i = 0; i < 2; ++i) { int R, C; stage_rc(tid * 16 + i * 8192, R, C); const int Rb = Epi::PERM ? ((R & ~31) + perm32(R & 31)) : R;
        voffA[i] = (unsigned)(R * K + C) * 2u; voffB[i] = (unsigned)(Rb * K + C) * 2u; }
    const size_t kstep = (size_t)(BK * 2);
    const size_t hstep = (size_t)HALF * K * 2;
    const size_t tstep = 2 * hstep;
    const unsigned ldsw = (unsigned)wid * 1024u;
    const int aoff = lds_byte(wr * 64 + fr, fq * 8), boff = lds_byte(wc * 32 + fr, fq * 8);
#define PG8_SA(b, h) (((b) * 2 + (h)) * HTB)
#define PG8_SB(b, h) ((4 + (b) * 2 + (h)) * HTB)
#define PG8_STAGE(bufoff, gbase, voff) do { _Pragma("unroll") for (int _i = 0; _i < 2; ++_i) \
        __builtin_amdgcn_global_load_lds((const unsigned*)((const char*)(gbase) + (voff)[_i]), (PG8_LAS unsigned*)(lds + (bufoff) + ldsw + _i * 8192), 16, 0, 0); } while (0)
#define PG8_LDA(dst, b, h) do { _Pragma("unroll") for (int m = 0; m < 4; ++m) _Pragma("unroll") for (int k = 0; k < 2; ++k) dst[m][k] = *(const PG8_LAS bf16x8*)(lds + PG8_SA(b, h) + aoff + m * 2048 + k * 1024); } while (0)
#define PG8_LDB(dst, b, h) do { _Pragma("unroll") for (int n = 0; n < 2; ++n) _Pragma("unroll") for (int k = 0; k < 2; ++k) dst[n][k] = *(const PG8_LAS bf16x8*)(lds + PG8_SB(b, h) + boff + n * 2048 + k * 1024); } while (0)
#define PG8_MMA(ai, bj, At, Bt) do { __builtin_amdgcn_s_setprio(1); _Pragma("unroll") for (int m = 0; m < 4; ++m) _Pragma("unroll") for (int n = 0; n < 2; ++n) _Pragma("unroll") for (int k = 0; k < 2; ++k) \
        acc[ai][bj][m][n] = __builtin_amdgcn_mfma_f32_16x16x32_bf16(Bt[n][k], At[m][k], acc[ai][bj][m][n], 0, 0, 0); __builtin_amdgcn_s_setprio(0); } while (0)
#define PG8_WAIT_V(n) asm volatile("s_waitcnt vmcnt(" #n ")" ::: "memory")
#define PG8_WAIT_L(n) asm volatile("s_waitcnt lgkmcnt(" #n ")" ::: "memory")
#define PG8_BAR __builtin_amdgcn_s_barrier()
#define PG8_SCHED __builtin_amdgcn_sched_barrier(0)
    Unit cur, nxt; int ui = 0;
    if (!S.next(0, cur)) return;
    f32x4 acc[2][2][4][2];
#pragma unroll
    for (int a = 0; a < 2; ++a)
#pragma unroll
        for (int b = 0; b < 2; ++b)
#pragma unroll
            for (int m = 0; m < 4; ++m)
#pragma unroll
                for (int n = 0; n < 2; ++n) acc[a][b][m][n] = (f32x4){0.f, 0.f, 0.f, 0.f};
    bf16x8 At[4][2], B0[2][2], B1[2][2];
    const char* cA = (const char*)g.A + (size_t)cur.pm * tstep; const char* cB = (const char*)g.Bt + (size_t)cur.pn * tstep;
    S.a_ready(cur);
    PG8_STAGE(PG8_SB(0, 0), cB, voffB); PG8_STAGE(PG8_SA(0, 0), cA, voffA); PG8_STAGE(PG8_SB(0, 1), cB + hstep, voffB); PG8_STAGE(PG8_SA(0, 1), cA + hstep, voffA);
    if (wr == 1) PG8_BAR;
    PG8_WAIT_V(4); PG8_BAR;
    PG8_STAGE(PG8_SB(1, 0), cB + kstep, voffB); PG8_STAGE(PG8_SA(1, 0), cA + kstep, voffA); PG8_STAGE(PG8_SB(1, 1), cB + hstep + kstep, voffB);
    PG8_WAIT_V(6); PG8_BAR;
    PG8_STAMP();
    for (;;) {
        const bool has_next = S.next(ui + 1, nxt);
        const char* nA = has_next ? (const char*)g.A + (size_t)nxt.pm * tstep : cA; const char* nB = has_next ? (const char*)g.Bt + (size_t)nxt.pn * tstep : cB;
        for (int t = 0; t < nt; t += 2) {
            const bool last = (t == nt - 2);
            const char* a1 = cA + (size_t)(t + 1) * kstep;
            const char* a2 = last ? nA : cA + (size_t)(t + 2) * kstep; const char* b2 = last ? nB : cB + (size_t)(t + 2) * kstep;
            const char* a3 = a2 + kstep; const char* b3 = b2 + kstep;
            if (last && has_next) S.a_ready(nxt);
            PG8_LDB(B0, 0, 0); PG8_SCHED; PG8_LDA(At, 0, 0); PG8_STAGE(PG8_SA(1, 1), a1 + hstep, voffA);
            PG8_WAIT_L(8); PG8_BAR; PG8_WAIT_L(0); PG8_MMA(0, 0, At, B0); PG8_BAR; PG8_SCHED;
            PG8_LDB(B1, 0, 1); PG8_STAGE(PG8_SB(0, 0), b2, voffB);
            PG8_BAR; PG8_WAIT_L(0); PG8_MMA(0, 1, At, B1); PG8_BAR;
            PG8_LDA(At, 0, 1); PG8_STAGE(PG8_SA(0, 0), a2, voffA);
            PG8_BAR; PG8_WAIT_L(0); PG8_MMA(1, 0, At, B0); PG8_BAR; PG8_SCHED;
            PG8_STAGE(PG8_SB(0, 1), b2 + hstep, voffB);
            PG8_WAIT_V(6); PG8_BAR; PG8_MMA(1, 1, At, B1); PG8_BAR;
            PG8_LDB(B0, 1, 0); PG8_SCHED; PG8_LDA(At, 1, 0); PG8_STAGE(PG8_SA(0, 1), a2 + hstep, voffA);
            PG8_WAIT_L(8); PG8_BAR; PG8_WAIT_L(0); PG8_MMA(0, 0, At, B0); PG8_BAR; PG8_SCHED;
            PG8_LDB(B1, 1, 1); PG8_STAGE(PG8_SB(1, 0), b3, voffB);
            PG8_BAR; PG8_WAIT_L(0); PG8_MMA(0, 1, At, B1); PG8_BAR;
            PG8_LDA(At, 1, 1); PG8_STAGE(PG8_SA(1, 0), a3, voffA);
            PG8_BAR; PG8_WAIT_L(0); PG8_MMA(1, 0, At, B0); PG8_BAR; PG8_SCHED;
            PG8_STAGE(PG8_SB(1, 1), b3 + hstep, voffB);
            PG8_WAIT_V(6); PG8_BAR; PG8_MMA(1, 1, At, B1); PG8_BAR;
        }
        PG8_STAMP();
        if constexpr (!Epi::AFTER_DRAIN) { E(acc, cur, wr, wc, fr, fq); S.done(cur); }
        PG8_STAMP();
        if (!has_next) break;
#pragma unroll
        for (int a = 0; a < 2; ++a)
#pragma unroll
            for (int b = 0; b < 2; ++b)
#pragma unroll
                for (int m = 0; m < 4; ++m)
#pragma unroll
                    for (int n = 0; n < 2; ++n) acc[a][b][m][n] = (f32x4){0.f, 0.f, 0.f, 0.f};
        cur = nxt; cA = nA; cB = nB; ++ui;
    }
    PG8_WAIT_V(0);
    if (wr == 0) PG8_BAR;
    PG8_BAR;
    if constexpr (Epi::AFTER_DRAIN) { E.fused(acc, cur, wr, wc, fr, fq, lds, wid, lane); S.done(cur); }
    PG8_STAMP();
    if (STAMP && wid == 0) { stamps[lane] = lane < nts ? (((unsigned long long)(unsigned)ts_hi << 32) | (unsigned)ts_lo) : 0ull;
        if (lane == 62) stamps[62] = rt_entry; if (lane == 63) stamps[63] = (unsigned long long)wall_clock64(); }
#undef PG8_STAMP
#undef PG8_SA
#undef PG8_SB
#undef PG8_STAGE
#undef PG8_LDA
#undef PG8_LDB
#undef PG8_MMA
#undef PG8_WAIT_V
#undef PG8_WAIT_L
#undef PG8_BAR
#undef PG8_SCHED
}
}

#define LAS __attribute__((address_space(3)))
using pg8::bf16_t; using pg8::bf16x8; using pg8::f32x4; using pg8::u32x4; using pg8::cvt_pk_bf16;
typedef unsigned u32x2 __attribute__((ext_vector_type(2)));
typedef float f32x2 __attribute__((ext_vector_type(2)));

constexpr int TP = 16384, TS = 512, TT = 16896, DM = 1024;
constexpr int NHA = 2560, NHB = 3584, DFF = 2816, NUP = 5632;
constexpr float ALPHA = 1.6817928305074292f;
constexpr int LDS_BYTES = 139264;

constexpr size_t WS_WINA = 0;
constexpr size_t WS_WOUTA = WS_WINA + (size_t)2 * NHA * DM * 2;
constexpr size_t WS_WINB = WS_WOUTA + (size_t)2 * DM * DM * 2;
constexpr size_t WS_WOUTB = WS_WINB + (size_t)2 * NHB * DM * 2;
constexpr size_t WS_WKV = WS_WOUTB + (size_t)2 * DM * DM * 2;
constexpr size_t WS_WUP = WS_WKV + (size_t)2048 * DM * 2;
constexpr size_t WS_WDOWN = WS_WUP + (size_t)4 * NUP * DM * 2;
constexpr size_t WS_XF = WS_WDOWN + (size_t)4 * DM * DFF * 2;
constexpr size_t WS_XB = WS_XF + (size_t)TT * DM * 4;
constexpr size_t WS_MEMB = WS_XB + (size_t)TT * DM * 2;
constexpr size_t WS_KB = WS_MEMB + (size_t)2048 * DM * 2;
constexpr size_t WS_VT = WS_KB + (size_t)4 * 8 * 4 * 256 * 64 * 2;
constexpr size_t WS_R = WS_VT + (size_t)4 * 8 * 4 * 256 * 64 * 2;
constexpr size_t WS_H = WS_R;
constexpr size_t WS_CAT = WS_H + (size_t)TT * NHB * 2;
constexpr size_t WS_QKVN = WS_CAT + (size_t)TT * DM * 2;
constexpr size_t WS_GB = WS_QKVN + (size_t)TT * 2304 * 2;
constexpr size_t WS_WC = WS_GB + (size_t)TT * 12 * 4;
constexpr size_t WS_QDC = WS_WC + (size_t)1536 * 16384;
constexpr size_t WS_KDT = WS_QDC + (size_t)1536 * 16384;
constexpr size_t WS_QKC = WS_KDT + (size_t)1536 * 16384;
constexpr size_t WS_UT = WS_QKC + (size_t)1536 * 8192;
constexpr size_t WS_GL = WS_UT + (size_t)1536 * 32768;
constexpr size_t WS_O = WS_GL + (size_t)1536 * 4 + 2048;
constexpr size_t WS_MIX_END = WS_O + (size_t)TT * 768 * 4;
constexpr size_t WS_HU = WS_R;
constexpr size_t WS_GACT = WS_HU + (size_t)TT * NUP * 2;
constexpr size_t WS_FFN_END = WS_GACT + (size_t)TT * DFF * 2;
constexpr size_t WS_END = WS_MIX_END > WS_FFN_END ? WS_MIX_END : WS_FFN_END;

constexpr size_t O_Y = 0;
constexpr size_t O_MK = O_Y + (size_t)TT * DM;
constexpr size_t O_MV = O_MK + (size_t)4 * 8 * 256 * 256;
constexpr size_t O_SCP = O_MV + (size_t)4 * 8 * 256 * 256;
constexpr size_t O_GCP = O_SCP + (size_t)2 * 8 * 2 * 768;
constexpr size_t O_GSP = O_GCP + (size_t)2 * 8 * 3 * 2304;
constexpr size_t O_FFP = O_GSP + (size_t)2 * 8 * 6 * 16384;
constexpr size_t O_SCS = O_FFP + (size_t)4 * 8 * 2 * NUP;
constexpr size_t O_GCS = O_SCS + (size_t)2 * 128 * 2 * 768;
constexpr size_t O_GSS = O_GCS + (size_t)2 * 128 * 3 * 2304;
constexpr size_t O_FFS = O_GSS + (size_t)2 * 128 * 6 * 16384;
constexpr size_t O_END = O_FFS + (size_t)4 * 128 * 2 * NUP;

#ifdef DIAG_GDN
constexpr size_t WS_NEED = WS_END + ((size_t)64 << 20);
#else
constexpr size_t WS_NEED = WS_END;
#endif
struct Params { const float* in[26]; float* out; unsigned char* ws; };
__device__ __forceinline__ int otid() { int t = threadIdx.x; asm volatile("" : "+v"(t)); return t; }

__device__ __forceinline__ float bflo(unsigned w) { return __uint_as_float(w << 16); }
__device__ __forceinline__ float bfhi(unsigned w) { return __uint_as_float(w & 0xffff0000u); }
__device__ __forceinline__ float bf1(bf16_t v) { return __uint_as_float((unsigned)v << 16); }
__device__ __forceinline__ float silu_f(float x) { return x / (1.f + __expf(-x)); }
__device__ __forceinline__ float wave_sum(float v) {
#pragma unroll
    for (int o = 1; o < 64; o <<= 1) v += __shfl_xor(v, o);
    return v;
}
__device__ __forceinline__ bf16x8 as_bf16x8(u32x4 v) { union { u32x4 u; bf16x8 b; } x; x.u = v; return x.b; }
__device__ __forceinline__ bf16x8 pack8(f32x4 a, f32x4 b) {
    u32x4 w; w.x = cvt_pk_bf16(a[0], a[1]); w.y = cvt_pk_bf16(a[2], a[3]); w.z = cvt_pk_bf16(b[0], b[1]); w.w = cvt_pk_bf16(b[2], b[3]);
    return as_bf16x8(w);
}
__device__ __forceinline__ int invperm32(int a) { return 8 * ((a & 15) >> 2) + (a & 3) + ((a >> 4) << 2); }
__device__ __forceinline__ int perm32k(int p) { const int g = p >> 3, jj = p & 7; return jj < 4 ? 4 * g + jj : 16 + 4 * g + (jj - 4); }

struct EpiStoreBf16 {
    static constexpr bool PERM = true, AFTER_DRAIN = false;
    bf16_t* O; int ldc;
    __device__ __forceinline__ void operator()(const f32x4 (&acc)[2][2][4][2], const pg8::Unit& u, int wr, int wc, int fr, int fq) const {
        const int row0 = u.pm * 256 + wr * 64 + fr, col0 = u.pn * 256 + wc * 32 + 8 * fq;
#pragma unroll
        for (int ai = 0; ai < 2; ++ai)
#pragma unroll
            for (int m = 0; m < 4; ++m) { bf16_t* rowp = O + (size_t)(row0 + ai * 128 + m * 16) * ldc + col0;
#pragma unroll
                for (int bj = 0; bj < 2; ++bj) { const f32x4 v0 = acc[ai][bj][m][0], v1 = acc[ai][bj][m][1];
                    u32x4 w; w.x = cvt_pk_bf16(v0[0], v0[1]); w.y = cvt_pk_bf16(v0[2], v0[3]); w.z = cvt_pk_bf16(v1[0], v1[1]); w.w = cvt_pk_bf16(v1[2], v1[3]);
                    *(u32x4*)(rowp + bj * 128) = w; } }
    }
};
struct EpiResid {
    static constexpr bool PERM = false, AFTER_DRAIN = false;
    float* X; int ldc;
    __device__ __forceinline__ void operator()(const f32x4 (&acc)[2][2][4][2], const pg8::Unit& u, int wr, int wc, int fr, int fq) const {
        const int row0 = u.pm * 256 + wr * 64 + fr, col0 = u.pn * 256 + wc * 32 + 4 * fq;
#pragma unroll
        for (int ai = 0; ai < 2; ++ai)
#pragma unroll
            for (int m = 0; m < 4; ++m) { float* rowp = X + (size_t)(row0 + ai * 128 + m * 16) * ldc + col0;
#pragma unroll
                for (int bj = 0; bj < 2; ++bj)
#pragma unroll
                    for (int n = 0; n < 2; ++n) { f32x4* p = (f32x4*)(rowp + bj * 128 + n * 16); const f32x4 x = *p; *p = x * ALPHA + acc[ai][bj][m][n]; } }
    }
};
struct EpiKV {
    static constexpr bool PERM = false, AFTER_DRAIN = false;
    float* outK; float* outV; bf16_t* Kb; bf16_t* Vt;
    __device__ __forceinline__ void operator()(const f32x4 (&acc)[2][2][4][2], const pg8::Unit& u, int wr, int wc, int fr, int fq) const {
        const int row0 = u.pm * 256 + wr * 64 + fr, col0 = u.pn * 256 + wc * 32 + 4 * fq;
#pragma unroll
        for (int ai = 0; ai < 2; ++ai)
#pragma unroll
            for (int m = 0; m < 4; ++m) { const int row = row0 + ai * 128 + m * 16; const int b = row >> 8, mm = row & 255;
#pragma unroll
                for (int bj = 0; bj < 2; ++bj)
#pragma unroll
                    for (int n = 0; n < 2; ++n) { const int col = col0 + bj * 128 + n * 16; const int l = col >> 9, e = col & 511; const f32x4 v = acc[ai][bj][m][n];
                        if (e < 256) { *(f32x4*)(outK + ((size_t)((l * 8 + b) * 256 + mm)) * 256 + e) = v;
                            u32x2 w; w.x = cvt_pk_bf16(v[0], v[1]); w.y = cvt_pk_bf16(v[2], v[3]);
                            *(u32x2*)(Kb + ((size_t)(((l * 8 + b) * 4 + (e >> 6)) * 256 + mm)) * 64 + (e & 63)) = w; }
                        else { const int e2 = e - 256; *(f32x4*)(outV + ((size_t)((l * 8 + b) * 256 + mm)) * 256 + e2) = v;
                            const unsigned w0 = cvt_pk_bf16(v[0], v[1]), w1 = cvt_pk_bf16(v[2], v[3]);
                            bf16_t* vp = Vt + ((size_t)(((l * 8 + b) * 4 + (e2 >> 6)) * 64 + (e2 & 63))) * 256 + mm;
                            vp[0] = (bf16_t)(w0 & 0xffffu); vp[256] = (bf16_t)(w0 >> 16); vp[512] = (bf16_t)(w1 & 0xffffu); vp[768] = (bf16_t)(w1 >> 16); } } }
    }
};

template <class Epi>
__device__ __forceinline__ void run_gemm(LAS unsigned char* lds, const bf16_t* A, const bf16_t* Bt, int M, int N, int K, const Epi& E, int c) {
    pg8::Gemm g{A, Bt, M, N, K}; pg8::StaticOrder S; S.init(M, N, (int)gridDim.x, c);
    pg8::gemm_phase<Epi, pg8::StaticOrder, false>(lds, g, S, E, nullptr);
}

__device__ __forceinline__ void p0_transpose_item(const float* W, int K, int Ns, int Nd, bool remap, bf16_t* WT, LAS float* scr, int item, int lane) {
    const int nblk = Nd / 32, kb = item / nblk, nb = item % nblk, k0 = 64 * kb, n0 = 32 * nb;
    const int n = n0 + (lane & 31); int sn = n;
    if (remap) sn = n < 3072 ? n : (n < 3328 ? n + 12 : (n < 3340 ? n - 256 : -1));
#pragma unroll 8
    for (int i = 0; i < 32; ++i) { const int kk = 2 * i + (lane >> 5); scr[kk * 33 + (lane & 31)] = sn >= 0 ? W[(size_t)(k0 + kk) * Ns + sn] : 0.f; }
    asm volatile("s_waitcnt lgkmcnt(0)" ::: "memory");
    const int c = lane & 7;
#pragma unroll
    for (int j = 0; j < 4; ++j) { const int nn = (lane >> 3) + 8 * j; const LAS float* s = scr + (8 * c) * 33 + nn;
        u32x4 o; o.x = cvt_pk_bf16(s[0 * 33], s[1 * 33]); o.y = cvt_pk_bf16(s[2 * 33], s[3 * 33]); o.z = cvt_pk_bf16(s[4 * 33], s[5 * 33]); o.w = cvt_pk_bf16(s[6 * 33], s[7 * 33]);
        *(u32x4*)(WT + (size_t)(n0 + nn) * K + k0 + 8 * c) = o; }
    asm volatile("s_waitcnt lgkmcnt(0)" ::: "memory");
}

__device__ __forceinline__ void phase_prep(const Params& p, LAS unsigned char* lds) {
    const int tid = otid(), lane = tid & 63, wave = __builtin_amdgcn_readfirstlane(tid >> 6);
    const int gw = blockIdx.x * 8 + wave, NGW = gridDim.x * 8;
    LAS float* scr = (LAS float*)(lds + wave * 16384);
    unsigned char* ws = p.ws;
    constexpr int I_INA = 16 * 80, I_OUT = 16 * 32, I_INB = 16 * 112, I_KV = 16 * 16, I_UP = 16 * 176, I_DN = 44 * 32;
    constexpr int NIT = 2 * I_INA + 2 * I_OUT + 2 * I_INB + 2 * I_OUT + 4 * I_KV + 4 * I_UP + 4 * I_DN;
    for (int it = gw; it < NIT; it += NGW) {
        int r = it;
        if (r < 2 * I_INA) { const int l = r / I_INA; r -= l * I_INA; p0_transpose_item(p.in[9] + (size_t)l * DM * NHA, DM, NHA, NHA, false, (bf16_t*)(ws + WS_WINA) + (size_t)l * NHA * DM, scr, r, lane); continue; } r -= 2 * I_INA;
        if (r < 2 * I_OUT) { const int l = r / I_OUT; r -= l * I_OUT; p0_transpose_item(p.in[11] + (size_t)l * DM * DM, DM, DM, DM, false, (bf16_t*)(ws + WS_WOUTA) + (size_t)l * DM * DM, scr, r, lane); continue; } r -= 2 * I_OUT;
        if (r < 2 * I_INB) { const int l = r / I_INB; r -= l * I_INB; p0_transpose_item(p.in[12] + (size_t)l * DM * 3340, DM, 3340, NHB, true, (bf16_t*)(ws + WS_WINB) + (size_t)l * NHB * DM, scr, r, lane); continue; } r -= 2 * I_INB;
        if (r < 2 * I_OUT) { const int l = r / I_OUT; r -= l * I_OUT; p0_transpose_item(p.in[17] + (size_t)l * DM * DM, DM, DM, DM, false, (bf16_t*)(ws + WS_WOUTB) + (size_t)l * DM * DM, scr, r, lane); continue; } r -= 2 * I_OUT;
        if (r < 4 * I_KV) { const int l = r / I_KV; r -= l * I_KV; p0_transpose_item(p.in[18] + (size_t)l * DM * 512, DM, 512, 512, false, (bf16_t*)(ws + WS_WKV) + (size_t)l * 512 * DM, scr, r, lane); continue; } r -= 4 * I_KV;
        if (r < 4 * I_UP) { const int l = r / I_UP; r -= l * I_UP; p0_transpose_item(p.in[23] + (size_t)l * DM * NUP, DM, NUP, NUP, false, (bf16_t*)(ws + WS_WUP) + (size_t)l * NUP * DM, scr, r, lane); continue; } r -= 4 * I_UP;
        { const int l = r / I_DN; r -= l * I_DN; p0_transpose_item(p.in[25] + (size_t)l * DFF * DM, DFF, DM, DM, false, (bf16_t*)(ws + WS_WDOWN) + (size_t)l * DM * DFF, scr, r, lane); }
    }
    const size_t gt = (size_t)blockIdx.x * 512 + tid, NT = (size_t)gridDim.x * 512;
    float* xf = (float*)(ws + WS_XF); bf16_t* xb = (bf16_t*)(ws + WS_XB); bf16_t* memb = (bf16_t*)(ws + WS_MEMB);
    for (size_t i = gt; i < (size_t)TT * 256; i += NT) {
        const f32x4 v = i < (size_t)TP * 256 ? ((const f32x4*)p.in[0])[i] : ((const f32x4*)p.in[1])[i - (size_t)TP * 256];
        ((f32x4*)xf)[i] = v; u32x2 w; w.x = cvt_pk_bf16(v[0], v[1]); w.y = cvt_pk_bf16(v[2], v[3]); ((u32x2*)xb)[i] = w;
    }
    for (size_t i = gt; i < (size_t)2048 * 256; i += NT) {
        const f32x4 v = ((const f32x4*)p.in[2])[i]; u32x2 w; w.x = cvt_pk_bf16(v[0], v[1]); w.y = cvt_pk_bf16(v[2], v[3]); ((u32x2*)memb)[i] = w;
    }
}

__device__ __forceinline__ void phase_ln(float* xf, bf16_t* xb, const float* gam, const float* bet, float* yout) {
    const int tid_ = otid(); const int lane = tid_ & 63, wave = __builtin_amdgcn_readfirstlane(tid_ >> 6);
    const int gw = blockIdx.x * 8 + wave, NGW = gridDim.x * 8;
    f32x4 gg[4], bb[4];
#pragma unroll
    for (int j = 0; j < 4; ++j) { gg[j] = ((const f32x4*)gam)[lane + 64 * j]; bb[j] = ((const f32x4*)bet)[lane + 64 * j]; }
    for (int row = gw; row < TT; row += NGW) {
        f32x4* xr = (f32x4*)(xf + (size_t)row * DM) + lane;
        f32x4 v[4]; float s = 0.f;
#pragma unroll
        for (int j = 0; j < 4; ++j) { v[j] = xr[64 * j]; s += (v[j][0] + v[j][1]) + (v[j][2] + v[j][3]); }
        const float mean = wave_sum(s) * (1.f / DM); float s2 = 0.f;
#pragma unroll
        for (int j = 0; j < 4; ++j) { v[j] = v[j] - mean; s2 += (v[j][0] * v[j][0] + v[j][1] * v[j][1]) + (v[j][2] * v[j][2] + v[j][3] * v[j][3]); }
        const float rstd = 1.f / sqrtf(wave_sum(s2) * (1.f / DM) + 1e-5f);
#pragma unroll
        for (int j = 0; j < 4; ++j) { const f32x4 o = v[j] * rstd * gg[j] + bb[j];
            if (yout) ((f32x4*)(yout + (size_t)row * DM))[lane + 64 * j] = o;
            else { xr[64 * j] = o; u32x2 w; w.x = cvt_pk_bf16(o[0], o[1]); w.y = cvt_pk_bf16(o[2], o[3]); ((u32x2*)(xb + (size_t)row * DM))[lane + 64 * j] = w; } }
    }
}

__device__ __forceinline__ void attn_prompt_item(LAS unsigned char* lds, const bf16_t* h, int ldh, int qoff, const bf16_t* Kb, const bf16_t* Vt, bf16_t* cat, int layer, int item) {
    const int tid = otid(), lane = tid & 63, wave = __builtin_amdgcn_readfirstlane(tid >> 6), c16 = lane & 15, g = lane >> 4;
    const int qc = item & 7, hd = (item >> 3) & 3, b = item >> 5;
    const size_t kvbase = ((size_t)((layer * 8 + b) * 4 + hd)) * 16384;
    constexpr int VOFF = 256 * 144;
#pragma unroll
    for (int i = 0; i < 4; ++i) { const int q = tid + 512 * i;
        const u32x4 kv = *(const u32x4*)(Kb + kvbase + (size_t)q * 8); *(LAS u32x4*)(lds + (q >> 3) * 144 + (q & 7) * 16) = kv;
        const u32x4 vv = *(const u32x4*)(Vt + kvbase + (size_t)q * 8); *(LAS u32x4*)(lds + VOFF + (q >> 5) * 528 + (q & 31) * 16) = vv; }
    __syncthreads();
#pragma unroll 1
    for (int qt = wave; qt < 16; qt += 8) {
        const int row = b * 2048 + qc * 256 + qt * 16 + c16;
        const bf16_t* qp = h + (size_t)row * ldh + qoff + hd * 64 + g * 8;
        const bf16x8 qf0 = *(const bf16x8*)qp, qf1 = *(const bf16x8*)(qp + 32);
        f32x4 acc[16];
#pragma unroll
        for (int kt = 0; kt < 16; ++kt) { acc[kt] = (f32x4){0.f, 0.f, 0.f, 0.f};
            const LAS unsigned char* kp = lds + (16 * kt + c16) * 144 + g * 16;
            const bf16x8 k0 = *(const LAS bf16x8*)kp, k1 = *(const LAS bf16x8*)(kp + 64);
            acc[kt] = __builtin_amdgcn_mfma_f32_16x16x32_bf16(k0, qf0, acc[kt], 0, 0, 0);
            acc[kt] = __builtin_amdgcn_mfma_f32_16x16x32_bf16(k1, qf1, acc[kt], 0, 0, 0); }
        float mx = -3.0e38f;
#pragma unroll
        for (int kt = 0; kt < 16; ++kt) mx = fmaxf(mx, fmaxf(fmaxf(acc[kt][0], acc[kt][1]), fmaxf(acc[kt][2], acc[kt][3])));
        mx = fmaxf(mx, __shfl_xor(mx, 16)); mx = fmaxf(mx, __shfl_xor(mx, 32));
        const float sc = 0.125f * 1.44269504089f; float sum = 0.f;
#pragma unroll
        for (int kt = 0; kt < 16; ++kt)
#pragma unroll
            for (int r = 0; r < 4; ++r) { const float e = __builtin_amdgcn_exp2f((acc[kt][r] - mx) * sc); acc[kt][r] = e; sum += e; }
        sum += __shfl_xor(sum, 16); sum += __shfl_xor(sum, 32);
        const float inv = 1.f / sum;
        f32x4 o[4];
#pragma unroll
        for (int dt = 0; dt < 4; ++dt) o[dt] = (f32x4){0.f, 0.f, 0.f, 0.f};
#pragma unroll
        for (int s = 0; s < 8; ++s) { const bf16x8 pf = pack8(acc[2 * s], acc[2 * s + 1]);
#pragma unroll
            for (int dt = 0; dt < 4; ++dt) { const LAS unsigned char* vp = lds + VOFF + (16 * dt + c16) * 528 + (32 * s + 4 * g) * 2;
                const u32x2 a0 = *(const LAS u32x2*)vp, a1 = *(const LAS u32x2*)(vp + 32);
                u32x4 av; av.x = a0.x; av.y = a0.y; av.z = a1.x; av.w = a1.y;
                o[dt] = __builtin_amdgcn_mfma_f32_16x16x32_bf16(as_bf16x8(av), pf, o[dt], 0, 0, 0); } }
#pragma unroll
        for (int dt = 0; dt < 4; ++dt) { u32x2 w; w.x = cvt_pk_bf16(o[dt][0] * inv, o[dt][1] * inv); w.y = cvt_pk_bf16(o[dt][2] * inv, o[dt][3] * inv);
            *(u32x2*)(cat + (size_t)row * DM + 768 + hd * 64 + 16 * dt + 4 * g) = w; }
    }
    __syncthreads();
}

__device__ __forceinline__ void attn_prompt_item_naive(LAS unsigned char* lds, const bf16_t* h, int ldh, int qoff, const float* outK, const float* outV, bf16_t* cat, int layer, int item) {
    const int tid = otid();
    const int qc = item & 7, hd = (item >> 3) & 3, b = item >> 5;
    LAS float* Ks = (LAS float*)lds; LAS float* Vs = Ks + 256 * 64;
    for (int i = tid; i < 256 * 64; i += 512) { const int m = i >> 6, d = i & 63; const size_t src = ((size_t)((layer * 8 + b) * 256 + m)) * 256 + hd * 64 + d; Ks[i] = outK[src]; Vs[i] = outV[src]; }
    __syncthreads();
    const int ql = tid & 255, half = tid >> 8;
    const int row = b * 2048 + qc * 256 + ql;
    float q[64];
#pragma unroll
    for (int d = 0; d < 64; ++d) q[d] = bf1(h[(size_t)row * ldh + qoff + hd * 64 + d]);
    float mx = -3.0e38f, l = 0.f; float acc[64];
#pragma unroll
    for (int d = 0; d < 64; ++d) acc[d] = 0.f;
#pragma unroll 1
    for (int m = half * 128; m < half * 128 + 128; ++m) {
        float sdot = 0.f;
#pragma unroll
        for (int d = 0; d < 64; ++d) sdot += q[d] * Ks[m * 64 + d];
        sdot *= 0.125f;
        const float nm = fmaxf(mx, sdot); const float corr = __expf(mx - nm), pe = __expf(sdot - nm);
        l = l * corr + pe;
#pragma unroll
        for (int d = 0; d < 64; ++d) acc[d] = acc[d] * corr + pe * Vs[m * 64 + d];
        mx = nm;
    }
    __syncthreads();
    LAS float* ex = (LAS float*)lds;
    if (half == 1) { ex[ql * 66 + 64] = mx; ex[ql * 66 + 65] = l;
#pragma unroll
        for (int d = 0; d < 64; ++d) ex[ql * 66 + d] = acc[d]; }
    __syncthreads();
    if (half == 0) { const float m2 = ex[ql * 66 + 64], l2 = ex[ql * 66 + 65]; const float nm = fmaxf(mx, m2); const float c1 = __expf(mx - nm), c2 = __expf(m2 - nm); const float inv = 1.f / (l * c1 + l2 * c2);
#pragma unroll
        for (int d = 0; d < 64; ++d) { const float o = (acc[d] * c1 + ex[ql * 66 + d] * c2) * inv; cat[(size_t)row * DM + 768 + hd * 64 + d] = (bf16_t)(cvt_pk_bf16(o, 0.f) & 0xffffu); } }
    __syncthreads();
}
__device__ __forceinline__ void attn_sample_item(LAS unsigned char* lds, const bf16_t* h, int ldh, int qoff, const float* ck, const float* cv, bf16_t* cat, int layer, int item) {
    const int tid = otid(), lane = tid & 63, wave = __builtin_amdgcn_readfirstlane(tid >> 6);
    const int hp = item & 1, sb = item >> 1;
    LAS float* qs = (LAS float*)lds;
    LAS float* scs = qs + 512;
    LAS float* red = scs + 2048;
    { const int t = tid >> 7, hh = (tid >> 6) & 1, d = tid & 63;
      qs[tid] = bf1(h[(size_t)(TP + sb * 4 + t) * ldh + qoff + (2 * hp + hh) * 64 + d]); }
    __syncthreads();
    { const int m = tid & 255, hh = tid >> 8;
      const f32x4* kp = (const f32x4*)(ck + (((size_t)(layer * 128 + sb) * 256 + m) * 4 + (2 * hp + hh)) * 64);
      float a0 = 0.f, a1 = 0.f, a2 = 0.f, a3 = 0.f;
#pragma unroll
      for (int i = 0; i < 16; ++i) { const f32x4 kv = kp[i];
#pragma unroll
          for (int e = 0; e < 4; ++e) { const int d = 4 * i + e; a0 += kv[e] * qs[(0 * 2 + hh) * 64 + d]; a1 += kv[e] * qs[(1 * 2 + hh) * 64 + d]; a2 += kv[e] * qs[(2 * 2 + hh) * 64 + d]; a3 += kv[e] * qs[(3 * 2 + hh) * 64 + d]; } }
      scs[(0 * 2 + hh) * 256 + m] = a0 * 0.125f; scs[(1 * 2 + hh) * 256 + m] = a1 * 0.125f; scs[(2 * 2 + hh) * 256 + m] = a2 * 0.125f; scs[(3 * 2 + hh) * 256 + m] = a3 * 0.125f; }
    __syncthreads();
    { LAS float* sp = scs + wave * 256; float v[4]; float mx = -3.0e38f;
#pragma unroll
      for (int i = 0; i < 4; ++i) { v[i] = sp[lane + 64 * i]; mx = fmaxf(mx, v[i]); }
#pragma unroll
      for (int o = 1; o < 64; o <<= 1) mx = fmaxf(mx, __shfl_xor(mx, o));
      float s = 0.f;
#pragma unroll
      for (int i = 0; i < 4; ++i) { v[i] = __expf(v[i] - mx); s += v[i]; }
      s = wave_sum(s); const float inv = 1.f / s;
#pragma unroll
      for (int i = 0; i < 4; ++i) sp[lane + 64 * i] = v[i] * inv; }
    __syncthreads();
    { const int d = tid & 63, hh = (tid >> 6) & 1, mp = tid >> 7;
      float a0 = 0.f, a1 = 0.f, a2 = 0.f, a3 = 0.f;
      const float* vp = cv + (((size_t)(layer * 128 + sb) * 256 + mp * 64) * 4 + (2 * hp + hh)) * 64 + d;
#pragma unroll 8
      for (int m = 0; m < 64; ++m) { const float vv = vp[(size_t)m * 256]; const int mm = mp * 64 + m;
          a0 += scs[(0 * 2 + hh) * 256 + mm] * vv; a1 += scs[(1 * 2 + hh) * 256 + mm] * vv; a2 += scs[(2 * 2 + hh) * 256 + mm] * vv; a3 += scs[(3 * 2 + hh) * 256 + mm] * vv; }
      red[(mp * 8 + 0 * 2 + hh) * 64 + d] = a0; red[(mp * 8 + 1 * 2 + hh) * 64 + d] = a1; red[(mp * 8 + 2 * 2 + hh) * 64 + d] = a2; red[(mp * 8 + 3 * 2 + hh) * 64 + d] = a3; }
    __syncthreads();
    { const int t = tid >> 7, hh = (tid >> 6) & 1, d = tid & 63; const int idx = (t * 2 + hh) * 64 + d;
      const float o = red[idx] + red[512 + idx] + red[1024 + idx] + red[1536 + idx];
      cat[(size_t)(TP + sb * 4 + t) * DM + 768 + (2 * hp + hh) * 64 + d] = (bf16_t)(cvt_pk_bf16(o, 0.f) & 0xffffu); }
    __syncthreads();
}

__device__ __forceinline__ void load_u8(const bf16_t* h, size_t row, int c, float* u) {
    const u32x4 xi = *(const u32x4*)(h + row * NHA + c), cg = *(const u32x4*)(h + row * NHA + 1536 + c);
#pragma unroll
    for (int i = 0; i < 4; ++i) { u[2 * i] = bflo(xi[i]) * bflo(cg[i]); u[2 * i + 1] = bfhi(xi[i]) * bfhi(cg[i]); }
}
__device__ __forceinline__ void phase_mixA_elem(const Params& p, int j) {
    const bf16_t* h = (const bf16_t*)(p.ws + WS_H); bf16_t* cat = (bf16_t*)(p.ws + WS_CAT);
    const float* cw = p.in[10] + (size_t)j * 3 * 768; const float* hist = p.in[5] + (size_t)j * 128 * 2 * 768;
    const size_t gt = (size_t)blockIdx.x * 512 + otid(), NT = (size_t)gridDim.x * 512;
    for (size_t idx = gt; idx < (size_t)TT * 96; idx += NT) {
        const int row = (int)(idx / 96), c = (int)(idx % 96) * 8;
        const bool smp = row >= TP; const int t = smp ? ((row - TP) & 3) : (row & 2047); const int bb = smp ? ((row - TP) >> 2) : (row >> 11);
        float u0[8], u1[8], u2[8];
        load_u8(h, row, c, u2);
        if (t >= 1) load_u8(h, row - 1, c, u1);
        else if (smp) { const f32x4* hp = (const f32x4*)(hist + ((size_t)bb * 2 + 1) * 768 + c); const f32x4 a = hp[0], b2 = hp[1];
#pragma unroll
            for (int i = 0; i < 4; ++i) { u1[i] = a[i]; u1[4 + i] = b2[i]; } }
        else {
#pragma unroll
            for (int i = 0; i < 8; ++i) u1[i] = 0.f; }
        if (t >= 2) load_u8(h, row - 2, c, u0);
        else if (smp) { const f32x4* hp = (const f32x4*)(hist + ((size_t)bb * 2 + t) * 768 + c); const f32x4 a = hp[0], b2 = hp[1];
#pragma unroll
            for (int i = 0; i < 4; ++i) { u0[i] = a[i]; u0[4 + i] = b2[i]; } }
        else {
#pragma unroll
            for (int i = 0; i < 8; ++i) u0[i] = 0.f; }
        const u32x4 bg = *(const u32x4*)(h + (size_t)row * NHA + 768 + c);
        float y[8];
#pragma unroll
        for (int i = 0; i < 8; ++i) { const float w0 = cw[c + i], w1 = cw[768 + c + i], w2 = cw[1536 + c + i];
            const float bgv = (i & 1) ? bfhi(bg[i >> 1]) : bflo(bg[i >> 1]);
            y[i] = bgv * (w0 * u0[i] + w1 * u1[i] + w2 * u2[i]); }
        u32x4 w; w.x = cvt_pk_bf16(y[0], y[1]); w.y = cvt_pk_bf16(y[2], y[3]); w.z = cvt_pk_bf16(y[4], y[5]); w.w = cvt_pk_bf16(y[6], y[7]);
        *(u32x4*)(cat + (size_t)row * DM + c) = w;
        const int T = smp ? 4 : 2048;
        if (t >= T - 2) { float* op = p.out + (smp ? O_SCS : O_SCP) + (((size_t)j * (smp ? 128 : 8) + bb) * 2 + (t - (T - 2))) * 768 + c;
            ((f32x4*)op)[0] = (f32x4){u2[0], u2[1], u2[2], u2[3]}; ((f32x4*)op)[1] = (f32x4){u2[4], u2[5], u2[6], u2[7]}; }
    }
}

__device__ __forceinline__ void load_h8(const bf16_t* hu, size_t row, int c, float* v) {
    const u32x4 x = *(const u32x4*)(hu + row * NUP + c);
#pragma unroll
    for (int i = 0; i < 4; ++i) { v[2 * i] = bflo(x[i]); v[2 * i + 1] = bfhi(x[i]); }
}
__device__ __forceinline__ void load_f8(const float* src, float* v) {
    const f32x4 a = ((const f32x4*)src)[0], b = ((const f32x4*)src)[1];
#pragma unroll
    for (int i = 0; i < 4; ++i) { v[i] = a[i]; v[4 + i] = b[i]; }
}
__device__ __forceinline__ void phase_convgate(const Params& p, int l) {
    const bf16_t* hu = (const bf16_t*)(p.ws + WS_HU); bf16_t* gact = (bf16_t*)(p.ws + WS_GACT);
    const float* cw = p.in[24] + (size_t)l * 3 * NUP; const float* hist = p.in[8] + (size_t)l * 128 * 2 * NUP;
    const size_t gt = (size_t)blockIdx.x * 512 + otid(), NT = (size_t)gridDim.x * 512;
    for (size_t idx = gt; idx < (size_t)TT * 352; idx += NT) {
        const int row = (int)(idx / 352), c = (int)(idx % 352) * 8;
        const bool smp = row >= TP; const int t = smp ? ((row - TP) & 3) : (row & 2047); const int bb = smp ? ((row - TP) >> 2) : (row >> 11);
        float res[2][8];
#pragma unroll
        for (int half = 0; half < 2; ++half) {
            const int cc = c + half * DFF;
            float v0[8], v1[8], v2[8];
            load_h8(hu, row, cc, v2);
            if (t >= 1) load_h8(hu, row - 1, cc, v1);
            else if (smp) load_f8(hist + ((size_t)bb * 2 + 1) * NUP + cc, v1);
            else {
#pragma unroll
                for (int i = 0; i < 8; ++i) v1[i] = 0.f; }
            if (t >= 2) load_h8(hu, row - 2, cc, v0);
            else if (smp) load_f8(hist + ((size_t)bb * 2 + t) * NUP + cc, v0);
            else {
#pragma unroll
                for (int i = 0; i < 8; ++i) v0[i] = 0.f; }
#pragma unroll
            for (int i = 0; i < 8; ++i) res[half][i] = cw[cc + i] * v0[i] + cw[NUP + cc + i] * v1[i] + cw[2 * NUP + cc + i] * v2[i];
        }
        float y[8];
#pragma unroll
        for (int i = 0; i < 8; ++i) y[i] = silu_f(res[0][i]) * res[1][i];
        u32x4 w; w.x = cvt_pk_bf16(y[0], y[1]); w.y = cvt_pk_bf16(y[2], y[3]); w.z = cvt_pk_bf16(y[4], y[5]); w.w = cvt_pk_bf16(y[6], y[7]);
        *(u32x4*)(gact + (size_t)row * DFF + c) = w;
    }
    for (size_t idx = gt; idx < (size_t)(8 + 128) * 2 * (NUP / 8); idx += NT) {
        const int c = (int)(idx % (NUP / 8)) * 8; const int rr = (int)(idx / (NUP / 8)); const int k = rr & 1, bq = rr >> 1;
        const bool smp = bq >= 8; const int bb = smp ? bq - 8 : bq;
        const size_t row = smp ? (size_t)TP + bb * 4 + 2 + k : (size_t)bb * 2048 + 2046 + k;
        float v[8]; load_h8(hu, row, c, v);
        float* op = p.out + (smp ? O_FFS : O_FFP) + (((size_t)l * (smp ? 128 : 8) + bb) * 2 + k) * NUP + c;
        ((f32x4*)op)[0] = (f32x4){v[0], v[1], v[2], v[3]}; ((f32x4*)op)[1] = (f32x4){v[4], v[5], v[6], v[7]};
    }
}

__device__ __forceinline__ void phase_gdn_pre(const Params& p, int j) {
    const bf16_t* h = (const bf16_t*)(p.ws + WS_H); bf16_t* qkvn = (bf16_t*)(p.ws + WS_QKVN); float* gb = (float*)(p.ws + WS_GB);
    const float* cw = p.in[13] + (size_t)j * 4 * 2304; const float* hist = p.in[6] + (size_t)j * 128 * 3 * 2304;
    const int tid_ = otid(); const int lane = tid_ & 63, wave = __builtin_amdgcn_readfirstlane(tid_ >> 6);
    const int gw = blockIdx.x * 8 + wave, NGW = gridDim.x * 8;
    for (int it = gw; it < TT * 6; it += NGW) {
        const int row = it / 6, hd = it % 6;
        const bool smp = row >= TP; const int t = smp ? ((row - TP) & 3) : (row & 2047); const int bb = smp ? ((row - TP) >> 2) : (row >> 11);
        const int T = smp ? 4 : 2048;
        float val[3][2];
#pragma unroll
        for (int sec = 0; sec < 3; ++sec) {
            const int col = sec * 768 + hd * 128 + 2 * lane;
            float a0 = 0.f, a1 = 0.f;
#pragma unroll
            for (int k = 0; k < 4; ++k) { const int tt = t - 3 + k; float x0, x1;
                if (tt >= 0) { const unsigned w = *(const unsigned*)(h + (size_t)(row - 3 + k) * NHB + col); x0 = bflo(w); x1 = bfhi(w); }
                else if (smp) { const f32x2 hv = *(const f32x2*)(hist + ((size_t)bb * 3 + (tt + 3)) * 2304 + col); x0 = hv[0]; x1 = hv[1]; }
                else { x0 = 0.f; x1 = 0.f; }
                const f32x2 wv = *(const f32x2*)(cw + (size_t)k * 2304 + col);
                a0 += wv[0] * x0; a1 += wv[1] * x1;
                if (k == 3 && t >= T - 3) { float* op = p.out + (smp ? O_GCS : O_GCP) + (((size_t)j * (smp ? 128 : 8) + bb) * 3 + (t - (T - 3))) * 2304 + col; *(f32x2*)op = (f32x2){x0, x1}; }
            }
            val[sec][0] = silu_f(a0); val[sec][1] = silu_f(a1);
        }
#pragma unroll
        for (int sec = 0; sec < 2; ++sec) { const float ss = wave_sum(val[sec][0] * val[sec][0] + val[sec][1] * val[sec][1]); const float r = 1.f / sqrtf(ss + 1e-6f); val[sec][0] *= r; val[sec][1] *= r; }
#pragma unroll
        for (int sec = 0; sec < 3; ++sec) *(unsigned*)(qkvn + (size_t)row * 2304 + sec * 768 + hd * 128 + 2 * lane) = cvt_pk_bf16(val[sec][0], val[sec][1]);
        if (lane == 0) {
            const float bv = bf1(h[(size_t)row * NHB + 3328 + hd]), av = bf1(h[(size_t)row * NHB + 3334 + hd]);
            const float x = av + p.in[15][j * 6 + hd];
            const float sp = fmaxf(x, 0.f) + log1pf(__expf(-fabsf(x)));
            gb[(size_t)row * 12 + hd] = -__expf(p.in[14][j * 6 + hd]) * sp;
            gb[(size_t)row * 12 + 6 + hd] = 1.f / (1.f + __expf(-bv));
        }
    }
}

__device__ __forceinline__ void solve_lds(LAS float* sol, const LAS float* A, int lane) {
#pragma unroll 1
    for (int i = 1; i < 64; ++i) {
        float r0 = sol[i * 64 + lane], r1 = 0.f;
        const int n4 = (i + 3) >> 2;
#pragma unroll 2
        for (int j4 = 0; j4 < n4; ++j4) {
            const f32x4 a = *(const LAS f32x4*)(A + i * 64 + 4 * j4);
            const LAS float* sp = sol + (4 * j4) * 64 + lane;
            r0 -= a[0] * sp[0]; r1 -= a[1] * sp[64]; r0 -= a[2] * sp[128]; r1 -= a[3] * sp[192];
        }
        sol[i * 64 + lane] = r0 + r1;
    }
}
__device__ __forceinline__ void phase_gdn_prep(const Params& p, LAS unsigned char* lds) {
    const bf16_t* qkvn = (const bf16_t*)(p.ws + WS_QKVN); const float* gb = (const float*)(p.ws + WS_GB);
    bf16_t* Wc = (bf16_t*)(p.ws + WS_WC); bf16_t* QDc = (bf16_t*)(p.ws + WS_QDC); bf16_t* KDT = (bf16_t*)(p.ws + WS_KDT); bf16_t* QKc = (bf16_t*)(p.ws + WS_QKC);
    float* UT = (float*)(p.ws + WS_UT); float* GL = (float*)(p.ws + WS_GL);
    const int tid_ = otid(); const int lane0 = tid_ & 63, wave = __builtin_amdgcn_readfirstlane(tid_ >> 6);
    if (wave >= 4) return;
    const int gw = blockIdx.x * 4 + wave, NGW = gridDim.x * 4;
#pragma unroll 1
    for (int ci = gw; ci < 1536; ci += NGW) {
        int lane = lane0; unsigned aoff = (unsigned)wave * 32768u;
        asm volatile("" : "+v"(lane), "+v"(aoff));
        const int c16 = lane & 15, g = lane >> 4;
        LAS float* A = (LAS float*)(lds + aoff);
        const int n = ci & 31, hd = (ci >> 5) % 6, b = ci / 192;
        const int tok0 = b * 2048 + n * 64;
        const float gi = gb[(size_t)(tok0 + lane) * 12 + hd], beta = gb[(size_t)(tok0 + lane) * 12 + 6 + hd];
        float gc = gi;
#pragma unroll
        for (int o = 1; o < 64; o <<= 1) { const float tv = __shfl_up(gc, o); if (lane >= o) gc += tv; }
        const float gl = __shfl(gc, 63);
        const float egc = __expf(gc), edl = __expf(gl - gc);
        if (lane == 0) GL[ci] = __expf(gl);
        {
            bf16x8 kf[4][4];
#pragma unroll
            for (int t = 0; t < 4; ++t)
#pragma unroll
                for (int ks = 0; ks < 4; ++ks) kf[t][ks] = *(const bf16x8*)(qkvn + (size_t)(tok0 + 16 * t + c16) * 2304 + 768 + hd * 128 + 32 * ks + 8 * g);
#pragma unroll
            for (int it = 0; it < 4; ++it)
#pragma unroll
                for (int jt = 0; jt <= it; ++jt) {
                    f32x4 acc = (f32x4){0.f, 0.f, 0.f, 0.f};
#pragma unroll
                    for (int ks = 0; ks < 4; ++ks) acc = __builtin_amdgcn_mfma_f32_16x16x32_bf16(kf[it][ks], kf[jt][ks], acc, 0, 0, 0);
                    const int jj = 16 * jt + c16; const float gcj = __shfl(gc, jj);
#pragma unroll
                    for (int r = 0; r < 4; ++r) { const int ii = 16 * it + 4 * g + r; const float gci = __shfl(gc, ii), bi = __shfl(beta, ii);
                        A[ii * 64 + jj] = ii > jj ? bi * acc[r] * __expf(gci - gcj) : 0.f; }
                }
#pragma unroll
            for (int it = 0; it < 4; ++it) {
                bf16x8 qf[4];
#pragma unroll
                for (int ks = 0; ks < 4; ++ks) qf[ks] = *(const bf16x8*)(qkvn + (size_t)(tok0 + 16 * it + c16) * 2304 + hd * 128 + 32 * ks + 8 * g);
#pragma unroll
                for (int jt = 0; jt < 4; ++jt) {
                    f32x4 acc = (f32x4){0.f, 0.f, 0.f, 0.f};
                    if (jt <= it) {
#pragma unroll
                        for (int ks = 0; ks < 4; ++ks) acc = __builtin_amdgcn_mfma_f32_16x16x32_bf16(qf[ks], kf[jt][ks], acc, 0, 0, 0);
                    }
                    const int jj = 16 * jt + c16; const float gcj = __shfl(gc, jj);
                    const int pos = (jj & 32) + invperm32(jj & 31);
#pragma unroll
                    for (int r = 0; r < 4; ++r) { const int ii = 16 * it + 4 * g + r; const float gci = __shfl(gc, ii);
                        const float v = ii >= jj ? acc[r] * 0.08838834764831845f * __expf(gci - gcj) : 0.f;
                        QKc[(size_t)ci * 4096 + ii * 64 + pos] = (bf16_t)(cvt_pk_bf16(v, 0.f) & 0xffffu); }
                }
            }
        }
        asm volatile("s_waitcnt lgkmcnt(0)" ::: "memory");
        LAS float* sol = A + 4096;
#pragma unroll 1
        for (int pass = 0; pass < 4; ++pass) {
            const int half = pass & 1, isw = pass >> 1;
            const int c = lane + 64 * half; const int posc = (c & ~31) + invperm32(c & 31);
            const bf16_t* src = qkvn + (size_t)tok0 * 2304 + (isw ? 768 : 1536) + hd * 128 + c;
#pragma unroll 8
            for (int i = 0; i < 64; ++i) { float f = __shfl(beta, i); if (isw) f *= __shfl(egc, i); sol[i * 64 + lane] = bf1(src[(size_t)i * 2304]) * f; }
            asm volatile("s_waitcnt lgkmcnt(0)" ::: "memory");
            solve_lds(sol, A, lane);
            asm volatile("s_waitcnt lgkmcnt(0)" ::: "memory");
            if (!isw) { float* up = UT + (size_t)ci * 8192 + (size_t)c * 64;
#pragma unroll 4
                for (int i = 0; i < 64; i += 4) *(f32x4*)(up + i) = (f32x4){sol[i * 64 + lane], sol[(i + 1) * 64 + lane], sol[(i + 2) * 64 + lane], sol[(i + 3) * 64 + lane]}; }
            else {
#pragma unroll 8
                for (int i = 0; i < 64; ++i) Wc[(size_t)ci * 8192 + i * 128 + posc] = (bf16_t)(cvt_pk_bf16(sol[i * 64 + lane], 0.f) & 0xffffu); }
            asm volatile("s_waitcnt lgkmcnt(0)" ::: "memory");
        }
        const int c0 = 2 * lane; const int pos0 = (c0 & ~31) + invperm32(c0 & 31);
#pragma unroll 8
        for (int i = 0; i < 64; ++i) { const unsigned w = *(const unsigned*)(qkvn + (size_t)(tok0 + i) * 2304 + hd * 128 + 2 * lane);
            const float s = __shfl(egc, i) * 0.08838834764831845f;
            *(unsigned*)(QDc + (size_t)ci * 8192 + i * 128 + pos0) = cvt_pk_bf16(bflo(w) * s, bfhi(w) * s); }
        asm volatile("s_waitcnt lgkmcnt(0)" ::: "memory");
        {
            LAS bf16_t* kt = (LAS bf16_t*)A;
#pragma unroll 8
            for (int i = 0; i < 64; ++i) { const unsigned w = *(const unsigned*)(qkvn + (size_t)(tok0 + i) * 2304 + 768 + hd * 128 + 2 * lane);
                *(LAS unsigned*)(kt + i * 128 + 2 * lane) = w; }
            asm volatile("s_waitcnt lgkmcnt(0)" ::: "memory");
#pragma unroll
            for (int hh = 0; hh < 2; ++hh) { const int dk = lane + 64 * hh;
#pragma unroll
                for (int p8 = 0; p8 < 8; ++p8) { float v[8];
#pragma unroll
                    for (int e = 0; e < 8; ++e) { const int pp = p8 * 8 + e; const int c = (pp & 32) + perm32k(pp & 31);
                        v[e] = bf1(kt[c * 128 + dk]) * __uint_as_float((unsigned)__builtin_amdgcn_readlane((int)__float_as_uint(edl), c)); }
                    u32x4 w; w.x = cvt_pk_bf16(v[0], v[1]); w.y = cvt_pk_bf16(v[2], v[3]); w.z = cvt_pk_bf16(v[4], v[5]); w.w = cvt_pk_bf16(v[6], v[7]);
                    *(u32x4*)(KDT + (size_t)ci * 8192 + dk * 64 + p8 * 8) = w; } }
            asm volatile("s_waitcnt lgkmcnt(0)" ::: "memory");
        }
    }
}

constexpr int RB_W = 0, RB_QD = 17408, RB_KD = 34816, RB_QK = 34816 + 18432, RB_SZ = 62464;
__device__ __forceinline__ void rec_load(u32x4 (&r)[7], const bf16_t* Wc, const bf16_t* QDc, const bf16_t* KDT, const bf16_t* QKc, int ci, int tid) {
    r[0] = *(const u32x4*)(Wc + (size_t)ci * 8192 + (size_t)tid * 8); r[1] = *(const u32x4*)(Wc + (size_t)ci * 8192 + (size_t)(512 + tid) * 8);
    r[2] = *(const u32x4*)(QDc + (size_t)ci * 8192 + (size_t)tid * 8); r[3] = *(const u32x4*)(QDc + (size_t)ci * 8192 + (size_t)(512 + tid) * 8);
    r[4] = *(const u32x4*)(KDT + (size_t)ci * 8192 + (size_t)tid * 8); r[5] = *(const u32x4*)(KDT + (size_t)ci * 8192 + (size_t)(512 + tid) * 8);
    r[6] = *(const u32x4*)(QKc + (size_t)ci * 4096 + (size_t)tid * 8);
}
__device__ __forceinline__ void rec_store(const u32x4 (&r)[7], LAS unsigned char* buf, int tid) {
#pragma unroll
    for (int k = 0; k < 2; ++k) { const int q = tid + 512 * k;
        *(LAS u32x4*)(buf + RB_W + (q >> 4) * 272 + (q & 15) * 16) = r[k];
        *(LAS u32x4*)(buf + RB_QD + (q >> 4) * 272 + (q & 15) * 16) = r[2 + k];
        *(LAS u32x4*)(buf + RB_KD + (q >> 3) * 144 + (q & 7) * 16) = r[4 + k]; }
    *(LAS u32x4*)(buf + RB_QK + (tid >> 3) * 144 + (tid & 7) * 16) = r[6];
}
__device__ __forceinline__ void gdn_recur_prompt(const Params& p, LAS unsigned char* lds, int j, int bh, float* ob, float* gsbase) {
    const bf16_t* Wc = (const bf16_t*)(p.ws + WS_WC); const bf16_t* QDc = (const bf16_t*)(p.ws + WS_QDC); const bf16_t* KDT = (const bf16_t*)(p.ws + WS_KDT); const bf16_t* QKc = (const bf16_t*)(p.ws + WS_QKC);
    const float* UT = (const float*)(p.ws + WS_UT); const float* GL = (const float*)(p.ws + WS_GL);
    const int tid = otid(), lane = tid & 63, wave = __builtin_amdgcn_readfirstlane(tid >> 6), c16 = lane & 15, g = lane >> 4;
    const int b = bh / 6, hd = bh % 6, dv0 = wave * 16;
    f32x4 S[8];
#pragma unroll
    for (int i = 0; i < 8; ++i) S[i] = (f32x4){0.f, 0.f, 0.f, 0.f};
    u32x4 rg[7];
    rec_load(rg, Wc, QDc, KDT, QKc, bh * 32, tid);
    rec_store(rg, lds, tid);
    __syncthreads();
#pragma unroll 1
    for (int n = 0; n < 32; ++n) {
        const int ci = bh * 32 + n;
        LAS unsigned char* buf = lds + (n & 1) * RB_SZ;
        if (n + 1 < 32) rec_load(rg, Wc, QDc, KDT, QKc, ci + 1, tid);
        f32x4 u[4];
#pragma unroll
        for (int ct = 0; ct < 4; ++ct) u[ct] = *(const f32x4*)(UT + (size_t)ci * 8192 + (size_t)(dv0 + c16) * 64 + 16 * ct + 4 * g);
        const float egl = GL[ci];
        bf16x8 bS[4];
#pragma unroll
        for (int ks = 0; ks < 4; ++ks) bS[ks] = pack8(S[2 * ks], S[2 * ks + 1]);
        f32x4 vn[4], o[4];
#pragma unroll
        for (int ct = 0; ct < 4; ++ct) {
            f32x4 ws = (f32x4){0.f, 0.f, 0.f, 0.f}, oo = (f32x4){0.f, 0.f, 0.f, 0.f};
#pragma unroll
            for (int ks = 0; ks < 4; ++ks) {
                const bf16x8 wf = *(const LAS bf16x8*)(buf + RB_W + (16 * ct + c16) * 272 + ks * 64 + g * 16);
                const bf16x8 qf = *(const LAS bf16x8*)(buf + RB_QD + (16 * ct + c16) * 272 + ks * 64 + g * 16);
                ws = __builtin_amdgcn_mfma_f32_16x16x32_bf16(wf, bS[ks], ws, 0, 0, 0);
                oo = __builtin_amdgcn_mfma_f32_16x16x32_bf16(qf, bS[ks], oo, 0, 0, 0);
            }
            vn[ct] = u[ct] - ws; o[ct] = oo;
        }
        bf16x8 bV[2];
#pragma unroll
        for (int k2 = 0; k2 < 2; ++k2) bV[k2] = pack8(vn[2 * k2], vn[2 * k2 + 1]);
#pragma unroll
        for (int ct = 0; ct < 4; ++ct) {
#pragma unroll
            for (int k2 = 0; k2 < 2; ++k2) { const bf16x8 af = *(const LAS bf16x8*)(buf + RB_QK + (16 * ct + c16) * 144 + k2 * 64 + g * 16);
                o[ct] = __builtin_amdgcn_mfma_f32_16x16x32_bf16(af, bV[k2], o[ct], 0, 0, 0); }
#pragma unroll
            for (int r = 0; r < 4; ++r) ob[(size_t)(b * 2048 + n * 64 + 16 * ct + 4 * g + r) * 768 + hd * 128 + dv0 + c16] = o[ct][r];
        }
#pragma unroll
        for (int dt = 0; dt < 8; ++dt) { f32x4 s = S[dt] * egl;
#pragma unroll
            for (int k2 = 0; k2 < 2; ++k2) { const bf16x8 af = *(const LAS bf16x8*)(buf + RB_KD + (16 * dt + c16) * 144 + k2 * 64 + g * 16);
                s = __builtin_amdgcn_mfma_f32_16x16x32_bf16(af, bV[k2], s, 0, 0, 0); }
            S[dt] = s; }
        if (n + 1 < 32) rec_store(rg, lds + ((n + 1) & 1) * RB_SZ, tid);
        __syncthreads();
    }
    float* so = gsbase + ((size_t)(j * 8 + b) * 6 + hd) * 16384;
#pragma unroll
    for (int dt = 0; dt < 8; ++dt)
#pragma unroll
        for (int r = 0; r < 4; ++r) so[(size_t)(16 * dt + 4 * g + r) * 128 + dv0 + c16] = S[dt][r];
}
__device__ __forceinline__ void gdn_naive_item(const Params& p, LAS unsigned char* lds, int row0, int T, int hd, const float* s0, float* sout) {
    const bf16_t* qkvn = (const bf16_t*)(p.ws + WS_QKVN); const float* gb = (const float*)(p.ws + WS_GB); float* ob = (float*)(p.ws + WS_O);
    const int tid = otid(), e = tid & 127, part = tid >> 7;
    LAS float* kq = (LAS float*)lds;
    LAS float* red = kq + 1024;
    LAS float* red2 = red + 512;
    float S[32];
#pragma unroll
    for (int i = 0; i < 32; ++i) S[i] = s0 ? s0[(size_t)(part * 32 + i) * 128 + e] : 0.f;
#pragma unroll 1
    for (int tb = 0; tb < T; tb += 4) {
        __syncthreads();
        for (int i = tid; i < 1024; i += 512) { const int t = i >> 8, s = (i >> 7) & 1, d = i & 127;
            kq[i] = bf1(qkvn[(size_t)(row0 + tb + t) * 2304 + (s == 0 ? 768 : 0) + hd * 128 + d]); }
        __syncthreads();
#pragma unroll 1
        for (int t = 0; t < 4; ++t) {
            const int row = row0 + tb + t;
            const float a = __expf(gb[(size_t)row * 12 + hd]), bt = gb[(size_t)row * 12 + 6 + hd];
            const float v = bf1(qkvn[(size_t)row * 2304 + 1536 + hd * 128 + e]);
            float ps = 0.f;
#pragma unroll
            for (int i = 0; i < 32; ++i) ps += S[i] * kq[(t * 2 + 0) * 128 + part * 32 + i];
            red[part * 128 + e] = ps;
            __syncthreads();
            const float kS = red[e] + red[128 + e] + red[256 + e] + red[384 + e];
            const float vnew = bt * (v - a * kS);
            float po = 0.f;
#pragma unroll
            for (int i = 0; i < 32; ++i) { S[i] = a * S[i] + kq[(t * 2 + 0) * 128 + part * 32 + i] * vnew; po += S[i] * kq[(t * 2 + 1) * 128 + part * 32 + i]; }
            red2[part * 128 + e] = po;
            __syncthreads();
            if (part == 0) ob[(size_t)row * 768 + hd * 128 + e] = (red2[e] + red2[128 + e] + red2[256 + e] + red2[384 + e]) * 0.08838834764831845f;
        }
    }
#pragma unroll
    for (int i = 0; i < 32; ++i) sout[(size_t)(part * 32 + i) * 128 + e] = S[i];
    __syncthreads();
}
__device__ __forceinline__ void gdn_sample_item(const Params& p, LAS unsigned char* lds, int j, int item) {
    const int sb = item / 6, hd = item % 6;
    gdn_naive_item(p, lds, TP + sb * 4, 4, hd, p.in[7] + ((size_t)(j * 128 + sb) * 6 + hd) * 16384, p.out + O_GSS + ((size_t)(j * 128 + sb) * 6 + hd) * 16384);
}
__device__ __forceinline__ void phase_gdn_post(const Params& p, int j) {
    const bf16_t* h = (const bf16_t*)(p.ws + WS_H); const float* ob = (const float*)(p.ws + WS_O); bf16_t* cat = (bf16_t*)(p.ws + WS_CAT);
    const int tid_ = otid(); const int lane = tid_ & 63, wave = __builtin_amdgcn_readfirstlane(tid_ >> 6);
    const int gw = blockIdx.x * 8 + wave, NGW = gridDim.x * 8;
    const f32x2 nw = *(const f32x2*)(p.in[16] + j * 128 + 2 * lane);
    for (int it = gw; it < TT * 6; it += NGW) {
        const int row = it / 6, hd = it % 6;
        const f32x2 o = *(const f32x2*)(ob + (size_t)row * 768 + hd * 128 + 2 * lane);
        const float ss = wave_sum(o[0] * o[0] + o[1] * o[1]);
        const float r = 1.f / sqrtf(ss * (1.f / 128.f) + 1e-6f);
        const unsigned zw = *(const unsigned*)(h + (size_t)row * NHB + 2304 + hd * 128 + 2 * lane);
        const float y0 = o[0] * r * nw[0] * silu_f(bflo(zw)), y1 = o[1] * r * nw[1] * silu_f(bfhi(zw));
        *(unsigned*)(cat + (size_t)row * DM + hd * 128 + 2 * lane) = cvt_pk_bf16(y0, y1);
    }
}


#ifdef DIAG_GDN
constexpr size_t WS_DBG = WS_END;
constexpr size_t WS_OB2 = WS_END + 4096;
constexpr size_t WS_GS2 = WS_OB2 + (size_t)TT * 768 * 4;
constexpr size_t WS_DIAG_END = WS_GS2 + (size_t)2 * 8 * 6 * 16384 * 4;
__device__ __forceinline__ void diag_compare(const Params& p, int j) {
    const float* ob = (const float*)(p.ws + WS_O); const float* ob2 = (const float*)(p.ws + WS_OB2);
    const float* gs = p.out + O_GSP + (size_t)j * 8 * 6 * 16384; const float* gs2 = (const float*)(p.ws + WS_GS2) + (size_t)j * 8 * 6 * 16384;
    float* dbg = (float*)(p.ws + WS_DBG);
    const size_t gt = (size_t)blockIdx.x * 512 + otid(), NT = (size_t)gridDim.x * 512;
    float n1 = 0.f, d1 = 0.f, n3 = 0.f, d3 = 0.f, n2 = 0.f, d2 = 0.f, n4 = 0.f, d4 = 0.f;
    for (size_t i = gt; i < (size_t)TP * 768; i += NT) { const int row = (int)(i / 768); const float a = ob[i], b = ob2[i]; const float e = (a - b) * (a - b);
        n3 += e; d3 += a * a; if ((row & 2047) < 64) { n1 += e; d1 += a * a; } else if ((row & 2047) < 128) { n4 += e; d4 += a * a; } }
    for (size_t i = gt; i < (size_t)8 * 6 * 16384; i += NT) { const float a = gs[i], b = gs2[i]; n2 += (a - b) * (a - b); d2 += a * a; }
    n1 = wave_sum(n1); d1 = wave_sum(d1); n2 = wave_sum(n2); d2 = wave_sum(d2); n3 = wave_sum(n3); d3 = wave_sum(d3); n4 = wave_sum(n4); d4 = wave_sum(d4);
    if ((otid() & 63) == 0) { atomicAdd(dbg + 0, n1); atomicAdd(dbg + 1, d1); atomicAdd(dbg + 2, n2); atomicAdd(dbg + 3, d2); atomicAdd(dbg + 4, n3); atomicAdd(dbg + 5, d3); atomicAdd(dbg + 6, n4); atomicAdd(dbg + 7, d4); }
}
__device__ __forceinline__ void diag_compare2(const Params& p) {
    const bf16_t* qkvn = (const bf16_t*)(p.ws + WS_QKVN); const float* gb = (const float*)(p.ws + WS_GB);
    const bf16_t* Wc = (const bf16_t*)(p.ws + WS_WC); const bf16_t* QDc = (const bf16_t*)(p.ws + WS_QDC); const bf16_t* KDT = (const bf16_t*)(p.ws + WS_KDT);
    float* dbg = (float*)(p.ws + WS_DBG);
    const int tid_ = otid(); const int lane = tid_ & 63, wave = __builtin_amdgcn_readfirstlane(tid_ >> 6);
    const int gw = blockIdx.x * 8 + wave, NGW = gridDim.x * 8;
    float n8 = 0.f, d8 = 0.f, n10 = 0.f, d10 = 0.f, n12 = 0.f, d12 = 0.f;
    for (int ci = gw; ci < 1536; ci += NGW) {
        const int n = ci & 31, hd = (ci >> 5) % 6, b = ci / 192; const int tok0 = b * 2048 + n * 64;
        float gcs = 0.f, mygc = 0.f;
        for (int t = 0; t < 64; ++t) { gcs += gb[(size_t)(tok0 + t) * 12 + hd]; if (t == lane) mygc = gcs; }
        const float gl = gcs;
        for (int c = 0; c < 128; ++c) { const int pos = (c & ~31) + invperm32(c & 31);
            const float qe = bf1(qkvn[(size_t)(tok0 + lane) * 2304 + hd * 128 + c]) * 0.08838834764831845f * __expf(mygc);
            const float qg = bf1(QDc[(size_t)ci * 8192 + lane * 128 + pos]); n8 += (qe - qg) * (qe - qg); d8 += qe * qe;
            const float ke = bf1(qkvn[(size_t)(tok0 + lane) * 2304 + 768 + hd * 128 + c]) * __expf(gl - mygc);
            const int posl = (lane & 32) + invperm32(lane & 31);
            const float kg = bf1(KDT[(size_t)ci * 8192 + c * 64 + posl]); n10 += (ke - kg) * (ke - kg); d10 += ke * ke; }
        { const float beta0 = gb[(size_t)tok0 * 12 + 6 + hd], g0 = gb[(size_t)tok0 * 12 + hd];
          for (int c = lane; c < 128; c += 64) { const int pos = (c & ~31) + invperm32(c & 31);
            const float we = bf1(qkvn[(size_t)tok0 * 2304 + 768 + hd * 128 + c]) * beta0 * __expf(g0);
            const float wg = bf1(Wc[(size_t)ci * 8192 + pos]); n12 += (we - wg) * (we - wg); d12 += we * we; } }
    }
    n8 = wave_sum(n8); d8 = wave_sum(d8); n10 = wave_sum(n10); d10 = wave_sum(d10); n12 = wave_sum(n12); d12 = wave_sum(d12);
    if (lane == 0) { atomicAdd(dbg + 8, n8); atomicAdd(dbg + 9, d8); atomicAdd(dbg + 10, n10); atomicAdd(dbg + 11, d10); atomicAdd(dbg + 12, n12); atomicAdd(dbg + 13, d12); }
}
__device__ __forceinline__ int diag_class(float n, float d) { const float r = n / (d + 1e-30f); return r < 4e-4f ? 0 : (r < 0.09f ? 1 : 2); }
#endif
__global__ void __launch_bounds__(512, 2) fwd_megakernel(Params p) {
    extern __shared__ __attribute__((aligned(16))) unsigned char lds_raw[];
    LAS unsigned char* lds = (LAS unsigned char*)lds_raw;
    cg::grid_group grid = cg::this_grid();
    unsigned char* ws = p.ws;
    float* xf = (float*)(ws + WS_XF); bf16_t* xb = (bf16_t*)(ws + WS_XB);
    bf16_t* hbuf = (bf16_t*)(ws + WS_H); bf16_t* cat = (bf16_t*)(ws + WS_CAT);
    bf16_t* hu = (bf16_t*)(ws + WS_HU); bf16_t* gact = (bf16_t*)(ws + WS_GACT);
    const bf16_t* Kb = (const bf16_t*)(ws + WS_KB); const bf16_t* Vt = (const bf16_t*)(ws + WS_VT);
    const int bid = blockIdx.x, G = gridDim.x;

#ifdef DIAG_GDN
    if (bid == 0 && threadIdx.x < 64) ((float*)(ws + WS_DBG))[threadIdx.x] = 0.f;
#endif
    phase_prep(p, lds);
    grid.sync();
    {
        EpiKV E{p.out + O_MK, p.out + O_MV, (bf16_t*)(ws + WS_KB), (bf16_t*)(ws + WS_VT)};
        run_gemm(lds, (const bf16_t*)(ws + WS_MEMB), (const bf16_t*)(ws + WS_WKV), 2048, 2048, DM, E, (bid + 64) % G);
    }
#pragma unroll 1
    for (int l = 0; l < 4; ++l) {
        const int j = l >> 1; const bool isB = (l & 1) != 0;
        if (!isB) {
            { EpiStoreBf16 E{hbuf, NHA}; run_gemm(lds, xb, (const bf16_t*)(ws + WS_WINA) + (size_t)j * NHA * DM, TT, NHA, DM, E, bid); }
            grid.sync();
            phase_mixA_elem(p, j);
#ifdef NAIVE_ATTN
            for (int it = bid; it < 256; it += G) attn_prompt_item_naive(lds, hbuf, NHA, 2304, p.out + O_MK, p.out + O_MV, cat, l, it);
#else
            for (int it = bid; it < 256; it += G) attn_prompt_item(lds, hbuf, NHA, 2304, Kb, Vt, cat, l, it);
#endif
            for (int it = bid; it < 256; it += G) attn_sample_item(lds, hbuf, NHA, 2304, p.in[3], p.in[4], cat, l, it);
            grid.sync();
            { EpiResid E{xf, DM}; run_gemm(lds, cat, (const bf16_t*)(ws + WS_WOUTA) + (size_t)j * DM * DM, TT, DM, DM, E, bid); }
        } else {
            { EpiStoreBf16 E{hbuf, NHB}; run_gemm(lds, xb, (const bf16_t*)(ws + WS_WINB) + (size_t)j * NHB * DM, TT, NHB, DM, E, bid); }
            grid.sync();
            phase_gdn_pre(p, j);
            grid.sync();
#ifndef NAIVE_GDN
            phase_gdn_prep(p, lds);
            grid.sync();
#endif
#ifdef NAIVE_GDN
            if (bid < 48) gdn_naive_item(p, lds, (bid / 6) * 2048, 2048, bid % 6, nullptr, p.out + O_GSP + ((size_t)(j * 8 + bid / 6) * 6 + bid % 6) * 16384);
#else
            if (bid < 48) gdn_recur_prompt(p, lds, j, bid, (float*)(ws + WS_O), p.out + O_GSP);
#endif
            else {
                const int nb = G - 48;
                for (int it = bid - 48; it < 768; it += nb) gdn_sample_item(p, lds, j, it);
#ifdef NAIVE_ATTN
                for (int it = bid - 48; it < 256; it += nb) attn_prompt_item_naive(lds, hbuf, NHB, 3072, p.out + O_MK, p.out + O_MV, cat, l, it);
#else
                for (int it = bid - 48; it < 256; it += nb) attn_prompt_item(lds, hbuf, NHB, 3072, Kb, Vt, cat, l, it);
#endif
                for (int it = bid - 48; it < 256; it += nb) attn_sample_item(lds, hbuf, NHB, 3072, p.in[3], p.in[4], cat, l, it);
            }
            grid.sync();
#ifdef DIAG_GDN
            if (l == 1) {
                phase_gdn_prep(p, lds);
                grid.sync();
                if (bid < 48) gdn_recur_prompt(p, lds, j, bid, (float*)(ws + WS_OB2), (float*)(ws + WS_GS2));
                grid.sync();
                diag_compare(p, j);
                diag_compare2(p);
                grid.sync();
            }
#endif
            phase_gdn_post(p, j);
            grid.sync();
            { EpiResid E{xf, DM}; run_gemm(lds, cat, (const bf16_t*)(ws + WS_WOUTB) + (size_t)j * DM * DM, TT, DM, DM, E, bid); }
        }
        grid.sync();
        phase_ln(xf, xb, p.in[19] + l * DM, p.in[20] + l * DM, nullptr);
        grid.sync();
        { EpiStoreBf16 E{hu, NUP}; run_gemm(lds, xb, (const bf16_t*)(ws + WS_WUP) + (size_t)l * NUP * DM, TT, NUP, DM, E, bid); }
        grid.sync();
        phase_convgate(p, l);
        grid.sync();
        { EpiResid E{xf, DM}; run_gemm(lds, gact, (const bf16_t*)(ws + WS_WDOWN) + (size_t)l * DM * DFF, TT, DM, DFF, E, bid); }
        grid.sync();
        phase_ln(xf, xb, p.in[21] + l * DM, p.in[22] + l * DM, l == 3 ? p.out + O_Y : nullptr);
        if (l < 3) grid.sync();
    }
#ifdef DIAG_GDN
    grid.sync();
    if (bid == 0 && threadIdx.x == 0) { const float* dbg = (const float*)(ws + WS_DBG);
        const int code = 9 * diag_class(dbg[8], dbg[9]) + 3 * diag_class(dbg[10], dbg[11]) + diag_class(dbg[12], dbg[13]);
        float v = 1.0e4f; for (int i = 0; i < code; ++i) v *= 1.25f;
        p.out[0] = v; }
#endif
}

extern "C" void kernel_launch(void* const* d_in, const int* in_sizes, int n_in, void* d_out, int out_size, void* d_ws, size_t ws_size, hipStream_t stream) {
    static int grid_blocks = 0;
    if (grid_blocks == 0) {
        if (n_in != 26 || (size_t)out_size != O_END || ws_size < WS_NEED) { fprintf(stderr, "kernel_launch: unexpected shapes n_in %d out %d (want %zu) ws %zu (need %zu)\n", n_in, out_size, (size_t)O_END, ws_size, (size_t)WS_END); grid_blocks = -1; return; }
        int dev = 0, cus = 0, per_cu = 0;
        hipGetDevice(&dev);
        hipDeviceGetAttribute(&cus, hipDeviceAttributeMultiprocessorCount, dev);
        if (hipFuncSetAttribute((const void*)fwd_megakernel, hipFuncAttributeMaxDynamicSharedMemorySize, LDS_BYTES) != hipSuccess) { fprintf(stderr, "kernel_launch: hipFuncSetAttribute failed\n"); grid_blocks = -1; return; }
        hipOccupancyMaxActiveBlocksPerMultiprocessor(&per_cu, (const void*)fwd_megakernel, 512, LDS_BYTES);
        if (per_cu < 1) { fprintf(stderr, "kernel_launch: occupancy query says %d blocks/CU\n", per_cu); grid_blocks = -1; return; }
        grid_blocks = cus;
        if (grid_blocks > 256) grid_blocks = 256;
    }
    if (grid_blocks < 0) return;
    Params p{};
    for (int i = 0; i < 26; ++i) p.in[i] = (const float*)d_in[i];
    p.out = (float*)d_out; p.ws = (unsigned char*)d_ws;
    void* args[] = {&p};
    hipError_t e = hipLaunchCooperativeKernel((const void*)fwd_megakernel, dim3(grid_blocks), dim3(512), args, LDS_BYTES, stream);
    if (e != hipSuccess) fprintf(stderr, "cooperative launch failed: %s (grid %d)\n", hipGetErrorString(e), grid_blocks);
}
```

```cpp
#include <hip/hip_runtime.h>
#include <hip/hip_cooperative_groups.h>
#include <cstdio>
namespace cg = cooperative_groups;
namespace pg8 {
#define PG8_LAS __attribute__((address_space(3)))
typedef unsigned short bf16_t;
typedef short bf16x8 __attribute__((ext_vector_type(8)));
typedef float f32x4 __attribute__((ext_vector_type(4)));
typedef unsigned u32x4 __attribute__((ext_vector_type(4)));
constexpr int BM = 256, BK = 64, HALF = 128, HTB = HALF * BK * 2  , STAGE_BYTES = 8 * HTB, NXCD = 8, WGM = 8;

__host__ __device__ __forceinline__ int lds_byte(int r, int c) { const int st = (r >> 4) * 2 + (c >> 5), rr = r & 15, cc = c & 31, ob = rr * 64 + cc * 2; return st * 1024 + (ob ^ (((ob >> 9) & 1) << 5)); }
__host__ __device__ __forceinline__ void stage_rc(int b, int& R, int& C) { const int st = b / 1024, sb = b % 1024, swz = sb ^ (((sb >> 9) & 1) << 5); R = (st >> 1) * 16 + swz / 64; C = (st & 1) * 32 + (swz % 64) / 2; }
__host__ __device__ __forceinline__ int perm32(int rho) { const int n = rho >> 4, i = rho & 15; return 8 * (i >> 2) + 4 * n + (i & 3); }

struct Unit { int pm, pn; };
struct Gemm { const bf16_t* A; const bf16_t* Bt; int M, N, K; };

struct StaticOrder {
    int nM, nN, nwg, G, c;
    __host__ __device__ void init(int M, int N, int G_, int c_) { nM = M / BM; nN = N / BM; nwg = nM * nN; G = G_; c = c_; }
    __host__ __device__ bool next(int i, Unit& u) const {
        const long L = (long)i * G + c; if (L >= nwg) return false;
        int wgid = (int)L; { const int q = nwg / NXCD, r = nwg % NXCD, xcd = wgid % NXCD, off = wgid / NXCD; wgid = (xcd < r ? xcd * (q + 1) : r * (q + 1) + (xcd - r) * q) + off; }
        const int nig = WGM * nN, gid = wgid / nig, fm = gid * WGM, gsz = (nM - fm) < WGM ? (nM - fm) : WGM;
        u.pm = fm + ((wgid % nig) % gsz); u.pn = (wgid % nig) / gsz; return true;
    }
    __device__ __forceinline__ void a_ready(const Unit&) const {}
    __device__ __forceinline__ void done(const Unit&) const {}
};
__device__ __forceinline__ unsigned cvt_pk_bf16(float lo, float hi) { unsigned r; asm volatile("v_cvt_pk_bf16_f32 %0, %1, %2" : "=v"(r) : "v"(lo), "v"(hi)); return r; }
typedef float f32x2 __attribute__((ext_vector_type(2)));
template <class Epi, class Sched, bool STAMP = false>
__device__ __forceinline__ void gemm_phase(PG8_LAS unsigned char* lds, const Gemm g, const Sched& S, const Epi& E, unsigned long long* stamps) {
    int tid = threadIdx.x; asm volatile("" : "+v"(tid)); const int wid = __builtin_amdgcn_readfirstlane(tid >> 6), lane = tid & 63, wr = wid >> 2, wc = wid & 3, fr = lane & 15, fq = lane >> 4;
    const int K = g.K, nt = K / BK;
    int ts_lo = 0, ts_hi = 0, nts = 0; const unsigned long long rt_entry = STAMP ? (unsigned long long)wall_clock64() : 0ull;
#define PG8_STAMP() do { if (STAMP && wid == 0 && nts < 64) { const unsigned long long _c = (unsigned long long)clock64(); \
        ts_lo = (lane == nts) ? (int)(unsigned)_c : ts_lo; ts_hi = (lane == nts) ? (int)(unsigned)(_c >> 32) : ts_hi; ++nts; } } while (0)
    PG8_STAMP();
    unsigned voffA[2], voffB[2];
#pragma unroll
    for (int i = 0; i < 2; ++i) { int R, C; stage_rc(tid * 16 + i * 8192, R, C); const int Rb = Epi::PERM ? ((R & ~31) + perm32(R & 31)) : R;
        voffA[i] = (unsigned)(R * K + C) * 2u; voffB[i] = (unsigned)(Rb * K + C) * 2u; }
    const size_t kstep = (size_t)(BK * 2);
    const size_t hstep = (size_t)HALF * K * 2;
    const size_t tstep = 2 * hstep;
    const unsigned ldsw = (unsigned)wid * 1024u;
    const int aoff = lds_byte(wr * 64 + fr, fq * 8), boff = lds_byte(wc * 32 + fr, fq * 8);
#define PG8_SA(b, h) (((b) * 2 + (h)) * HTB)
#define PG8_SB(b, h) ((4 + (b) * 2 + (h)) * HTB)
#define PG8_STAGE(bufoff, gbase, voff) do { _Pragma("unroll") for (int _i = 0; _i < 2; ++_i) \
        __builtin_amdgcn_global_load_lds((const unsigned*)((const char*)(gbase) + (voff)[_i]), (PG8_LAS unsigned*)(lds + (bufoff) + ldsw + _i * 8192), 16, 0, 0); } while (0)
#define PG8_LDA(dst, b, h) do { _Pragma("unroll") for (int m = 0; m < 4; ++m) _Pragma("unroll") for (int k = 0; k < 2; ++k) dst[m][k] = *(const PG8_LAS bf16x8*)(lds + PG8_SA(b, h) + aoff + m * 2048 + k * 1024); } while (0)
#define PG8_LDB(dst, b, h) do { _Pragma("unroll") for (int n = 0; n < 2; ++n) _Pragma("unroll") for (int k = 0; k < 2; ++k) dst[n][k] = *(const PG8_LAS bf16x8*)(lds + PG8_SB(b, h) + boff + n * 2048 + k * 1024); } while (0)
#define PG8_MMA(ai, bj, At, Bt) do { __builtin_amdgcn_s_setprio(1); _Pragma("unroll") for (int m = 0; m < 4; ++m) _Pragma("unroll") for (int n = 0; n < 2; ++n) _Pragma("unroll") for (int k = 0; k < 2; ++k) \
        acc[ai][bj][m][n] = __builtin_amdgcn_mfma_f32_16x16x32_bf16(Bt[n][k], At[m][k], acc[ai][bj][m][n], 0, 0, 0); __builtin_amdgcn_s_setprio(0); } while (0)
#define PG8_WAIT_V(n) asm volatile("s_waitcnt vmcnt(" #n ")" ::: "memory")
#define PG8_WAIT_L(n) asm volatile("s_waitcnt lgkmcnt(" #n ")" ::: "memory")
#define PG8_BAR __builtin_amdgcn_s_barrier()
#define PG8_SCHED __builtin_amdgcn_sched_barrier(0)
    Unit cur, nxt; int ui = 0;
    if (!S.next(0, cur)) return;
    f32x4 acc[2][2][4][2];
#pragma unroll
    for (int a = 0; a < 2; ++a)
#pragma unroll
        for (int b = 0; b < 2; ++b)
#pragma unroll
            for (int m = 0; m < 4; ++m)
#pragma unroll
                for (int n = 0; n < 2; ++n) acc[a][b][m][n] = (f32x4){0.f, 0.f, 0.f, 0.f};
    bf16x8 At[4][2], B0[2][2], B1[2][2];
    const char* cA = (const char*)g.A + (size_t)cur.pm * tstep; const char* cB = (const char*)g.Bt + (size_t)cur.pn * tstep;
    S.a_ready(cur);
    PG8_STAGE(PG8_SB(0, 0), cB, voffB); PG8_STAGE(PG8_SA(0, 0), cA, voffA); PG8_STAGE(PG8_SB(0, 1), cB + hstep, voffB); PG8_STAGE(PG8_SA(0, 1), cA + hstep, voffA);
    if (wr == 1) PG8_BAR;
    PG8_WAIT_V(4); PG8_BAR;
    PG8_STAGE(PG8_SB(1, 0), cB + kstep, voffB); PG8_STAGE(PG8_SA(1, 0), cA + kstep, voffA); PG8_STAGE(PG8_SB(1, 1), cB + hstep + kstep, voffB);
    PG8_WAIT_V(6); PG8_BAR;
    PG8_STAMP();
    for (;;) {
        const bool has_next = S.next(ui + 1, nxt);
        const char* nA = has_next ? (const char*)g.A + (size_t)nxt.pm * tstep : cA; const char* nB = has_next ? (const char*)g.Bt + (size_t)nxt.pn * tstep : cB;
        for (int t = 0; t < nt; t += 2) {
            const bool last = (t == nt - 2);
            const char* a1 = cA + (size_t)(t + 1) * kstep;
            const char* a2 = last ? nA : cA + (size_t)(t + 2) * kstep; const char* b2 = last ? nB : cB + (size_t)(t + 2) * kstep;
            const char* a3 = a2 + kstep; const char* b3 = b2 + kstep;
            if (last && has_next) S.a_ready(nxt);
            PG8_LDB(B0, 0, 0); PG8_SCHED; PG8_LDA(At, 0, 0); PG8_STAGE(PG8_SA(1, 1), a1 + hstep, voffA);
            PG8_WAIT_L(8); PG8_BAR; PG8_WAIT_L(0); PG8_MMA(0, 0, At, B0); PG8_BAR; PG8_SCHED;
            PG8_LDB(B1, 0, 1); PG8_STAGE(PG8_SB(0, 0), b2, voffB);
            PG8_BAR; PG8_WAIT_L(0); PG8_MMA(0, 1, At, B1); PG8_BAR;
            PG8_LDA(At, 0, 1); PG8_STAGE(PG8_SA(0, 0), a2, voffA);
            PG8_BAR; PG8_WAIT_L(0); PG8_MMA(1, 0, At, B0); PG8_BAR; PG8_SCHED;
            PG8_STAGE(PG8_SB(0, 1), b2 + hstep, voffB);
            PG8_WAIT_V(6); PG8_BAR; PG8_MMA(1, 1, At, B1); PG8_BAR;
            PG8_LDB(B0, 1, 0); PG8_SCHED; PG8_LDA(At, 1, 0); PG8_STAGE(PG8_SA(0, 1), a2 + hstep, voffA);
            PG8_WAIT_L(8); PG8_BAR; PG8_WAIT_L(0); PG8_MMA(0, 0, At, B0); PG8_BAR; PG8_SCHED;
            PG8_LDB(B1, 1, 1); PG8_STAGE(PG8_SB(1, 0), b3, voffB);
            PG8_BAR; PG8_WAIT_L(0); PG8_MMA(0, 1, At, B1); PG8_BAR;
            PG8_LDA(At, 1, 1); PG8_STAGE(PG8_SA(1, 0), a3, voffA);
            PG8_BAR; PG8_WAIT_L(0); PG8_MMA(1, 0, At, B0); PG8_BAR; PG8_SCHED;
            PG8_STAGE(PG8_SB(1, 1), b3 + hstep, voffB);
            PG8_WAIT_V(6); PG8_BAR; PG8_MMA(1, 1, At, B1); PG8_BAR;
        }
        PG8_STAMP();
        if constexpr (!Epi::AFTER_DRAIN) { E(acc, cur, wr, wc, fr, fq); S.done(cur); }
        PG8_STAMP();
        if (!has_next) break;
#pragma unroll
        for (int a = 0; a < 2; ++a)
#pragma unroll
            for (int b = 0; b < 2; ++b)
#pragma unroll
                for (int m = 0; m < 4; ++m)
#pragma unroll
                    for (int n = 0; n < 2; ++n) acc[a][b][m][n] = (f32x4){0.f, 0.f, 0.f, 0.f};
        cur = nxt; cA = nA; cB = nB; ++ui;
    }
    PG8_WAIT_V(0);
    if (wr == 0) PG8_BAR;
    PG8_BAR;
    if constexpr (Epi::AFTER_DRAIN) { E.fused(acc, cur, wr, wc, fr, fq, lds, wid, lane); S.done(cur); }
    PG8_STAMP();
    if (STAMP && wid == 0) { stamps[lane] = lane < nts ? (((unsigned long long)(unsigned)ts_hi << 32) | (unsigned)ts_lo) : 0ull;
        if (lane == 62) stamps[62] = rt_entry; if (lane == 63) stamps[63] = (unsigned long long)wall_clock64(); }
#undef PG8_STAMP
#undef PG8_SA
#undef PG8_SB
#undef PG8_STAGE
#undef PG8_LDA
#undef PG8_LDB
#undef PG8_MMA
#undef PG8_WAIT_V
#undef PG8_WAIT_L
#undef PG8_BAR
#undef PG8_SCHED
}
}

#define LAS __attribute__((address_space(3)))
using pg8::bf16_t; using pg8::bf16x8; using pg8::f32x4; using pg8::u32x4; using pg8::cvt_pk_bf16;
typedef unsigned u32x2 __attribute__((ext_vector_type(2)));
typedef float f32x2 __attribute__((ext_vector_type(2)));

constexpr int TP = 16384, TS = 512, TT = 16896, DM = 1024;
constexpr int NHA = 2560, NHB = 3584, DFF = 2816, NUP = 5632;
constexpr float ALPHA = 1.6817928305074292f;
constexpr int LDS_BYTES = 139264;

constexpr size_t WS_WINA = 0;
constexpr size_t WS_WOUTA = WS_WINA + (size_t)2 * NHA * DM * 2;
constexpr size_t WS_WINB = WS_WOUTA + (size_t)2 * DM * DM * 2;
constexpr size_t WS_WOUTB = WS_WINB + (size_t)2 * NHB * DM * 2;
constexpr size_t WS_WKV = WS_WOUTB + (size_t)2 * DM * DM * 2;
constexpr size_t WS_WUP = WS_WKV + (size_t)2048 * DM * 2;
constexpr size_t WS_WDOWN = WS_WUP + (size_t)4 * NUP * DM * 2;
constexpr size_t WS_XF = WS_WDOWN + (size_t)4 * DM * DFF * 2;
constexpr size_t WS_XB = WS_XF + (size_t)TT * DM * 4;
constexpr size_t WS_MEMB = WS_XB + (size_t)TT * DM * 2;
constexpr size_t WS_KB = WS_MEMB + (size_t)2048 * DM * 2;
constexpr size_t WS_VT = WS_KB + (size_t)4 * 8 * 4 * 256 * 64 * 2;
constexpr size_t WS_R = WS_VT + (size_t)4 * 8 * 4 * 256 * 64 * 2;
constexpr size_t WS_H = WS_R;
constexpr size_t WS_CAT = WS_H + (size_t)TT * NHB * 2;
constexpr size_t WS_QKVN = WS_CAT + (size_t)TT * DM * 2;
constexpr size_t WS_GB = WS_QKVN + (size_t)TT * 2304 * 2;
constexpr size_t WS_WC = WS_GB + (size_t)TT * 12 * 4;
constexpr size_t WS_QDC = WS_WC + (size_t)1536 * 16384;
constexpr size_t WS_KDT = WS_QDC + (size_t)1536 * 16384;
constexpr size_t WS_QKC = WS_KDT + (size_t)1536 * 16384;
constexpr size_t WS_UT = WS_QKC + (size_t)1536 * 8192;
constexpr size_t WS_GL = WS_UT + (size_t)1536 * 32768;
constexpr size_t WS_O = WS_GL + (size_t)1536 * 4 + 2048;
constexpr size_t WS_MIX_END = WS_O + (size_t)TT * 768 * 4;
constexpr size_t WS_HU = WS_R;
constexpr size_t WS_GACT = WS_HU + (size_t)TT * NUP * 2;
constexpr size_t WS_FFN_END = WS_GACT + (size_t)TT * DFF * 2;
constexpr size_t WS_END = WS_MIX_END > WS_FFN_END ? WS_MIX_END : WS_FFN_END;

constexpr size_t O_Y = 0;
constexpr size_t O_MK = O_Y + (size_t)TT * DM;
constexpr size_t O_MV = O_MK + (size_t)4 * 8 * 256 * 256;
constexpr size_t O_SCP = O_MV + (size_t)4 * 8 * 256 * 256;
constexpr size_t O_GCP = O_SCP + (size_t)2 * 8 * 2 * 768;
constexpr size_t O_GSP = O_GCP + (size_t)2 * 8 * 3 * 2304;
constexpr size_t O_FFP = O_GSP + (size_t)2 * 8 * 6 * 16384;
constexpr size_t O_SCS = O_FFP + (size_t)4 * 8 * 2 * NUP;
constexpr size_t O_GCS = O_SCS + (size_t)2 * 128 * 2 * 768;
constexpr size_t O_GSS = O_GCS + (size_t)2 * 128 * 3 * 2304;
constexpr size_t O_FFS = O_GSS + (size_t)2 * 128 * 6 * 16384;
constexpr size_t O_END = O_FFS + (size_t)4 * 128 * 2 * NUP;

#ifdef DIAG_GDN
constexpr size_t WS_NEED = WS_END + ((size_t)64 << 20);
#else
constexpr size_t WS_NEED = WS_END;
#endif
constexpr size_t WS_BAR = (WS_NEED + 255) / 256 * 256;
constexpr size_t WS_TOTAL = WS_BAR + 16384;
struct Params { const float* in[26]; float* out; unsigned char* ws; };
__device__ __forceinline__ int otid() { int t = threadIdx.x; asm volatile("" : "+v"(t)); return t; }

__device__ __forceinline__ float bflo(unsigned w) { return __uint_as_float(w << 16); }
__device__ __forceinline__ float bfhi(unsigned w) { return __uint_as_float(w & 0xffff0000u); }
__device__ __forceinline__ float bf1(bf16_t v) { return __uint_as_float((unsigned)v << 16); }
__device__ __forceinline__ float silu_f(float x) { return x / (1.f + __expf(-x)); }
__device__ __forceinline__ float wave_sum(float v) {
#pragma unroll
    for (int o = 1; o < 64; o <<= 1) v += __shfl_xor(v, o);
    return v;
}
__device__ __forceinline__ bf16x8 as_bf16x8(u32x4 v) { union { u32x4 u; bf16x8 b; } x; x.u = v; return x.b; }
__device__ __forceinline__ bf16x8 pack8(f32x4 a, f32x4 b) {
    u32x4 w; w.x = cvt_pk_bf16(a[0], a[1]); w.y = cvt_pk_bf16(a[2], a[3]); w.z = cvt_pk_bf16(b[0], b[1]); w.w = cvt_pk_bf16(b[2], b[3]);
    return as_bf16x8(w);
}
__device__ __forceinline__ int invperm32(int a) { return 8 * ((a & 15) >> 2) + (a & 3) + ((a >> 4) << 2); }
__device__ __forceinline__ int perm32k(int p) { const int g = p >> 3, jj = p & 7; return jj < 4 ? 4 * g + jj : 16 + 4 * g + (jj - 4); }

struct EpiStoreBf16 {
    static constexpr bool PERM = true, AFTER_DRAIN = false;
    bf16_t* O; int ldc;
    __device__ __forceinline__ void operator()(const f32x4 (&acc)[2][2][4][2], const pg8::Unit& u, int wr, int wc, int fr, int fq) const {
        const int row0 = u.pm * 256 + wr * 64 + fr, col0 = u.pn * 256 + wc * 32 + 8 * fq;
#pragma unroll
        for (int ai = 0; ai < 2; ++ai)
#pragma unroll
            for (int m = 0; m < 4; ++m) { bf16_t* rowp = O + (size_t)(row0 + ai * 128 + m * 16) * ldc + col0;
#pragma unroll
                for (int bj = 0; bj < 2; ++bj) { const f32x4 v0 = acc[ai][bj][m][0], v1 = acc[ai][bj][m][1];
                    u32x4 w; w.x = cvt_pk_bf16(v0[0], v0[1]); w.y = cvt_pk_bf16(v0[2], v0[3]); w.z = cvt_pk_bf16(v1[0], v1[1]); w.w = cvt_pk_bf16(v1[2], v1[3]);
                    *(u32x4*)(rowp + bj * 128) = w; } }
    }
};
struct EpiResid {
    static constexpr bool PERM = false, AFTER_DRAIN = false;
    float* X; int ldc;
    __device__ __forceinline__ void operator()(const f32x4 (&acc)[2][2][4][2], const pg8::Unit& u, int wr, int wc, int fr, int fq) const {
        const int row0 = u.pm * 256 + wr * 64 + fr, col0 = u.pn * 256 + wc * 32 + 4 * fq;
#pragma unroll
        for (int ai = 0; ai < 2; ++ai)
#pragma unroll
            for (int m = 0; m < 4; ++m) { float* rowp = X + (size_t)(row0 + ai * 128 + m * 16) * ldc + col0;
#pragma unroll
                for (int bj = 0; bj < 2; ++bj)
#pragma unroll
                    for (int n = 0; n < 2; ++n) { f32x4* p = (f32x4*)(rowp + bj * 128 + n * 16); const f32x4 x = *p; *p = x * ALPHA + acc[ai][bj][m][n]; } }
    }
};
struct EpiKV {
    static constexpr bool PERM = false, AFTER_DRAIN = false;
    float* outK; float* outV; bf16_t* Kb; bf16_t* Vt;
    __device__ __forceinline__ void operator()(const f32x4 (&acc)[2][2][4][2], const pg8::Unit& u, int wr, int wc, int fr, int fq) const {
        const int row0 = u.pm * 256 + wr * 64 + fr, col0 = u.pn * 256 + wc * 32 + 4 * fq;
#pragma unroll
        for (int ai = 0; ai < 2; ++ai)
#pragma unroll
            for (int m = 0; m < 4; ++m) { const int row = row0 + ai * 128 + m * 16; const int b = row >> 8, mm = row & 255;
#pragma unroll
                for (int bj = 0; bj < 2; ++bj)
#pragma unroll
                    for (int n = 0; n < 2; ++n) { const int col = col0 + bj * 128 + n * 16; const int l = col >> 9, e = col & 511; const f32x4 v = acc[ai][bj][m][n];
                        if (e < 256) { *(f32x4*)(outK + ((size_t)((l * 8 + b) * 256 + mm)) * 256 + e) = v;
                            u32x2 w; w.x = cvt_pk_bf16(v[0], v[1]); w.y = cvt_pk_bf16(v[2], v[3]);
                            *(u32x2*)(Kb + ((size_t)(((l * 8 + b) * 4 + (e >> 6)) * 256 + mm)) * 64 + (e & 63)) = w; }
                        else { const int e2 = e - 256; *(f32x4*)(outV + ((size_t)((l * 8 + b) * 256 + mm)) * 256 + e2) = v;
                            const unsigned w0 = cvt_pk_bf16(v[0], v[1]), w1 = cvt_pk_bf16(v[2], v[3]);
                            bf16_t* vp = Vt + ((size_t)(((l * 8 + b) * 4 + (e2 >> 6)) * 64 + (e2 & 63))) * 256 + mm;
                            vp[0] = (bf16_t)(w0 & 0xffffu); vp[256] = (bf16_t)(w0 >> 16); vp[512] = (bf16_t)(w1 & 0xffffu); vp[768] = (bf16_t)(w1 >> 16); } } }
    }
};

template <class Epi>
__device__ __forceinline__ void run_gemm(LAS unsigned char* lds, const bf16_t* A, const bf16_t* Bt, int M, int N, int K, const Epi& E, int c) {
    pg8::Gemm g{A, Bt, M, N, K}; pg8::StaticOrder S; S.init(M, N, (int)gridDim.x, c);
    pg8::gemm_phase<Epi, pg8::StaticOrder, false>(lds, g, S, E, nullptr);
}

__device__ __forceinline__ void p0_transpose_item(const float* W, int K, int Ns, int Nd, bool remap, bf16_t* WT, LAS float* scr, int item, int lane) {
    const int nblk = Nd / 32, kb = item / nblk, nb = item % nblk, k0 = 64 * kb, n0 = 32 * nb;
    const int n = n0 + (lane & 31); int sn = n;
    if (remap) sn = n < 3072 ? n : (n < 3328 ? n + 12 : (n < 3340 ? n - 256 : -1));
#pragma unroll 8
    for (int i = 0; i < 32; ++i) { const int kk = 2 * i + (lane >> 5); scr[kk * 33 + (lane & 31)] = sn >= 0 ? W[(size_t)(k0 + kk) * Ns + sn] : 0.f; }
    asm volatile("s_waitcnt lgkmcnt(0)" ::: "memory");
    const int c = lane & 7;
#pragma unroll
    for (int j = 0; j < 4; ++j) { const int nn = (lane >> 3) + 8 * j; const LAS float* s = scr + (8 * c) * 33 + nn;
        u32x4 o; o.x = cvt_pk_bf16(s[0 * 33], s[1 * 33]); o.y = cvt_pk_bf16(s[2 * 33], s[3 * 33]); o.z = cvt_pk_bf16(s[4 * 33], s[5 * 33]); o.w = cvt_pk_bf16(s[6 * 33], s[7 * 33]);
        *(u32x4*)(WT + (size_t)(n0 + nn) * K + k0 + 8 * c) = o; }
    asm volatile("s_waitcnt lgkmcnt(0)" ::: "memory");
}

__device__ __forceinline__ void phase_prep(const Params& p, LAS unsigned char* lds) {
    const int tid = otid(), lane = tid & 63, wave = __builtin_amdgcn_readfirstlane(tid >> 6);
    const int gw = blockIdx.x * 8 + wave, NGW = gridDim.x * 8;
    LAS float* scr = (LAS float*)(lds + wave * 16384);
    unsigned char* ws = p.ws;
    constexpr int I_INA = 16 * 80, I_OUT = 16 * 32, I_INB = 16 * 112, I_KV = 16 * 16, I_UP = 16 * 176, I_DN = 44 * 32;
    constexpr int NIT = 2 * I_INA + 2 * I_OUT + 2 * I_INB + 2 * I_OUT + 4 * I_KV + 4 * I_UP + 4 * I_DN;
    for (int it = gw; it < NIT; it += NGW) {
        int r = it;
        if (r < 2 * I_INA) { const int l = r / I_INA; r -= l * I_INA; p0_transpose_item(p.in[9] + (size_t)l * DM * NHA, DM, NHA, NHA, false, (bf16_t*)(ws + WS_WINA) + (size_t)l * NHA * DM, scr, r, lane); continue; } r -= 2 * I_INA;
        if (r < 2 * I_OUT) { const int l = r / I_OUT; r -= l * I_OUT; p0_transpose_item(p.in[11] + (size_t)l * DM * DM, DM, DM, DM, false, (bf16_t*)(ws + WS_WOUTA) + (size_t)l * DM * DM, scr, r, lane); continue; } r -= 2 * I_OUT;
        if (r < 2 * I_INB) { const int l = r / I_INB; r -= l * I_INB; p0_transpose_item(p.in[12] + (size_t)l * DM * 3340, DM, 3340, NHB, true, (bf16_t*)(ws + WS_WINB) + (size_t)l * NHB * DM, scr, r, lane); continue; } r -= 2 * I_INB;
        if (r < 2 * I_OUT) { const int l = r / I_OUT; r -= l * I_OUT; p0_transpose_item(p.in[17] + (size_t)l * DM * DM, DM, DM, DM, false, (bf16_t*)(ws + WS_WOUTB) + (size_t)l * DM * DM, scr, r, lane); continue; } r -= 2 * I_OUT;
        if (r < 4 * I_KV) { const int l = r / I_KV; r -= l * I_KV; p0_transpose_item(p.in[18] + (size_t)l * DM * 512, DM, 512, 512, false, (bf16_t*)(ws + WS_WKV) + (size_t)l * 512 * DM, scr, r, lane); continue; } r -= 4 * I_KV;
        if (r < 4 * I_UP) { const int l = r / I_UP; r -= l * I_UP; p0_transpose_item(p.in[23] + (size_t)l * DM * NUP, DM, NUP, NUP, false, (bf16_t*)(ws + WS_WUP) + (size_t)l * NUP * DM, scr, r, lane); continue; } r -= 4 * I_UP;
        { const int l = r / I_DN; r -= l * I_DN; p0_transpose_item(p.in[25] + (size_t)l * DFF * DM, DFF, DM, DM, false, (bf16_t*)(ws + WS_WDOWN) + (size_t)l * DM * DFF, scr, r, lane); }
    }
    const size_t gt = (size_t)blockIdx.x * 512 + tid, NT = (size_t)gridDim.x * 512;
    float* xf = (float*)(ws + WS_XF); bf16_t* xb = (bf16_t*)(ws + WS_XB); bf16_t* memb = (bf16_t*)(ws + WS_MEMB);
    for (size_t i = gt; i < (size_t)TT * 256; i += NT) {
        const f32x4 v = i < (size_t)TP * 256 ? ((const f32x4*)p.in[0])[i] : ((const f32x4*)p.in[1])[i - (size_t)TP * 256];
        ((f32x4*)xf)[i] = v; u32x2 w; w.x = cvt_pk_bf16(v[0], v[1]); w.y = cvt_pk_bf16(v[2], v[3]); ((u32x2*)xb)[i] = w;
    }
    for (size_t i = gt; i < (size_t)2048 * 256; i += NT) {
        const f32x4 v = ((const f32x4*)p.in[2])[i]; u32x2 w; w.x = cvt_pk_bf16(v[0], v[1]); w.y = cvt_pk_bf16(v[2], v[3]); ((u32x2*)memb)[i] = w;
    }
}

__device__ __forceinline__ void phase_ln(float* xf, bf16_t* xb, const float* gam, const float* bet, float* yout) {
    const int tid_ = otid(); const int lane = tid_ & 63, wave = __builtin_amdgcn_readfirstlane(tid_ >> 6);
    const int gw = blockIdx.x * 8 + wave, NGW = gridDim.x * 8;
    f32x4 gg[4], bb[4];
#pragma unroll
    for (int j = 0; j < 4; ++j) { gg[j] = ((const f32x4*)gam)[lane + 64 * j]; bb[j] = ((const f32x4*)bet)[lane + 64 * j]; }
    for (int row = gw; row < TT; row += NGW) {
        f32x4* xr = (f32x4*)(xf + (size_t)row * DM) + lane;
        f32x4 v[4]; float s = 0.f;
#pragma unroll
        for (int j = 0; j < 4; ++j) { v[j] = xr[64 * j]; s += (v[j][0] + v[j][1]) + (v[j][2] + v[j][3]); }
        const float mean = wave_sum(s) * (1.f / DM); float s2 = 0.f;
#pragma unroll
        for (int j = 0; j < 4; ++j) { v[j] = v[j] - mean; s2 += (v[j][0] * v[j][0] + v[j][1] * v[j][1]) + (v[j][2] * v[j][2] + v[j][3] * v[j][3]); }
        const float rstd = 1.f / sqrtf(wave_sum(s2) * (1.f / DM) + 1e-5f);
#pragma unroll
        for (int j = 0; j < 4; ++j) { const f32x4 o = v[j] * rstd * gg[j] + bb[j];
            if (yout) ((f32x4*)(yout + (size_t)row * DM))[lane + 64 * j] = o;
            else { xr[64 * j] = o; u32x2 w; w.x = cvt_pk_bf16(o[0], o[1]); w.y = cvt_pk_bf16(o[2], o[3]); ((u32x2*)(xb + (size_t)row * DM))[lane + 64 * j] = w; } }
    }
}

__device__ __forceinline__ void attn_prompt_item(LAS unsigned char* lds, const bf16_t* h, int ldh, int qoff, const bf16_t* Kb, const bf16_t* Vt, bf16_t* cat, int layer, int item) {
    const int tid = otid(), lane = tid & 63, wave = __builtin_amdgcn_readfirstlane(tid >> 6), c16 = lane & 15, g = lane >> 4;
    const int qc = item & 7, hd = (item >> 3) & 3, b = item >> 5;
    const size_t kvbase = ((size_t)((layer * 8 + b) * 4 + hd)) * 16384;
    constexpr int VOFF = 256 * 144;
#pragma unroll
    for (int i = 0; i < 4; ++i) { const int q = tid + 512 * i;
        const u32x4 kv = *(const u32x4*)(Kb + kvbase + (size_t)q * 8); *(LAS u32x4*)(lds + (q >> 3) * 144 + (q & 7) * 16) = kv;
        const u32x4 vv = *(const u32x4*)(Vt + kvbase + (size_t)q * 8); *(LAS u32x4*)(lds + VOFF + (q >> 5) * 528 + (q & 31) * 16) = vv; }
    __syncthreads();
#pragma unroll 1
    for (int qt = wave; qt < 16; qt += 8) {
        const int row = b * 2048 + qc * 256 + qt * 16 + c16;
        const bf16_t* qp = h + (size_t)row * ldh + qoff + hd * 64 + g * 8;
        const bf16x8 qf0 = *(const bf16x8*)qp, qf1 = *(const bf16x8*)(qp + 32);
        f32x4 acc[16];
#pragma unroll
        for (int kt = 0; kt < 16; ++kt) { acc[kt] = (f32x4){0.f, 0.f, 0.f, 0.f};
            const LAS unsigned char* kp = lds + (16 * kt + c16) * 144 + g * 16;
            const bf16x8 k0 = *(const LAS bf16x8*)kp, k1 = *(const LAS bf16x8*)(kp + 64);
            acc[kt] = __builtin_amdgcn_mfma_f32_16x16x32_bf16(k0, qf0, acc[kt], 0, 0, 0);
            acc[kt] = __builtin_amdgcn_mfma_f32_16x16x32_bf16(k1, qf1, acc[kt], 0, 0, 0); }
        float mx = -3.0e38f;
#pragma unroll
        for (int kt = 0; kt < 16; ++kt) mx = fmaxf(mx, fmaxf(fmaxf(acc[kt][0], acc[kt][1]), fmaxf(acc[kt][2], acc[kt][3])));
        mx = fmaxf(mx, __shfl_xor(mx, 16)); mx = fmaxf(mx, __shfl_xor(mx, 32));
        const float sc = 0.125f * 1.44269504089f; float sum = 0.f;
#pragma unroll
        for (int kt = 0; kt < 16; ++kt)
#pragma unroll
            for (int r = 0; r < 4; ++r) { const float e = __builtin_amdgcn_exp2f((acc[kt][r] - mx) * sc); acc[kt][r] = e; sum += e; }
        sum += __shfl_xor(sum, 16); sum += __shfl_xor(sum, 32);
        const float inv = 1.f / sum;
        f32x4 o[4];
#pragma unroll
        for (int dt = 0; dt < 4; ++dt) o[dt] = (f32x4){0.f, 0.f, 0.f, 0.f};
#pragma unroll
        for (int s = 0; s < 8; ++s) { const bf16x8 pf = pack8(acc[2 * s], acc[2 * s + 1]);
#pragma unroll
            for (int dt = 0; dt < 4; ++dt) { const LAS unsigned char* vp = lds + VOFF + (16 * dt + c16) * 528 + (32 * s + 4 * g) * 2;
                const u32x2 a0 = *(const LAS u32x2*)vp, a1 = *(const LAS u32x2*)(vp + 32);
                u32x4 av; av.x = a0.x; av.y = a0.y; av.z = a1.x; av.w = a1.y;
                o[dt] = __builtin_amdgcn_mfma_f32_16x16x32_bf16(as_bf16x8(av), pf, o[dt], 0, 0, 0); } }
#pragma unroll
        for (int dt = 0; dt < 4; ++dt) { u32x2 w; w.x = cvt_pk_bf16(o[dt][0] * inv, o[dt][1] * inv); w.y = cvt_pk_bf16(o[dt][2] * inv, o[dt][3] * inv);
            *(u32x2*)(cat + (size_t)row * DM + 768 + hd * 64 + 16 * dt + 4 * g) = w; }
    }
    __syncthreads();
}

__device__ __forceinline__ void attn_prompt_item_naive(LAS unsigned char* lds, const bf16_t* h, int ldh, int qoff, const float* outK, const float* outV, bf16_t* cat, int layer, int item) {
    const int tid = otid();
    const int qc = item & 7, hd = (item >> 3) & 3, b = item >> 5;
    LAS float* Ks = (LAS float*)lds; LAS float* Vs = Ks + 256 * 64;
    for (int i = tid; i < 256 * 64; i += 512) { const int m = i >> 6, d = i & 63; const size_t src = ((size_t)((layer * 8 + b) * 256 + m)) * 256 + hd * 64 + d; Ks[i] = outK[src]; Vs[i] = outV[src]; }
    __syncthreads();
    const int ql = tid & 255, half = tid >> 8;
    const int row = b * 2048 + qc * 256 + ql;
    float q[64];
#pragma unroll
    for (int d = 0; d < 64; ++d) q[d] = bf1(h[(size_t)row * ldh + qoff + hd * 64 + d]);
    float mx = -3.0e38f, l = 0.f; float acc[64];
#pragma unroll
    for (int d = 0; d < 64; ++d) acc[d] = 0.f;
#pragma unroll 1
    for (int m = half * 128; m < half * 128 + 128; ++m) {
        float sdot = 0.f;
#pragma unroll
        for (int d = 0; d < 64; ++d) sdot += q[d] * Ks[m * 64 + d];
        sdot *= 0.125f;
        const float nm = fmaxf(mx, sdot); const float corr = __expf(mx - nm), pe = __expf(sdot - nm);
        l = l * corr + pe;
#pragma unroll
        for (int d = 0; d < 64; ++d) acc[d] = acc[d] * corr + pe * Vs[m * 64 + d];
        mx = nm;
    }
    __syncthreads();
    LAS float* ex = (LAS float*)lds;
    if (half == 1) { ex[ql * 66 + 64] = mx; ex[ql * 66 + 65] = l;
#pragma unroll
        for (int d = 0; d < 64; ++d) ex[ql * 66 + d] = acc[d]; }
    __syncthreads();
    if (half == 0) { const float m2 = ex[ql * 66 + 64], l2 = ex[ql * 66 + 65]; const float nm = fmaxf(mx, m2); const float c1 = __expf(mx - nm), c2 = __expf(m2 - nm); const float inv = 1.f / (l * c1 + l2 * c2);
#pragma unroll
        for (int d = 0; d < 64; ++d) { const float o = (acc[d] * c1 + ex[ql * 66 + d] * c2) * inv; cat[(size_t)row * DM + 768 + hd * 64 + d] = (bf16_t)(cvt_pk_bf16(o, 0.f) & 0xffffu); } }
    __syncthreads();
}
__device__ __forceinline__ void attn_sample_item(LAS unsigned char* lds, const bf16_t* h, int ldh, int qoff, const float* ck, const float* cv, bf16_t* cat, int layer, int item) {
    const int tid = otid(), lane = tid & 63, wave = __builtin_amdgcn_readfirstlane(tid >> 6);
    const int hp = item & 1, sb = item >> 1;
    LAS float* qs = (LAS float*)lds;
    LAS float* scs = qs + 512;
    LAS float* red = scs + 2048;
    { const int t = tid >> 7, hh = (tid >> 6) & 1, d = tid & 63;
      qs[tid] = bf1(h[(size_t)(TP + sb * 4 + t) * ldh + qoff + (2 * hp + hh) * 64 + d]); }
    __syncthreads();
    { const int m = tid & 255, hh = tid >> 8;
      const f32x4* kp = (const f32x4*)(ck + (((size_t)(layer * 128 + sb) * 256 + m) * 4 + (2 * hp + hh)) * 64);
      float a0 = 0.f, a1 = 0.f, a2 = 0.f, a3 = 0.f;
#pragma unroll
      for (int i = 0; i < 16; ++i) { const f32x4 kv = kp[i];
#pragma unroll
          for (int e = 0; e < 4; ++e) { const int d = 4 * i + e; a0 += kv[e] * qs[(0 * 2 + hh) * 64 + d]; a1 += kv[e] * qs[(1 * 2 + hh) * 64 + d]; a2 += kv[e] * qs[(2 * 2 + hh) * 64 + d]; a3 += kv[e] * qs[(3 * 2 + hh) * 64 + d]; } }
      scs[(0 * 2 + hh) * 256 + m] = a0 * 0.125f; scs[(1 * 2 + hh) * 256 + m] = a1 * 0.125f; scs[(2 * 2 + hh) * 256 + m] = a2 * 0.125f; scs[(3 * 2 + hh) * 256 + m] = a3 * 0.125f; }
    __syncthreads();
    { LAS float* sp = scs + wave * 256; float v[4]; float mx = -3.0e38f;
#pragma unroll
      for (int i = 0; i < 4; ++i) { v[i] = sp[lane + 64 * i]; mx = fmaxf(mx, v[i]); }
#pragma unroll
      for (int o = 1; o < 64; o <<= 1) mx = fmaxf(mx, __shfl_xor(mx, o));
      float s = 0.f;
#pragma unroll
      for (int i = 0; i < 4; ++i) { v[i] = __expf(v[i] - mx); s += v[i]; }
      s = wave_sum(s); const float inv = 1.f / s;
#pragma unroll
      for (int i = 0; i < 4; ++i) sp[lane + 64 * i] = v[i] * inv; }
    __syncthreads();
    { const int d = tid & 63, hh = (tid >> 6) & 1, mp = tid >> 7;
      float a0 = 0.f, a1 = 0.f, a2 = 0.f, a3 = 0.f;
      const float* vp = cv + (((size_t)(layer * 128 + sb) * 256 + mp * 64) * 4 + (2 * hp + hh)) * 64 + d;
#pragma unroll 8
      for (int m = 0; m < 64; ++m) { const float vv = vp[(size_t)m * 256]; const int mm = mp * 64 + m;
          a0 += scs[(0 * 2 + hh) * 256 + mm] * vv; a1 += scs[(1 * 2 + hh) * 256 + mm] * vv; a2 += scs[(2 * 2 + hh) * 256 + mm] * vv; a3 += scs[(3 * 2 + hh) * 256 + mm] * vv; }
      red[(mp * 8 + 0 * 2 + hh) * 64 + d] = a0; red[(mp * 8 + 1 * 2 + hh) * 64 + d] = a1; red[(mp * 8 + 2 * 2 + hh) * 64 + d] = a2; red[(mp * 8 + 3 * 2 + hh) * 64 + d] = a3; }
    __syncthreads();
    { const int t = tid >> 7, hh = (tid >> 6) & 1, d = tid & 63; const int idx = (t * 2 + hh) * 64 + d;
      const float o = red[idx] + red[512 + idx] + red[1024 + idx] + red[1536 + idx];
      cat[(size_t)(TP + sb * 4 + t) * DM + 768 + (2 * hp + hh) * 64 + d] = (bf16_t)(cvt_pk_bf16(o, 0.f) & 0xffffu); }
    __syncthreads();
}

__device__ __forceinline__ void load_u8(const bf16_t* h, size_t row, int c, float* u) {
    const u32x4 xi = *(const u32x4*)(h + row * NHA + c), cg = *(const u32x4*)(h + row * NHA + 1536 + c);
#pragma unroll
    for (int i = 0; i < 4; ++i) { u[2 * i] = bflo(xi[i]) * bflo(cg[i]); u[2 * i + 1] = bfhi(xi[i]) * bfhi(cg[i]); }
}
__device__ __forceinline__ void phase_mixA_elem(const Params& p, int j) {
    const bf16_t* h = (const bf16_t*)(p.ws + WS_H); bf16_t* cat = (bf16_t*)(p.ws + WS_CAT);
    const float* cw = p.in[10] + (size_t)j * 3 * 768; const float* hist = p.in[5] + (size_t)j * 128 * 2 * 768;
    const size_t gt = (size_t)blockIdx.x * 512 + otid(), NT = (size_t)gridDim.x * 512;
    for (size_t idx = gt; idx < (size_t)TT * 96; idx += NT) {
        const int row = (int)(idx / 96), c = (int)(idx % 96) * 8;
        const bool smp = row >= TP; const int t = smp ? ((row - TP) & 3) : (row & 2047); const int bb = smp ? ((row - TP) >> 2) : (row >> 11);
        float u0[8], u1[8], u2[8];
        load_u8(h, row, c, u2);
        if (t >= 1) load_u8(h, row - 1, c, u1);
        else if (smp) { const f32x4* hp = (const f32x4*)(hist + ((size_t)bb * 2 + 1) * 768 + c); const f32x4 a = hp[0], b2 = hp[1];
#pragma unroll
            for (int i = 0; i < 4; ++i) { u1[i] = a[i]; u1[4 + i] = b2[i]; } }
        else {
#pragma unroll
            for (int i = 0; i < 8; ++i) u1[i] = 0.f; }
        if (t >= 2) load_u8(h, row - 2, c, u0);
        else if (smp) { const f32x4* hp = (const f32x4*)(hist + ((size_t)bb * 2 + t) * 768 + c); const f32x4 a = hp[0], b2 = hp[1];
#pragma unroll
            for (int i = 0; i < 4; ++i) { u0[i] = a[i]; u0[4 + i] = b2[i]; } }
        else {
#pragma unroll
            for (int i = 0; i < 8; ++i) u0[i] = 0.f; }
        const u32x4 bg = *(const u32x4*)(h + (size_t)row * NHA + 768 + c);
        float y[8];
#pragma unroll
        for (int i = 0; i < 8; ++i) { const float w0 = cw[c + i], w1 = cw[768 + c + i], w2 = cw[1536 + c + i];
            const float bgv = (i & 1) ? bfhi(bg[i >> 1]) : bflo(bg[i >> 1]);
            y[i] = bgv * (w0 * u0[i] + w1 * u1[i] + w2 * u2[i]); }
        u32x4 w; w.x = cvt_pk_bf16(y[0], y[1]); w.y = cvt_pk_bf16(y[2], y[3]); w.z = cvt_pk_bf16(y[4], y[5]); w.w = cvt_pk_bf16(y[6], y[7]);
        *(u32x4*)(cat + (size_t)row * DM + c) = w;
        const int T = smp ? 4 : 2048;
        if (t >= T - 2) { float* op = p.out + (smp ? O_SCS : O_SCP) + (((size_t)j * (smp ? 128 : 8) + bb) * 2 + (t - (T - 2))) * 768 + c;
            ((f32x4*)op)[0] = (f32x4){u2[0], u2[1], u2[2], u2[3]}; ((f32x4*)op)[1] = (f32x4){u2[4], u2[5], u2[6], u2[7]}; }
    }
}

__device__ __forceinline__ void load_h8(const bf16_t* hu, size_t row, int c, float* v) {
    const u32x4 x = *(const u32x4*)(hu + row * NUP + c);
#pragma unroll
    for (int i = 0; i < 4; ++i) { v[2 * i] = bflo(x[i]); v[2 * i + 1] = bfhi(x[i]); }
}
__device__ __forceinline__ void load_f8(const float* src, float* v) {
    const f32x4 a = ((const f32x4*)src)[0], b = ((const f32x4*)src)[1];
#pragma unroll
    for (int i = 0; i < 4; ++i) { v[i] = a[i]; v[4 + i] = b[i]; }
}
__device__ __forceinline__ void phase_convgate(const Params& p, int l) {
    const bf16_t* hu = (const bf16_t*)(p.ws + WS_HU); bf16_t* gact = (bf16_t*)(p.ws + WS_GACT);
    const float* cw = p.in[24] + (size_t)l * 3 * NUP; const float* hist = p.in[8] + (size_t)l * 128 * 2 * NUP;
    const size_t gt = (size_t)blockIdx.x * 512 + otid(), NT = (size_t)gridDim.x * 512;
    for (size_t idx = gt; idx < (size_t)TT * 352; idx += NT) {
        const int row = (int)(idx / 352), c = (int)(idx % 352) * 8;
        const bool smp = row >= TP; const int t = smp ? ((row - TP) & 3) : (row & 2047); const int bb = smp ? ((row - TP) >> 2) : (row >> 11);
        float res[2][8];
#pragma unroll
        for (int half = 0; half < 2; ++half) {
            const int cc = c + half * DFF;
            float v0[8], v1[8], v2[8];
            load_h8(hu, row, cc, v2);
            if (t >= 1) load_h8(hu, row - 1, cc, v1);
            else if (smp) load_f8(hist + ((size_t)bb * 2 + 1) * NUP + cc, v1);
            else {
#pragma unroll
                for (int i = 0; i < 8; ++i) v1[i] = 0.f; }
            if (t >= 2) load_h8(hu, row - 2, cc, v0);
            else if (smp) load_f8(hist + ((size_t)bb * 2 + t) * NUP + cc, v0);
            else {
#pragma unroll
                for (int i = 0; i < 8; ++i) v0[i] = 0.f; }
#pragma unroll
            for (int i = 0; i < 8; ++i) res[half][i] = cw[cc + i] * v0[i] + cw[NUP + cc + i] * v1[i] + cw[2 * NUP + cc + i] * v2[i];
        }
        float y[8];
#pragma unroll
        for (int i = 0; i < 8; ++i) y[i] = silu_f(res[0][i]) * res[1][i];
        u32x4 w; w.x = cvt_pk_bf16(y[0], y[1]); w.y = cvt_pk_bf16(y[2], y[3]); w.z = cvt_pk_bf16(y[4], y[5]); w.w = cvt_pk_bf16(y[6], y[7]);
        *(u32x4*)(gact + (size_t)row * DFF + c) = w;
    }
    for (size_t idx = gt; idx < (size_t)(8 + 128) * 2 * (NUP / 8); idx += NT) {
        const int c = (int)(idx % (NUP / 8)) * 8; const int rr = (int)(idx / (NUP / 8)); const int k = rr & 1, bq = rr >> 1;
        const bool smp = bq >= 8; const int bb = smp ? bq - 8 : bq;
        const size_t row = smp ? (size_t)TP + bb * 4 + 2 + k : (size_t)bb * 2048 + 2046 + k;
        float v[8]; load_h8(hu, row, c, v);
        float* op = p.out + (smp ? O_FFS : O_FFP) + (((size_t)l * (smp ? 128 : 8) + bb) * 2 + k) * NUP + c;
        ((f32x4*)op)[0] = (f32x4){v[0], v[1], v[2], v[3]}; ((f32x4*)op)[1] = (f32x4){v[4], v[5], v[6], v[7]};
    }
}

__device__ __forceinline__ void phase_gdn_pre(const Params& p, int j) {
    const bf16_t* h = (const bf16_t*)(p.ws + WS_H); bf16_t* qkvn = (bf16_t*)(p.ws + WS_QKVN); float* gb = (float*)(p.ws + WS_GB);
    const float* cw = p.in[13] + (size_t)j * 4 * 2304; const float* hist = p.in[6] + (size_t)j * 128 * 3 * 2304;
    const int tid_ = otid(); const int lane = tid_ & 63, wave = __builtin_amdgcn_readfirstlane(tid_ >> 6);
    const int gw = blockIdx.x * 8 + wave, NGW = gridDim.x * 8;
    for (int it = gw; it < TT * 6; it += NGW) {
        const int row = it / 6, hd = it % 6;
        const bool smp = row >= TP; const int t = smp ? ((row - TP) & 3) : (row & 2047); const int bb = smp ? ((row - TP) >> 2) : (row >> 11);
        const int T = smp ? 4 : 2048;
        float val[3][2];
#pragma unroll
        for (int sec = 0; sec < 3; ++sec) {
            const int col = sec * 768 + hd * 128 + 2 * lane;
            float a0 = 0.f, a1 = 0.f;
#pragma unroll
            for (int k = 0; k < 4; ++k) { const int tt = t - 3 + k; float x0, x1;
                if (tt >= 0) { const unsigned w = *(const unsigned*)(h + (size_t)(row - 3 + k) * NHB + col); x0 = bflo(w); x1 = bfhi(w); }
                else if (smp) { const f32x2 hv = *(const f32x2*)(hist + ((size_t)bb * 3 + (tt + 3)) * 2304 + col); x0 = hv[0]; x1 = hv[1]; }
                else { x0 = 0.f; x1 = 0.f; }
                const f32x2 wv = *(const f32x2*)(cw + (size_t)k * 2304 + col);
                a0 += wv[0] * x0; a1 += wv[1] * x1;
                if (k == 3 && t >= T - 3) { float* op = p.out + (smp ? O_GCS : O_GCP) + (((size_t)j * (smp ? 128 : 8) + bb) * 3 + (t - (T - 3))) * 2304 + col; *(f32x2*)op = (f32x2){x0, x1}; }
            }
            val[sec][0] = silu_f(a0); val[sec][1] = silu_f(a1);
        }
#pragma unroll
        for (int sec = 0; sec < 2; ++sec) { const float ss = wave_sum(val[sec][0] * val[sec][0] + val[sec][1] * val[sec][1]); const float r = 1.f / sqrtf(ss + 1e-6f); val[sec][0] *= r; val[sec][1] *= r; }
#pragma unroll
        for (int sec = 0; sec < 3; ++sec) *(unsigned*)(qkvn + (size_t)row * 2304 + sec * 768 + hd * 128 + 2 * lane) = cvt_pk_bf16(val[sec][0], val[sec][1]);
        if (lane == 0) {
            const float bv = bf1(h[(size_t)row * NHB + 3328 + hd]), av = bf1(h[(size_t)row * NHB + 3334 + hd]);
            const float x = av + p.in[15][j * 6 + hd];
            const float sp = fmaxf(x, 0.f) + log1pf(__expf(-fabsf(x)));
            gb[(size_t)row * 12 + hd] = -__expf(p.in[14][j * 6 + hd]) * sp;
            gb[(size_t)row * 12 + 6 + hd] = 1.f / (1.f + __expf(-bv));
        }
    }
}

__device__ __forceinline__ void solve_lds(LAS float* sol, const LAS float* A, int lane) {
#pragma unroll 1
    for (int i = 1; i < 64; ++i) {
        float r0 = sol[i * 64 + lane], r1 = 0.f;
        const int n4 = (i + 3) >> 2;
#pragma unroll 2
        for (int j4 = 0; j4 < n4; ++j4) {
            const f32x4 a = *(const LAS f32x4*)(A + i * 64 + 4 * j4);
            const LAS float* sp = sol + (4 * j4) * 64 + lane;
            r0 -= a[0] * sp[0]; r1 -= a[1] * sp[64]; r0 -= a[2] * sp[128]; r1 -= a[3] * sp[192];
        }
        sol[i * 64 + lane] = r0 + r1;
    }
}
__device__ __forceinline__ void phase_gdn_prep(const Params& p, LAS unsigned char* lds) {
    const bf16_t* qkvn = (const bf16_t*)(p.ws + WS_QKVN); const float* gb = (const float*)(p.ws + WS_GB);
    bf16_t* Wc = (bf16_t*)(p.ws + WS_WC); bf16_t* QDc = (bf16_t*)(p.ws + WS_QDC); bf16_t* KDT = (bf16_t*)(p.ws + WS_KDT); bf16_t* QKc = (bf16_t*)(p.ws + WS_QKC);
    float* UT = (float*)(p.ws + WS_UT); float* GL = (float*)(p.ws + WS_GL);
    const int tid_ = otid(); const int lane0 = tid_ & 63, wave = __builtin_amdgcn_readfirstlane(tid_ >> 6);
    if (wave >= 4) return;
    const int gw = blockIdx.x * 4 + wave, NGW = gridDim.x * 4;
#pragma unroll 1
    for (int ci = gw; ci < 1536; ci += NGW) {
        int lane = lane0; unsigned aoff = (unsigned)wave * 32768u;
        asm volatile("" : "+v"(lane), "+v"(aoff));
        const int c16 = lane & 15, g = lane >> 4;
        LAS float* A = (LAS float*)(lds + aoff);
        const int n = ci & 31, hd = (ci >> 5) % 6, b = ci / 192;
        const int tok0 = b * 2048 + n * 64;
        const float gi = gb[(size_t)(tok0 + lane) * 12 + hd], beta = gb[(size_t)(tok0 + lane) * 12 + 6 + hd];
        float gc = gi;
#pragma unroll
        for (int o = 1; o < 64; o <<= 1) { const float tv = __shfl_up(gc, o); if (lane >= o) gc += tv; }
        const float gl = __shfl(gc, 63);
        const float egc = __expf(gc), edl = __expf(gl - gc);
        if (lane == 0) GL[ci] = __expf(gl);
        {
            bf16x8 kf[4][4];
#pragma unroll
            for (int t = 0; t < 4; ++t)
#pragma unroll
                for (int ks = 0; ks < 4; ++ks) kf[t][ks] = *(const bf16x8*)(qkvn + (size_t)(tok0 + 16 * t + c16) * 2304 + 768 + hd * 128 + 32 * ks + 8 * g);
#pragma unroll
            for (int it = 0; it < 4; ++it)
#pragma unroll
                for (int jt = 0; jt <= it; ++jt) {
                    f32x4 acc = (f32x4){0.f, 0.f, 0.f, 0.f};
#pragma unroll
                    for (int ks = 0; ks < 4; ++ks) acc = __builtin_amdgcn_mfma_f32_16x16x32_bf16(kf[it][ks], kf[jt][ks], acc, 0, 0, 0);
                    const int jj = 16 * jt + c16; const float gcj = __shfl(gc, jj);
#pragma unroll
                    for (int r = 0; r < 4; ++r) { const int ii = 16 * it + 4 * g + r; const float gci = __shfl(gc, ii), bi = __shfl(beta, ii);
                        A[ii * 64 + jj] = ii > jj ? bi * acc[r] * __expf(gci - gcj) : 0.f; }
                }
#pragma unroll
            for (int it = 0; it < 4; ++it) {
                bf16x8 qf[4];
#pragma unroll
                for (int ks = 0; ks < 4; ++ks) qf[ks] = *(const bf16x8*)(qkvn + (size_t)(tok0 + 16 * it + c16) * 2304 + hd * 128 + 32 * ks + 8 * g);
#pragma unroll
                for (int jt = 0; jt < 4; ++jt) {
                    f32x4 acc = (f32x4){0.f, 0.f, 0.f, 0.f};
                    if (jt <= it) {
#pragma unroll
                        for (int ks = 0; ks < 4; ++ks) acc = __builtin_amdgcn_mfma_f32_16x16x32_bf16(qf[ks], kf[jt][ks], acc, 0, 0, 0);
                    }
                    const int jj = 16 * jt + c16; const float gcj = __shfl(gc, jj);
                    const int pos = (jj & 32) + invperm32(jj & 31);
#pragma unroll
                    for (int r = 0; r < 4; ++r) { const int ii = 16 * it + 4 * g + r; const float gci = __shfl(gc, ii);
                        const float v = ii >= jj ? acc[r] * 0.08838834764831845f * __expf(gci - gcj) : 0.f;
                        QKc[(size_t)ci * 4096 + ii * 64 + pos] = (bf16_t)(cvt_pk_bf16(v, 0.f) & 0xffffu); }
                }
            }
        }
        asm volatile("s_waitcnt lgkmcnt(0)" ::: "memory");
        LAS float* sol = A + 4096;
#pragma unroll 1
        for (int pass = 0; pass < 4; ++pass) {
            const int half = pass & 1, isw = pass >> 1;
            const int c = lane + 64 * half; const int posc = (c & ~31) + invperm32(c & 31);
            const bf16_t* src = qkvn + (size_t)tok0 * 2304 + (isw ? 768 : 1536) + hd * 128 + c;
#pragma unroll 8
            for (int i = 0; i < 64; ++i) { float f = __shfl(beta, i); if (isw) f *= __shfl(egc, i); sol[i * 64 + lane] = bf1(src[(size_t)i * 2304]) * f; }
            asm volatile("s_waitcnt lgkmcnt(0)" ::: "memory");
            solve_lds(sol, A, lane);
            asm volatile("s_waitcnt lgkmcnt(0)" ::: "memory");
            if (!isw) { float* up = UT + (size_t)ci * 8192 + (size_t)c * 64;
#pragma unroll 4
                for (int i = 0; i < 64; i += 4) *(f32x4*)(up + i) = (f32x4){sol[i * 64 + lane], sol[(i + 1) * 64 + lane], sol[(i + 2) * 64 + lane], sol[(i + 3) * 64 + lane]}; }
            else {
#pragma unroll 8
                for (int i = 0; i < 64; ++i) Wc[(size_t)ci * 8192 + i * 128 + posc] = (bf16_t)(cvt_pk_bf16(sol[i * 64 + lane], 0.f) & 0xffffu); }
            asm volatile("s_waitcnt lgkmcnt(0)" ::: "memory");
        }
        const int c0 = 2 * lane; const int pos0 = (c0 & ~31) + invperm32(c0 & 31);
#pragma unroll 8
        for (int i = 0; i < 64; ++i) { const unsigned w = *(const unsigned*)(qkvn + (size_t)(tok0 + i) * 2304 + hd * 128 + 2 * lane);
            const float s = __shfl(egc, i) * 0.08838834764831845f;
            *(unsigned*)(QDc + (size_t)ci * 8192 + i * 128 + pos0) = cvt_pk_bf16(bflo(w) * s, bfhi(w) * s); }
        asm volatile("s_waitcnt lgkmcnt(0)" ::: "memory");
        {
            LAS bf16_t* kt = (LAS bf16_t*)A;
#pragma unroll 8
            for (int i = 0; i < 64; ++i) { const unsigned w = *(const unsigned*)(qkvn + (size_t)(tok0 + i) * 2304 + 768 + hd * 128 + 2 * lane);
                *(LAS unsigned*)(kt + i * 128 + 2 * lane) = w; }
            asm volatile("s_waitcnt lgkmcnt(0)" ::: "memory");
#pragma unroll
            for (int hh = 0; hh < 2; ++hh) { const int dk = lane + 64 * hh;
#pragma unroll
                for (int p8 = 0; p8 < 8; ++p8) { float v[8];
#pragma unroll
                    for (int e = 0; e < 8; ++e) { const int pp = p8 * 8 + e; const int c = (pp & 32) + perm32k(pp & 31);
                        v[e] = bf1(kt[c * 128 + dk]) * __uint_as_float((unsigned)__builtin_amdgcn_readlane((int)__float_as_uint(edl), c)); }
                    u32x4 w; w.x = cvt_pk_bf16(v[0], v[1]); w.y = cvt_pk_bf16(v[2], v[3]); w.z = cvt_pk_bf16(v[4], v[5]); w.w = cvt_pk_bf16(v[6], v[7]);
                    *(u32x4*)(KDT + (size_t)ci * 8192 + dk * 64 + p8 * 8) = w; } }
            asm volatile("s_waitcnt lgkmcnt(0)" ::: "memory");
        }
    }
}

constexpr int RB_W = 0, RB_QD = 17408, RB_KD = 34816, RB_QK = 34816 + 18432, RB_SZ = 62464;
__device__ __forceinline__ void rec_load(u32x4 (&r)[7], const bf16_t* Wc, const bf16_t* QDc, const bf16_t* KDT, const bf16_t* QKc, int ci, int tid) {
    r[0] = *(const u32x4*)(Wc + (size_t)ci * 8192 + (size_t)tid * 8); r[1] = *(const u32x4*)(Wc + (size_t)ci * 8192 + (size_t)(512 + tid) * 8);
    r[2] = *(const u32x4*)(QDc + (size_t)ci * 8192 + (size_t)tid * 8); r[3] = *(const u32x4*)(QDc + (size_t)ci * 8192 + (size_t)(512 + tid) * 8);
    r[4] = *(const u32x4*)(KDT + (size_t)ci * 8192 + (size_t)tid * 8); r[5] = *(const u32x4*)(KDT + (size_t)ci * 8192 + (size_t)(512 + tid) * 8);
    r[6] = *(const u32x4*)(QKc + (size_t)ci * 4096 + (size_t)tid * 8);
}
__device__ __forceinline__ void rec_store(const u32x4 (&r)[7], LAS unsigned char* buf, int tid) {
#pragma unroll
    for (int k = 0; k < 2; ++k) { const int q = tid + 512 * k;
        *(LAS u32x4*)(buf + RB_W + (q >> 4) * 272 + (q & 15) * 16) = r[k];
        *(LAS u32x4*)(buf + RB_QD + (q >> 4) * 272 + (q & 15) * 16) = r[2 + k];
        *(LAS u32x4*)(buf + RB_KD + (q >> 3) * 144 + (q & 7) * 16) = r[4 + k]; }
    *(LAS u32x4*)(buf + RB_QK + (tid >> 3) * 144 + (tid & 7) * 16) = r[6];
}
__device__ __forceinline__ void gdn_recur_prompt(const Params& p, LAS unsigned char* lds, int j, int bh, float* ob, float* gsbase) {
    const bf16_t* Wc = (const bf16_t*)(p.ws + WS_WC); const bf16_t* QDc = (const bf16_t*)(p.ws + WS_QDC); const bf16_t* KDT = (const bf16_t*)(p.ws + WS_KDT); const bf16_t* QKc = (const bf16_t*)(p.ws + WS_QKC);
    const float* UT = (const float*)(p.ws + WS_UT); const float* GL = (const float*)(p.ws + WS_GL);
    const int tid = otid(), lane = tid & 63, wave = __builtin_amdgcn_readfirstlane(tid >> 6), c16 = lane & 15, g = lane >> 4;
    const int b = bh / 6, hd = bh % 6, dv0 = wave * 16;
    f32x4 S[8];
#pragma unroll
    for (int i = 0; i < 8; ++i) S[i] = (f32x4){0.f, 0.f, 0.f, 0.f};
    u32x4 rg[7];
    rec_load(rg, Wc, QDc, KDT, QKc, bh * 32, tid);
    rec_store(rg, lds, tid);
    __syncthreads();
#pragma unroll 1
    for (int n = 0; n < 32; ++n) {
        const int ci = bh * 32 + n;
        LAS unsigned char* buf = lds + (n & 1) * RB_SZ;
        if (n + 1 < 32) rec_load(rg, Wc, QDc, KDT, QKc, ci + 1, tid);
        f32x4 u[4];
#pragma unroll
        for (int ct = 0; ct < 4; ++ct) u[ct] = *(const f32x4*)(UT + (size_t)ci * 8192 + (size_t)(dv0 + c16) * 64 + 16 * ct + 4 * g);
        const float egl = GL[ci];
        bf16x8 bS[4];
#pragma unroll
        for (int ks = 0; ks < 4; ++ks) bS[ks] = pack8(S[2 * ks], S[2 * ks + 1]);
        f32x4 vn[4], o[4];
#pragma unroll
        for (int ct = 0; ct < 4; ++ct) {
            f32x4 ws = (f32x4){0.f, 0.f, 0.f, 0.f}, oo = (f32x4){0.f, 0.f, 0.f, 0.f};
#pragma unroll
            for (int ks = 0; ks < 4; ++ks) {
                const bf16x8 wf = *(const LAS bf16x8*)(buf + RB_W + (16 * ct + c16) * 272 + ks * 64 + g * 16);
                const bf16x8 qf = *(const LAS bf16x8*)(buf + RB_QD + (16 * ct + c16) * 272 + ks * 64 + g * 16);
                ws = __builtin_amdgcn_mfma_f32_16x16x32_bf16(wf, bS[ks], ws, 0, 0, 0);
                oo = __builtin_amdgcn_mfma_f32_16x16x32_bf16(qf, bS[ks], oo, 0, 0, 0);
            }
            vn[ct] = u[ct] - ws; o[ct] = oo;
        }
        bf16x8 bV[2];
#pragma unroll
        for (int k2 = 0; k2 < 2; ++k2) bV[k2] = pack8(vn[2 * k2], vn[2 * k2 + 1]);
#pragma unroll
        for (int ct = 0; ct < 4; ++ct) {
#pragma unroll
            for (int k2 = 0; k2 < 2; ++k2) { const bf16x8 af = *(const LAS bf16x8*)(buf + RB_QK + (16 * ct + c16) * 144 + k2 * 64 + g * 16);
                o[ct] = __builtin_amdgcn_mfma_f32_16x16x32_bf16(af, bV[k2], o[ct], 0, 0, 0); }
#pragma unroll
            for (int r = 0; r < 4; ++r) ob[(size_t)(b * 2048 + n * 64 + 16 * ct + 4 * g + r) * 768 + hd * 128 + dv0 + c16] = o[ct][r];
        }
#pragma unroll
        for (int dt = 0; dt < 8; ++dt) { f32x4 s = S[dt] * egl;
#pragma unroll
            for (int k2 = 0; k2 < 2; ++k2) { const bf16x8 af = *(const LAS bf16x8*)(buf + RB_KD + (16 * dt + c16) * 144 + k2 * 64 + g * 16);
                s = __builtin_amdgcn_mfma_f32_16x16x32_bf16(af, bV[k2], s, 0, 0, 0); }
            S[dt] = s; }
        if (n + 1 < 32) rec_store(rg, lds + ((n + 1) & 1) * RB_SZ, tid);
        __syncthreads();
    }
    float* so = gsbase + ((size_t)(j * 8 + b) * 6 + hd) * 16384;
#pragma unroll
    for (int dt = 0; dt < 8; ++dt)
#pragma unroll
        for (int r = 0; r < 4; ++r) so[(size_t)(16 * dt + 4 * g + r) * 128 + dv0 + c16] = S[dt][r];
}
__device__ __forceinline__ void gdn_naive_item(const Params& p, LAS unsigned char* lds, int row0, int T, int hd, const float* s0, float* sout) {
    const bf16_t* qkvn = (const bf16_t*)(p.ws + WS_QKVN); const float* gb = (const float*)(p.ws + WS_GB); float* ob = (float*)(p.ws + WS_O);
    const int tid = otid(), e = tid & 127, part = tid >> 7;
    LAS float* kq = (LAS float*)lds;
    LAS float* red = kq + 1024;
    LAS float* red2 = red + 512;
    float S[32];
#pragma unroll
    for (int i = 0; i < 32; ++i) S[i] = s0 ? s0[(size_t)(part * 32 + i) * 128 + e] : 0.f;
#pragma unroll 1
    for (int tb = 0; tb < T; tb += 4) {
        __syncthreads();
        for (int i = tid; i < 1024; i += 512) { const int t = i >> 8, s = (i >> 7) & 1, d = i & 127;
            kq[i] = bf1(qkvn[(size_t)(row0 + tb + t) * 2304 + (s == 0 ? 768 : 0) + hd * 128 + d]); }
        __syncthreads();
#pragma unroll 1
        for (int t = 0; t < 4; ++t) {
            const int row = row0 + tb + t;
            const float a = __expf(gb[(size_t)row * 12 + hd]), bt = gb[(size_t)row * 12 + 6 + hd];
            const float v = bf1(qkvn[(size_t)row * 2304 + 1536 + hd * 128 + e]);
            float ps = 0.f;
#pragma unroll
            for (int i = 0; i < 32; ++i) ps += S[i] * kq[(t * 2 + 0) * 128 + part * 32 + i];
            red[part * 128 + e] = ps;
            __syncthreads();
            const float kS = red[e] + red[128 + e] + red[256 + e] + red[384 + e];
            const float vnew = bt * (v - a * kS);
            float po = 0.f;
#pragma unroll
            for (int i = 0; i < 32; ++i) { S[i] = a * S[i] + kq[(t * 2 + 0) * 128 + part * 32 + i] * vnew; po += S[i] * kq[(t * 2 + 1) * 128 + part * 32 + i]; }
            red2[part * 128 + e] = po;
            __syncthreads();
            if (part == 0) ob[(size_t)row * 768 + hd * 128 + e] = (red2[e] + red2[128 + e] + red2[256 + e] + red2[384 + e]) * 0.08838834764831845f;
        }
    }
#pragma unroll
    for (int i = 0; i < 32; ++i) sout[(size_t)(part * 32 + i) * 128 + e] = S[i];
    __syncthreads();
}
__device__ __forceinline__ void gdn_sample_item(const Params& p, LAS unsigned char* lds, int j, int item) {
    const int sb = item / 6, hd = item % 6;
    gdn_naive_item(p, lds, TP + sb * 4, 4, hd, p.in[7] + ((size_t)(j * 128 + sb) * 6 + hd) * 16384, p.out + O_GSS + ((size_t)(j * 128 + sb) * 6 + hd) * 16384);
}
__device__ __forceinline__ void phase_gdn_post(const Params& p, int j) {
    const bf16_t* h = (const bf16_t*)(p.ws + WS_H); const float* ob = (const float*)(p.ws + WS_O); bf16_t* cat = (bf16_t*)(p.ws + WS_CAT);
    const int tid_ = otid(); const int lane = tid_ & 63, wave = __builtin_amdgcn_readfirstlane(tid_ >> 6);
    const int gw = blockIdx.x * 8 + wave, NGW = gridDim.x * 8;
    const f32x2 nw = *(const f32x2*)(p.in[16] + j * 128 + 2 * lane);
    for (int it = gw; it < TT * 6; it += NGW) {
        const int row = it / 6, hd = it % 6;
        const f32x2 o = *(const f32x2*)(ob + (size_t)row * 768 + hd * 128 + 2 * lane);
        const float ss = wave_sum(o[0] * o[0] + o[1] * o[1]);
        const float r = 1.f / sqrtf(ss * (1.f / 128.f) + 1e-6f);
        const unsigned zw = *(const unsigned*)(h + (size_t)row * NHB + 2304 + hd * 128 + 2 * lane);
        const float y0 = o[0] * r * nw[0] * silu_f(bflo(zw)), y1 = o[1] * r * nw[1] * silu_f(bfhi(zw));
        *(unsigned*)(cat + (size_t)row * DM + hd * 128 + 2 * lane) = cvt_pk_bf16(y0, y1);
    }
}


#ifdef DIAG_GDN
constexpr size_t WS_DBG = WS_END;
constexpr size_t WS_OB2 = WS_END + 4096;
constexpr size_t WS_GS2 = WS_OB2 + (size_t)TT * 768 * 4;
constexpr size_t WS_DIAG_END = WS_GS2 + (size_t)2 * 8 * 6 * 16384 * 4;
__device__ __forceinline__ void diag_compare(const Params& p, int j) {
    const float* ob = (const float*)(p.ws + WS_O); const float* ob2 = (const float*)(p.ws + WS_OB2);
    const float* gs = p.out + O_GSP + (size_t)j * 8 * 6 * 16384; const float* gs2 = (const float*)(p.ws + WS_GS2) + (size_t)j * 8 * 6 * 16384;
    float* dbg = (float*)(p.ws + WS_DBG);
    const size_t gt = (size_t)blockIdx.x * 512 + otid(), NT = (size_t)gridDim.x * 512;
    float n1 = 0.f, d1 = 0.f, n3 = 0.f, d3 = 0.f, n2 = 0.f, d2 = 0.f, n4 = 0.f, d4 = 0.f;
    for (size_t i = gt; i < (size_t)TP * 768; i += NT) { const int row = (int)(i / 768); const float a = ob[i], b = ob2[i]; const float e = (a - b) * (a - b);
        n3 += e; d3 += a * a; if ((row & 2047) < 64) { n1 += e; d1 += a * a; } else if ((row & 2047) < 128) { n4 += e; d4 += a * a; } }
    for (size_t i = gt; i < (size_t)8 * 6 * 16384; i += NT) { const float a = gs[i], b = gs2[i]; n2 += (a - b) * (a - b); d2 += a * a; }
    n1 = wave_sum(n1); d1 = wave_sum(d1); n2 = wave_sum(n2); d2 = wave_sum(d2); n3 = wave_sum(n3); d3 = wave_sum(d3); n4 = wave_sum(n4); d4 = wave_sum(d4);
    if ((otid() & 63) == 0) { atomicAdd(dbg + 0, n1); atomicAdd(dbg + 1, d1); atomicAdd(dbg + 2, n2); atomicAdd(dbg + 3, d2); atomicAdd(dbg + 4, n3); atomicAdd(dbg + 5, d3); atomicAdd(dbg + 6, n4); atomicAdd(dbg + 7, d4); }
}
__device__ __forceinline__ void diag_compare2(const Params& p) {
    const bf16_t* qkvn = (const bf16_t*)(p.ws + WS_QKVN); const float* gb = (const float*)(p.ws + WS_GB);
    const bf16_t* Wc = (const bf16_t*)(p.ws + WS_WC); const bf16_t* QDc = (const bf16_t*)(p.ws + WS_QDC); const bf16_t* KDT = (const bf16_t*)(p.ws + WS_KDT);
    float* dbg = (float*)(p.ws + WS_DBG);
    const int tid_ = otid(); const int lane = tid_ & 63, wave = __builtin_amdgcn_readfirstlane(tid_ >> 6);
    const int gw = blockIdx.x * 8 + wave, NGW = gridDim.x * 8;
    float n8 = 0.f, d8 = 0.f, n10 = 0.f, d10 = 0.f, n12 = 0.f, d12 = 0.f;
    for (int ci = gw; ci < 1536; ci += NGW) {
        const int n = ci & 31, hd = (ci >> 5) % 6, b = ci / 192; const int tok0 = b * 2048 + n * 64;
        float gcs = 0.f, mygc = 0.f;
        for (int t = 0; t < 64; ++t) { gcs += gb[(size_t)(tok0 + t) * 12 + hd]; if (t == lane) mygc = gcs; }
        const float gl = gcs;
        for (int c = 0; c < 128; ++c) { const int pos = (c & ~31) + invperm32(c & 31);
            const float qe = bf1(qkvn[(size_t)(tok0 + lane) * 2304 + hd * 128 + c]) * 0.08838834764831845f * __expf(mygc);
            const float qg = bf1(QDc[(size_t)ci * 8192 + lane * 128 + pos]); n8 += (qe - qg) * (qe - qg); d8 += qe * qe;
            const float ke = bf1(qkvn[(size_t)(tok0 + lane) * 2304 + 768 + hd * 128 + c]) * __expf(gl - mygc);
            const int posl = (lane & 32) + invperm32(lane & 31);
            const float kg = bf1(KDT[(size_t)ci * 8192 + c * 64 + posl]); n10 += (ke - kg) * (ke - kg); d10 += ke * ke; }
        { const float beta0 = gb[(size_t)tok0 * 12 + 6 + hd], g0 = gb[(size_t)tok0 * 12 + hd];
          for (int c = lane; c < 128; c += 64) { const int pos = (c & ~31) + invperm32(c & 31);
            const float we = bf1(qkvn[(size_t)tok0 * 2304 + 768 + hd * 128 + c]) * beta0 * __expf(g0);
            const float wg = bf1(Wc[(size_t)ci * 8192 + pos]); n12 += (we - wg) * (we - wg); d12 += we * we; } }
    }
    n8 = wave_sum(n8); d8 = wave_sum(d8); n10 = wave_sum(n10); d10 = wave_sum(d10); n12 = wave_sum(n12); d12 = wave_sum(d12);
    if (lane == 0) { atomicAdd(dbg + 8, n8); atomicAdd(dbg + 9, d8); atomicAdd(dbg + 10, n10); atomicAdd(dbg + 11, d10); atomicAdd(dbg + 12, n12); atomicAdd(dbg + 13, d12); }
}
__device__ __forceinline__ int diag_class(float n, float d) { const float r = n / (d + 1e-30f); return r < 4e-4f ? 0 : (r < 0.09f ? 1 : 2); }
#endif
#define XB_TMO      128
#define XB_XCNT(j)  (256  + 64 * (j))
#define XB_XSUB(j)  (1280 + 64 * (j))
#define XB_XGEN(j)  (2304 + 64 * (j))
#define XB_TOP      3328
#define XB_TOPGEN   3392
#define XCD_BAR_WORDS 3456
#define XB_SPIN_CAP (1u << 18)

__device__ __forceinline__ unsigned xb_ld(unsigned* p)              { return __hip_atomic_load(p, __ATOMIC_RELAXED, __HIP_MEMORY_SCOPE_AGENT); }
__device__ __forceinline__ unsigned xb_add(unsigned* p, unsigned v) { return __hip_atomic_fetch_add(p, v, __ATOMIC_RELAXED, __HIP_MEMORY_SCOPE_AGENT); }
__device__ __forceinline__ unsigned xb_xcc_id() { return (unsigned)__builtin_amdgcn_s_getreg((3 << 11) | 20) & 0xFu; }
#define XB_SPIN(cond, bar) do { unsigned _sp = 0; while (cond) { __builtin_amdgcn_s_sleep(1); \
    if ((++_sp & 255u) == 0u) { if (xb_ld(&(bar)[XB_TMO])) break; if (_sp > XB_SPIN_CAP) { atomicAdd(&(bar)[XB_TMO], 1u); break; } } } } while (0)

struct XcdBarrier {
    unsigned* bar; unsigned x;
    volatile LAS unsigned* st;
};

__device__ __forceinline__ XcdBarrier xcd_barrier_post(unsigned* bar, volatile LAS unsigned* st) {
    XcdBarrier b; b.bar = bar; b.x = xb_xcc_id(); b.st = st;
    if (threadIdx.x == 0) (void)xb_add(&bar[XB_XCNT(b.x)], 1u);
    return b;
}
__device__ __forceinline__ void xcd_barrier_complete(unsigned* bar, unsigned x, unsigned& nloc, unsigned& nx) {
    const unsigned G = gridDim.x * gridDim.y * gridDim.z;
    unsigned sum, cnt, mine, sp = 0u;
    for (;;) {
        sum = 0u; cnt = 0u; mine = 0u;
#pragma unroll
        for (unsigned j = 0; j < 16; ++j) { const unsigned c = xb_ld(&bar[XB_XCNT(j)]); sum += c; cnt += (c > 0u) ? 1u : 0u; mine = (j == x) ? c : mine; }
        if (sum == G) break;
        __builtin_amdgcn_s_sleep(1);
        if ((++sp & 255u) == 0u) { if (xb_ld(&bar[XB_TMO])) break; if (sp > XB_SPIN_CAP) { atomicAdd(&bar[XB_TMO], 1u); break; } }
    }
    nloc = mine > 0u ? mine : 1u; nx = cnt > 0u ? cnt : 1u;
}

__device__ __forceinline__ void xcd_barrier(const XcdBarrier& b) {
    asm volatile("s_waitcnt vmcnt(0)" ::: "memory");
    __syncthreads();
    if (threadIdx.x == 0) {
        unsigned* bar = b.bar;
        __builtin_amdgcn_s_waitcnt(0);
        unsigned nloc = b.st[0], nx = b.st[1];
        if (nloc == 0u) { xcd_barrier_complete(bar, b.x, nloc, nx); b.st[0] = nloc; b.st[1] = nx; }
        const unsigned old = xb_add(&bar[XB_XSUB(b.x)], 1u);
        const unsigned gen = old / nloc;
        if (old + 1u == (gen + 1u) * nloc) {
            __builtin_amdgcn_fence(__ATOMIC_RELEASE, "agent");
            asm volatile("s_waitcnt vmcnt(0)" ::: "memory");
            const unsigned og = xb_add(&bar[XB_TOP], 1u);
            const unsigned tg = og / nx;
            if (og + 1u == (tg + 1u) * nx) xb_add(&bar[XB_TOPGEN], 1u);
            else XB_SPIN(xb_ld(&bar[XB_TOPGEN]) == tg, bar);
            __builtin_amdgcn_fence(__ATOMIC_ACQUIRE, "agent");
            xb_add(&bar[XB_XGEN(b.x)], 1u);
            asm volatile("s_waitcnt vmcnt(0)" ::: "memory");
        } else {
            XB_SPIN(xb_ld(&bar[XB_XGEN(b.x)]) == gen, bar);
            __builtin_amdgcn_fence(__ATOMIC_ACQUIRE, "agent");
            asm volatile("s_waitcnt vmcnt(0)" ::: "memory");
        }
    }
    __syncthreads();
}


#ifdef EXP_SYNC2
#define GSYNC() do { xcd_barrier(xbar); xcd_barrier(xbar); } while (0)
#else
#define GSYNC() xcd_barrier(xbar)
#endif
#ifdef EXP_ELEM2
#define ELEM2(x) do { x; x; } while (0)
#else
#define ELEM2(x) do { x; } while (0)
#endif
#ifdef EXP_GEMM2
#define GEMM2(x) do { x; x; } while (0)
#else
#define GEMM2(x) do { x; } while (0)
#endif
#ifdef EXP_GDN2
#define GDN2(x) do { x; x; } while (0)
#else
#define GDN2(x) do { x; } while (0)
#endif
__global__ void __launch_bounds__(512, 2) fwd_megakernel(Params p) {
    extern __shared__ __attribute__((aligned(16))) unsigned char lds_raw[];
    LAS unsigned char* lds = (LAS unsigned char*)lds_raw;
    cg::grid_group grid = cg::this_grid();
    unsigned char* ws = p.ws;
    float* xf = (float*)(ws + WS_XF); bf16_t* xb = (bf16_t*)(ws + WS_XB);
    bf16_t* hbuf = (bf16_t*)(ws + WS_H); bf16_t* cat = (bf16_t*)(ws + WS_CAT);
    bf16_t* hu = (bf16_t*)(ws + WS_HU); bf16_t* gact = (bf16_t*)(ws + WS_GACT);
    const bf16_t* Kb = (const bf16_t*)(ws + WS_KB); const bf16_t* Vt = (const bf16_t*)(ws + WS_VT);
    const int bid = blockIdx.x, G = gridDim.x;
    volatile LAS unsigned* xst = (volatile LAS unsigned*)(lds + LDS_BYTES - 16);
    if (threadIdx.x < 4) xst[threadIdx.x] = 0u;
    __syncthreads();
    XcdBarrier xbar = xcd_barrier_post((unsigned*)(ws + WS_BAR), xst);

#ifdef DIAG_GDN
    if (bid == 0 && threadIdx.x < 64) ((float*)(ws + WS_DBG))[threadIdx.x] = 0.f;
#endif
    phase_prep(p, lds);
    grid.sync();
    {
        EpiKV E{p.out + O_MK, p.out + O_MV, (bf16_t*)(ws + WS_KB), (bf16_t*)(ws + WS_VT)};
        run_gemm(lds, (const bf16_t*)(ws + WS_MEMB), (const bf16_t*)(ws + WS_WKV), 2048, 2048, DM, E, (bid + 64) % G);
    }
#pragma unroll 1
    for (int l = 0; l < 4; ++l) {
        const int j = l >> 1; const bool isB = (l & 1) != 0;
        if (!isB) {
            { EpiStoreBf16 E{hbuf, NHA}; GEMM2(run_gemm(lds, xb, (const bf16_t*)(ws + WS_WINA) + (size_t)j * NHA * DM, TT, NHA, DM, E, bid)); }
            GSYNC();
            ELEM2(phase_mixA_elem(p, j));
#ifdef NAIVE_ATTN
            for (int it = bid; it < 256; it += G) attn_prompt_item_naive(lds, hbuf, NHA, 2304, p.out + O_MK, p.out + O_MV, cat, l, it);
#else
            for (int it = bid; it < 256; it += G) attn_prompt_item(lds, hbuf, NHA, 2304, Kb, Vt, cat, l, it);
#endif
            for (int it = bid; it < 256; it += G) attn_sample_item(lds, hbuf, NHA, 2304, p.in[3], p.in[4], cat, l, it);
            GSYNC();
            { EpiResid E{xf, DM}; run_gemm(lds, cat, (const bf16_t*)(ws + WS_WOUTA) + (size_t)j * DM * DM, TT, DM, DM, E, bid); }
        } else {
            { EpiStoreBf16 E{hbuf, NHB}; GEMM2(run_gemm(lds, xb, (const bf16_t*)(ws + WS_WINB) + (size_t)j * NHB * DM, TT, NHB, DM, E, bid)); }
            GSYNC();
            ELEM2(phase_gdn_pre(p, j));
            GSYNC();
#ifndef NAIVE_GDN
            phase_gdn_prep(p, lds);
            GSYNC();
#endif
#ifdef NAIVE_GDN
            if (bid < 48) gdn_naive_item(p, lds, (bid / 6) * 2048, 2048, bid % 6, nullptr, p.out + O_GSP + ((size_t)(j * 8 + bid / 6) * 6 + bid % 6) * 16384);
#else
            if (bid < 48) gdn_recur_prompt(p, lds, j, bid, (float*)(ws + WS_O), p.out + O_GSP);
#endif
            else {
                const int nb = G - 48;
                for (int it = bid - 48; it < 768; it += nb) gdn_sample_item(p, lds, j, it);
#ifdef NAIVE_ATTN
                for (int it = bid - 48; it < 256; it += nb) attn_prompt_item_naive(lds, hbuf, NHB, 3072, p.out + O_MK, p.out + O_MV, cat, l, it);
#else
                for (int it = bid - 48; it < 256; it += nb) attn_prompt_item(lds, hbuf, NHB, 3072, Kb, Vt, cat, l, it);
#endif
                for (int it = bid - 48; it < 256; it += nb) attn_sample_item(lds, hbuf, NHB, 3072, p.in[3], p.in[4], cat, l, it);
            }
            GSYNC();
#ifdef DIAG_GDN
            if (l == 1) {
                phase_gdn_prep(p, lds);
                GSYNC();
                if (bid < 48) gdn_recur_prompt(p, lds, j, bid, (float*)(ws + WS_OB2), (float*)(ws + WS_GS2));
                GSYNC();
                diag_compare(p, j);
                diag_compare2(p);
                GSYNC();
            }
#endif
            ELEM2(phase_gdn_post(p, j));
            GSYNC();
            { EpiResid E{xf, DM}; run_gemm(lds, cat, (const bf16_t*)(ws + WS_WOUTB) + (size_t)j * DM * DM, TT, DM, DM, E, bid); }
        }
        GSYNC();
        phase_ln(xf, xb, p.in[19] + l * DM, p.in[20] + l * DM, nullptr);
        GSYNC();
        { EpiStoreBf16 E{hu, NUP}; GEMM2(run_gemm(lds, xb, (const bf16_t*)(ws + WS_WUP) + (size_t)l * NUP * DM, TT, NUP, DM, E, bid)); }
        GSYNC();
        ELEM2(phase_convgate(p, l));
        GSYNC();
        { EpiResid E{xf, DM}; run_gemm(lds, gact, (const bf16_t*)(ws + WS_WDOWN) + (size_t)l * DM * DFF, TT, DM, DFF, E, bid); }
        GSYNC();
        phase_ln(xf, xb, p.in[21] + l * DM, p.in[22] + l * DM, l == 3 ? p.out + O_Y : nullptr);
        if (l < 3) GSYNC();
    }
#ifdef DIAG_GDN
    GSYNC();
    if (bid == 0 && threadIdx.x == 0) { const float* dbg = (const float*)(ws + WS_DBG);
        const int code = 9 * diag_class(dbg[8], dbg[9]) + 3 * diag_class(dbg[10], dbg[11]) + diag_class(dbg[12], dbg[13]);
        float v = 1.0e4f; for (int i = 0; i < code; ++i) v *= 1.25f;
        p.out[0] = v; }
#endif
}

extern "C" void kernel_launch(void* const* d_in, const int* in_sizes, int n_in, void* d_out, int out_size, void* d_ws, size_t ws_size, hipStream_t stream) {
    static int grid_blocks = 0;
    if (grid_blocks == 0) {
        if (n_in != 26 || (size_t)out_size != O_END || ws_size < WS_TOTAL) { fprintf(stderr, "kernel_launch: unexpected shapes n_in %d out %d (want %zu) ws %zu (need %zu)\n", n_in, out_size, (size_t)O_END, ws_size, (size_t)WS_END); grid_blocks = -1; return; }
        int dev = 0, cus = 0, per_cu = 0;
        hipGetDevice(&dev);
        hipDeviceGetAttribute(&cus, hipDeviceAttributeMultiprocessorCount, dev);
        if (hipFuncSetAttribute((const void*)fwd_megakernel, hipFuncAttributeMaxDynamicSharedMemorySize, LDS_BYTES) != hipSuccess) { fprintf(stderr, "kernel_launch: hipFuncSetAttribute failed\n"); grid_blocks = -1; return; }
        hipOccupancyMaxActiveBlocksPerMultiprocessor(&per_cu, (const void*)fwd_megakernel, 512, LDS_BYTES);
        if (per_cu < 1) { fprintf(stderr, "kernel_launch: occupancy query says %d blocks/CU\n", per_cu); grid_blocks = -1; return; }
        grid_blocks = cus;
        if (grid_blocks > 256) grid_blocks = 256;
    }
    if (grid_blocks < 0) return;
    if (hipMemsetAsync((char*)d_ws + WS_BAR, 0, 16384, stream) != hipSuccess) { fprintf(stderr, "kernel_launch: memset of barrier words failed\n"); return; }
    Params p{};
    for (int i = 0; i < 26; ++i) p.in[i] = (const float*)d_in[i];
    p.out = (float*)d_out; p.ws = (unsigned char*)d_ws;
    void* args[] = {&p};
    hipError_t e = hipLaunchCooperativeKernel((const void*)fwd_megakernel, dim3(grid_blocks), dim3(512), args, LDS_BYTES, stream);
    if (e != hipSuccess) fprintf(stderr, "cooperative launch failed: %s (grid %d)\n", hipGetErrorString(e), grid_blocks);
}
```

```cpp
#include <hip/hip_runtime.h>
#include <hip/hip_cooperative_groups.h>
#include <cstdio>
namespace cg = cooperative_groups;
namespace pg8 {
#define PG8_LAS __attribute__((address_space(3)))
typedef unsigned short bf16_t;
typedef short bf16x8 __attribute__((ext_vector_type(8)));
typedef float f32x4 __attribute__((ext_vector_type(4)));
typedef unsigned u32x4 __attribute__((ext_vector_type(4)));
constexpr int BM = 256, BK = 64, HALF = 128, HTB = HALF * BK * 2  , STAGE_BYTES = 8 * HTB, NXCD = 8, WGM = 8;

__host__ __device__ __forceinline__ int lds_byte(int r, int c) { const int st = (r >> 4) * 2 + (c >> 5), rr = r & 15, cc = c & 31, ob = rr * 64 + cc * 2; return st * 1024 + (ob ^ (((ob >> 9) & 1) << 5)); }
__host__ __device__ __forceinline__ void stage_rc(int b, int& R, int& C) { const int st = b / 1024, sb = b % 1024, swz = sb ^ (((sb >> 9) & 1) << 5); R = (st >> 1) * 16 + swz / 64; C = (st & 1) * 32 + (swz % 64) / 2; }
__host__ __device__ __forceinline__ int perm32(int rho) { const int n = rho >> 4, i = rho & 15; return 8 * (i >> 2) + 4 * n + (i & 3); }

struct Unit { int pm, pn; };
struct Gemm { const bf16_t* A; const bf16_t* Bt; int M, N, K; };

struct StaticOrder {
    int nM, nN, nwg, G, c;
    __host__ __device__ void init(int M, int N, int G_, int c_) { nM = M / BM; nN = N / BM; nwg = nM * nN; G = G_; c = c_; }
    __host__ __device__ bool next(int i, Unit& u) const {
        const long L = (long)i * G + c; if (L >= nwg) return false;
        int wgid = (int)L; { const int q = nwg / NXCD, r = nwg % NXCD, xcd = wgid % NXCD, off = wgid / NXCD; wgid = (xcd < r ? xcd * (q + 1) : r * (q + 1) + (xcd - r) * q) + off; }
        const int nig = WGM * nN, gid = wgid / nig, fm = gid * WGM, gsz = (nM - fm) < WGM ? (nM - fm) : WGM;
        u.pm = fm + ((wgid % nig) % gsz); u.pn = (wgid % nig) / gsz; return true;
    }
    __device__ __forceinline__ void a_ready(const Unit&) const {}
    __device__ __forceinline__ void done(const Unit&) const {}
};
__device__ __forceinline__ unsigned cvt_pk_bf16(float lo, float hi) { unsigned r; asm volatile("v_cvt_pk_bf16_f32 %0, %1, %2" : "=v"(r) : "v"(lo), "v"(hi)); return r; }
typedef float f32x2 __attribute__((ext_vector_type(2)));
template <class Epi, class Sched, bool STAMP = false>
__device__ __forceinline__ void gemm_phase(PG8_LAS unsigned char* lds, const Gemm g, const Sched& S, const Epi& E, unsigned long long* stamps) {
    int tid = threadIdx.x; asm volatile("" : "+v"(tid)); const int wid = __builtin_amdgcn_readfirstlane(tid >> 6), lane = tid & 63, wr = wid >> 2, wc = wid & 3, fr = lane & 15, fq = lane >> 4;
    const int K = g.K, nt = K / BK;
    int ts_lo = 0, ts_hi = 0, nts = 0; const unsigned long long rt_entry = STAMP ? (unsigned long long)wall_clock64() : 0ull;
#define PG8_STAMP() do { if (STAMP && wid == 0 && nts < 64) { const unsigned long long _c = (unsigned long long)clock64(); \
        ts_lo = (lane == nts) ? (int)(unsigned)_c : ts_lo; ts_hi = (lane == nts) ? (int)(unsigned)(_c >> 32) : ts_hi; ++nts; } } while (0)
    PG8_STAMP();
    unsigned voffA[2], voffB[2];
#pragma unroll
    for (int i = 0; i < 2; ++i) { int R, C; stage_rc(tid * 16 + i * 8192, R, C); const int Rb = Epi::PERM ? ((R & ~31) + perm32(R & 31)) : R;
        voffA[i] = (unsigned)(R * K + C) * 2u; voffB[i] = (unsigned)(Rb * K + C) * 2u; }
    const size_t kstep = (size_t)(BK * 2);
    const size_t hstep = (size_t)HALF * K * 2;
    const size_t tstep = 2 * hstep;
    const unsigned ldsw = (unsigned)wid * 1024u;
    const int aoff = lds_byte(wr * 64 + fr, fq * 8), boff = lds_byte(wc * 32 + fr, fq * 8);
#define PG8_SA(b, h) (((b) * 2 + (h)) * HTB)
#define PG8_SB(b, h) ((4 + (b) * 2 + (h)) * HTB)
#define PG8_STAGE(bufoff, gbase, voff) do { _Pragma("unroll") for (int _i = 0; _i < 2; ++_i) \
        __builtin_amdgcn_global_load_lds((const unsigned*)((const char*)(gbase) + (voff)[_i]), (PG8_LAS unsigned*)(lds + (bufoff) + ldsw + _i * 8192), 16, 0, 0); } while (0)
#define PG8_LDA(dst, b, h) do { _Pragma("unroll") for (int m = 0; m < 4; ++m) _Pragma("unroll") for (int k = 0; k < 2; ++k) dst[m][k] = *(const PG8_LAS bf16x8*)(lds + PG8_SA(b, h) + aoff + m * 2048 + k * 1024); } while (0)
#define PG8_LDB(dst, b, h) do { _Pragma("unroll") for (int n = 0; n < 2; ++n) _Pragma("unroll") for (int k = 0; k < 2; ++k) dst[n][k] = *(const PG8_LAS bf16x8*)(lds + PG8_SB(b, h) + boff + n * 2048 + k * 1024); } while (0)
#define PG8_MMA(ai, bj, At, Bt) do { __builtin_amdgcn_s_setprio(1); _Pragma("unroll") for (int m = 0; m < 4; ++m) _Pragma("unroll") for (int n = 0; n < 2; ++n) _Pragma("unroll") for (int k = 0; k < 2; ++k) \
        acc[ai][bj][m][n] = __builtin_amdgcn_mfma_f32_16x16x32_bf16(Bt[n][k], At[m][k], acc[ai][bj][m][n], 0, 0, 0); __builtin_amdgcn_s_setprio(0); } while (0)
#define PG8_WAIT_V(n) asm volatile("s_waitcnt vmcnt(" #n ")" ::: "memory")
#define PG8_WAIT_L(n) asm volatile("s_waitcnt lgkmcnt(" #n ")" ::: "memory")
#define PG8_BAR __builtin_amdgcn_s_barrier()
#define PG8_SCHED __builtin_amdgcn_sched_barrier(0)
    Unit cur, nxt; int ui = 0;
    if (!S.next(0, cur)) return;
    f32x4 acc[2][2][4][2];
#pragma unroll
    for (int a = 0; a < 2; ++a)
#pragma unroll
        for (int b = 0; b < 2; ++b)
#pragma unroll
            for (int m = 0; m < 4; ++m)
#pragma unroll
                for (int n = 0; n < 2; ++n) acc[a][b][m][n] = (f32x4){0.f, 0.f, 0.f, 0.f};
    bf16x8 At[4][2], B0[2][2], B1[2][2];
    const char* cA = (const char*)g.A + (size_t)cur.pm * tstep; const char* cB = (const char*)g.Bt + (size_t)cur.pn * tstep;
    S.a_ready(cur);
    PG8_STAGE(PG8_SB(0, 0), cB, voffB); PG8_STAGE(PG8_SA(0, 0), cA, voffA); PG8_STAGE(PG8_SB(0, 1), cB + hstep, voffB); PG8_STAGE(PG8_SA(0, 1), cA + hstep, voffA);
    if (wr == 1) PG8_BAR;
    PG8_WAIT_V(4); PG8_BAR;
    PG8_STAGE(PG8_SB(1, 0), cB + kstep, voffB); PG8_STAGE(PG8_SA(1, 0), cA + kstep, voffA); PG8_STAGE(PG8_SB(1, 1), cB + hstep + kstep, voffB);
    PG8_WAIT_V(6); PG8_BAR;
    PG8_STAMP();
    for (;;) {
        const bool has_next = S.next(ui + 1, nxt);
        const char* nA = has_next ? (const char*)g.A + (size_t)nxt.pm * tstep : cA; const char* nB = has_next ? (const char*)g.Bt + (size_t)nxt.pn * tstep : cB;
        for (int t = 0; t < nt; t += 2) {
            const bool last = (t == nt - 2);
            const char* a1 = cA + (size_t)(t + 1) * kstep;
            const char* a2 = last ? nA : cA + (size_t)(t + 2) * kstep; const char* b2 = last ? nB : cB + (size_t)(t + 2) * kstep;
            const char* a3 = a2 + kstep; const char* b3 = b2 + kstep;
            if (last && has_next) S.a_ready(nxt);
            PG8_LDB(B0, 0, 0); PG8_SCHED; PG8_LDA(At, 0, 0); PG8_STAGE(PG8_SA(1, 1), a1 + hstep, voffA);
            PG8_WAIT_L(8); PG8_BAR; PG8_WAIT_L(0); PG8_MMA(0, 0, At, B0); PG8_BAR; PG8_SCHED;
            PG8_LDB(B1, 0, 1); PG8_STAGE(PG8_SB(0, 0), b2, voffB);
            PG8_BAR; PG8_WAIT_L(0); PG8_MMA(0, 1, At, B1); PG8_BAR;
            PG8_LDA(At, 0, 1); PG8_STAGE(PG8_SA(0, 0), a2, voffA);
            PG8_BAR; PG8_WAIT_L(0); PG8_MMA(1, 0, At, B0); PG8_BAR; PG8_SCHED;
            PG8_STAGE(PG8_SB(0, 1), b2 + hstep, voffB);
            PG8_WAIT_V(6); PG8_BAR; PG8_MMA(1, 1, At, B1); PG8_BAR;
            PG8_LDB(B0, 1, 0); PG8_SCHED; PG8_LDA(At, 1, 0); PG8_STAGE(PG8_SA(0, 1), a2 + hstep, voffA);
            PG8_WAIT_L(8); PG8_BAR; PG8_WAIT_L(0); PG8_MMA(0, 0, At, B0); PG8_BAR; PG8_SCHED;
            PG8_LDB(B1, 1, 1); PG8_STAGE(PG8_SB(1, 0), b3, voffB);
            PG8_BAR; PG8_WAIT_L(0); PG8_MMA(0, 1, At, B1); PG8_BAR;
            PG8_LDA(At, 1, 1); PG8_STAGE(PG8_SA(1, 0), a3, voffA);
            PG8_BAR; PG8_WAIT_L(0); PG8_MMA(1, 0, At, B0); PG8_BAR; PG8_SCHED;
            PG8_STAGE(PG8_SB(1, 1), b3 + hstep, voffB);
            PG8_WAIT_V(6); PG8_BAR; PG8_MMA(1, 1, At, B1); PG8_BAR;
        }
        PG8_STAMP();
        if constexpr (!Epi::AFTER_DRAIN) { E(acc, cur, wr, wc, fr, fq); S.done(cur); }
        PG8_STAMP();
        if (!has_next) break;
#pragma unroll
        for (int a = 0; a < 2; ++a)
#pragma unroll
            for (int b = 0; b < 2; ++b)
#pragma unroll
                for (int m = 0; m < 4; ++m)
#pragma unroll
                    for (int n = 0; n < 2; ++n) acc[a][b][m][n] = (f32x4){0.f, 0.f, 0.f, 0.f};
        cur = nxt; cA = nA; cB = nB; ++ui;
    }
    PG8_WAIT_V(0);
    if (wr == 0) PG8_BAR;
    PG8_BAR;
    if constexpr (Epi::AFTER_DRAIN) { E.fused(acc, cur, wr, wc, fr, fq, lds, wid, lane); S.done(cur); }
    PG8_STAMP();
    if (STAMP && wid == 0) { stamps[lane] = lane < nts ? (((unsigned long long)(unsigned)ts_hi << 32) | (unsigned)ts_lo) : 0ull;
        if (lane == 62) stamps[62] = rt_entry; if (lane == 63) stamps[63] = (unsigned long long)wall_clock64(); }
#undef PG8_STAMP
#undef PG8_SA
#undef PG8_SB
#undef PG8_STAGE
#undef PG8_LDA
#undef PG8_LDB
#undef PG8_MMA
#undef PG8_WAIT_V
#undef PG8_WAIT_L
#undef PG8_BAR
#undef PG8_SCHED
}
}

#define LAS __attribute__((address_space(3)))
using pg8::bf16_t; using pg8::bf16x8; using pg8::f32x4; using pg8::u32x4; using pg8::cvt_pk_bf16;
typedef unsigned u32x2 __attribute__((ext_vector_type(2)));
typedef float f32x2 __attribute__((ext_vector_type(2)));

constexpr int TP = 16384, TS = 512, TT = 16896, DM = 1024;
constexpr int NHA = 2560, NHB = 3584, DFF = 2816, NUP = 5632;
constexpr float ALPHA = 1.6817928305074292f;
constexpr int LDS_BYTES = 139264;

constexpr size_t WS_WINA = 0;
constexpr size_t WS_WOUTA = WS_WINA + (size_t)2 * NHA * DM * 2;
constexpr size_t WS_WINB = WS_WOUTA + (size_t)2 * DM * DM * 2;
constexpr size_t WS_WOUTB = WS_WINB + (size_t)2 * NHB * DM * 2;
constexpr size_t WS_WKV = WS_WOUTB + (size_t)2 * DM * DM * 2;
constexpr size_t WS_WUP = WS_WKV + (size_t)2048 * DM * 2;
constexpr size_t WS_WDOWN = WS_WUP + (size_t)4 * NUP * DM * 2;
constexpr size_t WS_XF = WS_WDOWN + (size_t)4 * DM * DFF * 2;
constexpr size_t WS_XB = WS_XF + (size_t)TT * DM * 4;
constexpr size_t WS_MEMB = WS_XB + (size_t)TT * DM * 2;
constexpr size_t WS_KB = WS_MEMB + (size_t)2048 * DM * 2;
constexpr size_t WS_VT = WS_KB + (size_t)4 * 8 * 4 * 256 * 64 * 2;
constexpr size_t WS_R = WS_VT + (size_t)4 * 8 * 4 * 256 * 64 * 2;
constexpr size_t WS_H = WS_R;
constexpr size_t WS_CAT = WS_H + (size_t)TT * NHB * 2;
constexpr size_t WS_QKVN = WS_CAT + (size_t)TT * DM * 2;
constexpr size_t WS_GB = WS_QKVN + (size_t)TT * 2304 * 2;
constexpr size_t WS_WC = WS_GB + (size_t)TT * 12 * 4;
constexpr size_t WS_QDC = WS_WC + (size_t)1536 * 16384;
constexpr size_t WS_KDT = WS_QDC + (size_t)1536 * 16384;
constexpr size_t WS_QKC = WS_KDT + (size_t)1536 * 16384;
constexpr size_t WS_UT = WS_QKC + (size_t)1536 * 8192;
constexpr size_t WS_GL = WS_UT + (size_t)1536 * 32768;
constexpr size_t WS_O = WS_GL + (size_t)1536 * 4 + 2048;
constexpr size_t WS_MIX_END = WS_O + (size_t)TT * 768 * 4;
constexpr size_t WS_HU = WS_R;
constexpr size_t WS_GACT = WS_HU + (size_t)TT * NUP * 2;
constexpr size_t WS_FFN_END = WS_GACT + (size_t)TT * DFF * 2;
constexpr size_t WS_END = WS_MIX_END > WS_FFN_END ? WS_MIX_END : WS_FFN_END;

constexpr size_t O_Y = 0;
constexpr size_t O_MK = O_Y + (size_t)TT * DM;
constexpr size_t O_MV = O_MK + (size_t)4 * 8 * 256 * 256;
constexpr size_t O_SCP = O_MV + (size_t)4 * 8 * 256 * 256;
constexpr size_t O_GCP = O_SCP + (size_t)2 * 8 * 2 * 768;
constexpr size_t O_GSP = O_GCP + (size_t)2 * 8 * 3 * 2304;
constexpr size_t O_FFP = O_GSP + (size_t)2 * 8 * 6 * 16384;
constexpr size_t O_SCS = O_FFP + (size_t)4 * 8 * 2 * NUP;
constexpr size_t O_GCS = O_SCS + (size_t)2 * 128 * 2 * 768;
constexpr size_t O_GSS = O_GCS + (size_t)2 * 128 * 3 * 2304;
constexpr size_t O_FFS = O_GSS + (size_t)2 * 128 * 6 * 16384;
constexpr size_t O_END = O_FFS + (size_t)4 * 128 * 2 * NUP;

#ifdef DIAG_GDN
constexpr size_t WS_NEED = WS_END + ((size_t)64 << 20);
#else
constexpr size_t WS_NEED = WS_END;
#endif
constexpr size_t WS_BAR = (WS_NEED + 255) / 256 * 256;
constexpr size_t WS_TOTAL = WS_BAR + 16384;
struct Params { const float* in[26]; float* out; unsigned char* ws; };
__device__ __forceinline__ int otid() { int t = threadIdx.x; asm volatile("" : "+v"(t)); return t; }

__device__ __forceinline__ float bflo(unsigned w) { return __uint_as_float(w << 16); }
__device__ __forceinline__ float bfhi(unsigned w) { return __uint_as_float(w & 0xffff0000u); }
__device__ __forceinline__ float bf1(bf16_t v) { return __uint_as_float((unsigned)v << 16); }
__device__ __forceinline__ float silu_f(float x) { return x / (1.f + __expf(-x)); }
__device__ __forceinline__ float wave_sum(float v) {
#pragma unroll
    for (int o = 1; o < 64; o <<= 1) v += __shfl_xor(v, o);
    return v;
}
__device__ __forceinline__ bf16x8 as_bf16x8(u32x4 v) { union { u32x4 u; bf16x8 b; } x; x.u = v; return x.b; }
__device__ __forceinline__ bf16x8 pack8(f32x4 a, f32x4 b) {
    u32x4 w; w.x = cvt_pk_bf16(a[0], a[1]); w.y = cvt_pk_bf16(a[2], a[3]); w.z = cvt_pk_bf16(b[0], b[1]); w.w = cvt_pk_bf16(b[2], b[3]);
    return as_bf16x8(w);
}
__device__ __forceinline__ int invperm32(int a) { return 8 * ((a & 15) >> 2) + (a & 3) + ((a >> 4) << 2); }
__device__ __forceinline__ int perm32k(int p) { const int g = p >> 3, jj = p & 7; return jj < 4 ? 4 * g + jj : 16 + 4 * g + (jj - 4); }

struct EpiStoreBf16 {
    static constexpr bool PERM = true, AFTER_DRAIN = false;
    bf16_t* O; int ldc;
    __device__ __forceinline__ void operator()(const f32x4 (&acc)[2][2][4][2], const pg8::Unit& u, int wr, int wc, int fr, int fq) const {
        const int row0 = u.pm * 256 + wr * 64 + fr, col0 = u.pn * 256 + wc * 32 + 8 * fq;
#pragma unroll
        for (int ai = 0; ai < 2; ++ai)
#pragma unroll
            for (int m = 0; m < 4; ++m) { bf16_t* rowp = O + (size_t)(row0 + ai * 128 + m * 16) * ldc + col0;
#pragma unroll
                for (int bj = 0; bj < 2; ++bj) { const f32x4 v0 = acc[ai][bj][m][0], v1 = acc[ai][bj][m][1];
                    u32x4 w; w.x = cvt_pk_bf16(v0[0], v0[1]); w.y = cvt_pk_bf16(v0[2], v0[3]); w.z = cvt_pk_bf16(v1[0], v1[1]); w.w = cvt_pk_bf16(v1[2], v1[3]);
                    *(u32x4*)(rowp + bj * 128) = w; } }
    }
};
struct EpiResid {
    static constexpr bool PERM = false, AFTER_DRAIN = false;
    float* X; int ldc;
    __device__ __forceinline__ void operator()(const f32x4 (&acc)[2][2][4][2], const pg8::Unit& u, int wr, int wc, int fr, int fq) const {
        const int row0 = u.pm * 256 + wr * 64 + fr, col0 = u.pn * 256 + wc * 32 + 4 * fq;
#pragma unroll
        for (int ai = 0; ai < 2; ++ai)
#pragma unroll
            for (int m = 0; m < 4; ++m) { float* rowp = X + (size_t)(row0 + ai * 128 + m * 16) * ldc + col0;
#pragma unroll
                for (int bj = 0; bj < 2; ++bj)
#pragma unroll
                    for (int n = 0; n < 2; ++n) { f32x4* p = (f32x4*)(rowp + bj * 128 + n * 16); const f32x4 x = *p; *p = x * ALPHA + acc[ai][bj][m][n]; } }
    }
};
struct EpiKV {
    static constexpr bool PERM = false, AFTER_DRAIN = false;
    float* outK; float* outV; bf16_t* Kb; bf16_t* Vt;
    __device__ __forceinline__ void operator()(const f32x4 (&acc)[2][2][4][2], const pg8::Unit& u, int wr, int wc, int fr, int fq) const {
        const int row0 = u.pm * 256 + wr * 64 + fr, col0 = u.pn * 256 + wc * 32 + 4 * fq;
#pragma unroll
        for (int ai = 0; ai < 2; ++ai)
#pragma unroll
            for (int m = 0; m < 4; ++m) { const int row = row0 + ai * 128 + m * 16; const int b = row >> 8, mm = row & 255;
#pragma unroll
                for (int bj = 0; bj < 2; ++bj)
#pragma unroll
                    for (int n = 0; n < 2; ++n) { const int col = col0 + bj * 128 + n * 16; const int l = col >> 9, e = col & 511; const f32x4 v = acc[ai][bj][m][n];
                        if (e < 256) { *(f32x4*)(outK + ((size_t)((l * 8 + b) * 256 + mm)) * 256 + e) = v;
                            u32x2 w; w.x = cvt_pk_bf16(v[0], v[1]); w.y = cvt_pk_bf16(v[2], v[3]);
                            *(u32x2*)(Kb + ((size_t)(((l * 8 + b) * 4 + (e >> 6)) * 256 + mm)) * 64 + (e & 63)) = w; }
                        else { const int e2 = e - 256; *(f32x4*)(outV + ((size_t)((l * 8 + b) * 256 + mm)) * 256 + e2) = v;
                            const unsigned w0 = cvt_pk_bf16(v[0], v[1]), w1 = cvt_pk_bf16(v[2], v[3]);
                            bf16_t* vp = Vt + ((size_t)(((l * 8 + b) * 4 + (e2 >> 6)) * 64 + (e2 & 63))) * 256 + mm;
                            vp[0] = (bf16_t)(w0 & 0xffffu); vp[256] = (bf16_t)(w0 >> 16); vp[512] = (bf16_t)(w1 & 0xffffu); vp[768] = (bf16_t)(w1 >> 16); } } }
    }
};

template <class Epi>
__device__ __forceinline__ void run_gemm(LAS unsigned char* lds, const bf16_t* A, const bf16_t* Bt, int M, int N, int K, const Epi& E, int c) {
    pg8::Gemm g{A, Bt, M, N, K}; pg8::StaticOrder S; S.init(M, N, (int)gridDim.x, c);
    pg8::gemm_phase<Epi, pg8::StaticOrder, false>(lds, g, S, E, nullptr);
}

__device__ __forceinline__ void p0_transpose_item(const float* W, int K, int Ns, int Nd, bool remap, bf16_t* WT, LAS float* scr, int item, int lane) {
    const int nblk = Nd / 32, kb = item / nblk, nb = item % nblk, k0 = 64 * kb, n0 = 32 * nb;
    const int n = n0 + (lane & 31); int sn = n;
    if (remap) sn = n < 3072 ? n : (n < 3328 ? n + 12 : (n < 3340 ? n - 256 : -1));
#pragma unroll 8
    for (int i = 0; i < 32; ++i) { const int kk = 2 * i + (lane >> 5); scr[kk * 33 + (lane & 31)] = sn >= 0 ? W[(size_t)(k0 + kk) * Ns + sn] : 0.f; }
    asm volatile("s_waitcnt lgkmcnt(0)" ::: "memory");
    const int c = lane & 7;
#pragma unroll
    for (int j = 0; j < 4; ++j) { const int nn = (lane >> 3) + 8 * j; const LAS float* s = scr + (8 * c) * 33 + nn;
        u32x4 o; o.x = cvt_pk_bf16(s[0 * 33], s[1 * 33]); o.y = cvt_pk_bf16(s[2 * 33], s[3 * 33]); o.z = cvt_pk_bf16(s[4 * 33], s[5 * 33]); o.w = cvt_pk_bf16(s[6 * 33], s[7 * 33]);
        *(u32x4*)(WT + (size_t)(n0 + nn) * K + k0 + 8 * c) = o; }
    asm volatile("s_waitcnt lgkmcnt(0)" ::: "memory");
}

__device__ __forceinline__ void phase_prep(const Params& p, LAS unsigned char* lds) {
    const int tid = otid(), lane = tid & 63, wave = __builtin_amdgcn_readfirstlane(tid >> 6);
    const int gw = blockIdx.x * 8 + wave, NGW = gridDim.x * 8;
    LAS float* scr = (LAS float*)(lds + wave * 16384);
    unsigned char* ws = p.ws;
    constexpr int I_INA = 16 * 80, I_OUT = 16 * 32, I_INB = 16 * 112, I_KV = 16 * 16, I_UP = 16 * 176, I_DN = 44 * 32;
    constexpr int NIT = 2 * I_INA + 2 * I_OUT + 2 * I_INB + 2 * I_OUT + 4 * I_KV + 4 * I_UP + 4 * I_DN;
    for (int it = gw; it < NIT; it += NGW) {
        int r = it;
        if (r < 2 * I_INA) { const int l = r / I_INA; r -= l * I_INA; p0_transpose_item(p.in[9] + (size_t)l * DM * NHA, DM, NHA, NHA, false, (bf16_t*)(ws + WS_WINA) + (size_t)l * NHA * DM, scr, r, lane); continue; } r -= 2 * I_INA;
        if (r < 2 * I_OUT) { const int l = r / I_OUT; r -= l * I_OUT; p0_transpose_item(p.in[11] + (size_t)l * DM * DM, DM, DM, DM, false, (bf16_t*)(ws + WS_WOUTA) + (size_t)l * DM * DM, scr, r, lane); continue; } r -= 2 * I_OUT;
        if (r < 2 * I_INB) { const int l = r / I_INB; r -= l * I_INB; p0_transpose_item(p.in[12] + (size_t)l * DM * 3340, DM, 3340, NHB, true, (bf16_t*)(ws + WS_WINB) + (size_t)l * NHB * DM, scr, r, lane); continue; } r -= 2 * I_INB;
        if (r < 2 * I_OUT) { const int l = r / I_OUT; r -= l * I_OUT; p0_transpose_item(p.in[17] + (size_t)l * DM * DM, DM, DM, DM, false, (bf16_t*)(ws + WS_WOUTB) + (size_t)l * DM * DM, scr, r, lane); continue; } r -= 2 * I_OUT;
        if (r < 4 * I_KV) { const int l = r / I_KV; r -= l * I_KV; p0_transpose_item(p.in[18] + (size_t)l * DM * 512, DM, 512, 512, false, (bf16_t*)(ws + WS_WKV) + (size_t)l * 512 * DM, scr, r, lane); continue; } r -= 4 * I_KV;
        if (r < 4 * I_UP) { const int l = r / I_UP; r -= l * I_UP; p0_transpose_item(p.in[23] + (size_t)l * DM * NUP, DM, NUP, NUP, false, (bf16_t*)(ws + WS_WUP) + (size_t)l * NUP * DM, scr, r, lane); continue; } r -= 4 * I_UP;
        { const int l = r / I_DN; r -= l * I_DN; p0_transpose_item(p.in[25] + (size_t)l * DFF * DM, DFF, DM, DM, false, (bf16_t*)(ws + WS_WDOWN) + (size_t)l * DM * DFF, scr, r, lane); }
    }
    const size_t gt = (size_t)blockIdx.x * 512 + tid, NT = (size_t)gridDim.x * 512;
    float* xf = (float*)(ws + WS_XF); bf16_t* xb = (bf16_t*)(ws + WS_XB); bf16_t* memb = (bf16_t*)(ws + WS_MEMB);
    for (size_t i = gt; i < (size_t)TT * 256; i += NT) {
        const f32x4 v = i < (size_t)TP * 256 ? ((const f32x4*)p.in[0])[i] : ((const f32x4*)p.in[1])[i - (size_t)TP * 256];
        ((f32x4*)xf)[i] = v; u32x2 w; w.x = cvt_pk_bf16(v[0], v[1]); w.y = cvt_pk_bf16(v[2], v[3]); ((u32x2*)xb)[i] = w;
    }
    for (size_t i = gt; i < (size_t)2048 * 256; i += NT) {
        const f32x4 v = ((const f32x4*)p.in[2])[i]; u32x2 w; w.x = cvt_pk_bf16(v[0], v[1]); w.y = cvt_pk_bf16(v[2], v[3]); ((u32x2*)memb)[i] = w;
    }
}

__device__ __forceinline__ void phase_ln(float* xf, bf16_t* xb, const float* gam, const float* bet, float* yout) {
    const int tid_ = otid(); const int lane = tid_ & 63, wave = __builtin_amdgcn_readfirstlane(tid_ >> 6);
    const int gw = blockIdx.x * 8 + wave, NGW = gridDim.x * 8;
    f32x4 gg[4], bb[4];
#pragma unroll
    for (int j = 0; j < 4; ++j) { gg[j] = ((const f32x4*)gam)[lane + 64 * j]; bb[j] = ((const f32x4*)bet)[lane + 64 * j]; }
    for (int row = gw; row < TT; row += NGW) {
        f32x4* xr = (f32x4*)(xf + (size_t)row * DM) + lane;
        f32x4 v[4]; float s = 0.f;
#pragma unroll
        for (int j = 0; j < 4; ++j) { v[j] = xr[64 * j]; s += (v[j][0] + v[j][1]) + (v[j][2] + v[j][3]); }
        const float mean = wave_sum(s) * (1.f / DM); float s2 = 0.f;
#pragma unroll
        for (int j = 0; j < 4; ++j) { v[j] = v[j] - mean; s2 += (v[j][0] * v[j][0] + v[j][1] * v[j][1]) + (v[j][2] * v[j][2] + v[j][3] * v[j][3]); }
        const float rstd = 1.f / sqrtf(wave_sum(s2) * (1.f / DM) + 1e-5f);
#pragma unroll
        for (int j = 0; j < 4; ++j) { const f32x4 o = v[j] * rstd * gg[j] + bb[j];
            if (yout) ((f32x4*)(yout + (size_t)row * DM))[lane + 64 * j] = o;
            else { xr[64 * j] = o; u32x2 w; w.x = cvt_pk_bf16(o[0], o[1]); w.y = cvt_pk_bf16(o[2], o[3]); ((u32x2*)(xb + (size_t)row * DM))[lane + 64 * j] = w; } }
    }
}

__device__ __forceinline__ void attn_prompt_item(LAS unsigned char* lds, const bf16_t* h, int ldh, int qoff, const bf16_t* Kb, const bf16_t* Vt, bf16_t* cat, int layer, int item) {
    const int tid = otid(), lane = tid & 63, wave = __builtin_amdgcn_readfirstlane(tid >> 6), c16 = lane & 15, g = lane >> 4;
    const int qc = item & 7, hd = (item >> 3) & 3, b = item >> 5;
    const size_t kvbase = ((size_t)((layer * 8 + b) * 4 + hd)) * 16384;
    constexpr int VOFF = 256 * 144;
#pragma unroll
    for (int i = 0; i < 4; ++i) { const int q = tid + 512 * i;
        const u32x4 kv = *(const u32x4*)(Kb + kvbase + (size_t)q * 8); *(LAS u32x4*)(lds + (q >> 3) * 144 + (q & 7) * 16) = kv;
        const u32x4 vv = *(const u32x4*)(Vt + kvbase + (size_t)q * 8); *(LAS u32x4*)(lds + VOFF + (q >> 5) * 528 + (q & 31) * 16) = vv; }
    __syncthreads();
#pragma unroll 1
    for (int qt = wave; qt < 16; qt += 8) {
        const int row = b * 2048 + qc * 256 + qt * 16 + c16;
        const bf16_t* qp = h + (size_t)row * ldh + qoff + hd * 64 + g * 8;
        const bf16x8 qf0 = *(const bf16x8*)qp, qf1 = *(const bf16x8*)(qp + 32);
        f32x4 acc[16];
#pragma unroll
        for (int kt = 0; kt < 16; ++kt) { acc[kt] = (f32x4){0.f, 0.f, 0.f, 0.f};
            const LAS unsigned char* kp = lds + (16 * kt + c16) * 144 + g * 16;
            const bf16x8 k0 = *(const LAS bf16x8*)kp, k1 = *(const LAS bf16x8*)(kp + 64);
            acc[kt] = __builtin_amdgcn_mfma_f32_16x16x32_bf16(k0, qf0, acc[kt], 0, 0, 0);
            acc[kt] = __builtin_amdgcn_mfma_f32_16x16x32_bf16(k1, qf1, acc[kt], 0, 0, 0); }
        float mx = -3.0e38f;
#pragma unroll
        for (int kt = 0; kt < 16; ++kt) mx = fmaxf(mx, fmaxf(fmaxf(acc[kt][0], acc[kt][1]), fmaxf(acc[kt][2], acc[kt][3])));
        mx = fmaxf(mx, __shfl_xor(mx, 16)); mx = fmaxf(mx, __shfl_xor(mx, 32));
        const float sc = 0.125f * 1.44269504089f; float sum = 0.f;
#pragma unroll
        for (int kt = 0; kt < 16; ++kt)
#pragma unroll
            for (int r = 0; r < 4; ++r) { const float e = __builtin_amdgcn_exp2f((acc[kt][r] - mx) * sc); acc[kt][r] = e; sum += e; }
        sum += __shfl_xor(sum, 16); sum += __shfl_xor(sum, 32);
        const float inv = 1.f / sum;
        f32x4 o[4];
#pragma unroll
        for (int dt = 0; dt < 4; ++dt) o[dt] = (f32x4){0.f, 0.f, 0.f, 0.f};
#pragma unroll
        for (int s = 0; s < 8; ++s) { const bf16x8 pf = pack8(acc[2 * s], acc[2 * s + 1]);
#pragma unroll
            for (int dt = 0; dt < 4; ++dt) { const LAS unsigned char* vp = lds + VOFF + (16 * dt + c16) * 528 + (32 * s + 4 * g) * 2;
                const u32x2 a0 = *(const LAS u32x2*)vp, a1 = *(const LAS u32x2*)(vp + 32);
                u32x4 av; av.x = a0.x; av.y = a0.y; av.z = a1.x; av.w = a1.y;
                o[dt] = __builtin_amdgcn_mfma_f32_16x16x32_bf16(as_bf16x8(av), pf, o[dt], 0, 0, 0); } }
#pragma unroll
        for (int dt = 0; dt < 4; ++dt) { u32x2 w; w.x = cvt_pk_bf16(o[dt][0] * inv, o[dt][1] * inv); w.y = cvt_pk_bf16(o[dt][2] * inv, o[dt][3] * inv);
            *(u32x2*)(cat + (size_t)row * DM + 768 + hd * 64 + 16 * dt + 4 * g) = w; }
    }
    __syncthreads();
}

__device__ __forceinline__ void attn_prompt_item_naive(LAS unsigned char* lds, const bf16_t* h, int ldh, int qoff, const float* outK, const float* outV, bf16_t* cat, int layer, int item) {
    const int tid = otid();
    const int qc = item & 7, hd = (item >> 3) & 3, b = item >> 5;
    LAS float* Ks = (LAS float*)lds; LAS float* Vs = Ks + 256 * 64;
    for (int i = tid; i < 256 * 64; i += 512) { const int m = i >> 6, d = i & 63; const size_t src = ((size_t)((layer * 8 + b) * 256 + m)) * 256 + hd * 64 + d; Ks[i] = outK[src]; Vs[i] = outV[src]; }
    __syncthreads();
    const int ql = tid & 255, half = tid >> 8;
    const int row = b * 2048 + qc * 256 + ql;
    float q[64];
#pragma unroll
    for (int d = 0; d < 64; ++d) q[d] = bf1(h[(size_t)row * ldh + qoff + hd * 64 + d]);
    float mx = -3.0e38f, l = 0.f; float acc[64];
#pragma unroll
    for (int d = 0; d < 64; ++d) acc[d] = 0.f;
#pragma unroll 1
    for (int m = half * 128; m < half * 128 + 128; ++m) {
        float sdot = 0.f;
#pragma unroll
        for (int d = 0; d < 64; ++d) sdot += q[d] * Ks[m * 64 + d];
        sdot *= 0.125f;
        const float nm = fmaxf(mx, sdot); const float corr = __expf(mx - nm), pe = __expf(sdot - nm);
        l = l * corr + pe;
#pragma unroll
        for (int d = 0; d < 64; ++d) acc[d] = acc[d] * corr + pe * Vs[m * 64 + d];
        mx = nm;
    }
    __syncthreads();
    LAS float* ex = (LAS float*)lds;
    if (half == 1) { ex[ql * 66 + 64] = mx; ex[ql * 66 + 65] = l;
#pragma unroll
        for (int d = 0; d < 64; ++d) ex[ql * 66 + d] = acc[d]; }
    __syncthreads();
    if (half == 0) { const float m2 = ex[ql * 66 + 64], l2 = ex[ql * 66 + 65]; const float nm = fmaxf(mx, m2); const float c1 = __expf(mx - nm), c2 = __expf(m2 - nm); const float inv = 1.f / (l * c1 + l2 * c2);
#pragma unroll
        for (int d = 0; d < 64; ++d) { const float o = (acc[d] * c1 + ex[ql * 66 + d] * c2) * inv; cat[(size_t)row * DM + 768 + hd * 64 + d] = (bf16_t)(cvt_pk_bf16(o, 0.f) & 0xffffu); } }
    __syncthreads();
}
__device__ __forceinline__ void attn_sample_item(LAS unsigned char* lds, const bf16_t* h, int ldh, int qoff, const float* ck, const float* cv, bf16_t* cat, int layer, int item) {
    const int tid = otid(), lane = tid & 63, wave = __builtin_amdgcn_readfirstlane(tid >> 6);
    const int hp = item & 1, sb = item >> 1;
    LAS float* qs = (LAS float*)lds;
    LAS float* scs = qs + 512;
    LAS float* red = scs + 2048;
    { const int t = tid >> 7, hh = (tid >> 6) & 1, d = tid & 63;
      qs[tid] = bf1(h[(size_t)(TP + sb * 4 + t) * ldh + qoff + (2 * hp + hh) * 64 + d]); }
    __syncthreads();
    { const int m = tid & 255, hh = tid >> 8;
      const f32x4* kp = (const f32x4*)(ck + (((size_t)(layer * 128 + sb) * 256 + m) * 4 + (2 * hp + hh)) * 64);
      float a0 = 0.f, a1 = 0.f, a2 = 0.f, a3 = 0.f;
#pragma unroll
      for (int i = 0; i < 16; ++i) { const f32x4 kv = kp[i];
#pragma unroll
          for (int e = 0; e < 4; ++e) { const int d = 4 * i + e; a0 += kv[e] * qs[(0 * 2 + hh) * 64 + d]; a1 += kv[e] * qs[(1 * 2 + hh) * 64 + d]; a2 += kv[e] * qs[(2 * 2 + hh) * 64 + d]; a3 += kv[e] * qs[(3 * 2 + hh) * 64 + d]; } }
      scs[(0 * 2 + hh) * 256 + m] = a0 * 0.125f; scs[(1 * 2 + hh) * 256 + m] = a1 * 0.125f; scs[(2 * 2 + hh) * 256 + m] = a2 * 0.125f; scs[(3 * 2 + hh) * 256 + m] = a3 * 0.125f; }
    __syncthreads();
    { LAS float* sp = scs + wave * 256; float v[4]; float mx = -3.0e38f;
#pragma unroll
      for (int i = 0; i < 4; ++i) { v[i] = sp[lane + 64 * i]; mx = fmaxf(mx, v[i]); }
#pragma unroll
      for (int o = 1; o < 64; o <<= 1) mx = fmaxf(mx, __shfl_xor(mx, o));
      float s = 0.f;
#pragma unroll
      for (int i = 0; i < 4; ++i) { v[i] = __expf(v[i] - mx); s += v[i]; }
      s = wave_sum(s); const float inv = 1.f / s;
#pragma unroll
      for (int i = 0; i < 4; ++i) sp[lane + 64 * i] = v[i] * inv; }
    __syncthreads();
    { const int d = tid & 63, hh = (tid >> 6) & 1, mp = tid >> 7;
      float a0 = 0.f, a1 = 0.f, a2 = 0.f, a3 = 0.f;
      const float* vp = cv + (((size_t)(layer * 128 + sb) * 256 + mp * 64) * 4 + (2 * hp + hh)) * 64 + d;
#pragma unroll 8
      for (int m = 0; m < 64; ++m) { const float vv = vp[(size_t)m * 256]; const int mm = mp * 64 + m;
          a0 += scs[(0 * 2 + hh) * 256 + mm] * vv; a1 += scs[(1 * 2 + hh) * 256 + mm] * vv; a2 += scs[(2 * 2 + hh) * 256 + mm] * vv; a3 += scs[(3 * 2 + hh) * 256 + mm] * vv; }
      red[(mp * 8 + 0 * 2 + hh) * 64 + d] = a0; red[(mp * 8 + 1 * 2 + hh) * 64 + d] = a1; red[(mp * 8 + 2 * 2 + hh) * 64 + d] = a2; red[(mp * 8 + 3 * 2 + hh) * 64 + d] = a3; }
    __syncthreads();
    { const int t = tid >> 7, hh = (tid >> 6) & 1, d = tid & 63; const int idx = (t * 2 + hh) * 64 + d;
      const float o = red[idx] + red[512 + idx] + red[1024 + idx] + red[1536 + idx];
      cat[(size_t)(TP + sb * 4 + t) * DM + 768 + (2 * hp + hh) * 64 + d] = (bf16_t)(cvt_pk_bf16(o, 0.f) & 0xffffu); }
    __syncthreads();
}

__device__ __forceinline__ void load_u8(const bf16_t* h, size_t row, int c, float* u) {
    const u32x4 xi = *(const u32x4*)(h + row * NHA + c), cg = *(const u32x4*)(h + row * NHA + 1536 + c);
#pragma unroll
    for (int i = 0; i < 4; ++i) { u[2 * i] = bflo(xi[i]) * bflo(cg[i]); u[2 * i + 1] = bfhi(xi[i]) * bfhi(cg[i]); }
}
__device__ __forceinline__ void load_f8(const float* src, float* v) {
    const f32x4 a = ((const f32x4*)src)[0], b = ((const f32x4*)src)[1];
#pragma unroll
    for (int i = 0; i < 4; ++i) { v[i] = a[i]; v[4 + i] = b[i]; }
}
__device__ __forceinline__ void phase_mixA_elem(const Params& p, int j) {
    const bf16_t* h = (const bf16_t*)(p.ws + WS_H); bf16_t* cat = (bf16_t*)(p.ws + WS_CAT);
    const float* cw = p.in[10] + (size_t)j * 3 * 768; const float* hist = p.in[5] + (size_t)j * 128 * 2 * 768;
    const int gt = blockIdx.x * 512 + otid(), NT = gridDim.x * 512;
    constexpr int RB = 4, NPB = TP / RB, NIT = (NPB + 128) * 96;
    for (int it = gt; it < NIT; it += NT) {
        const int blk = it / 96, c = (it % 96) * 8;
        const bool smp = blk >= NPB; const int row0 = smp ? TP + (blk - NPB) * 4 : blk * RB; const int t0 = smp ? 0 : (row0 & 2047); const int bb = smp ? blk - NPB : (row0 >> 11);
        float w0[8], w1[8], w2[8];
        load_f8(cw + c, w0); load_f8(cw + 768 + c, w1); load_f8(cw + 1536 + c, w2);
        float u0[8], u1[8], u2[8];
        if (t0 >= 2) { load_u8(h, row0 - 2, c, u0); load_u8(h, row0 - 1, c, u1); }
        else if (smp) { load_f8(hist + ((size_t)bb * 2 + 0) * 768 + c, u0); load_f8(hist + ((size_t)bb * 2 + 1) * 768 + c, u1); }
        else {
#pragma unroll
            for (int i = 0; i < 8; ++i) { u0[i] = 0.f; u1[i] = 0.f; } }
        const int T = smp ? 4 : 2048;
#pragma unroll
        for (int r = 0; r < RB; ++r) {
            const size_t row = (size_t)row0 + r;
            load_u8(h, row, c, u2);
            const u32x4 bg = *(const u32x4*)(h + row * NHA + 768 + c);
            float y[8];
#pragma unroll
            for (int i = 0; i < 8; ++i) { const float bgv = (i & 1) ? bfhi(bg[i >> 1]) : bflo(bg[i >> 1]); y[i] = bgv * (w0[i] * u0[i] + w1[i] * u1[i] + w2[i] * u2[i]); }
            u32x4 w; w.x = cvt_pk_bf16(y[0], y[1]); w.y = cvt_pk_bf16(y[2], y[3]); w.z = cvt_pk_bf16(y[4], y[5]); w.w = cvt_pk_bf16(y[6], y[7]);
            *(u32x4*)(cat + row * DM + c) = w;
            const int t = t0 + r;
            if (t >= T - 2) { float* op = p.out + (smp ? O_SCS : O_SCP) + (((size_t)j * (smp ? 128 : 8) + bb) * 2 + (t - (T - 2))) * 768 + c;
                ((f32x4*)op)[0] = (f32x4){u2[0], u2[1], u2[2], u2[3]}; ((f32x4*)op)[1] = (f32x4){u2[4], u2[5], u2[6], u2[7]}; }
#pragma unroll
            for (int i = 0; i < 8; ++i) { u0[i] = u1[i]; u1[i] = u2[i]; }
        }
    }
}

__device__ __forceinline__ void load_h8(const bf16_t* hu, size_t row, int c, float* v) {
    const u32x4 x = *(const u32x4*)(hu + row * NUP + c);
#pragma unroll
    for (int i = 0; i < 4; ++i) { v[2 * i] = bflo(x[i]); v[2 * i + 1] = bfhi(x[i]); }
}
__device__ __forceinline__ void phase_convgate(const Params& p, int l) {
    const bf16_t* hu = (const bf16_t*)(p.ws + WS_HU); bf16_t* gact = (bf16_t*)(p.ws + WS_GACT);
    const float* cw = p.in[24] + (size_t)l * 3 * NUP; const float* hist = p.in[8] + (size_t)l * 128 * 2 * NUP;
    const int gt = blockIdx.x * 512 + otid(), NT = gridDim.x * 512;
    constexpr int RB = 8, NPB = TP / RB, NIT = (NPB + 128) * 352;
    for (int it = gt; it < NIT; it += NT) {
        const int blk = it / 352, c = (it % 352) * 8;
        const bool smp = blk >= NPB; const int row0 = smp ? TP + (blk - NPB) * 4 : blk * RB; const int t0 = smp ? 0 : (row0 & 2047); const int bb = smp ? blk - NPB : (row0 >> 11);
        const int nr = smp ? 4 : RB; const int T = smp ? 4 : 2048;
        float wg0[8], wg1[8], wg2[8], wu0[8], wu1[8], wu2[8];
        load_f8(cw + c, wg0); load_f8(cw + NUP + c, wg1); load_f8(cw + 2 * NUP + c, wg2);
        load_f8(cw + DFF + c, wu0); load_f8(cw + NUP + DFF + c, wu1); load_f8(cw + 2 * NUP + DFF + c, wu2);
        float g0[8], g1[8], g2[8], a0[8], a1[8], a2[8];
        if (t0 >= 2) { load_h8(hu, row0 - 2, c, g0); load_h8(hu, row0 - 1, c, g1); load_h8(hu, row0 - 2, c + DFF, a0); load_h8(hu, row0 - 1, c + DFF, a1); }
        else if (smp) { load_f8(hist + ((size_t)bb * 2 + 0) * NUP + c, g0); load_f8(hist + ((size_t)bb * 2 + 1) * NUP + c, g1); load_f8(hist + ((size_t)bb * 2 + 0) * NUP + DFF + c, a0); load_f8(hist + ((size_t)bb * 2 + 1) * NUP + DFF + c, a1); }
        else {
#pragma unroll
            for (int i = 0; i < 8; ++i) { g0[i] = 0.f; g1[i] = 0.f; a0[i] = 0.f; a1[i] = 0.f; } }
#pragma unroll
        for (int r = 0; r < RB; ++r) {
            if (r < nr) {
                const size_t row = (size_t)row0 + r;
                load_h8(hu, row, c, g2); load_h8(hu, row, c + DFF, a2);
                float y[8];
#pragma unroll
                for (int i = 0; i < 8; ++i) { const float gg = wg0[i] * g0[i] + wg1[i] * g1[i] + wg2[i] * g2[i], uu = wu0[i] * a0[i] + wu1[i] * a1[i] + wu2[i] * a2[i]; y[i] = silu_f(gg) * uu; }
                u32x4 w; w.x = cvt_pk_bf16(y[0], y[1]); w.y = cvt_pk_bf16(y[2], y[3]); w.z = cvt_pk_bf16(y[4], y[5]); w.w = cvt_pk_bf16(y[6], y[7]);
                *(u32x4*)(gact + row * DFF + c) = w;
                const int t = t0 + r;
                if (t >= T - 2) { float* op = p.out + (smp ? O_FFS : O_FFP) + (((size_t)l * (smp ? 128 : 8) + bb) * 2 + (t - (T - 2))) * NUP + c;
                    ((f32x4*)op)[0] = (f32x4){g2[0], g2[1], g2[2], g2[3]}; ((f32x4*)op)[1] = (f32x4){g2[4], g2[5], g2[6], g2[7]};
                    ((f32x4*)(op + DFF))[0] = (f32x4){a2[0], a2[1], a2[2], a2[3]}; ((f32x4*)(op + DFF))[1] = (f32x4){a2[4], a2[5], a2[6], a2[7]}; }
#pragma unroll
                for (int i = 0; i < 8; ++i) { g0[i] = g1[i]; g1[i] = g2[i]; a0[i] = a1[i]; a1[i] = a2[i]; }
            }
        }
    }
}

__device__ __forceinline__ void phase_gdn_pre(const Params& p, int j) {
    const bf16_t* h = (const bf16_t*)(p.ws + WS_H); bf16_t* qkvn = (bf16_t*)(p.ws + WS_QKVN); float* gb = (float*)(p.ws + WS_GB);
    const float* cw = p.in[13] + (size_t)j * 4 * 2304; const float* hist = p.in[6] + (size_t)j * 128 * 3 * 2304;
    const int tid_ = otid(); const int lane = tid_ & 63, wave = __builtin_amdgcn_readfirstlane(tid_ >> 6);
    const int gw = blockIdx.x * 8 + wave, NGW = gridDim.x * 8;
    constexpr int RB = 8, NPB = TP / RB, NIT = (NPB + 128) * 6;
    for (int it = gw; it < NIT; it += NGW) {
        const int blk = it / 6, hd = it % 6;
        const bool smp = blk >= NPB; const int row0 = smp ? TP + (blk - NPB) * 4 : blk * RB; const int t0 = smp ? 0 : (row0 & 2047); const int bb = smp ? blk - NPB : (row0 >> 11);
        const int nr = smp ? 4 : RB; const int T = smp ? 4 : 2048;
        const float alog = -__expf(p.in[14][j * 6 + hd]), dtb = p.in[15][j * 6 + hd];
        f32x2 wv[3][4], x[3][4];
#pragma unroll
        for (int sec = 0; sec < 3; ++sec) { const int col = sec * 768 + hd * 128 + 2 * lane;
#pragma unroll
            for (int k = 0; k < 4; ++k) wv[sec][k] = *(const f32x2*)(cw + (size_t)k * 2304 + col);
#pragma unroll
            for (int k = 0; k < 3; ++k) {
                if (t0 >= 3) { const unsigned w = *(const unsigned*)(h + (size_t)(row0 - 3 + k) * NHB + col); x[sec][k] = (f32x2){bflo(w), bfhi(w)}; }
                else if (smp) x[sec][k] = *(const f32x2*)(hist + ((size_t)bb * 3 + k) * 2304 + col);
                else x[sec][k] = (f32x2){0.f, 0.f}; } }
#pragma unroll
        for (int r = 0; r < RB; ++r) {
            if (r < nr) {
                const int row = row0 + r, t = t0 + r;
                float val[3][2];
#pragma unroll
                for (int sec = 0; sec < 3; ++sec) { const int col = sec * 768 + hd * 128 + 2 * lane;
                    const unsigned w = *(const unsigned*)(h + (size_t)row * NHB + col); x[sec][3] = (f32x2){bflo(w), bfhi(w)};
                    const f32x2 a = wv[sec][0] * x[sec][0] + wv[sec][1] * x[sec][1] + wv[sec][2] * x[sec][2] + wv[sec][3] * x[sec][3];
                    val[sec][0] = silu_f(a[0]); val[sec][1] = silu_f(a[1]);
                    if (t >= T - 3) { float* op = p.out + (smp ? O_GCS : O_GCP) + (((size_t)j * (smp ? 128 : 8) + bb) * 3 + (t - (T - 3))) * 2304 + col; *(f32x2*)op = x[sec][3]; }
                    x[sec][0] = x[sec][1]; x[sec][1] = x[sec][2]; x[sec][2] = x[sec][3]; }
#pragma unroll
                for (int sec = 0; sec < 2; ++sec) { const float ss = wave_sum(val[sec][0] * val[sec][0] + val[sec][1] * val[sec][1]); const float rr = 1.f / sqrtf(ss + 1e-6f); val[sec][0] *= rr; val[sec][1] *= rr; }
#pragma unroll
                for (int sec = 0; sec < 3; ++sec) *(unsigned*)(qkvn + (size_t)row * 2304 + sec * 768 + hd * 128 + 2 * lane) = cvt_pk_bf16(val[sec][0], val[sec][1]);
                if (lane == 0) {
                    const float bv = bf1(h[(size_t)row * NHB + 3328 + hd]), av = bf1(h[(size_t)row * NHB + 3334 + hd]);
                    const float xx = av + dtb;
                    const float sp = fmaxf(xx, 0.f) + log1pf(__expf(-fabsf(xx)));
                    gb[(size_t)row * 12 + hd] = alog * sp;
                    gb[(size_t)row * 12 + 6 + hd] = 1.f / (1.f + __expf(-bv));
                }
            }
        }
    }
}

__device__ __forceinline__ void solve_lds(LAS float* sol, const LAS float* A, int lane) {
#pragma unroll 1
    for (int i = 1; i < 64; ++i) {
        float r0 = sol[i * 64 + lane], r1 = 0.f;
        const int n4 = (i + 3) >> 2;
#pragma unroll 2
        for (int j4 = 0; j4 < n4; ++j4) {
            const f32x4 a = *(const LAS f32x4*)(A + i * 64 + 4 * j4);
            const LAS float* sp = sol + (4 * j4) * 64 + lane;
            r0 -= a[0] * sp[0]; r1 -= a[1] * sp[64]; r0 -= a[2] * sp[128]; r1 -= a[3] * sp[192];
        }
        sol[i * 64 + lane] = r0 + r1;
    }
}
__device__ __forceinline__ void phase_gdn_prep(const Params& p, LAS unsigned char* lds) {
    const bf16_t* qkvn = (const bf16_t*)(p.ws + WS_QKVN); const float* gb = (const float*)(p.ws + WS_GB);
    bf16_t* Wc = (bf16_t*)(p.ws + WS_WC); bf16_t* QDc = (bf16_t*)(p.ws + WS_QDC); bf16_t* KDT = (bf16_t*)(p.ws + WS_KDT); bf16_t* QKc = (bf16_t*)(p.ws + WS_QKC);
    float* UT = (float*)(p.ws + WS_UT); float* GL = (float*)(p.ws + WS_GL);
    const int tid_ = otid(); const int lane0 = tid_ & 63, wave = __builtin_amdgcn_readfirstlane(tid_ >> 6);
    if (wave >= 4) return;
    const int gw = blockIdx.x * 4 + wave, NGW = gridDim.x * 4;
#pragma unroll 1
    for (int ci = gw; ci < 1536; ci += NGW) {
        int lane = lane0; unsigned aoff = (unsigned)wave * 32768u;
        asm volatile("" : "+v"(lane), "+v"(aoff));
        const int c16 = lane & 15, g = lane >> 4;
        LAS float* A = (LAS float*)(lds + aoff);
        const int n = ci & 31, hd = (ci >> 5) % 6, b = ci / 192;
        const int tok0 = b * 2048 + n * 64;
        const float gi = gb[(size_t)(tok0 + lane) * 12 + hd], beta = gb[(size_t)(tok0 + lane) * 12 + 6 + hd];
        float gc = gi;
#pragma unroll
        for (int o = 1; o < 64; o <<= 1) { const float tv = __shfl_up(gc, o); if (lane >= o) gc += tv; }
        const float gl = __shfl(gc, 63);
        const float egc = __expf(gc), edl = __expf(gl - gc);
        if (lane == 0) GL[ci] = __expf(gl);
        {
            bf16x8 kf[4][4];
#pragma unroll
            for (int t = 0; t < 4; ++t)
#pragma unroll
                for (int ks = 0; ks < 4; ++ks) kf[t][ks] = *(const bf16x8*)(qkvn + (size_t)(tok0 + 16 * t + c16) * 2304 + 768 + hd * 128 + 32 * ks + 8 * g);
#pragma unroll
            for (int it = 0; it < 4; ++it)
#pragma unroll
                for (int jt = 0; jt <= it; ++jt) {
                    f32x4 acc = (f32x4){0.f, 0.f, 0.f, 0.f};
#pragma unroll
                    for (int ks = 0; ks < 4; ++ks) acc = __builtin_amdgcn_mfma_f32_16x16x32_bf16(kf[it][ks], kf[jt][ks], acc, 0, 0, 0);
                    const int jj = 16 * jt + c16; const float gcj = __shfl(gc, jj);
#pragma unroll
                    for (int r = 0; r < 4; ++r) { const int ii = 16 * it + 4 * g + r; const float gci = __shfl(gc, ii), bi = __shfl(beta, ii);
                        A[ii * 64 + jj] = ii > jj ? bi * acc[r] * __expf(gci - gcj) : 0.f; }
                }
#pragma unroll
            for (int it = 0; it < 4; ++it) {
                bf16x8 qf[4];
#pragma unroll
                for (int ks = 0; ks < 4; ++ks) qf[ks] = *(const bf16x8*)(qkvn + (size_t)(tok0 + 16 * it + c16) * 2304 + hd * 128 + 32 * ks + 8 * g);
#pragma unroll
                for (int jt = 0; jt < 4; ++jt) {
                    f32x4 acc = (f32x4){0.f, 0.f, 0.f, 0.f};
                    if (jt <= it) {
#pragma unroll
                        for (int ks = 0; ks < 4; ++ks) acc = __builtin_amdgcn_mfma_f32_16x16x32_bf16(qf[ks], kf[jt][ks], acc, 0, 0, 0);
                    }
                    const int jj = 16 * jt + c16; const float gcj = __shfl(gc, jj);
                    const int pos = (jj & 32) + invperm32(jj & 31);
#pragma unroll
                    for (int r = 0; r < 4; ++r) { const int ii = 16 * it + 4 * g + r; const float gci = __shfl(gc, ii);
                        const float v = ii >= jj ? acc[r] * 0.08838834764831845f * __expf(gci - gcj) : 0.f;
                        QKc[(size_t)ci * 4096 + ii * 64 + pos] = (bf16_t)(cvt_pk_bf16(v, 0.f) & 0xffffu); }
                }
            }
        }
        asm volatile("s_waitcnt lgkmcnt(0)" ::: "memory");
        LAS float* sol = A + 4096;
#pragma unroll 1
        for (int pass = 0; pass < 4; ++pass) {
            const int half = pass & 1, isw = pass >> 1;
            const int c = lane + 64 * half; const int posc = (c & ~31) + invperm32(c & 31);
            const bf16_t* src = qkvn + (size_t)tok0 * 2304 + (isw ? 768 : 1536) + hd * 128 + c;
#pragma unroll 8
            for (int i = 0; i < 64; ++i) { float f = __shfl(beta, i); if (isw) f *= __shfl(egc, i); sol[i * 64 + lane] = bf1(src[(size_t)i * 2304]) * f; }
            asm volatile("s_waitcnt lgkmcnt(0)" ::: "memory");
            solve_lds(sol, A, lane);
            asm volatile("s_waitcnt lgkmcnt(0)" ::: "memory");
            if (!isw) { float* up = UT + (size_t)ci * 8192 + (size_t)c * 64;
#pragma unroll 4
                for (int i = 0; i < 64; i += 4) *(f32x4*)(up + i) = (f32x4){sol[i * 64 + lane], sol[(i + 1) * 64 + lane], sol[(i + 2) * 64 + lane], sol[(i + 3) * 64 + lane]}; }
            else {
#pragma unroll 8
                for (int i = 0; i < 64; ++i) Wc[(size_t)ci * 8192 + i * 128 + posc] = (bf16_t)(cvt_pk_bf16(sol[i * 64 + lane], 0.f) & 0xffffu); }
            asm volatile("s_waitcnt lgkmcnt(0)" ::: "memory");
        }
        const int c0 = 2 * lane; const int pos0 = (c0 & ~31) + invperm32(c0 & 31);
#pragma unroll 8
        for (int i = 0; i < 64; ++i) { const unsigned w = *(const unsigned*)(qkvn + (size_t)(tok0 + i) * 2304 + hd * 128 + 2 * lane);
            const float s = __shfl(egc, i) * 0.08838834764831845f;
            *(unsigned*)(QDc + (size_t)ci * 8192 + i * 128 + pos0) = cvt_pk_bf16(bflo(w) * s, bfhi(w) * s); }
        asm volatile("s_waitcnt lgkmcnt(0)" ::: "memory");
        {
            LAS bf16_t* kt = (LAS bf16_t*)A;
#pragma unroll 8
            for (int i = 0; i < 64; ++i) { const unsigned w = *(const unsigned*)(qkvn + (size_t)(tok0 + i) * 2304 + 768 + hd * 128 + 2 * lane);
                *(LAS unsigned*)(kt + i * 128 + 2 * lane) = w; }
            asm volatile("s_waitcnt lgkmcnt(0)" ::: "memory");
#pragma unroll
            for (int hh = 0; hh < 2; ++hh) { const int dk = lane + 64 * hh;
#pragma unroll
                for (int p8 = 0; p8 < 8; ++p8) { float v[8];
#pragma unroll
                    for (int e = 0; e < 8; ++e) { const int pp = p8 * 8 + e; const int c = (pp & 32) + perm32k(pp & 31);
                        v[e] = bf1(kt[c * 128 + dk]) * __uint_as_float((unsigned)__builtin_amdgcn_readlane((int)__float_as_uint(edl), c)); }
                    u32x4 w; w.x = cvt_pk_bf16(v[0], v[1]); w.y = cvt_pk_bf16(v[2], v[3]); w.z = cvt_pk_bf16(v[4], v[5]); w.w = cvt_pk_bf16(v[6], v[7]);
                    *(u32x4*)(KDT + (size_t)ci * 8192 + dk * 64 + p8 * 8) = w; } }
            asm volatile("s_waitcnt lgkmcnt(0)" ::: "memory");
        }
    }
}

constexpr int RB_W = 0, RB_QD = 17408, RB_KD = 34816, RB_QK = 34816 + 18432, RB_SZ = 62464;
__device__ __forceinline__ void rec_load(u32x4 (&r)[7], const bf16_t* Wc, const bf16_t* QDc, const bf16_t* KDT, const bf16_t* QKc, int ci, int tid) {
    r[0] = *(const u32x4*)(Wc + (size_t)ci * 8192 + (size_t)tid * 8); r[1] = *(const u32x4*)(Wc + (size_t)ci * 8192 + (size_t)(512 + tid) * 8);
    r[2] = *(const u32x4*)(QDc + (size_t)ci * 8192 + (size_t)tid * 8); r[3] = *(const u32x4*)(QDc + (size_t)ci * 8192 + (size_t)(512 + tid) * 8);
    r[4] = *(const u32x4*)(KDT + (size_t)ci * 8192 + (size_t)tid * 8); r[5] = *(const u32x4*)(KDT + (size_t)ci * 8192 + (size_t)(512 + tid) * 8);
    r[6] = *(const u32x4*)(QKc + (size_t)ci * 4096 + (size_t)tid * 8);
}
__device__ __forceinline__ void rec_store(const u32x4 (&r)[7], LAS unsigned char* buf, int tid) {
#pragma unroll
    for (int k = 0; k < 2; ++k) { const int q = tid + 512 * k;
        *(LAS u32x4*)(buf + RB_W + (q >> 4) * 272 + (q & 15) * 16) = r[k];
        *(LAS u32x4*)(buf + RB_QD + (q >> 4) * 272 + (q & 15) * 16) = r[2 + k];
        *(LAS u32x4*)(buf + RB_KD + (q >> 3) * 144 + (q & 7) * 16) = r[4 + k]; }
    *(LAS u32x4*)(buf + RB_QK + (tid >> 3) * 144 + (tid & 7) * 16) = r[6];
}
__device__ __forceinline__ void gdn_recur_prompt(const Params& p, LAS unsigned char* lds, int j, int bh, float* ob, float* gsbase) {
    const bf16_t* Wc = (const bf16_t*)(p.ws + WS_WC); const bf16_t* QDc = (const bf16_t*)(p.ws + WS_QDC); const bf16_t* KDT = (const bf16_t*)(p.ws + WS_KDT); const bf16_t* QKc = (const bf16_t*)(p.ws + WS_QKC);
    const float* UT = (const float*)(p.ws + WS_UT); const float* GL = (const float*)(p.ws + WS_GL);
    const int tid = otid(), lane = tid & 63, wave = __builtin_amdgcn_readfirstlane(tid >> 6), c16 = lane & 15, g = lane >> 4;
    const int b = bh / 6, hd = bh % 6, dv0 = wave * 16;
    f32x4 S[8];
#pragma unroll
    for (int i = 0; i < 8; ++i) S[i] = (f32x4){0.f, 0.f, 0.f, 0.f};
    u32x4 rg[7];
    rec_load(rg, Wc, QDc, KDT, QKc, bh * 32, tid);
    rec_store(rg, lds, tid);
    __syncthreads();
#pragma unroll 1
    for (int n = 0; n < 32; ++n) {
        const int ci = bh * 32 + n;
        LAS unsigned char* buf = lds + (n & 1) * RB_SZ;
        if (n + 1 < 32) rec_load(rg, Wc, QDc, KDT, QKc, ci + 1, tid);
        f32x4 u[4];
#pragma unroll
        for (int ct = 0; ct < 4; ++ct) u[ct] = *(const f32x4*)(UT + (size_t)ci * 8192 + (size_t)(dv0 + c16) * 64 + 16 * ct + 4 * g);
        const float egl = GL[ci];
        bf16x8 bS[4];
#pragma unroll
        for (int ks = 0; ks < 4; ++ks) bS[ks] = pack8(S[2 * ks], S[2 * ks + 1]);
        f32x4 vn[4], o[4];
#pragma unroll
        for (int ct = 0; ct < 4; ++ct) {
            f32x4 ws = (f32x4){0.f, 0.f, 0.f, 0.f}, oo = (f32x4){0.f, 0.f, 0.f, 0.f};
#pragma unroll
            for (int ks = 0; ks < 4; ++ks) {
                const bf16x8 wf = *(const LAS bf16x8*)(buf + RB_W + (16 * ct + c16) * 272 + ks * 64 + g * 16);
                const bf16x8 qf = *(const LAS bf16x8*)(buf + RB_QD + (16 * ct + c16) * 272 + ks * 64 + g * 16);
                ws = __builtin_amdgcn_mfma_f32_16x16x32_bf16(wf, bS[ks], ws, 0, 0, 0);
                oo = __builtin_amdgcn_mfma_f32_16x16x32_bf16(qf, bS[ks], oo, 0, 0, 0);
            }
            vn[ct] = u[ct] - ws; o[ct] = oo;
        }
        bf16x8 bV[2];
#pragma unroll
        for (int k2 = 0; k2 < 2; ++k2) bV[k2] = pack8(vn[2 * k2], vn[2 * k2 + 1]);
#pragma unroll
        for (int ct = 0; ct < 4; ++ct) {
#pragma unroll
            for (int k2 = 0; k2 < 2; ++k2) { const bf16x8 af = *(const LAS bf16x8*)(buf + RB_QK + (16 * ct + c16) * 144 + k2 * 64 + g * 16);
                o[ct] = __builtin_amdgcn_mfma_f32_16x16x32_bf16(af, bV[k2], o[ct], 0, 0, 0); }
#pragma unroll
            for (int r = 0; r < 4; ++r) ob[(size_t)(b * 2048 + n * 64 + 16 * ct + 4 * g + r) * 768 + hd * 128 + dv0 + c16] = o[ct][r];
        }
#pragma unroll
        for (int dt = 0; dt < 8; ++dt) { f32x4 s = S[dt] * egl;
#pragma unroll
            for (int k2 = 0; k2 < 2; ++k2) { const bf16x8 af = *(const LAS bf16x8*)(buf + RB_KD + (16 * dt + c16) * 144 + k2 * 64 + g * 16);
                s = __builtin_amdgcn_mfma_f32_16x16x32_bf16(af, bV[k2], s, 0, 0, 0); }
            S[dt] = s; }
        if (n + 1 < 32) rec_store(rg, lds + ((n + 1) & 1) * RB_SZ, tid);
        __syncthreads();
    }
    float* so = gsbase + ((size_t)(j * 8 + b) * 6 + hd) * 16384;
#pragma unroll
    for (int dt = 0; dt < 8; ++dt)
#pragma unroll
        for (int r = 0; r < 4; ++r) so[(size_t)(16 * dt + 4 * g + r) * 128 + dv0 + c16] = S[dt][r];
}
__device__ __forceinline__ void gdn_naive_item(const Params& p, LAS unsigned char* lds, int row0, int T, int hd, const float* s0, float* sout) {
    const bf16_t* qkvn = (const bf16_t*)(p.ws + WS_QKVN); const float* gb = (const float*)(p.ws + WS_GB); float* ob = (float*)(p.ws + WS_O);
    const int tid = otid(), e = tid & 127, part = tid >> 7;
    LAS float* kq = (LAS float*)lds;
    LAS float* red = kq + 1024;
    LAS float* red2 = red + 512;
    float S[32];
#pragma unroll
    for (int i = 0; i < 32; ++i) S[i] = s0 ? s0[(size_t)(part * 32 + i) * 128 + e] : 0.f;
#pragma unroll 1
    for (int tb = 0; tb < T; tb += 4) {
        __syncthreads();
        for (int i = tid; i < 1024; i += 512) { const int t = i >> 8, s = (i >> 7) & 1, d = i & 127;
            kq[i] = bf1(qkvn[(size_t)(row0 + tb + t) * 2304 + (s == 0 ? 768 : 0) + hd * 128 + d]); }
        __syncthreads();
#pragma unroll 1
        for (int t = 0; t < 4; ++t) {
            const int row = row0 + tb + t;
            const float a = __expf(gb[(size_t)row * 12 + hd]), bt = gb[(size_t)row * 12 + 6 + hd];
            const float v = bf1(qkvn[(size_t)row * 2304 + 1536 + hd * 128 + e]);
            float ps = 0.f;
#pragma unroll
            for (int i = 0; i < 32; ++i) ps += S[i] * kq[(t * 2 + 0) * 128 + part * 32 + i];
            red[part * 128 + e] = ps;
            __syncthreads();
            const float kS = red[e] + red[128 + e] + red[256 + e] + red[384 + e];
            const float vnew = bt * (v - a * kS);
            float po = 0.f;
#pragma unroll
            for (int i = 0; i < 32; ++i) { S[i] = a * S[i] + kq[(t * 2 + 0) * 128 + part * 32 + i] * vnew; po += S[i] * kq[(t * 2 + 1) * 128 + part * 32 + i]; }
            red2[part * 128 + e] = po;
            __syncthreads();
            if (part == 0) ob[(size_t)row * 768 + hd * 128 + e] = (red2[e] + red2[128 + e] + red2[256 + e] + red2[384 + e]) * 0.08838834764831845f;
        }
    }
#pragma unroll
    for (int i = 0; i < 32; ++i) sout[(size_t)(part * 32 + i) * 128 + e] = S[i];
    __syncthreads();
}
__device__ __forceinline__ void gdn_sample_item(const Params& p, LAS unsigned char* lds, int j, int item) {
    const int sb = item / 6, hd = item % 6;
    gdn_naive_item(p, lds, TP + sb * 4, 4, hd, p.in[7] + ((size_t)(j * 128 + sb) * 6 + hd) * 16384, p.out + O_GSS + ((size_t)(j * 128 + sb) * 6 + hd) * 16384);
}
__device__ __forceinline__ void phase_gdn_post(const Params& p, int j) {
    const bf16_t* h = (const bf16_t*)(p.ws + WS_H); const float* ob = (const float*)(p.ws + WS_O); bf16_t* cat = (bf16_t*)(p.ws + WS_CAT);
    const int tid_ = otid(); const int lane = tid_ & 63, wave = __builtin_amdgcn_readfirstlane(tid_ >> 6);
    const int gw = blockIdx.x * 8 + wave, NGW = gridDim.x * 8;
    const f32x2 nw = *(const f32x2*)(p.in[16] + j * 128 + 2 * lane);
    for (int it = gw; it < TT * 6; it += NGW) {
        const int row = it / 6, hd = it % 6;
        const f32x2 o = *(const f32x2*)(ob + (size_t)row * 768 + hd * 128 + 2 * lane);
        const float ss = wave_sum(o[0] * o[0] + o[1] * o[1]);
        const float r = 1.f / sqrtf(ss * (1.f / 128.f) + 1e-6f);
        const unsigned zw = *(const unsigned*)(h + (size_t)row * NHB + 2304 + hd * 128 + 2 * lane);
        const float y0 = o[0] * r * nw[0] * silu_f(bflo(zw)), y1 = o[1] * r * nw[1] * silu_f(bfhi(zw));
        *(unsigned*)(cat + (size_t)row * DM + hd * 128 + 2 * lane) = cvt_pk_bf16(y0, y1);
    }
}


#ifdef DIAG_GDN
constexpr size_t WS_DBG = WS_END;
constexpr size_t WS_OB2 = WS_END + 4096;
constexpr size_t WS_GS2 = WS_OB2 + (size_t)TT * 768 * 4;
constexpr size_t WS_DIAG_END = WS_GS2 + (size_t)2 * 8 * 6 * 16384 * 4;
__device__ __forceinline__ void diag_compare(const Params& p, int j) {
    const float* ob = (const float*)(p.ws + WS_O); const float* ob2 = (const float*)(p.ws + WS_OB2);
    const float* gs = p.out + O_GSP + (size_t)j * 8 * 6 * 16384; const float* gs2 = (const float*)(p.ws + WS_GS2) + (size_t)j * 8 * 6 * 16384;
    float* dbg = (float*)(p.ws + WS_DBG);
    const size_t gt = (size_t)blockIdx.x * 512 + otid(), NT = (size_t)gridDim.x * 512;
    float n1 = 0.f, d1 = 0.f, n3 = 0.f, d3 = 0.f, n2 = 0.f, d2 = 0.f, n4 = 0.f, d4 = 0.f;
    for (size_t i = gt; i < (size_t)TP * 768; i += NT) { const int row = (int)(i / 768); const float a = ob[i], b = ob2[i]; const float e = (a - b) * (a - b);
        n3 += e; d3 += a * a; if ((row & 2047) < 64) { n1 += e; d1 += a * a; } else if ((row & 2047) < 128) { n4 += e; d4 += a * a; } }
    for (size_t i = gt; i < (size_t)8 * 6 * 16384; i += NT) { const float a = gs[i], b = gs2[i]; n2 += (a - b) * (a - b); d2 += a * a; }
    n1 = wave_sum(n1); d1 = wave_sum(d1); n2 = wave_sum(n2); d2 = wave_sum(d2); n3 = wave_sum(n3); d3 = wave_sum(d3); n4 = wave_sum(n4); d4 = wave_sum(d4);
    if ((otid() & 63) == 0) { atomicAdd(dbg + 0, n1); atomicAdd(dbg + 1, d1); atomicAdd(dbg + 2, n2); atomicAdd(dbg + 3, d2); atomicAdd(dbg + 4, n3); atomicAdd(dbg + 5, d3); atomicAdd(dbg + 6, n4); atomicAdd(dbg + 7, d4); }
}
__device__ __forceinline__ void diag_compare2(const Params& p) {
    const bf16_t* qkvn = (const bf16_t*)(p.ws + WS_QKVN); const float* gb = (const float*)(p.ws + WS_GB);
    const bf16_t* Wc = (const bf16_t*)(p.ws + WS_WC); const bf16_t* QDc = (const bf16_t*)(p.ws + WS_QDC); const bf16_t* KDT = (const bf16_t*)(p.ws + WS_KDT);
    float* dbg = (float*)(p.ws + WS_DBG);
    const int tid_ = otid(); const int lane = tid_ & 63, wave = __builtin_amdgcn_readfirstlane(tid_ >> 6);
    const int gw = blockIdx.x * 8 + wave, NGW = gridDim.x * 8;
    float n8 = 0.f, d8 = 0.f, n10 = 0.f, d10 = 0.f, n12 = 0.f, d12 = 0.f;
    for (int ci = gw; ci < 1536; ci += NGW) {
        const int n = ci & 31, hd = (ci >> 5) % 6, b = ci / 192; const int tok0 = b * 2048 + n * 64;
        float gcs = 0.f, mygc = 0.f;
        for (int t = 0; t < 64; ++t) { gcs += gb[(size_t)(tok0 + t) * 12 + hd]; if (t == lane) mygc = gcs; }
        const float gl = gcs;
        for (int c = 0; c < 128; ++c) { const int pos = (c & ~31) + invperm32(c & 31);
            const float qe = bf1(qkvn[(size_t)(tok0 + lane) * 2304 + hd * 128 + c]) * 0.08838834764831845f * __expf(mygc);
            const float qg = bf1(QDc[(size_t)ci * 8192 + lane * 128 + pos]); n8 += (qe - qg) * (qe - qg); d8 += qe * qe;
            const float ke = bf1(qkvn[(size_t)(tok0 + lane) * 2304 + 768 + hd * 128 + c]) * __expf(gl - mygc);
            const int posl = (lane & 32) + invperm32(lane & 31);
            const float kg = bf1(KDT[(size_t)ci * 8192 + c * 64 + posl]); n10 += (ke - kg) * (ke - kg); d10 += ke * ke; }
        { const float beta0 = gb[(size_t)tok0 * 12 + 6 + hd], g0 = gb[(size_t)tok0 * 12 + hd];
          for (int c = lane; c < 128; c += 64) { const int pos = (c & ~31) + invperm32(c & 31);
            const float we = bf1(qkvn[(size_t)tok0 * 2304 + 768 + hd * 128 + c]) * beta0 * __expf(g0);
            const float wg = bf1(Wc[(size_t)ci * 8192 + pos]); n12 += (we - wg) * (we - wg); d12 += we * we; } }
    }
    n8 = wave_sum(n8); d8 = wave_sum(d8); n10 = wave_sum(n10); d10 = wave_sum(d10); n12 = wave_sum(n12); d12 = wave_sum(d12);
    if (lane == 0) { atomicAdd(dbg + 8, n8); atomicAdd(dbg + 9, d8); atomicAdd(dbg + 10, n10); atomicAdd(dbg + 11, d10); atomicAdd(dbg + 12, n12); atomicAdd(dbg + 13, d12); }
}
__device__ __forceinline__ int diag_class(float n, float d) { const float r = n / (d + 1e-30f); return r < 4e-4f ? 0 : (r < 0.09f ? 1 : 2); }
#endif
#define XB_TMO      128
#define XB_XCNT(j)  (256  + 64 * (j))
#define XB_XSUB(j)  (1280 + 64 * (j))
#define XB_XGEN(j)  (2304 + 64 * (j))
#define XB_TOP      3328
#define XB_TOPGEN   3392
#define XCD_BAR_WORDS 3456
#define XB_SPIN_CAP (1u << 18)

__device__ __forceinline__ unsigned xb_ld(unsigned* p)              { return __hip_atomic_load(p, __ATOMIC_RELAXED, __HIP_MEMORY_SCOPE_AGENT); }
__device__ __forceinline__ unsigned xb_add(unsigned* p, unsigned v) { return __hip_atomic_fetch_add(p, v, __ATOMIC_RELAXED, __HIP_MEMORY_SCOPE_AGENT); }
__device__ __forceinline__ unsigned xb_xcc_id() { return (unsigned)__builtin_amdgcn_s_getreg((3 << 11) | 20) & 0xFu; }
#define XB_SPIN(cond, bar) do { unsigned _sp = 0; while (cond) { __builtin_amdgcn_s_sleep(1); \
    if ((++_sp & 255u) == 0u) { if (xb_ld(&(bar)[XB_TMO])) break; if (_sp > XB_SPIN_CAP) { atomicAdd(&(bar)[XB_TMO], 1u); break; } } } } while (0)

struct XcdBarrier {
    unsigned* bar; unsigned x;
    volatile LAS unsigned* st;
};

__device__ __forceinline__ XcdBarrier xcd_barrier_post(unsigned* bar, volatile LAS unsigned* st) {
    XcdBarrier b; b.bar = bar; b.x = xb_xcc_id(); b.st = st;
    if (threadIdx.x == 0) (void)xb_add(&bar[XB_XCNT(b.x)], 1u);
    return b;
}
__device__ __forceinline__ void xcd_barrier_complete(unsigned* bar, unsigned x, unsigned& nloc, unsigned& nx) {
    const unsigned G = gridDim.x * gridDim.y * gridDim.z;
    unsigned sum, cnt, mine, sp = 0u;
    for (;;) {
        sum = 0u; cnt = 0u; mine = 0u;
#pragma unroll
        for (unsigned j = 0; j < 16; ++j) { const unsigned c = xb_ld(&bar[XB_XCNT(j)]); sum += c; cnt += (c > 0u) ? 1u : 0u; mine = (j == x) ? c : mine; }
        if (sum == G) break;
        __builtin_amdgcn_s_sleep(1);
        if ((++sp & 255u) == 0u) { if (xb_ld(&bar[XB_TMO])) break; if (sp > XB_SPIN_CAP) { atomicAdd(&bar[XB_TMO], 1u); break; } }
    }
    nloc = mine > 0u ? mine : 1u; nx = cnt > 0u ? cnt : 1u;
}

__device__ __forceinline__ void xcd_barrier(const XcdBarrier& b) {
    asm volatile("s_waitcnt vmcnt(0)" ::: "memory");
    __syncthreads();
    if (threadIdx.x == 0) {
        unsigned* bar = b.bar;
        __builtin_amdgcn_s_waitcnt(0);
        unsigned nloc = b.st[0], nx = b.st[1];
        if (nloc == 0u) { xcd_barrier_complete(bar, b.x, nloc, nx); b.st[0] = nloc; b.st[1] = nx; }
        const unsigned old = xb_add(&bar[XB_XSUB(b.x)], 1u);
        const unsigned gen = old / nloc;
        if (old + 1u == (gen + 1u) * nloc) {
            __builtin_amdgcn_fence(__ATOMIC_RELEASE, "agent");
            asm volatile("s_waitcnt vmcnt(0)" ::: "memory");
            const unsigned og = xb_add(&bar[XB_TOP], 1u);
            const unsigned tg = og / nx;
            if (og + 1u == (tg + 1u) * nx) xb_add(&bar[XB_TOPGEN], 1u);
            else XB_SPIN(xb_ld(&bar[XB_TOPGEN]) == tg, bar);
            __builtin_amdgcn_fence(__ATOMIC_ACQUIRE, "agent");
            xb_add(&bar[XB_XGEN(b.x)], 1u);
            asm volatile("s_waitcnt vmcnt(0)" ::: "memory");
        } else {
            XB_SPIN(xb_ld(&bar[XB_XGEN(b.x)]) == gen, bar);
            __builtin_amdgcn_fence(__ATOMIC_ACQUIRE, "agent");
            asm volatile("s_waitcnt vmcnt(0)" ::: "memory");
        }
    }
    __syncthreads();
}


#ifdef EXP_SYNC2
#define GSYNC() do { xcd_barrier(xbar); xcd_barrier(xbar); } while (0)
#else
#define GSYNC() xcd_barrier(xbar)
#endif
#ifdef EXP_ELEM2
#define ELEM2(x) do { x; x; } while (0)
#else
#define ELEM2(x) do { x; } while (0)
#endif
#ifdef EXP_GEMM2
#define GEMM2(x) do { x; x; } while (0)
#else
#define GEMM2(x) do { x; } while (0)
#endif
#ifdef EXP_GDN2
#define GDN2(x) do { x; x; } while (0)
#else
#define GDN2(x) do { x; } while (0)
#endif
__global__ void __launch_bounds__(512, 2) fwd_megakernel(Params p) {
    extern __shared__ __attribute__((aligned(16))) unsigned char lds_raw[];
    LAS unsigned char* lds = (LAS unsigned char*)lds_raw;
    cg::grid_group grid = cg::this_grid();
    unsigned char* ws = p.ws;
    float* xf = (float*)(ws + WS_XF); bf16_t* xb = (bf16_t*)(ws + WS_XB);
    bf16_t* hbuf = (bf16_t*)(ws + WS_H); bf16_t* cat = (bf16_t*)(ws + WS_CAT);
    bf16_t* hu = (bf16_t*)(ws + WS_HU); bf16_t* gact = (bf16_t*)(ws + WS_GACT);
    const bf16_t* Kb = (const bf16_t*)(ws + WS_KB); const bf16_t* Vt = (const bf16_t*)(ws + WS_VT);
    const int bid = blockIdx.x, G = gridDim.x;
    volatile LAS unsigned* xst = (volatile LAS unsigned*)(lds + LDS_BYTES - 16);
    if (threadIdx.x < 4) xst[threadIdx.x] = 0u;
    __syncthreads();
    XcdBarrier xbar = xcd_barrier_post((unsigned*)(ws + WS_BAR), xst);

#ifdef DIAG_GDN
    if (bid == 0 && threadIdx.x < 64) ((float*)(ws + WS_DBG))[threadIdx.x] = 0.f;
#endif
    phase_prep(p, lds);
    grid.sync();
    {
        EpiKV E{p.out + O_MK, p.out + O_MV, (bf16_t*)(ws + WS_KB), (bf16_t*)(ws + WS_VT)};
        run_gemm(lds, (const bf16_t*)(ws + WS_MEMB), (const bf16_t*)(ws + WS_WKV), 2048, 2048, DM, E, (bid + 64) % G);
    }
#pragma unroll 1
    for (int l = 0; l < 4; ++l) {
        const int j = l >> 1; const bool isB = (l & 1) != 0;
        if (!isB) {
            { EpiStoreBf16 E{hbuf, NHA}; GEMM2(run_gemm(lds, xb, (const bf16_t*)(ws + WS_WINA) + (size_t)j * NHA * DM, TT, NHA, DM, E, bid)); }
            GSYNC();
            ELEM2(phase_mixA_elem(p, j));
#ifdef NAIVE_ATTN
            for (int it = bid; it < 256; it += G) attn_prompt_item_naive(lds, hbuf, NHA, 2304, p.out + O_MK, p.out + O_MV, cat, l, it);
#else
            for (int it = bid; it < 256; it += G) attn_prompt_item(lds, hbuf, NHA, 2304, Kb, Vt, cat, l, it);
#endif
            for (int it = bid; it < 256; it += G) attn_sample_item(lds, hbuf, NHA, 2304, p.in[3], p.in[4], cat, l, it);
            GSYNC();
            { EpiResid E{xf, DM}; run_gemm(lds, cat, (const bf16_t*)(ws + WS_WOUTA) + (size_t)j * DM * DM, TT, DM, DM, E, bid); }
        } else {
            { EpiStoreBf16 E{hbuf, NHB}; GEMM2(run_gemm(lds, xb, (const bf16_t*)(ws + WS_WINB) + (size_t)j * NHB * DM, TT, NHB, DM, E, bid)); }
            GSYNC();
            ELEM2(phase_gdn_pre(p, j));
            GSYNC();
#ifndef NAIVE_GDN
            phase_gdn_prep(p, lds);
            GSYNC();
#endif
#ifdef NAIVE_GDN
            if (bid < 48) gdn_naive_item(p, lds, (bid / 6) * 2048, 2048, bid % 6, nullptr, p.out + O_GSP + ((size_t)(j * 8 + bid / 6) * 6 + bid % 6) * 16384);
#else
            if (bid < 48) gdn_recur_prompt(p, lds, j, bid, (float*)(ws + WS_O), p.out + O_GSP);
#endif
            else {
                const int nb = G - 48;
                for (int it = bid - 48; it < 768; it += nb) gdn_sample_item(p, lds, j, it);
#ifdef NAIVE_ATTN
                for (int it = bid - 48; it < 256; it += nb) attn_prompt_item_naive(lds, hbuf, NHB, 3072, p.out + O_MK, p.out + O_MV, cat, l, it);
#else
                for (int it = bid - 48; it < 256; it += nb) attn_prompt_item(lds, hbuf, NHB, 3072, Kb, Vt, cat, l, it);
#endif
                for (int it = bid - 48; it < 256; it += nb) attn_sample_item(lds, hbuf, NHB, 3072, p.in[3], p.in[4], cat, l, it);
            }
            GSYNC();
#ifdef DIAG_GDN
            if (l == 1) {
                phase_gdn_prep(p, lds);
                GSYNC();
                if (bid < 48) gdn_recur_prompt(p, lds, j, bid, (float*)(ws + WS_OB2), (float*)(ws + WS_GS2));
                GSYNC();
                diag_compare(p, j);
                diag_compare2(p);
                GSYNC();
            }
#endif
            ELEM2(phase_gdn_post(p, j));
            GSYNC();
            { EpiResid E{xf, DM}; run_gemm(lds, cat, (const bf16_t*)(ws + WS_WOUTB) + (size_t)j * DM * DM, TT, DM, DM, E, bid); }
        }
        GSYNC();
        phase_ln(xf, xb, p.in[19] + l * DM, p.in[20] + l * DM, nullptr);
        GSYNC();
        { EpiStoreBf16 E{hu, NUP}; GEMM2(run_gemm(lds, xb, (const bf16_t*)(ws + WS_WUP) + (size_t)l * NUP * DM, TT, NUP, DM, E, bid)); }
        GSYNC();
        ELEM2(phase_convgate(p, l));
        GSYNC();
        { EpiResid E{xf, DM}; run_gemm(lds, gact, (const bf16_t*)(ws + WS_WDOWN) + (size_t)l * DM * DFF, TT, DM, DFF, E, bid); }
        GSYNC();
        phase_ln(xf, xb, p.in[21] + l * DM, p.in[22] + l * DM, l == 3 ? p.out + O_Y : nullptr);
        if (l < 3) GSYNC();
    }
#ifdef DIAG_GDN
    GSYNC();
    if (bid == 0 && threadIdx.x == 0) { const float* dbg = (const float*)(ws + WS_DBG);
        const int code = 9 * diag_class(dbg[8], dbg[9]) + 3 * diag_class(dbg[10], dbg[11]) + diag_class(dbg[12], dbg[13]);
        float v = 1.0e4f; for (int i = 0; i < code; ++i) v *= 1.25f;
        p.out[0] = v; }
#endif
}

extern "C" void kernel_launch(void* const* d_in, const int* in_sizes, int n_in, void* d_out, int out_size, void* d_ws, size_t ws_size, hipStream_t stream) {
    static int grid_blocks = 0;
    if (grid_blocks == 0) {
        if (n_in != 26 || (size_t)out_size != O_END || ws_size < WS_TOTAL) { fprintf(stderr, "kernel_launch: unexpected shapes n_in %d out %d (want %zu) ws %zu (need %zu)\n", n_in, out_size, (size_t)O_END, ws_size, (size_t)WS_END); grid_blocks = -1; return; }
        int dev = 0, cus = 0, per_cu = 0;
        hipGetDevice(&dev);
        hipDeviceGetAttribute(&cus, hipDeviceAttributeMultiprocessorCount, dev);
        if (hipFuncSetAttribute((const void*)fwd_megakernel, hipFuncAttributeMaxDynamicSharedMemorySize, LDS_BYTES) != hipSuccess) { fprintf(stderr, "kernel_launch: hipFuncSetAttribute failed\n"); grid_blocks = -1; return; }
        hipOccupancyMaxActiveBlocksPerMultiprocessor(&per_cu, (const void*)fwd_megakernel, 512, LDS_BYTES);
        if (per_cu < 1) { fprintf(stderr, "kernel_launch: occupancy query says %d blocks/CU\n", per_cu); grid_blocks = -1; return; }
        grid_blocks = cus;
        if (grid_blocks > 256) grid_blocks = 256;
    }
    if (grid_blocks < 0) return;
    if (hipMemsetAsync((char*)d_ws + WS_BAR, 0, 16384, stream) != hipSuccess) { fprintf(stderr, "kernel_launch: memset of barrier words failed\n"); return; }
    Params p{};
    for (int i = 0; i < 26; ++i) p.in[i] = (const float*)d_in[i];
    p.out = (float*)d_out; p.ws = (unsigned char*)d_ws;
    void* args[] = {&p};
    hipError_t e = hipLaunchCooperativeKernel((const void*)fwd_megakernel, dim3(grid_blocks), dim3(512), args, LDS_BYTES, stream);
    if (e != hipSuccess) fprintf(stderr, "cooperative launch failed: %s (grid %d)\n", hipGetErrorString(e), grid_blocks);
}
```

```cpp
#include <hip/hip_runtime.h>
#include <hip/hip_cooperative_groups.h>
#include <cstdio>
namespace cg = cooperative_groups;
namespace pg8 {
#define PG8_LAS __attribute__((address_space(3)))
typedef unsigned short bf16_t;
typedef short bf16x8 __attribute__((ext_vector_type(8)));
typedef float f32x4 __attribute__((ext_vector_type(4)));
typedef unsigned u32x4 __attribute__((ext_vector_type(4)));
constexpr int BM = 256, BK = 64, HALF = 128, HTB = HALF * BK * 2  , STAGE_BYTES = 8 * HTB, NXCD = 8, WGM = 8;

__host__ __device__ __forceinline__ int lds_byte(int r, int c) { const int st = (r >> 4) * 2 + (c >> 5), rr = r & 15, cc = c & 31, ob = rr * 64 + cc * 2; return st * 1024 + (ob ^ (((ob >> 9) & 1) << 5)); }
__host__ __device__ __forceinline__ void stage_rc(int b, int& R, int& C) { const int st = b / 1024, sb = b % 1024, swz = sb ^ (((sb >> 9) & 1) << 5); R = (st >> 1) * 16 + swz / 64; C = (st & 1) * 32 + (swz % 64) / 2; }
__host__ __device__ __forceinline__ int perm32(int rho) { const int n = rho >> 4, i = rho & 15; return 8 * (i >> 2) + 4 * n + (i & 3); }

struct Unit { int pm, pn; };
struct Gemm { const bf16_t* A; const bf16_t* Bt; int M, N, K; };

struct StaticOrder {
    int nM, nN, nwg, G, c;
    __host__ __device__ void init(int M, int N, int G_, int c_) { nM = M / BM; nN = N / BM; nwg = nM * nN; G = G_; c = c_; }
    __host__ __device__ bool next(int i, Unit& u) const {
        const long L = (long)i * G + c; if (L >= nwg) return false;
        int wgid = (int)L; { const int q = nwg / NXCD, r = nwg % NXCD, xcd = wgid % NXCD, off = wgid / NXCD; wgid = (xcd < r ? xcd * (q + 1) : r * (q + 1) + (xcd - r) * q) + off; }
        const int nig = WGM * nN, gid = wgid / nig, fm = gid * WGM, gsz = (nM - fm) < WGM ? (nM - fm) : WGM;
        u.pm = fm + ((wgid % nig) % gsz); u.pn = (wgid % nig) / gsz; return true;
    }
    __device__ __forceinline__ void a_ready(const Unit&) const {}
    __device__ __forceinline__ void done(const Unit&) const {}
};
__device__ __forceinline__ unsigned cvt_pk_bf16(float lo, float hi) { unsigned r; asm volatile("v_cvt_pk_bf16_f32 %0, %1, %2" : "=v"(r) : "v"(lo), "v"(hi)); return r; }
typedef float f32x2 __attribute__((ext_vector_type(2)));
template <class Epi, class Sched, bool STAMP = false>
__device__ __forceinline__ void gemm_phase(PG8_LAS unsigned char* lds, const Gemm g, const Sched& S, const Epi& E, unsigned long long* stamps) {
    int tid = threadIdx.x; asm volatile("" : "+v"(tid)); const int wid = __builtin_amdgcn_readfirstlane(tid >> 6), lane = tid & 63, wr = wid >> 2, wc = wid & 3, fr = lane & 15, fq = lane >> 4;
    const int K = g.K, nt = K / BK;
    int ts_lo = 0, ts_hi = 0, nts = 0; const unsigned long long rt_entry = STAMP ? (unsigned long long)wall_clock64() : 0ull;
#define PG8_STAMP() do { if (STAMP && wid == 0 && nts < 64) { const unsigned long long _c = (unsigned long long)clock64(); \
        ts_lo = (lane == nts) ? (int)(unsigned)_c : ts_lo; ts_hi = (lane == nts) ? (int)(unsigned)(_c >> 32) : ts_hi; ++nts; } } while (0)
    PG8_STAMP();
    unsigned voffA[2], voffB[2];
#pragma unroll
    for (int i = 0; i < 2; ++i) { int R, C; stage_rc(tid * 16 + i * 8192, R, C); const int Rb = Epi::PERM ? ((R & ~31) + perm32(R & 31)) : R;
        voffA[i] = (unsigned)(R * K + C) * 2u; voffB[i] = (unsigned)(Rb * K + C) * 2u; }
    const size_t kstep = (size_t)(BK * 2);
    const size_t hstep = (size_t)HALF * K * 2;
    const size_t tstep = 2 * hstep;
    const unsigned ldsw = (unsigned)wid * 1024u;
    const int aoff = lds_byte(wr * 64 + fr, fq * 8), boff = lds_byte(wc * 32 + fr, fq * 8);
#define PG8_SA(b, h) (((b) * 2 + (h)) * HTB)
#define PG8_SB(b, h) ((4 + (b) * 2 + (h)) * HTB)
#define PG8_STAGE(bufoff, gbase, voff) do { _Pragma("unroll") for (int _i = 0; _i < 2; ++_i) \
        __builtin_amdgcn_global_load_lds((const unsigned*)((const char*)(gbase) + (voff)[_i]), (PG8_LAS unsigned*)(lds + (bufoff) + ldsw + _i * 8192), 16, 0, 0); } while (0)
#define PG8_LDA(dst, b, h) do { _Pragma("unroll") for (int m = 0; m < 4; ++m) _Pragma("unroll") for (int k = 0; k < 2; ++k) dst[m][k] = *(const PG8_LAS bf16x8*)(lds + PG8_SA(b, h) + aoff + m * 2048 + k * 1024); } while (0)
#define PG8_LDB(dst, b, h) do { _Pragma("unroll") for (int n = 0; n < 2; ++n) _Pragma("unroll") for (int k = 0; k < 2; ++k) dst[n][k] = *(const PG8_LAS bf16x8*)(lds + PG8_SB(b, h) + boff + n * 2048 + k * 1024); } while (0)
#define PG8_MMA(ai, bj, At, Bt) do { __builtin_amdgcn_s_setprio(1); _Pragma("unroll") for (int m = 0; m < 4; ++m) _Pragma("unroll") for (int n = 0; n < 2; ++n) _Pragma("unroll") for (int k = 0; k < 2; ++k) \
        acc[ai][bj][m][n] = __builtin_amdgcn_mfma_f32_16x16x32_bf16(Bt[n][k], At[m][k], acc[ai][bj][m][n], 0, 0, 0); __builtin_amdgcn_s_setprio(0); } while (0)
#define PG8_WAIT_V(n) asm volatile("s_waitcnt vmcnt(" #n ")" ::: "memory")
#define PG8_WAIT_L(n) asm volatile("s_waitcnt lgkmcnt(" #n ")" ::: "memory")
#define PG8_BAR __builtin_amdgcn_s_barrier()
#define PG8_SCHED __builtin_amdgcn_sched_barrier(0)
    Unit cur, nxt; int ui = 0;
    if (!S.next(0, cur)) return;
    f32x4 acc[2][2][4][2];
#pragma unroll
    for (int a = 0; a < 2; ++a)
#pragma unroll
        for (int b = 0; b < 2; ++b)
#pragma unroll
            for (int m = 0; m < 4; ++m)
#pragma unroll
                for (int n = 0; n < 2; ++n) acc[a][b][m][n] = (f32x4){0.f, 0.f, 0.f, 0.f};
    bf16x8 At[4][2], B0[2][2], B1[2][2];
    const char* cA = (const char*)g.A + (size_t)cur.pm * tstep; const char* cB = (const char*)g.Bt + (size_t)cur.pn * tstep;
    S.a_ready(cur);
    PG8_STAGE(PG8_SB(0, 0), cB, voffB); PG8_STAGE(PG8_SA(0, 0), cA, voffA); PG8_STAGE(PG8_SB(0, 1), cB + hstep, voffB); PG8_STAGE(PG8_SA(0, 1), cA + hstep, voffA);
    if (wr == 1) PG8_BAR;
    PG8_WAIT_V(4); PG8_BAR;
    PG8_STAGE(PG8_SB(1, 0), cB + kstep, voffB); PG8_STAGE(PG8_SA(1, 0), cA + kstep, voffA); PG8_STAGE(PG8_SB(1, 1), cB + hstep + kstep, voffB);
    PG8_WAIT_V(6); PG8_BAR;
    PG8_STAMP();
    for (;;) {
        const bool has_next = S.next(ui + 1, nxt);
        const char* nA = has_next ? (const char*)g.A + (size_t)nxt.pm * tstep : cA; const char* nB = has_next ? (const char*)g.Bt + (size_t)nxt.pn * tstep : cB;
        for (int t = 0; t < nt; t += 2) {
            const bool last = (t == nt - 2);
            const char* a1 = cA + (size_t)(t + 1) * kstep;
            const char* a2 = last ? nA : cA + (size_t)(t + 2) * kstep; const char* b2 = last ? nB : cB + (size_t)(t + 2) * kstep;
            const char* a3 = a2 + kstep; const char* b3 = b2 + kstep;
            if (last && has_next) S.a_ready(nxt);
            PG8_LDB(B0, 0, 0); PG8_SCHED; PG8_LDA(At, 0, 0); PG8_STAGE(PG8_SA(1, 1), a1 + hstep, voffA);
            PG8_WAIT_L(8); PG8_BAR; PG8_WAIT_L(0); PG8_MMA(0, 0, At, B0); PG8_BAR; PG8_SCHED;
            PG8_LDB(B1, 0, 1); PG8_STAGE(PG8_SB(0, 0), b2, voffB);
            PG8_BAR; PG8_WAIT_L(0); PG8_MMA(0, 1, At, B1); PG8_BAR;
            PG8_LDA(At, 0, 1); PG8_STAGE(PG8_SA(0, 0), a2, voffA);
            PG8_BAR; PG8_WAIT_L(0); PG8_MMA(1, 0, At, B0); PG8_BAR; PG8_SCHED;
            PG8_STAGE(PG8_SB(0, 1), b2 + hstep, voffB);
            PG8_WAIT_V(6); PG8_BAR; PG8_MMA(1, 1, At, B1); PG8_BAR;
            PG8_LDB(B0, 1, 0); PG8_SCHED; PG8_LDA(At, 1, 0); PG8_STAGE(PG8_SA(0, 1), a2 + hstep, voffA);
            PG8_WAIT_L(8); PG8_BAR; PG8_WAIT_L(0); PG8_MMA(0, 0, At, B0); PG8_BAR; PG8_SCHED;
            PG8_LDB(B1, 1, 1); PG8_STAGE(PG8_SB(1, 0), b3, voffB);
            PG8_BAR; PG8_WAIT_L(0); PG8_MMA(0, 1, At, B1); PG8_BAR;
            PG8_LDA(At, 1, 1); PG8_STAGE(PG8_SA(1, 0), a3, voffA);
            PG8_BAR; PG8_WAIT_L(0); PG8_MMA(1, 0, At, B0); PG8_BAR; PG8_SCHED;
            PG8_STAGE(PG8_SB(1, 1), b3 + hstep, voffB);
            PG8_WAIT_V(6); PG8_BAR; PG8_MMA(1, 1, At, B1); PG8_BAR;
        }
        PG8_STAMP();
        if constexpr (!Epi::AFTER_DRAIN) { E(acc, cur, wr, wc, fr, fq); S.done(cur); }
        PG8_STAMP();
        if (!has_next) break;
#pragma unroll
        for (int a = 0; a < 2; ++a)
#pragma unroll
            for (int b = 0; b < 2; ++b)
#pragma unroll
                for (int m = 0; m < 4; ++m)
#pragma unroll
                    for (int n = 0; n < 2; ++n) acc[a][b][m][n] = (f32x4){0.f, 0.f, 0.f, 0.f};
        cur = nxt; cA = nA; cB = nB; ++ui;
    }
    PG8_WAIT_V(0);
    if (wr == 0) PG8_BAR;
    PG8_BAR;
    if constexpr (Epi::AFTER_DRAIN) { E.fused(acc, cur, wr, wc, fr, fq, lds, wid, lane); S.done(cur); }
    PG8_STAMP();
    if (STAMP && wid == 0) { stamps[lane] = lane < nts ? (((unsigned long long)(unsigned)ts_hi << 32) | (unsigned)ts_lo) : 0ull;
        if (lane == 62) stamps[62] = rt_entry; if (lane == 63) stamps[63] = (unsigned long long)wall_clock64(); }
#undef PG8_STAMP
#undef PG8_SA
#undef PG8_SB
#undef PG8_STAGE
#undef PG8_LDA
#undef PG8_LDB
#undef PG8_MMA
#undef PG8_WAIT_V
#undef PG8_WAIT_L
#undef PG8_BAR
#undef PG8_SCHED
}
}

#define LAS __attribute__((address_space(3)))
using pg8::bf16_t; using pg8::bf16x8; using pg8::f32x4; using pg8::u32x4; using pg8::cvt_pk_bf16;
typedef unsigned u32x2 __attribute__((ext_vector_type(2)));
typedef float f32x2 __attribute__((ext_vector_type(2)));

constexpr int TP = 16384, TS = 512, TT = 16896, DM = 1024;
constexpr int NHA = 2560, NHB = 3584, DFF = 2816, NUP = 5632;
constexpr float ALPHA = 1.6817928305074292f;
constexpr int LDS_BYTES = 139264;

constexpr size_t WS_WINA = 0;
constexpr size_t WS_WOUTA = WS_WINA + (size_t)2 * NHA * DM * 2;
constexpr size_t WS_WINB = WS_WOUTA + (size_t)2 * DM * DM * 2;
constexpr size_t WS_WOUTB = WS_WINB + (size_t)2 * NHB * DM * 2;
constexpr size_t WS_WKV = WS_WOUTB + (size_t)2 * DM * DM * 2;
constexpr size_t WS_WUP = WS_WKV + (size_t)2048 * DM * 2;
constexpr size_t WS_WDOWN = WS_WUP + (size_t)4 * NUP * DM * 2;
constexpr size_t WS_XF = WS_WDOWN + (size_t)4 * DM * DFF * 2;
constexpr size_t WS_XB = WS_XF + (size_t)TT * DM * 4;
constexpr size_t WS_MEMB = WS_XB + (size_t)TT * DM * 2;
constexpr size_t WS_KB = WS_MEMB + (size_t)2048 * DM * 2;
constexpr size_t WS_VT = WS_KB + (size_t)4 * 8 * 4 * 256 * 64 * 2;
constexpr size_t WS_R = WS_VT + (size_t)4 * 8 * 4 * 256 * 64 * 2;
constexpr size_t WS_H = WS_R;
constexpr size_t WS_CAT = WS_H + (size_t)TT * NHB * 2;
constexpr size_t WS_QKVN = WS_CAT + (size_t)TT * DM * 2;
constexpr size_t WS_GB = WS_QKVN + (size_t)TT * 2304 * 2;
constexpr size_t WS_WC = WS_GB + (size_t)TT * 12 * 4;
constexpr size_t WS_QDC = WS_WC + (size_t)1536 * 16384;
constexpr size_t WS_KDT = WS_QDC + (size_t)1536 * 16384;
constexpr size_t WS_QKC = WS_KDT + (size_t)1536 * 16384;
constexpr size_t WS_UT = WS_QKC + (size_t)1536 * 8192;
constexpr size_t WS_GL = WS_UT + (size_t)1536 * 32768;
constexpr size_t WS_O = WS_GL + (size_t)1536 * 4 + 2048;
constexpr size_t WS_MIX_END = WS_O + (size_t)TT * 768 * 4;
constexpr size_t WS_HU = WS_R;
constexpr size_t WS_GACT = WS_HU + (size_t)TT * NUP * 2;
constexpr size_t WS_FFN_END = WS_GACT + (size_t)TT * DFF * 2;
constexpr size_t WS_END = WS_MIX_END > WS_FFN_END ? WS_MIX_END : WS_FFN_END;

constexpr size_t O_Y = 0;
constexpr size_t O_MK = O_Y + (size_t)TT * DM;
constexpr size_t O_MV = O_MK + (size_t)4 * 8 * 256 * 256;
constexpr size_t O_SCP = O_MV + (size_t)4 * 8 * 256 * 256;
constexpr size_t O_GCP = O_SCP + (size_t)2 * 8 * 2 * 768;
constexpr size_t O_GSP = O_GCP + (size_t)2 * 8 * 3 * 2304;
constexpr size_t O_FFP = O_GSP + (size_t)2 * 8 * 6 * 16384;
constexpr size_t O_SCS = O_FFP + (size_t)4 * 8 * 2 * NUP;
constexpr size_t O_GCS = O_SCS + (size_t)2 * 128 * 2 * 768;
constexpr size_t O_GSS = O_GCS + (size_t)2 * 128 * 3 * 2304;
constexpr size_t O_FFS = O_GSS + (size_t)2 * 128 * 6 * 16384;
constexpr size_t O_END = O_FFS + (size_t)4 * 128 * 2 * NUP;

#ifdef DIAG_GDN
constexpr size_t WS_NEED = WS_END + ((size_t)64 << 20);
#else
constexpr size_t WS_NEED = WS_END;
#endif
constexpr size_t WS_BAR = (WS_NEED + 255) / 256 * 256;
constexpr size_t WS_TOTAL = WS_BAR + 16384;
struct Params { const float* in[26]; float* out; unsigned char* ws; };
__device__ __forceinline__ int otid() { int t = threadIdx.x; asm volatile("" : "+v"(t)); return t; }

__device__ __forceinline__ float bflo(unsigned w) { return __uint_as_float(w << 16); }
__device__ __forceinline__ float bfhi(unsigned w) { return __uint_as_float(w & 0xffff0000u); }
__device__ __forceinline__ float bf1(bf16_t v) { return __uint_as_float((unsigned)v << 16); }
__device__ __forceinline__ float silu_f(float x) { return x / (1.f + __expf(-x)); }
__device__ __forceinline__ float wave_sum(float v) {
#pragma unroll
    for (int o = 1; o < 64; o <<= 1) v += __shfl_xor(v, o);
    return v;
}
__device__ __forceinline__ bf16x8 as_bf16x8(u32x4 v) { union { u32x4 u; bf16x8 b; } x; x.u = v; return x.b; }
__device__ __forceinline__ bf16x8 pack8(f32x4 a, f32x4 b) {
    u32x4 w; w.x = cvt_pk_bf16(a[0], a[1]); w.y = cvt_pk_bf16(a[2], a[3]); w.z = cvt_pk_bf16(b[0], b[1]); w.w = cvt_pk_bf16(b[2], b[3]);
    return as_bf16x8(w);
}
__device__ __forceinline__ int invperm32(int a) { return 8 * ((a & 15) >> 2) + (a & 3) + ((a >> 4) << 2); }
__device__ __forceinline__ int perm32k(int p) { const int g = p >> 3, jj = p & 7; return jj < 4 ? 4 * g + jj : 16 + 4 * g + (jj - 4); }

struct EpiStoreBf16 {
    static constexpr bool PERM = true, AFTER_DRAIN = false;
    bf16_t* O; int ldc;
    __device__ __forceinline__ void operator()(const f32x4 (&acc)[2][2][4][2], const pg8::Unit& u, int wr, int wc, int fr, int fq) const {
        const int row0 = u.pm * 256 + wr * 64 + fr, col0 = u.pn * 256 + wc * 32 + 8 * fq;
#pragma unroll
        for (int ai = 0; ai < 2; ++ai)
#pragma unroll
            for (int m = 0; m < 4; ++m) { bf16_t* rowp = O + (size_t)(row0 + ai * 128 + m * 16) * ldc + col0;
#pragma unroll
                for (int bj = 0; bj < 2; ++bj) { const f32x4 v0 = acc[ai][bj][m][0], v1 = acc[ai][bj][m][1];
                    u32x4 w; w.x = cvt_pk_bf16(v0[0], v0[1]); w.y = cvt_pk_bf16(v0[2], v0[3]); w.z = cvt_pk_bf16(v1[0], v1[1]); w.w = cvt_pk_bf16(v1[2], v1[3]);
                    *(u32x4*)(rowp + bj * 128) = w; } }
    }
};
struct EpiResid {
    static constexpr bool PERM = false, AFTER_DRAIN = false;
    float* X; int ldc;
    __device__ __forceinline__ void operator()(const f32x4 (&acc)[2][2][4][2], const pg8::Unit& u, int wr, int wc, int fr, int fq) const {
        const int row0 = u.pm * 256 + wr * 64 + fr, col0 = u.pn * 256 + wc * 32 + 4 * fq;
#pragma unroll
        for (int ai = 0; ai < 2; ++ai)
#pragma unroll
            for (int m = 0; m < 4; ++m) { float* rowp = X + (size_t)(row0 + ai * 128 + m * 16) * ldc + col0;
#pragma unroll
                for (int bj = 0; bj < 2; ++bj)
#pragma unroll
                    for (int n = 0; n < 2; ++n) { f32x4* p = (f32x4*)(rowp + bj * 128 + n * 16); const f32x4 x = *p; *p = x * ALPHA + acc[ai][bj][m][n]; } }
    }
};
struct EpiKV {
    static constexpr bool PERM = false, AFTER_DRAIN = false;
    float* outK; float* outV; bf16_t* Kb; bf16_t* Vt;
    __device__ __forceinline__ void operator()(const f32x4 (&acc)[2][2][4][2], const pg8::Unit& u, int wr, int wc, int fr, int fq) const {
        const int row0 = u.pm * 256 + wr * 64 + fr, col0 = u.pn * 256 + wc * 32 + 4 * fq;
#pragma unroll
        for (int ai = 0; ai < 2; ++ai)
#pragma unroll
            for (int m = 0; m < 4; ++m) { const int row = row0 + ai * 128 + m * 16; const int b = row >> 8, mm = row & 255;
#pragma unroll
                for (int bj = 0; bj < 2; ++bj)
#pragma unroll
                    for (int n = 0; n < 2; ++n) { const int col = col0 + bj * 128 + n * 16; const int l = col >> 9, e = col & 511; const f32x4 v = acc[ai][bj][m][n];
                        if (e < 256) { *(f32x4*)(outK + ((size_t)((l * 8 + b) * 256 + mm)) * 256 + e) = v;
                            u32x2 w; w.x = cvt_pk_bf16(v[0], v[1]); w.y = cvt_pk_bf16(v[2], v[3]);
                            *(u32x2*)(Kb + ((size_t)(((l * 8 + b) * 4 + (e >> 6)) * 256 + mm)) * 64 + (e & 63)) = w; }
                        else { const int e2 = e - 256; *(f32x4*)(outV + ((size_t)((l * 8 + b) * 256 + mm)) * 256 + e2) = v;
                            const unsigned w0 = cvt_pk_bf16(v[0], v[1]), w1 = cvt_pk_bf16(v[2], v[3]);
                            bf16_t* vp = Vt + ((size_t)(((l * 8 + b) * 4 + (e2 >> 6)) * 64 + (e2 & 63))) * 256 + mm;
                            vp[0] = (bf16_t)(w0 & 0xffffu); vp[256] = (bf16_t)(w0 >> 16); vp[512] = (bf16_t)(w1 & 0xffffu); vp[768] = (bf16_t)(w1 >> 16); } } }
    }
};

template <class Epi>
__device__ __forceinline__ void run_gemm(LAS unsigned char* lds, const bf16_t* A, const bf16_t* Bt, int M, int N, int K, const Epi& E, int c) {
    pg8::Gemm g{A, Bt, M, N, K}; pg8::StaticOrder S; S.init(M, N, (int)gridDim.x, c);
    pg8::gemm_phase<Epi, pg8::StaticOrder, false>(lds, g, S, E, nullptr);
}


__device__ __forceinline__ void small_gemm_resid(const bf16_t* A, const bf16_t* Bt, int K, float* X) {
    const int tid_ = otid(); const int lane = tid_ & 63, wave = __builtin_amdgcn_readfirstlane(tid_ >> 6), c16 = lane & 15, g = lane >> 4;
    const int gw = blockIdx.x * 8 + wave, NGW = gridDim.x * 8;
    for (int tile = gw; tile < 2048; tile += NGW) {
        const int rt = tile >> 6, ct = tile & 63;
        const bf16_t* ap = A + (size_t)(TP + rt * 16 + c16) * K + 8 * g;
        const bf16_t* bp = Bt + (size_t)(ct * 16 + c16) * K + 8 * g;
        f32x4 acc = (f32x4){0.f, 0.f, 0.f, 0.f};
#pragma unroll 1
        for (int k = 0; k < K; k += 256) {
            bf16x8 a[8], b[8];
#pragma unroll
            for (int s2 = 0; s2 < 8; ++s2) { a[s2] = *(const bf16x8*)(ap + k + 32 * s2); b[s2] = *(const bf16x8*)(bp + k + 32 * s2); }
#pragma unroll
            for (int s2 = 0; s2 < 8; ++s2) acc = __builtin_amdgcn_mfma_f32_16x16x32_bf16(b[s2], a[s2], acc, 0, 0, 0);
        }
        f32x4* px = (f32x4*)(X + (size_t)(TP + rt * 16 + c16) * DM + ct * 16 + 4 * g);
        const f32x4 x = *px; *px = x * ALPHA + acc;
    }
}
__device__ __forceinline__ void p0_transpose_item(const float* W, int K, int Ns, int Nd, bool remap, bf16_t* WT, LAS float* scr, int item, int lane) {
    const int nblk = Nd / 32, kb = item / nblk, nb = item % nblk, k0 = 64 * kb, n0 = 32 * nb;
    const int n = n0 + (lane & 31); int sn = n;
    if (remap) sn = n < 3072 ? n : (n < 3328 ? n + 12 : (n < 3340 ? n - 256 : -1));
#pragma unroll 8
    for (int i = 0; i < 32; ++i) { const int kk = 2 * i + (lane >> 5); scr[kk * 33 + (lane & 31)] = sn >= 0 ? W[(size_t)(k0 + kk) * Ns + sn] : 0.f; }
    asm volatile("s_waitcnt lgkmcnt(0)" ::: "memory");
    const int c = lane & 7;
#pragma unroll
    for (int j = 0; j < 4; ++j) { const int nn = (lane >> 3) + 8 * j; const LAS float* s = scr + (8 * c) * 33 + nn;
        u32x4 o; o.x = cvt_pk_bf16(s[0 * 33], s[1 * 33]); o.y = cvt_pk_bf16(s[2 * 33], s[3 * 33]); o.z = cvt_pk_bf16(s[4 * 33], s[5 * 33]); o.w = cvt_pk_bf16(s[6 * 33], s[7 * 33]);
        *(u32x4*)(WT + (size_t)(n0 + nn) * K + k0 + 8 * c) = o; }
    asm volatile("s_waitcnt lgkmcnt(0)" ::: "memory");
}

__device__ __forceinline__ void phase_prep(const Params& p, LAS unsigned char* lds) {
    const int tid = otid(), lane = tid & 63, wave = __builtin_amdgcn_readfirstlane(tid >> 6);
    const int gw = blockIdx.x * 8 + wave, NGW = gridDim.x * 8;
    LAS float* scr = (LAS float*)(lds + wave * 16384);
    unsigned char* ws = p.ws;
    constexpr int I_INA = 16 * 80, I_OUT = 16 * 32, I_INB = 16 * 112, I_KV = 16 * 16, I_UP = 16 * 176, I_DN = 44 * 32;
    constexpr int NIT = 2 * I_INA + 2 * I_OUT + 2 * I_INB + 2 * I_OUT + 4 * I_KV + 4 * I_UP + 4 * I_DN;
    for (int it = gw; it < NIT; it += NGW) {
        int r = it;
        if (r < 2 * I_INA) { const int l = r / I_INA; r -= l * I_INA; p0_transpose_item(p.in[9] + (size_t)l * DM * NHA, DM, NHA, NHA, false, (bf16_t*)(ws + WS_WINA) + (size_t)l * NHA * DM, scr, r, lane); continue; } r -= 2 * I_INA;
        if (r < 2 * I_OUT) { const int l = r / I_OUT; r -= l * I_OUT; p0_transpose_item(p.in[11] + (size_t)l * DM * DM, DM, DM, DM, false, (bf16_t*)(ws + WS_WOUTA) + (size_t)l * DM * DM, scr, r, lane); continue; } r -= 2 * I_OUT;
        if (r < 2 * I_INB) { const int l = r / I_INB; r -= l * I_INB; p0_transpose_item(p.in[12] + (size_t)l * DM * 3340, DM, 3340, NHB, true, (bf16_t*)(ws + WS_WINB) + (size_t)l * NHB * DM, scr, r, lane); continue; } r -= 2 * I_INB;
        if (r < 2 * I_OUT) { const int l = r / I_OUT; r -= l * I_OUT; p0_transpose_item(p.in[17] + (size_t)l * DM * DM, DM, DM, DM, false, (bf16_t*)(ws + WS_WOUTB) + (size_t)l * DM * DM, scr, r, lane); continue; } r -= 2 * I_OUT;
        if (r < 4 * I_KV) { const int l = r / I_KV; r -= l * I_KV; p0_transpose_item(p.in[18] + (size_t)l * DM * 512, DM, 512, 512, false, (bf16_t*)(ws + WS_WKV) + (size_t)l * 512 * DM, scr, r, lane); continue; } r -= 4 * I_KV;
        if (r < 4 * I_UP) { const int l = r / I_UP; r -= l * I_UP; p0_transpose_item(p.in[23] + (size_t)l * DM * NUP, DM, NUP, NUP, false, (bf16_t*)(ws + WS_WUP) + (size_t)l * NUP * DM, scr, r, lane); continue; } r -= 4 * I_UP;
        { const int l = r / I_DN; r -= l * I_DN; p0_transpose_item(p.in[25] + (size_t)l * DFF * DM, DFF, DM, DM, false, (bf16_t*)(ws + WS_WDOWN) + (size_t)l * DM * DFF, scr, r, lane); }
    }
    const size_t gt = (size_t)blockIdx.x * 512 + tid, NT = (size_t)gridDim.x * 512;
    float* xf = (float*)(ws + WS_XF); bf16_t* xb = (bf16_t*)(ws + WS_XB); bf16_t* memb = (bf16_t*)(ws + WS_MEMB);
    for (size_t i = gt; i < (size_t)TT * 256; i += NT) {
        const f32x4 v = i < (size_t)TP * 256 ? ((const f32x4*)p.in[0])[i] : ((const f32x4*)p.in[1])[i - (size_t)TP * 256];
        ((f32x4*)xf)[i] = v; u32x2 w; w.x = cvt_pk_bf16(v[0], v[1]); w.y = cvt_pk_bf16(v[2], v[3]); ((u32x2*)xb)[i] = w;
    }
    for (size_t i = gt; i < (size_t)2048 * 256; i += NT) {
        const f32x4 v = ((const f32x4*)p.in[2])[i]; u32x2 w; w.x = cvt_pk_bf16(v[0], v[1]); w.y = cvt_pk_bf16(v[2], v[3]); ((u32x2*)memb)[i] = w;
    }
}

__device__ __forceinline__ void phase_ln(float* xf, bf16_t* xb, const float* gam, const float* bet, float* yout) {
    const int tid_ = otid(); const int lane = tid_ & 63, wave = __builtin_amdgcn_readfirstlane(tid_ >> 6);
    const int gw = blockIdx.x * 8 + wave, NGW = gridDim.x * 8;
    f32x4 gg[4], bb[4];
#pragma unroll
    for (int j = 0; j < 4; ++j) { gg[j] = ((const f32x4*)gam)[lane + 64 * j]; bb[j] = ((const f32x4*)bet)[lane + 64 * j]; }
    for (int row = gw; row < TT; row += NGW) {
        f32x4* xr = (f32x4*)(xf + (size_t)row * DM) + lane;
        f32x4 v[4]; float s = 0.f;
#pragma unroll
        for (int j = 0; j < 4; ++j) { v[j] = xr[64 * j]; s += (v[j][0] + v[j][1]) + (v[j][2] + v[j][3]); }
        const float mean = wave_sum(s) * (1.f / DM); float s2 = 0.f;
#pragma unroll
        for (int j = 0; j < 4; ++j) { v[j] = v[j] - mean; s2 += (v[j][0] * v[j][0] + v[j][1] * v[j][1]) + (v[j][2] * v[j][2] + v[j][3] * v[j][3]); }
        const float rstd = 1.f / sqrtf(wave_sum(s2) * (1.f / DM) + 1e-5f);
#pragma unroll
        for (int j = 0; j < 4; ++j) { const f32x4 o = v[j] * rstd * gg[j] + bb[j];
            if (yout) ((f32x4*)(yout + (size_t)row * DM))[lane + 64 * j] = o;
            else { xr[64 * j] = o; u32x2 w; w.x = cvt_pk_bf16(o[0], o[1]); w.y = cvt_pk_bf16(o[2], o[3]); ((u32x2*)(xb + (size_t)row * DM))[lane + 64 * j] = w; } }
    }
}

__device__ __forceinline__ void attn_prompt_item(LAS unsigned char* lds, const bf16_t* h, int ldh, int qoff, const bf16_t* Kb, const bf16_t* Vt, bf16_t* cat, int layer, int item) {
    const int tid = otid(), lane = tid & 63, wave = __builtin_amdgcn_readfirstlane(tid >> 6), c16 = lane & 15, g = lane >> 4;
    const int qc = item & 7, hd = (item >> 3) & 3, b = item >> 5;
    const size_t kvbase = ((size_t)((layer * 8 + b) * 4 + hd)) * 16384;
    constexpr int VOFF = 256 * 144;
#pragma unroll
    for (int i = 0; i < 4; ++i) { const int q = tid + 512 * i;
        const u32x4 kv = *(const u32x4*)(Kb + kvbase + (size_t)q * 8); *(LAS u32x4*)(lds + (q >> 3) * 144 + (q & 7) * 16) = kv;
        const u32x4 vv = *(const u32x4*)(Vt + kvbase + (size_t)q * 8); *(LAS u32x4*)(lds + VOFF + (q >> 5) * 528 + (q & 31) * 16) = vv; }
    __syncthreads();
#pragma unroll 1
    for (int qt = wave; qt < 16; qt += 8) {
        const int row = b * 2048 + qc * 256 + qt * 16 + c16;
        const bf16_t* qp = h + (size_t)row * ldh + qoff + hd * 64 + g * 8;
        const bf16x8 qf0 = *(const bf16x8*)qp, qf1 = *(const bf16x8*)(qp + 32);
        f32x4 acc[16];
#pragma unroll
        for (int kt = 0; kt < 16; ++kt) { acc[kt] = (f32x4){0.f, 0.f, 0.f, 0.f};
            const LAS unsigned char* kp = lds + (16 * kt + c16) * 144 + g * 16;
            const bf16x8 k0 = *(const LAS bf16x8*)kp, k1 = *(const LAS bf16x8*)(kp + 64);
            acc[kt] = __builtin_amdgcn_mfma_f32_16x16x32_bf16(k0, qf0, acc[kt], 0, 0, 0);
            acc[kt] = __builtin_amdgcn_mfma_f32_16x16x32_bf16(k1, qf1, acc[kt], 0, 0, 0); }
        float mx = -3.0e38f;
#pragma unroll
        for (int kt = 0; kt < 16; ++kt) mx = fmaxf(mx, fmaxf(fmaxf(acc[kt][0], acc[kt][1]), fmaxf(acc[kt][2], acc[kt][3])));
        mx = fmaxf(mx, __shfl_xor(mx, 16)); mx = fmaxf(mx, __shfl_xor(mx, 32));
        const float sc = 0.125f * 1.44269504089f; float sum = 0.f;
#pragma unroll
        for (int kt = 0; kt < 16; ++kt)
#pragma unroll
            for (int r = 0; r < 4; ++r) { const float e = __builtin_amdgcn_exp2f((acc[kt][r] - mx) * sc); acc[kt][r] = e; sum += e; }
        sum += __shfl_xor(sum, 16); sum += __shfl_xor(sum, 32);
        const float inv = 1.f / sum;
        f32x4 o[4];
#pragma unroll
        for (int dt = 0; dt < 4; ++dt) o[dt] = (f32x4){0.f, 0.f, 0.f, 0.f};
#pragma unroll
        for (int s = 0; s < 8; ++s) { const bf16x8 pf = pack8(acc[2 * s], acc[2 * s + 1]);
#pragma unroll
            for (int dt = 0; dt < 4; ++dt) { const LAS unsigned char* vp = lds + VOFF + (16 * dt + c16) * 528 + (32 * s + 4 * g) * 2;
                const u32x2 a0 = *(const LAS u32x2*)vp, a1 = *(const LAS u32x2*)(vp + 32);
                u32x4 av; av.x = a0.x; av.y = a0.y; av.z = a1.x; av.w = a1.y;
                o[dt] = __builtin_amdgcn_mfma_f32_16x16x32_bf16(as_bf16x8(av), pf, o[dt], 0, 0, 0); } }
#pragma unroll
        for (int dt = 0; dt < 4; ++dt) { u32x2 w; w.x = cvt_pk_bf16(o[dt][0] * inv, o[dt][1] * inv); w.y = cvt_pk_bf16(o[dt][2] * inv, o[dt][3] * inv);
            *(u32x2*)(cat + (size_t)row * DM + 768 + hd * 64 + 16 * dt + 4 * g) = w; }
    }
    __syncthreads();
}

__device__ __forceinline__ void attn_prompt_item_naive(LAS unsigned char* lds, const bf16_t* h, int ldh, int qoff, const float* outK, const float* outV, bf16_t* cat, int layer, int item) {
    const int tid = otid();
    const int qc = item & 7, hd = (item >> 3) & 3, b = item >> 5;
    LAS float* Ks = (LAS float*)lds; LAS float* Vs = Ks + 256 * 64;
    for (int i = tid; i < 256 * 64; i += 512) { const int m = i >> 6, d = i & 63; const size_t src = ((size_t)((layer * 8 + b) * 256 + m)) * 256 + hd * 64 + d; Ks[i] = outK[src]; Vs[i] = outV[src]; }
    __syncthreads();
    const int ql = tid & 255, half = tid >> 8;
    const int row = b * 2048 + qc * 256 + ql;
    float q[64];
#pragma unroll
    for (int d = 0; d < 64; ++d) q[d] = bf1(h[(size_t)row * ldh + qoff + hd * 64 + d]);
    float mx = -3.0e38f, l = 0.f; float acc[64];
#pragma unroll
    for (int d = 0; d < 64; ++d) acc[d] = 0.f;
#pragma unroll 1
    for (int m = half * 128; m < half * 128 + 128; ++m) {
        float sdot = 0.f;
#pragma unroll
        for (int d = 0; d < 64; ++d) sdot += q[d] * Ks[m * 64 + d];
        sdot *= 0.125f;
        const float nm = fmaxf(mx, sdot); const float corr = __expf(mx - nm), pe = __expf(sdot - nm);
        l = l * corr + pe;
#pragma unroll
        for (int d = 0; d < 64; ++d) acc[d] = acc[d] * corr + pe * Vs[m * 64 + d];
        mx = nm;
    }
    __syncthreads();
    LAS float* ex = (LAS float*)lds;
    if (half == 1) { ex[ql * 66 + 64] = mx; ex[ql * 66 + 65] = l;
#pragma unroll
        for (int d = 0; d < 64; ++d) ex[ql * 66 + d] = acc[d]; }
    __syncthreads();
    if (half == 0) { const float m2 = ex[ql * 66 + 64], l2 = ex[ql * 66 + 65]; const float nm = fmaxf(mx, m2); const float c1 = __expf(mx - nm), c2 = __expf(m2 - nm); const float inv = 1.f / (l * c1 + l2 * c2);
#pragma unroll
        for (int d = 0; d < 64; ++d) { const float o = (acc[d] * c1 + ex[ql * 66 + d] * c2) * inv; cat[(size_t)row * DM + 768 + hd * 64 + d] = (bf16_t)(cvt_pk_bf16(o, 0.f) & 0xffffu); } }
    __syncthreads();
}
__device__ __forceinline__ void attn_sample_item(LAS unsigned char* lds, const bf16_t* h, int ldh, int qoff, const float* ck, const float* cv, bf16_t* cat, int layer, int item) {
    const int tid = otid(), lane = tid & 63, wave = __builtin_amdgcn_readfirstlane(tid >> 6);
    const int hp = item & 1, sb = item >> 1;
    LAS float* qs = (LAS float*)lds;
    LAS float* scs = qs + 512;
    LAS float* red = scs + 2048;
    { const int t = tid >> 7, hh = (tid >> 6) & 1, d = tid & 63;
      qs[tid] = bf1(h[(size_t)(TP + sb * 4 + t) * ldh + qoff + (2 * hp + hh) * 64 + d]); }
    __syncthreads();
    { const int m = tid & 255, hh = tid >> 8;
      const f32x4* kp = (const f32x4*)(ck + (((size_t)(layer * 128 + sb) * 256 + m) * 4 + (2 * hp + hh)) * 64);
      float a0 = 0.f, a1 = 0.f, a2 = 0.f, a3 = 0.f;
#pragma unroll
      for (int i = 0; i < 16; ++i) { const f32x4 kv = kp[i];
#pragma unroll
          for (int e = 0; e < 4; ++e) { const int d = 4 * i + e; a0 += kv[e] * qs[(0 * 2 + hh) * 64 + d]; a1 += kv[e] * qs[(1 * 2 + hh) * 64 + d]; a2 += kv[e] * qs[(2 * 2 + hh) * 64 + d]; a3 += kv[e] * qs[(3 * 2 + hh) * 64 + d]; } }
      scs[(0 * 2 + hh) * 256 + m] = a0 * 0.125f; scs[(1 * 2 + hh) * 256 + m] = a1 * 0.125f; scs[(2 * 2 + hh) * 256 + m] = a2 * 0.125f; scs[(3 * 2 + hh) * 256 + m] = a3 * 0.125f; }
    __syncthreads();
    { LAS float* sp = scs + wave * 256; float v[4]; float mx = -3.0e38f;
#pragma unroll
      for (int i = 0; i < 4; ++i) { v[i] = sp[lane + 64 * i]; mx = fmaxf(mx, v[i]); }
#pragma unroll
      for (int o = 1; o < 64; o <<= 1) mx = fmaxf(mx, __shfl_xor(mx, o));
      float s = 0.f;
#pragma unroll
      for (int i = 0; i < 4; ++i) { v[i] = __expf(v[i] - mx); s += v[i]; }
      s = wave_sum(s); const float inv = 1.f / s;
#pragma unroll
      for (int i = 0; i < 4; ++i) sp[lane + 64 * i] = v[i] * inv; }
    __syncthreads();
    { const int d = tid & 63, hh = (tid >> 6) & 1, mp = tid >> 7;
      float a0 = 0.f, a1 = 0.f, a2 = 0.f, a3 = 0.f;
      const float* vp = cv + (((size_t)(layer * 128 + sb) * 256 + mp * 64) * 4 + (2 * hp + hh)) * 64 + d;
#pragma unroll 8
      for (int m = 0; m < 64; ++m) { const float vv = vp[(size_t)m * 256]; const int mm = mp * 64 + m;
          a0 += scs[(0 * 2 + hh) * 256 + mm] * vv; a1 += scs[(1 * 2 + hh) * 256 + mm] * vv; a2 += scs[(2 * 2 + hh) * 256 + mm] * vv; a3 += scs[(3 * 2 + hh) * 256 + mm] * vv; }
      red[(mp * 8 + 0 * 2 + hh) * 64 + d] = a0; red[(mp * 8 + 1 * 2 + hh) * 64 + d] = a1; red[(mp * 8 + 2 * 2 + hh) * 64 + d] = a2; red[(mp * 8 + 3 * 2 + hh) * 64 + d] = a3; }
    __syncthreads();
    { const int t = tid >> 7, hh = (tid >> 6) & 1, d = tid & 63; const int idx = (t * 2 + hh) * 64 + d;
      const float o = red[idx] + red[512 + idx] + red[1024 + idx] + red[1536 + idx];
      cat[(size_t)(TP + sb * 4 + t) * DM + 768 + (2 * hp + hh) * 64 + d] = (bf16_t)(cvt_pk_bf16(o, 0.f) & 0xffffu); }
    __syncthreads();
}

__device__ __forceinline__ void load_u8(const bf16_t* h, size_t row, int c, float* u) {
    const u32x4 xi = *(const u32x4*)(h + row * NHA + c), cg = *(const u32x4*)(h + row * NHA + 1536 + c);
#pragma unroll
    for (int i = 0; i < 4; ++i) { u[2 * i] = bflo(xi[i]) * bflo(cg[i]); u[2 * i + 1] = bfhi(xi[i]) * bfhi(cg[i]); }
}
__device__ __forceinline__ void load_f8(const float* src, float* v) {
    const f32x4 a = ((const f32x4*)src)[0], b = ((const f32x4*)src)[1];
#pragma unroll
    for (int i = 0; i < 4; ++i) { v[i] = a[i]; v[4 + i] = b[i]; }
}
__device__ __forceinline__ void phase_mixA_elem(const Params& p, int j) {
    const bf16_t* h = (const bf16_t*)(p.ws + WS_H); bf16_t* cat = (bf16_t*)(p.ws + WS_CAT);
    const float* cw = p.in[10] + (size_t)j * 3 * 768; const float* hist = p.in[5] + (size_t)j * 128 * 2 * 768;
    const int gt = blockIdx.x * 512 + otid(), NT = gridDim.x * 512;
    constexpr int RB = 4, NPB = TP / RB, NIT = (NPB + 128) * 96;
    for (int it = gt; it < NIT; it += NT) {
        const int blk = it / 96, c = (it % 96) * 8;
        const bool smp = blk >= NPB; const int row0 = smp ? TP + (blk - NPB) * 4 : blk * RB; const int t0 = smp ? 0 : (row0 & 2047); const int bb = smp ? blk - NPB : (row0 >> 11);
        float w0[8], w1[8], w2[8];
        load_f8(cw + c, w0); load_f8(cw + 768 + c, w1); load_f8(cw + 1536 + c, w2);
        float u0[8], u1[8], u2[8];
        if (t0 >= 2) { load_u8(h, row0 - 2, c, u0); load_u8(h, row0 - 1, c, u1); }
        else if (smp) { load_f8(hist + ((size_t)bb * 2 + 0) * 768 + c, u0); load_f8(hist + ((size_t)bb * 2 + 1) * 768 + c, u1); }
        else {
#pragma unroll
            for (int i = 0; i < 8; ++i) { u0[i] = 0.f; u1[i] = 0.f; } }
        const int T = smp ? 4 : 2048;
#pragma unroll
        for (int r = 0; r < RB; ++r) {
            const size_t row = (size_t)row0 + r;
            load_u8(h, row, c, u2);
            const u32x4 bg = *(const u32x4*)(h + row * NHA + 768 + c);
            float y[8];
#pragma unroll
            for (int i = 0; i < 8; ++i) { const float bgv = (i & 1) ? bfhi(bg[i >> 1]) : bflo(bg[i >> 1]); y[i] = bgv * (w0[i] * u0[i] + w1[i] * u1[i] + w2[i] * u2[i]); }
            u32x4 w; w.x = cvt_pk_bf16(y[0], y[1]); w.y = cvt_pk_bf16(y[2], y[3]); w.z = cvt_pk_bf16(y[4], y[5]); w.w = cvt_pk_bf16(y[6], y[7]);
            *(u32x4*)(cat + row * DM + c) = w;
            const int t = t0 + r;
            if (t >= T - 2) { float* op = p.out + (smp ? O_SCS : O_SCP) + (((size_t)j * (smp ? 128 : 8) + bb) * 2 + (t - (T - 2))) * 768 + c;
                ((f32x4*)op)[0] = (f32x4){u2[0], u2[1], u2[2], u2[3]}; ((f32x4*)op)[1] = (f32x4){u2[4], u2[5], u2[6], u2[7]}; }
#pragma unroll
            for (int i = 0; i < 8; ++i) { u0[i] = u1[i]; u1[i] = u2[i]; }
        }
    }
}

__device__ __forceinline__ void load_h8(const bf16_t* hu, size_t row, int c, float* v) {
    const u32x4 x = *(const u32x4*)(hu + row * NUP + c);
#pragma unroll
    for (int i = 0; i < 4; ++i) { v[2 * i] = bflo(x[i]); v[2 * i + 1] = bfhi(x[i]); }
}
__device__ __forceinline__ void phase_convgate(const Params& p, int l) {
    const bf16_t* hu = (const bf16_t*)(p.ws + WS_HU); bf16_t* gact = (bf16_t*)(p.ws + WS_GACT);
    const float* cw = p.in[24] + (size_t)l * 3 * NUP; const float* hist = p.in[8] + (size_t)l * 128 * 2 * NUP;
    const int gt = blockIdx.x * 512 + otid(), NT = gridDim.x * 512;
    constexpr int RB = 8, NPB = TP / RB, NIT = (NPB + 128) * 352;
    for (int it = gt; it < NIT; it += NT) {
        const int blk = it / 352, c = (it % 352) * 8;
        const bool smp = blk >= NPB; const int row0 = smp ? TP + (blk - NPB) * 4 : blk * RB; const int t0 = smp ? 0 : (row0 & 2047); const int bb = smp ? blk - NPB : (row0 >> 11);
        const int nr = smp ? 4 : RB; const int T = smp ? 4 : 2048;
        float wg0[8], wg1[8], wg2[8], wu0[8], wu1[8], wu2[8];
        load_f8(cw + c, wg0); load_f8(cw + NUP + c, wg1); load_f8(cw + 2 * NUP + c, wg2);
        load_f8(cw + DFF + c, wu0); load_f8(cw + NUP + DFF + c, wu1); load_f8(cw + 2 * NUP + DFF + c, wu2);
        float g0[8], g1[8], g2[8], a0[8], a1[8], a2[8];
        if (t0 >= 2) { load_h8(hu, row0 - 2, c, g0); load_h8(hu, row0 - 1, c, g1); load_h8(hu, row0 - 2, c + DFF, a0); load_h8(hu, row0 - 1, c + DFF, a1); }
        else if (smp) { load_f8(hist + ((size_t)bb * 2 + 0) * NUP + c, g0); load_f8(hist + ((size_t)bb * 2 + 1) * NUP + c, g1); load_f8(hist + ((size_t)bb * 2 + 0) * NUP + DFF + c, a0); load_f8(hist + ((size_t)bb * 2 + 1) * NUP + DFF + c, a1); }
        else {
#pragma unroll
            for (int i = 0; i < 8; ++i) { g0[i] = 0.f; g1[i] = 0.f; a0[i] = 0.f; a1[i] = 0.f; } }
#pragma unroll
        for (int r = 0; r < RB; ++r) {
            if (r < nr) {
                const size_t row = (size_t)row0 + r;
                load_h8(hu, row, c, g2); load_h8(hu, row, c + DFF, a2);
                float y[8];
#pragma unroll
                for (int i = 0; i < 8; ++i) { const float gg = wg0[i] * g0[i] + wg1[i] * g1[i] + wg2[i] * g2[i], uu = wu0[i] * a0[i] + wu1[i] * a1[i] + wu2[i] * a2[i]; y[i] = silu_f(gg) * uu; }
                u32x4 w; w.x = cvt_pk_bf16(y[0], y[1]); w.y = cvt_pk_bf16(y[2], y[3]); w.z = cvt_pk_bf16(y[4], y[5]); w.w = cvt_pk_bf16(y[6], y[7]);
                *(u32x4*)(gact + row * DFF + c) = w;
                const int t = t0 + r;
                if (t >= T - 2) { float* op = p.out + (smp ? O_FFS : O_FFP) + (((size_t)l * (smp ? 128 : 8) + bb) * 2 + (t - (T - 2))) * NUP + c;
                    ((f32x4*)op)[0] = (f32x4){g2[0], g2[1], g2[2], g2[3]}; ((f32x4*)op)[1] = (f32x4){g2[4], g2[5], g2[6], g2[7]};
                    ((f32x4*)(op + DFF))[0] = (f32x4){a2[0], a2[1], a2[2], a2[3]}; ((f32x4*)(op + DFF))[1] = (f32x4){a2[4], a2[5], a2[6], a2[7]}; }
#pragma unroll
                for (int i = 0; i < 8; ++i) { g0[i] = g1[i]; g1[i] = g2[i]; a0[i] = a1[i]; a1[i] = a2[i]; }
            }
        }
    }
}

__device__ __forceinline__ void phase_gdn_pre(const Params& p, int j) {
    const bf16_t* h = (const bf16_t*)(p.ws + WS_H); bf16_t* qkvn = (bf16_t*)(p.ws + WS_QKVN); float* gb = (float*)(p.ws + WS_GB);
    const float* cw = p.in[13] + (size_t)j * 4 * 2304; const float* hist = p.in[6] + (size_t)j * 128 * 3 * 2304;
    const int tid_ = otid(); const int lane = tid_ & 63, wave = __builtin_amdgcn_readfirstlane(tid_ >> 6);
    const int gw = blockIdx.x * 8 + wave, NGW = gridDim.x * 8;
    constexpr int RB = 8, NPB = TP / RB, NIT = (NPB + 128) * 6;
    for (int it = gw; it < NIT; it += NGW) {
        const int blk = it / 6, hd = it % 6;
        const bool smp = blk >= NPB; const int row0 = smp ? TP + (blk - NPB) * 4 : blk * RB; const int t0 = smp ? 0 : (row0 & 2047); const int bb = smp ? blk - NPB : (row0 >> 11);
        const int nr = smp ? 4 : RB; const int T = smp ? 4 : 2048;
        const float alog = -__expf(p.in[14][j * 6 + hd]), dtb = p.in[15][j * 6 + hd];
        f32x2 wv[3][4], x[3][4];
#pragma unroll
        for (int sec = 0; sec < 3; ++sec) { const int col = sec * 768 + hd * 128 + 2 * lane;
#pragma unroll
            for (int k = 0; k < 4; ++k) wv[sec][k] = *(const f32x2*)(cw + (size_t)k * 2304 + col);
#pragma unroll
            for (int k = 0; k < 3; ++k) {
                if (t0 >= 3) { const unsigned w = *(const unsigned*)(h + (size_t)(row0 - 3 + k) * NHB + col); x[sec][k] = (f32x2){bflo(w), bfhi(w)}; }
                else if (smp) x[sec][k] = *(const f32x2*)(hist + ((size_t)bb * 3 + k) * 2304 + col);
                else x[sec][k] = (f32x2){0.f, 0.f}; } }
#pragma unroll
        for (int r = 0; r < RB; ++r) {
            if (r < nr) {
                const int row = row0 + r, t = t0 + r;
                float val[3][2];
#pragma unroll
                for (int sec = 0; sec < 3; ++sec) { const int col = sec * 768 + hd * 128 + 2 * lane;
                    const unsigned w = *(const unsigned*)(h + (size_t)row * NHB + col); x[sec][3] = (f32x2){bflo(w), bfhi(w)};
                    const f32x2 a = wv[sec][0] * x[sec][0] + wv[sec][1] * x[sec][1] + wv[sec][2] * x[sec][2] + wv[sec][3] * x[sec][3];
                    val[sec][0] = silu_f(a[0]); val[sec][1] = silu_f(a[1]);
                    if (t >= T - 3) { float* op = p.out + (smp ? O_GCS : O_GCP) + (((size_t)j * (smp ? 128 : 8) + bb) * 3 + (t - (T - 3))) * 2304 + col; *(f32x2*)op = x[sec][3]; }
                    x[sec][0] = x[sec][1]; x[sec][1] = x[sec][2]; x[sec][2] = x[sec][3]; }
#pragma unroll
                for (int sec = 0; sec < 2; ++sec) { const float ss = wave_sum(val[sec][0] * val[sec][0] + val[sec][1] * val[sec][1]); const float rr = 1.f / sqrtf(ss + 1e-6f); val[sec][0] *= rr; val[sec][1] *= rr; }
#pragma unroll
                for (int sec = 0; sec < 3; ++sec) *(unsigned*)(qkvn + (size_t)row * 2304 + sec * 768 + hd * 128 + 2 * lane) = cvt_pk_bf16(val[sec][0], val[sec][1]);
                if (lane == 0) {
                    const float bv = bf1(h[(size_t)row * NHB + 3328 + hd]), av = bf1(h[(size_t)row * NHB + 3334 + hd]);
                    const float xx = av + dtb;
                    const float sp = fmaxf(xx, 0.f) + log1pf(__expf(-fabsf(xx)));
                    gb[(size_t)row * 12 + hd] = alog * sp;
                    gb[(size_t)row * 12 + 6 + hd] = 1.f / (1.f + __expf(-bv));
                }
            }
        }
    }
}

__device__ __forceinline__ void solve_lds(LAS float* sol, const LAS float* A, int lane) {
#pragma unroll 1
    for (int i = 1; i < 64; ++i) {
        float r0 = sol[i * 64 + lane], r1 = 0.f;
        const int n4 = (i + 3) >> 2;
#pragma unroll 2
        for (int j4 = 0; j4 < n4; ++j4) {
            const f32x4 a = *(const LAS f32x4*)(A + i * 64 + 4 * j4);
            const LAS float* sp = sol + (4 * j4) * 64 + lane;
            r0 -= a[0] * sp[0]; r1 -= a[1] * sp[64]; r0 -= a[2] * sp[128]; r1 -= a[3] * sp[192];
        }
        sol[i * 64 + lane] = r0 + r1;
    }
}
__device__ __forceinline__ void phase_gdn_prep(const Params& p, LAS unsigned char* lds) {
    const bf16_t* qkvn = (const bf16_t*)(p.ws + WS_QKVN); const float* gb = (const float*)(p.ws + WS_GB);
    bf16_t* Wc = (bf16_t*)(p.ws + WS_WC); bf16_t* QDc = (bf16_t*)(p.ws + WS_QDC); bf16_t* KDT = (bf16_t*)(p.ws + WS_KDT); bf16_t* QKc = (bf16_t*)(p.ws + WS_QKC);
    float* UT = (float*)(p.ws + WS_UT); float* GL = (float*)(p.ws + WS_GL);
    const int tid_ = otid(); const int lane0 = tid_ & 63, wave = __builtin_amdgcn_readfirstlane(tid_ >> 6);
    if (wave >= 4) return;
    const int gw = blockIdx.x * 4 + wave, NGW = gridDim.x * 4;
#pragma unroll 1
    for (int ci = gw; ci < 1536; ci += NGW) {
        int lane = lane0; unsigned aoff = (unsigned)wave * 32768u;
        asm volatile("" : "+v"(lane), "+v"(aoff));
        const int c16 = lane & 15, g = lane >> 4;
        LAS float* A = (LAS float*)(lds + aoff);
        const int n = ci & 31, hd = (ci >> 5) % 6, b = ci / 192;
        const int tok0 = b * 2048 + n * 64;
        const float gi = gb[(size_t)(tok0 + lane) * 12 + hd], beta = gb[(size_t)(tok0 + lane) * 12 + 6 + hd];
        float gc = gi;
#pragma unroll
        for (int o = 1; o < 64; o <<= 1) { const float tv = __shfl_up(gc, o); if (lane >= o) gc += tv; }
        const float gl = __shfl(gc, 63);
        const float egc = __expf(gc), edl = __expf(gl - gc);
        if (lane == 0) GL[ci] = __expf(gl);
        {
            bf16x8 kf[4][4];
#pragma unroll
            for (int t = 0; t < 4; ++t)
#pragma unroll
                for (int ks = 0; ks < 4; ++ks) kf[t][ks] = *(const bf16x8*)(qkvn + (size_t)(tok0 + 16 * t + c16) * 2304 + 768 + hd * 128 + 32 * ks + 8 * g);
#pragma unroll
            for (int it = 0; it < 4; ++it)
#pragma unroll
                for (int jt = 0; jt <= it; ++jt) {
                    f32x4 acc = (f32x4){0.f, 0.f, 0.f, 0.f};
#pragma unroll
                    for (int ks = 0; ks < 4; ++ks) acc = __builtin_amdgcn_mfma_f32_16x16x32_bf16(kf[it][ks], kf[jt][ks], acc, 0, 0, 0);
                    const int jj = 16 * jt + c16; const float gcj = __shfl(gc, jj);
#pragma unroll
                    for (int r = 0; r < 4; ++r) { const int ii = 16 * it + 4 * g + r; const float gci = __shfl(gc, ii), bi = __shfl(beta, ii);
                        A[ii * 64 + jj] = ii > jj ? bi * acc[r] * __expf(gci - gcj) : 0.f; }
                }
#pragma unroll
            for (int it = 0; it < 4; ++it) {
                bf16x8 qf[4];
#pragma unroll
                for (int ks = 0; ks < 4; ++ks) qf[ks] = *(const bf16x8*)(qkvn + (size_t)(tok0 + 16 * it + c16) * 2304 + hd * 128 + 32 * ks + 8 * g);
#pragma unroll
                for (int jt = 0; jt < 4; ++jt) {
                    f32x4 acc = (f32x4){0.f, 0.f, 0.f, 0.f};
                    if (jt <= it) {
#pragma unroll
                        for (int ks = 0; ks < 4; ++ks) acc = __builtin_amdgcn_mfma_f32_16x16x32_bf16(qf[ks], kf[jt][ks], acc, 0, 0, 0);
                    }
                    const int jj = 16 * jt + c16; const float gcj = __shfl(gc, jj);
                    const int pos = (jj & 32) + invperm32(jj & 31);
#pragma unroll
                    for (int r = 0; r < 4; ++r) { const int ii = 16 * it + 4 * g + r; const float gci = __shfl(gc, ii);
                        const float v = ii >= jj ? acc[r] * 0.08838834764831845f * __expf(gci - gcj) : 0.f;
                        QKc[(size_t)ci * 4096 + ii * 64 + pos] = (bf16_t)(cvt_pk_bf16(v, 0.f) & 0xffffu); }
                }
            }
        }
        asm volatile("s_waitcnt lgkmcnt(0)" ::: "memory");
        LAS float* sol = A + 4096;
#pragma unroll 1
        for (int pass = 0; pass < 4; ++pass) {
            const int half = pass & 1, isw = pass >> 1;
            const int c = lane + 64 * half; const int posc = (c & ~31) + invperm32(c & 31);
            const bf16_t* src = qkvn + (size_t)tok0 * 2304 + (isw ? 768 : 1536) + hd * 128 + c;
#pragma unroll 8
            for (int i = 0; i < 64; ++i) { float f = __shfl(beta, i); if (isw) f *= __shfl(egc, i); sol[i * 64 + lane] = bf1(src[(size_t)i * 2304]) * f; }
            asm volatile("s_waitcnt lgkmcnt(0)" ::: "memory");
            solve_lds(sol, A, lane);
            asm volatile("s_waitcnt lgkmcnt(0)" ::: "memory");
            if (!isw) { float* up = UT + (size_t)ci * 8192 + (size_t)c * 64;
#pragma unroll 4
                for (int i = 0; i < 64; i += 4) *(f32x4*)(up + i) = (f32x4){sol[i * 64 + lane], sol[(i + 1) * 64 + lane], sol[(i + 2) * 64 + lane], sol[(i + 3) * 64 + lane]}; }
            else {
#pragma unroll 8
                for (int i = 0; i < 64; ++i) Wc[(size_t)ci * 8192 + i * 128 + posc] = (bf16_t)(cvt_pk_bf16(sol[i * 64 + lane], 0.f) & 0xffffu); }
            asm volatile("s_waitcnt lgkmcnt(0)" ::: "memory");
        }
        const int c0 = 2 * lane; const int pos0 = (c0 & ~31) + invperm32(c0 & 31);
#pragma unroll 8
        for (int i = 0; i < 64; ++i) { const unsigned w = *(const unsigned*)(qkvn + (size_t)(tok0 + i) * 2304 + hd * 128 + 2 * lane);
            const float s = __shfl(egc, i) * 0.08838834764831845f;
            *(unsigned*)(QDc + (size_t)ci * 8192 + i * 128 + pos0) = cvt_pk_bf16(bflo(w) * s, bfhi(w) * s); }
        asm volatile("s_waitcnt lgkmcnt(0)" ::: "memory");
        {
            LAS bf16_t* kt = (LAS bf16_t*)A;
#pragma unroll 8
            for (int i = 0; i < 64; ++i) { const unsigned w = *(const unsigned*)(qkvn + (size_t)(tok0 + i) * 2304 + 768 + hd * 128 + 2 * lane);
                *(LAS unsigned*)(kt + i * 128 + 2 * lane) = w; }
            asm volatile("s_waitcnt lgkmcnt(0)" ::: "memory");
#pragma unroll
            for (int hh = 0; hh < 2; ++hh) { const int dk = lane + 64 * hh;
#pragma unroll
                for (int p8 = 0; p8 < 8; ++p8) { float v[8];
#pragma unroll
                    for (int e = 0; e < 8; ++e) { const int pp = p8 * 8 + e; const int c = (pp & 32) + perm32k(pp & 31);
                        v[e] = bf1(kt[c * 128 + dk]) * __uint_as_float((unsigned)__builtin_amdgcn_readlane((int)__float_as_uint(edl), c)); }
                    u32x4 w; w.x = cvt_pk_bf16(v[0], v[1]); w.y = cvt_pk_bf16(v[2], v[3]); w.z = cvt_pk_bf16(v[4], v[5]); w.w = cvt_pk_bf16(v[6], v[7]);
                    *(u32x4*)(KDT + (size_t)ci * 8192 + dk * 64 + p8 * 8) = w; } }
            asm volatile("s_waitcnt lgkmcnt(0)" ::: "memory");
        }
    }
}

constexpr int RB_W = 0, RB_QD = 17408, RB_KD = 34816, RB_QK = 34816 + 18432, RB_SZ = 62464;
__device__ __forceinline__ void rec_load(u32x4 (&r)[7], const bf16_t* Wc, const bf16_t* QDc, const bf16_t* KDT, const bf16_t* QKc, int ci, int tid) {
    r[0] = *(const u32x4*)(Wc + (size_t)ci * 8192 + (size_t)tid * 8); r[1] = *(const u32x4*)(Wc + (size_t)ci * 8192 + (size_t)(512 + tid) * 8);
    r[2] = *(const u32x4*)(QDc + (size_t)ci * 8192 + (size_t)tid * 8); r[3] = *(const u32x4*)(QDc + (size_t)ci * 8192 + (size_t)(512 + tid) * 8);
    r[4] = *(const u32x4*)(KDT + (size_t)ci * 8192 + (size_t)tid * 8); r[5] = *(const u32x4*)(KDT + (size_t)ci * 8192 + (size_t)(512 + tid) * 8);
    r[6] = *(const u32x4*)(QKc + (size_t)ci * 4096 + (size_t)tid * 8);
}
__device__ __forceinline__ void rec_store(const u32x4 (&r)[7], LAS unsigned char* buf, int tid) {
#pragma unroll
    for (int k = 0; k < 2; ++k) { const int q = tid + 512 * k;
        *(LAS u32x4*)(buf + RB_W + (q >> 4) * 272 + (q & 15) * 16) = r[k];
        *(LAS u32x4*)(buf + RB_QD + (q >> 4) * 272 + (q & 15) * 16) = r[2 + k];
        *(LAS u32x4*)(buf + RB_KD + (q >> 3) * 144 + (q & 7) * 16) = r[4 + k]; }
    *(LAS u32x4*)(buf + RB_QK + (tid >> 3) * 144 + (tid & 7) * 16) = r[6];
}
__device__ __forceinline__ void gdn_recur_prompt(const Params& p, LAS unsigned char* lds, int j, int bh, float* ob, float* gsbase) {
    const bf16_t* Wc = (const bf16_t*)(p.ws + WS_WC); const bf16_t* QDc = (const bf16_t*)(p.ws + WS_QDC); const bf16_t* KDT = (const bf16_t*)(p.ws + WS_KDT); const bf16_t* QKc = (const bf16_t*)(p.ws + WS_QKC);
    const float* UT = (const float*)(p.ws + WS_UT); const float* GL = (const float*)(p.ws + WS_GL);
    const int tid = otid(), lane = tid & 63, wave = __builtin_amdgcn_readfirstlane(tid >> 6), c16 = lane & 15, g = lane >> 4;
    const int b = bh / 6, hd = bh % 6, dv0 = wave * 16;
    f32x4 S[8];
#pragma unroll
    for (int i = 0; i < 8; ++i) S[i] = (f32x4){0.f, 0.f, 0.f, 0.f};
    u32x4 rg[7];
    rec_load(rg, Wc, QDc, KDT, QKc, bh * 32, tid);
    rec_store(rg, lds, tid);
    f32x4 un[4]; float egln;
#pragma unroll
    for (int ct = 0; ct < 4; ++ct) un[ct] = *(const f32x4*)(UT + (size_t)(bh * 32) * 8192 + (size_t)(dv0 + c16) * 64 + 16 * ct + 4 * g);
    egln = GL[bh * 32];
    __syncthreads();
#pragma unroll 1
    for (int n = 0; n < 32; ++n) {
        const int ci = bh * 32 + n;
        LAS unsigned char* buf = lds + (n & 1) * RB_SZ;
        if (n + 1 < 32) rec_load(rg, Wc, QDc, KDT, QKc, ci + 1, tid);
        f32x4 u[4];
#pragma unroll
        for (int ct = 0; ct < 4; ++ct) u[ct] = un[ct];
        const float egl = egln;
        { const int cn = (n + 1 < 32) ? ci + 1 : ci;
#pragma unroll
          for (int ct = 0; ct < 4; ++ct) un[ct] = *(const f32x4*)(UT + (size_t)cn * 8192 + (size_t)(dv0 + c16) * 64 + 16 * ct + 4 * g);
          egln = GL[cn]; }
        bf16x8 bS[4];
#pragma unroll
        for (int ks = 0; ks < 4; ++ks) bS[ks] = pack8(S[2 * ks], S[2 * ks + 1]);
        f32x4 vn[4], o[4];
#pragma unroll
        for (int ct = 0; ct < 4; ++ct) {
            f32x4 ws = (f32x4){0.f, 0.f, 0.f, 0.f}, oo = (f32x4){0.f, 0.f, 0.f, 0.f};
#pragma unroll
            for (int ks = 0; ks < 4; ++ks) {
                const bf16x8 wf = *(const LAS bf16x8*)(buf + RB_W + (16 * ct + c16) * 272 + ks * 64 + g * 16);
                const bf16x8 qf = *(const LAS bf16x8*)(buf + RB_QD + (16 * ct + c16) * 272 + ks * 64 + g * 16);
                ws = __builtin_amdgcn_mfma_f32_16x16x32_bf16(wf, bS[ks], ws, 0, 0, 0);
                oo = __builtin_amdgcn_mfma_f32_16x16x32_bf16(qf, bS[ks], oo, 0, 0, 0);
            }
            vn[ct] = u[ct] - ws; o[ct] = oo;
        }
        bf16x8 bV[2];
#pragma unroll
        for (int k2 = 0; k2 < 2; ++k2) bV[k2] = pack8(vn[2 * k2], vn[2 * k2 + 1]);
#pragma unroll
        for (int ct = 0; ct < 4; ++ct) {
#pragma unroll
            for (int k2 = 0; k2 < 2; ++k2) { const bf16x8 af = *(const LAS bf16x8*)(buf + RB_QK + (16 * ct + c16) * 144 + k2 * 64 + g * 16);
                o[ct] = __builtin_amdgcn_mfma_f32_16x16x32_bf16(af, bV[k2], o[ct], 0, 0, 0); }
#pragma unroll
            for (int r = 0; r < 4; ++r) ob[(size_t)(b * 2048 + n * 64 + 16 * ct + 4 * g + r) * 768 + hd * 128 + dv0 + c16] = o[ct][r];
        }
#pragma unroll
        for (int dt = 0; dt < 8; ++dt) { f32x4 s = S[dt] * egl;
#pragma unroll
            for (int k2 = 0; k2 < 2; ++k2) { const bf16x8 af = *(const LAS bf16x8*)(buf + RB_KD + (16 * dt + c16) * 144 + k2 * 64 + g * 16);
                s = __builtin_amdgcn_mfma_f32_16x16x32_bf16(af, bV[k2], s, 0, 0, 0); }
            S[dt] = s; }
        if (n + 1 < 32) rec_store(rg, lds + ((n + 1) & 1) * RB_SZ, tid);
        asm volatile("s_waitcnt lgkmcnt(0)" ::: "memory"); __builtin_amdgcn_s_barrier(); asm volatile("" ::: "memory");
    }
    float* so = gsbase + ((size_t)(j * 8 + b) * 6 + hd) * 16384;
#pragma unroll
    for (int dt = 0; dt < 8; ++dt)
#pragma unroll
        for (int r = 0; r < 4; ++r) so[(size_t)(16 * dt + 4 * g + r) * 128 + dv0 + c16] = S[dt][r];
}
__device__ __forceinline__ void gdn_naive_item(const Params& p, LAS unsigned char* lds, int row0, int T, int hd, const float* s0, float* sout) {
    const bf16_t* qkvn = (const bf16_t*)(p.ws + WS_QKVN); const float* gb = (const float*)(p.ws + WS_GB); float* ob = (float*)(p.ws + WS_O);
    const int tid = otid(), e = tid & 127, part = tid >> 7;
    LAS float* kq = (LAS float*)lds;
    LAS float* red = kq + 1024;
    LAS float* red2 = red + 512;
    float S[32];
#pragma unroll
    for (int i = 0; i < 32; ++i) S[i] = s0 ? s0[(size_t)(part * 32 + i) * 128 + e] : 0.f;
#pragma unroll 1
    for (int tb = 0; tb < T; tb += 4) {
        __syncthreads();
        for (int i = tid; i < 1024; i += 512) { const int t = i >> 8, s = (i >> 7) & 1, d = i & 127;
            kq[i] = bf1(qkvn[(size_t)(row0 + tb + t) * 2304 + (s == 0 ? 768 : 0) + hd * 128 + d]); }
        __syncthreads();
#pragma unroll 1
        for (int t = 0; t < 4; ++t) {
            const int row = row0 + tb + t;
            const float a = __expf(gb[(size_t)row * 12 + hd]), bt = gb[(size_t)row * 12 + 6 + hd];
            const float v = bf1(qkvn[(size_t)row * 2304 + 1536 + hd * 128 + e]);
            float ps = 0.f;
#pragma unroll
            for (int i = 0; i < 32; ++i) ps += S[i] * kq[(t * 2 + 0) * 128 + part * 32 + i];
            red[part * 128 + e] = ps;
            __syncthreads();
            const float kS = red[e] + red[128 + e] + red[256 + e] + red[384 + e];
            const float vnew = bt * (v - a * kS);
            float po = 0.f;
#pragma unroll
            for (int i = 0; i < 32; ++i) { S[i] = a * S[i] + kq[(t * 2 + 0) * 128 + part * 32 + i] * vnew; po += S[i] * kq[(t * 2 + 1) * 128 + part * 32 + i]; }
            red2[part * 128 + e] = po;
            __syncthreads();
            if (part == 0) ob[(size_t)row * 768 + hd * 128 + e] = (red2[e] + red2[128 + e] + red2[256 + e] + red2[384 + e]) * 0.08838834764831845f;
        }
    }
#pragma unroll
    for (int i = 0; i < 32; ++i) sout[(size_t)(part * 32 + i) * 128 + e] = S[i];
    __syncthreads();
}
__device__ __forceinline__ void gdn_sample_item(const Params& p, LAS unsigned char* lds, int j, int item) {
    const int sb = item / 6, hd = item % 6;
    gdn_naive_item(p, lds, TP + sb * 4, 4, hd, p.in[7] + ((size_t)(j * 128 + sb) * 6 + hd) * 16384, p.out + O_GSS + ((size_t)(j * 128 + sb) * 6 + hd) * 16384);
}
__device__ __forceinline__ void phase_gdn_post(const Params& p, int j) {
    const bf16_t* h = (const bf16_t*)(p.ws + WS_H); const float* ob = (const float*)(p.ws + WS_O); bf16_t* cat = (bf16_t*)(p.ws + WS_CAT);
    const int tid_ = otid(); const int lane = tid_ & 63, wave = __builtin_amdgcn_readfirstlane(tid_ >> 6);
    const int gw = blockIdx.x * 8 + wave, NGW = gridDim.x * 8;
    const f32x2 nw = *(const f32x2*)(p.in[16] + j * 128 + 2 * lane);
    for (int it = gw; it < TT * 6; it += NGW) {
        const int row = it / 6, hd = it % 6;
        const f32x2 o = *(const f32x2*)(ob + (size_t)row * 768 + hd * 128 + 2 * lane);
        const float ss = wave_sum(o[0] * o[0] + o[1] * o[1]);
        const float r = 1.f / sqrtf(ss * (1.f / 128.f) + 1e-6f);
        const unsigned zw = *(const unsigned*)(h + (size_t)row * NHB + 2304 + hd * 128 + 2 * lane);
        const float y0 = o[0] * r * nw[0] * silu_f(bflo(zw)), y1 = o[1] * r * nw[1] * silu_f(bfhi(zw));
        *(unsigned*)(cat + (size_t)row * DM + hd * 128 + 2 * lane) = cvt_pk_bf16(y0, y1);
    }
}


#ifdef DIAG_GDN
constexpr size_t WS_DBG = WS_END;
constexpr size_t WS_OB2 = WS_END + 4096;
constexpr size_t WS_GS2 = WS_OB2 + (size_t)TT * 768 * 4;
constexpr size_t WS_DIAG_END = WS_GS2 + (size_t)2 * 8 * 6 * 16384 * 4;
__device__ __forceinline__ void diag_compare(const Params& p, int j) {
    const float* ob = (const float*)(p.ws + WS_O); const float* ob2 = (const float*)(p.ws + WS_OB2);
    const float* gs = p.out + O_GSP + (size_t)j * 8 * 6 * 16384; const float* gs2 = (const float*)(p.ws + WS_GS2) + (size_t)j * 8 * 6 * 16384;
    float* dbg = (float*)(p.ws + WS_DBG);
    const size_t gt = (size_t)blockIdx.x * 512 + otid(), NT = (size_t)gridDim.x * 512;
    float n1 = 0.f, d1 = 0.f, n3 = 0.f, d3 = 0.f, n2 = 0.f, d2 = 0.f, n4 = 0.f, d4 = 0.f;
    for (size_t i = gt; i < (size_t)TP * 768; i += NT) { const int row = (int)(i / 768); const float a = ob[i], b = ob2[i]; const float e = (a - b) * (a - b);
        n3 += e; d3 += a * a; if ((row & 2047) < 64) { n1 += e; d1 += a * a; } else if ((row & 2047) < 128) { n4 += e; d4 += a * a; } }
    for (size_t i = gt; i < (size_t)8 * 6 * 16384; i += NT) { const float a = gs[i], b = gs2[i]; n2 += (a - b) * (a - b); d2 += a * a; }
    n1 = wave_sum(n1); d1 = wave_sum(d1); n2 = wave_sum(n2); d2 = wave_sum(d2); n3 = wave_sum(n3); d3 = wave_sum(d3); n4 = wave_sum(n4); d4 = wave_sum(d4);
    if ((otid() & 63) == 0) { atomicAdd(dbg + 0, n1); atomicAdd(dbg + 1, d1); atomicAdd(dbg + 2, n2); atomicAdd(dbg + 3, d2); atomicAdd(dbg + 4, n3); atomicAdd(dbg + 5, d3); atomicAdd(dbg + 6, n4); atomicAdd(dbg + 7, d4); }
}
__device__ __forceinline__ void diag_compare2(const Params& p) {
    const bf16_t* qkvn = (const bf16_t*)(p.ws + WS_QKVN); const float* gb = (const float*)(p.ws + WS_GB);
    const bf16_t* Wc = (const bf16_t*)(p.ws + WS_WC); const bf16_t* QDc = (const bf16_t*)(p.ws + WS_QDC); const bf16_t* KDT = (const bf16_t*)(p.ws + WS_KDT);
    float* dbg = (float*)(p.ws + WS_DBG);
    const int tid_ = otid(); const int lane = tid_ & 63, wave = __builtin_amdgcn_readfirstlane(tid_ >> 6);
    const int gw = blockIdx.x * 8 + wave, NGW = gridDim.x * 8;
    float n8 = 0.f, d8 = 0.f, n10 = 0.f, d10 = 0.f, n12 = 0.f, d12 = 0.f;
    for (int ci = gw; ci < 1536; ci += NGW) {
        const int n = ci & 31, hd = (ci >> 5) % 6, b = ci / 192; const int tok0 = b * 2048 + n * 64;
        float gcs = 0.f, mygc = 0.f;
        for (int t = 0; t < 64; ++t) { gcs += gb[(size_t)(tok0 + t) * 12 + hd]; if (t == lane) mygc = gcs; }
        const float gl = gcs;
        for (int c = 0; c < 128; ++c) { const int pos = (c & ~31) + invperm32(c & 31);
            const float qe = bf1(qkvn[(size_t)(tok0 + lane) * 2304 + hd * 128 + c]) * 0.08838834764831845f * __expf(mygc);
            const float qg = bf1(QDc[(size_t)ci * 8192 + lane * 128 + pos]); n8 += (qe - qg) * (qe - qg); d8 += qe * qe;
            const float ke = bf1(qkvn[(size_t)(tok0 + lane) * 2304 + 768 + hd * 128 + c]) * __expf(gl - mygc);
            const int posl = (lane & 32) + invperm32(lane & 31);
            const float kg = bf1(KDT[(size_t)ci * 8192 + c * 64 + posl]); n10 += (ke - kg) * (ke - kg); d10 += ke * ke; }
        { const float beta0 = gb[(size_t)tok0 * 12 + 6 + hd], g0 = gb[(size_t)tok0 * 12 + hd];
          for (int c = lane; c < 128; c += 64) { const int pos = (c & ~31) + invperm32(c & 31);
            const float we = bf1(qkvn[(size_t)tok0 * 2304 + 768 + hd * 128 + c]) * beta0 * __expf(g0);
            const float wg = bf1(Wc[(size_t)ci * 8192 + pos]); n12 += (we - wg) * (we - wg); d12 += we * we; } }
    }
    n8 = wave_sum(n8); d8 = wave_sum(d8); n10 = wave_sum(n10); d10 = wave_sum(d10); n12 = wave_sum(n12); d12 = wave_sum(d12);
    if (lane == 0) { atomicAdd(dbg + 8, n8); atomicAdd(dbg + 9, d8); atomicAdd(dbg + 10, n10); atomicAdd(dbg + 11, d10); atomicAdd(dbg + 12, n12); atomicAdd(dbg + 13, d12); }
}
__device__ __forceinline__ int diag_class(float n, float d) { const float r = n / (d + 1e-30f); return r < 4e-4f ? 0 : (r < 0.09f ? 1 : 2); }
#endif
#define XB_TMO      128
#define XB_XCNT(j)  (256  + 64 * (j))
#define XB_XSUB(j)  (1280 + 64 * (j))
#define XB_XGEN(j)  (2304 + 64 * (j))
#define XB_TOP      3328
#define XB_TOPGEN   3392
#define XCD_BAR_WORDS 3456
#define XB_SPIN_CAP (1u << 18)

__device__ __forceinline__ unsigned xb_ld(unsigned* p)              { return __hip_atomic_load(p, __ATOMIC_RELAXED, __HIP_MEMORY_SCOPE_AGENT); }
__device__ __forceinline__ unsigned xb_add(unsigned* p, unsigned v) { return __hip_atomic_fetch_add(p, v, __ATOMIC_RELAXED, __HIP_MEMORY_SCOPE_AGENT); }
__device__ __forceinline__ unsigned xb_xcc_id() { return (unsigned)__builtin_amdgcn_s_getreg((3 << 11) | 20) & 0xFu; }
#define XB_SPIN(cond, bar) do { unsigned _sp = 0; while (cond) { __builtin_amdgcn_s_sleep(1); \
    if ((++_sp & 255u) == 0u) { if (xb_ld(&(bar)[XB_TMO])) break; if (_sp > XB_SPIN_CAP) { atomicAdd(&(bar)[XB_TMO], 1u); break; } } } } while (0)

struct XcdBarrier {
    unsigned* bar; unsigned x;
    volatile LAS unsigned* st;
};

__device__ __forceinline__ XcdBarrier xcd_barrier_post(unsigned* bar, volatile LAS unsigned* st) {
    XcdBarrier b; b.bar = bar; b.x = xb_xcc_id(); b.st = st;
    if (threadIdx.x == 0) (void)xb_add(&bar[XB_XCNT(b.x)], 1u);
    return b;
}
__device__ __forceinline__ void xcd_barrier_complete(unsigned* bar, unsigned x, unsigned& nloc, unsigned& nx) {
    const unsigned G = gridDim.x * gridDim.y * gridDim.z;
    unsigned sum, cnt, mine, sp = 0u;
    for (;;) {
        sum = 0u; cnt = 0u; mine = 0u;
#pragma unroll
        for (unsigned j = 0; j < 16; ++j) { const unsigned c = xb_ld(&bar[XB_XCNT(j)]); sum += c; cnt += (c > 0u) ? 1u : 0u; mine = (j == x) ? c : mine; }
        if (sum == G) break;
        __builtin_amdgcn_s_sleep(1);
        if ((++sp & 255u) == 0u) { if (xb_ld(&bar[XB_TMO])) break; if (sp > XB_SPIN_CAP) { atomicAdd(&bar[XB_TMO], 1u); break; } }
    }
    nloc = mine > 0u ? mine : 1u; nx = cnt > 0u ? cnt : 1u;
}

__device__ __forceinline__ void xcd_barrier(const XcdBarrier& b) {
    asm volatile("s_waitcnt vmcnt(0)" ::: "memory");
    __syncthreads();
    if (threadIdx.x == 0) {
        unsigned* bar = b.bar;
        __builtin_amdgcn_s_waitcnt(0);
        unsigned nloc = b.st[0], nx = b.st[1];
        if (nloc == 0u) { xcd_barrier_complete(bar, b.x, nloc, nx); b.st[0] = nloc; b.st[1] = nx; }
        const unsigned old = xb_add(&bar[XB_XSUB(b.x)], 1u);
        const unsigned gen = old / nloc;
        if (old + 1u == (gen + 1u) * nloc) {
            __builtin_amdgcn_fence(__ATOMIC_RELEASE, "agent");
            asm volatile("s_waitcnt vmcnt(0)" ::: "memory");
            const unsigned og = xb_add(&bar[XB_TOP], 1u);
            const unsigned tg = og / nx;
            if (og + 1u == (tg + 1u) * nx) xb_add(&bar[XB_TOPGEN], 1u);
            else XB_SPIN(xb_ld(&bar[XB_TOPGEN]) == tg, bar);
            __builtin_amdgcn_fence(__ATOMIC_ACQUIRE, "agent");
            xb_add(&bar[XB_XGEN(b.x)], 1u);
            asm volatile("s_waitcnt vmcnt(0)" ::: "memory");
        } else {
            XB_SPIN(xb_ld(&bar[XB_XGEN(b.x)]) == gen, bar);
            __builtin_amdgcn_fence(__ATOMIC_ACQUIRE, "agent");
            asm volatile("s_waitcnt vmcnt(0)" ::: "memory");
        }
    }
    __syncthreads();
}


#ifdef EXP_SYNC2
#define GSYNC() do { xcd_barrier(xbar); xcd_barrier(xbar); } while (0)
#else
#define GSYNC() xcd_barrier(xbar)
#endif
#ifdef EXP_ELEM2
#define ELEM2(x) do { x; x; } while (0)
#else
#define ELEM2(x) do { x; } while (0)
#endif
#ifdef EXP_GEMM2
#define GEMM2(x) do { x; x; } while (0)
#else
#define GEMM2(x) do { x; } while (0)
#endif
#ifdef EXP_GDN2
#define GDN2(x) do { x; x; } while (0)
#else
#define GDN2(x) do { x; } while (0)
#endif
__global__ void __launch_bounds__(512, 2) fwd_megakernel(Params p) {
    extern __shared__ __attribute__((aligned(16))) unsigned char lds_raw[];
    LAS unsigned char* lds = (LAS unsigned char*)lds_raw;
    cg::grid_group grid = cg::this_grid();
    unsigned char* ws = p.ws;
    float* xf = (float*)(ws + WS_XF); bf16_t* xb = (bf16_t*)(ws + WS_XB);
    bf16_t* hbuf = (bf16_t*)(ws + WS_H); bf16_t* cat = (bf16_t*)(ws + WS_CAT);
    bf16_t* hu = (bf16_t*)(ws + WS_HU); bf16_t* gact = (bf16_t*)(ws + WS_GACT);
    const bf16_t* Kb = (const bf16_t*)(ws + WS_KB); const bf16_t* Vt = (const bf16_t*)(ws + WS_VT);
    const int bid = blockIdx.x, G = gridDim.x;
    volatile LAS unsigned* xst = (volatile LAS unsigned*)(lds + LDS_BYTES - 16);
    if (threadIdx.x < 4) xst[threadIdx.x] = 0u;
    __syncthreads();
    XcdBarrier xbar = xcd_barrier_post((unsigned*)(ws + WS_BAR), xst);

#ifdef DIAG_GDN
    if (bid == 0 && threadIdx.x < 64) ((float*)(ws + WS_DBG))[threadIdx.x] = 0.f;
#endif
#ifdef EXP_PREP2
    phase_prep(p, lds);
#endif
    phase_prep(p, lds);
    grid.sync();
    {
        EpiKV E{p.out + O_MK, p.out + O_MV, (bf16_t*)(ws + WS_KB), (bf16_t*)(ws + WS_VT)};
        run_gemm(lds, (const bf16_t*)(ws + WS_MEMB), (const bf16_t*)(ws + WS_WKV), 2048, 2048, DM, E, (bid + 64) % G);
    }
#pragma unroll 1
    for (int l = 0; l < 4; ++l) {
        const int j = l >> 1; const bool isB = (l & 1) != 0;
        if (!isB) {
            { EpiStoreBf16 E{hbuf, NHA}; GEMM2(run_gemm(lds, xb, (const bf16_t*)(ws + WS_WINA) + (size_t)j * NHA * DM, TT, NHA, DM, E, bid)); }
            GSYNC();
            ELEM2(phase_mixA_elem(p, j));
#ifdef NAIVE_ATTN
            for (int it = bid; it < 256; it += G) attn_prompt_item_naive(lds, hbuf, NHA, 2304, p.out + O_MK, p.out + O_MV, cat, l, it);
#else
            for (int it = bid; it < 256; it += G) attn_prompt_item(lds, hbuf, NHA, 2304, Kb, Vt, cat, l, it);
#endif
            for (int it = bid; it < 256; it += G) attn_sample_item(lds, hbuf, NHA, 2304, p.in[3], p.in[4], cat, l, it);
            GSYNC();
            { EpiResid E{xf, DM}; const bf16_t* W = (const bf16_t*)(ws + WS_WOUTA) + (size_t)j * DM * DM; small_gemm_resid(cat, W, DM, xf); run_gemm(lds, cat, W, TP, DM, DM, E, bid); }
        } else {
            { EpiStoreBf16 E{hbuf, NHB}; GEMM2(run_gemm(lds, xb, (const bf16_t*)(ws + WS_WINB) + (size_t)j * NHB * DM, TT, NHB, DM, E, bid)); }
            GSYNC();
            ELEM2(phase_gdn_pre(p, j));
            GSYNC();
#ifndef NAIVE_GDN
            GDN2(phase_gdn_prep(p, lds));
            GSYNC();
#endif
#ifdef NAIVE_GDN
            if (bid < 48) gdn_naive_item(p, lds, (bid / 6) * 2048, 2048, bid % 6, nullptr, p.out + O_GSP + ((size_t)(j * 8 + bid / 6) * 6 + bid % 6) * 16384);
#else
            if (bid < 48) { GDN2(gdn_recur_prompt(p, lds, j, bid, (float*)(ws + WS_O), p.out + O_GSP)); }
#endif
            else {
                const int nb = G - 48;
                for (int it = bid - 48; it < 768; it += nb) gdn_sample_item(p, lds, j, it);
#ifdef NAIVE_ATTN
                for (int it = bid - 48; it < 256; it += nb) attn_prompt_item_naive(lds, hbuf, NHB, 3072, p.out + O_MK, p.out + O_MV, cat, l, it);
#else
                for (int it = bid - 48; it < 256; it += nb) attn_prompt_item(lds, hbuf, NHB, 3072, Kb, Vt, cat, l, it);
#endif
                for (int it = bid - 48; it < 256; it += nb) attn_sample_item(lds, hbuf, NHB, 3072, p.in[3], p.in[4], cat, l, it);
            }
            GSYNC();
#ifdef DIAG_GDN
            if (l == 1) {
                phase_gdn_prep(p, lds);
                GSYNC();
                if (bid < 48) gdn_recur_prompt(p, lds, j, bid, (float*)(ws + WS_OB2), (float*)(ws + WS_GS2));
                GSYNC();
                diag_compare(p, j);
                diag_compare2(p);
                GSYNC();
            }
#endif
            ELEM2(phase_gdn_post(p, j));
            GSYNC();
            { EpiResid E{xf, DM}; const bf16_t* W = (const bf16_t*)(ws + WS_WOUTB) + (size_t)j * DM * DM; small_gemm_resid(cat, W, DM, xf); run_gemm(lds, cat, W, TP, DM, DM, E, bid); }
        }
        GSYNC();
#ifdef EXP_LN2
        phase_ln(xf, xb, p.in[19] + l * DM, p.in[20] + l * DM, (float*)(ws + WS_HU));
#endif
        phase_ln(xf, xb, p.in[19] + l * DM, p.in[20] + l * DM, nullptr);
        GSYNC();
        { EpiStoreBf16 E{hu, NUP}; GEMM2(run_gemm(lds, xb, (const bf16_t*)(ws + WS_WUP) + (size_t)l * NUP * DM, TT, NUP, DM, E, bid)); }
        GSYNC();
        ELEM2(phase_convgate(p, l));
        GSYNC();
        { EpiResid E{xf, DM}; const bf16_t* W = (const bf16_t*)(ws + WS_WDOWN) + (size_t)l * DM * DFF; small_gemm_resid(gact, W, DFF, xf); run_gemm(lds, gact, W, TP, DM, DFF, E, bid); }
        GSYNC();
#ifdef EXP_LN2
        phase_ln(xf, xb, p.in[21] + l * DM, p.in[22] + l * DM, (float*)(ws + WS_H));
#endif
        phase_ln(xf, xb, p.in[21] + l * DM, p.in[22] + l * DM, l == 3 ? p.out + O_Y : nullptr);
        if (l < 3) GSYNC();
    }
#ifdef DIAG_GDN
    GSYNC();
    if (bid == 0 && threadIdx.x == 0) { const float* dbg = (const float*)(ws + WS_DBG);
        const int code = 9 * diag_class(dbg[8], dbg[9]) + 3 * diag_class(dbg[10], dbg[11]) + diag_class(dbg[12], dbg[13]);
        float v = 1.0e4f; for (int i = 0; i < code; ++i) v *= 1.25f;
        p.out[0] = v; }
#endif
}

extern "C" void kernel_launch(void* const* d_in, const int* in_sizes, int n_in, void* d_out, int out_size, void* d_ws, size_t ws_size, hipStream_t stream) {
    static int grid_blocks = 0;
    if (grid_blocks == 0) {
        if (n_in != 26 || (size_t)out_size != O_END || ws_size < WS_TOTAL) { fprintf(stderr, "kernel_launch: unexpected shapes n_in %d out %d (want %zu) ws %zu (need %zu)\n", n_in, out_size, (size_t)O_END, ws_size, (size_t)WS_END); grid_blocks = -1; return; }
        int dev = 0, cus = 0, per_cu = 0;
        hipGetDevice(&dev);
        hipDeviceGetAttribute(&cus, hipDeviceAttributeMultiprocessorCount, dev);
        if (hipFuncSetAttribute((const void*)fwd_megakernel, hipFuncAttributeMaxDynamicSharedMemorySize, LDS_BYTES) != hipSuccess) { fprintf(stderr, "kernel_launch: hipFuncSetAttribute failed\n"); grid_blocks = -1; return; }
        hipOccupancyMaxActiveBlocksPerMultiprocessor(&per_cu, (const void*)fwd_megakernel, 512, LDS_BYTES);
        if (per_cu < 1) { fprintf(stderr, "kernel_launch: occupancy query says %d blocks/CU\n", per_cu); grid_blocks = -1; return; }
        grid_blocks = cus;
        if (grid_blocks > 256) grid_blocks = 256;
    }
    if (grid_blocks < 0) return;
    if (hipMemsetAsync((char*)d_ws + WS_BAR, 0, 16384, stream) != hipSuccess) { fprintf(stderr, "kernel_launch: memset of barrier words failed\n"); return; }
    Params p{};
    for (int i = 0; i < 26; ++i) p.in[i] = (const float*)d_in[i];
    p.out = (float*)d_out; p.ws = (unsigned char*)d_ws;
    void* args[] = {&p};
    hipError_t e = hipLaunchCooperativeKernel((const void*)fwd_megakernel, dim3(grid_blocks), dim3(512), args, LDS_BYTES, stream);
    if (e != hipSuccess) fprintf(stderr, "cooperative launch failed: %s (grid %d)\n", hipGetErrorString(e), grid_blocks);
}
```

```cpp
#include <hip/hip_runtime.h>
#include <hip/hip_cooperative_groups.h>
#include <cstdio>
namespace cg = cooperative_groups;
namespace pg8 {
#define PG8_LAS __attribute__((address_space(3)))
typedef unsigned short bf16_t;
typedef short bf16x8 __attribute__((ext_vector_type(8)));
typedef float f32x4 __attribute__((ext_vector_type(4)));
typedef unsigned u32x4 __attribute__((ext_vector_type(4)));
constexpr int BM = 256, BK = 64, HALF = 128, HTB = HALF * BK * 2  , STAGE_BYTES = 8 * HTB, NXCD = 8, WGM = 8;

__host__ __device__ __forceinline__ int lds_byte(int r, int c) { const int st = (r >> 4) * 2 + (c >> 5), rr = r & 15, cc = c & 31, ob = rr * 64 + cc * 2; return st * 1024 + (ob ^ (((ob >> 9) & 1) << 5)); }
__host__ __device__ __forceinline__ void stage_rc(int b, int& R, int& C) { const int st = b / 1024, sb = b % 1024, swz = sb ^ (((sb >> 9) & 1) << 5); R = (st >> 1) * 16 + swz / 64; C = (st & 1) * 32 + (swz % 64) / 2; }
__host__ __device__ __forceinline__ int perm32(int rho) { const int n = rho >> 4, i = rho & 15; return 8 * (i >> 2) + 4 * n + (i & 3); }

struct Unit { int pm, pn; };
struct Gemm { const bf16_t* A; const bf16_t* Bt; int M, N, K; };

struct StaticOrder {
    int nM, nN, nwg, G, c;
    __host__ __device__ void init(int M, int N, int G_, int c_) { nM = M / BM; nN = N / BM; nwg = nM * nN; G = G_; c = c_; }
    __host__ __device__ bool next(int i, Unit& u) const {
        const long L = (long)i * G + c; if (L >= nwg) return false;
        int wgid = (int)L; { const int q = nwg / NXCD, r = nwg % NXCD, xcd = wgid % NXCD, off = wgid / NXCD; wgid = (xcd < r ? xcd * (q + 1) : r * (q + 1) + (xcd - r) * q) + off; }
        const int nig = WGM * nN, gid = wgid / nig, fm = gid * WGM, gsz = (nM - fm) < WGM ? (nM - fm) : WGM;
        u.pm = fm + ((wgid % nig) % gsz); u.pn = (wgid % nig) / gsz; return true;
    }
    __device__ __forceinline__ void a_ready(const Unit&) const {}
    __device__ __forceinline__ void done(const Unit&) const {}
};
__device__ __forceinline__ unsigned cvt_pk_bf16(float lo, float hi) { unsigned r; asm volatile("v_cvt_pk_bf16_f32 %0, %1, %2" : "=v"(r) : "v"(lo), "v"(hi)); return r; }
typedef float f32x2cv __attribute__((ext_vector_type(2))); typedef __bf16 bf16x2cv __attribute__((ext_vector_type(2)));
__device__ __forceinline__ unsigned cvt_pk_safe(float lo, float hi) { const f32x2cv v = {lo, hi}; union { bf16x2cv b; unsigned u; } x; x.b = __builtin_convertvector(v, bf16x2cv); return x.u; }
typedef float f32x2 __attribute__((ext_vector_type(2)));
template <class Epi, class Sched, bool STAMP = false>
__device__ __forceinline__ void gemm_phase(PG8_LAS unsigned char* lds, const Gemm g, const Sched& S, const Epi& E, unsigned long long* stamps) {
    int tid = threadIdx.x; asm volatile("" : "+v"(tid)); const int wid = __builtin_amdgcn_readfirstlane(tid >> 6), lane = tid & 63, wr = wid >> 2, wc = wid & 3, fr = lane & 15, fq = lane >> 4;
    const int K = g.K, nt = K / BK;
    int ts_lo = 0, ts_hi = 0, nts = 0; const unsigned long long rt_entry = STAMP ? (unsigned long long)wall_clock64() : 0ull;
#define PG8_STAMP() do { if (STAMP && wid == 0 && nts < 64) { const unsigned long long _c = (unsigned long long)clock64(); \
        ts_lo = (lane == nts) ? (int)(unsigned)_c : ts_lo; ts_hi = (lane == nts) ? (int)(unsigned)(_c >> 32) : ts_hi; ++nts; } } while (0)
    PG8_STAMP();
    unsigned voffA[2], voffB[2];
#pragma unroll
    for (int i = 0; i < 2; ++i) { int R, C; stage_rc(tid * 16 + i * 8192, R, C); const int Rb = Epi::PERM ? ((R & ~31) + perm32(R & 31)) : R;
        voffA[i] = (unsigned)(R * K + C) * 2u; voffB[i] = (unsigned)(Rb * K + C) * 2u; }
    const size_t kstep = (size_t)(BK * 2);
    const size_t hstep = (size_t)HALF * K * 2;
    const size_t tstep = 2 * hstep;
    const unsigned ldsw = (unsigned)wid * 1024u;
    const int aoff = lds_byte(wr * 64 + fr, fq * 8), boff = lds_byte(wc * 32 + fr, fq * 8);
#define PG8_SA(b, h) (((b) * 2 + (h)) * HTB)
#define PG8_SB(b, h) ((4 + (b) * 2 + (h)) * HTB)
#define PG8_STAGE(bufoff, gbase, voff) do { _Pragma("unroll") for (int _i = 0; _i < 2; ++_i) \
        __builtin_amdgcn_global_load_lds((const unsigned*)((const char*)(gbase) + (voff)[_i]), (PG8_LAS unsigned*)(lds + (bufoff) + ldsw + _i * 8192), 16, 0, 0); } while (0)
#define PG8_LDA(dst, b, h) do { _Pragma("unroll") for (int m = 0; m < 4; ++m) _Pragma("unroll") for (int k = 0; k < 2; ++k) dst[m][k] = *(const PG8_LAS bf16x8*)(lds + PG8_SA(b, h) + aoff + m * 2048 + k * 1024); } while (0)
#define PG8_LDB(dst, b, h) do { _Pragma("unroll") for (int n = 0; n < 2; ++n) _Pragma("unroll") for (int k = 0; k < 2; ++k) dst[n][k] = *(const PG8_LAS bf16x8*)(lds + PG8_SB(b, h) + boff + n * 2048 + k * 1024); } while (0)
#define PG8_MMA(ai, bj, At, Bt) do { __builtin_amdgcn_s_setprio(1); _Pragma("unroll") for (int m = 0; m < 4; ++m) _Pragma("unroll") for (int n = 0; n < 2; ++n) _Pragma("unroll") for (int k = 0; k < 2; ++k) \
        acc[ai][bj][m][n] = __builtin_amdgcn_mfma_f32_16x16x32_bf16(Bt[n][k], At[m][k], acc[ai][bj][m][n], 0, 0, 0); __builtin_amdgcn_s_setprio(0); } while (0)
#define PG8_WAIT_V(n) asm volatile("s_waitcnt vmcnt(" #n ")" ::: "memory")
#define PG8_WAIT_L(n) asm volatile("s_waitcnt lgkmcnt(" #n ")" ::: "memory")
#define PG8_BAR __builtin_amdgcn_s_barrier()
#define PG8_SCHED __builtin_amdgcn_sched_barrier(0)
    Unit cur, nxt; int ui = 0;
    if (!S.next(0, cur)) return;
    f32x4 acc[2][2][4][2];
#pragma unroll
    for (int a = 0; a < 2; ++a)
#pragma unroll
        for (int b = 0; b < 2; ++b)
#pragma unroll
            for (int m = 0; m < 4; ++m)
#pragma unroll
                for (int n = 0; n < 2; ++n) acc[a][b][m][n] = (f32x4){0.f, 0.f, 0.f, 0.f};
    bf16x8 At[4][2], B0[2][2], B1[2][2];
    const char* cA = (const char*)g.A + (size_t)cur.pm * tstep; const char* cB = (const char*)g.Bt + (size_t)cur.pn * tstep;
    S.a_ready(cur);
    PG8_STAGE(PG8_SB(0, 0), cB, voffB); PG8_STAGE(PG8_SA(0, 0), cA, voffA); PG8_STAGE(PG8_SB(0, 1), cB + hstep, voffB); PG8_STAGE(PG8_SA(0, 1), cA + hstep, voffA);
    if (wr == 1) PG8_BAR;
    PG8_WAIT_V(4); PG8_BAR;
    PG8_STAGE(PG8_SB(1, 0), cB + kstep, voffB); PG8_STAGE(PG8_SA(1, 0), cA + kstep, voffA); PG8_STAGE(PG8_SB(1, 1), cB + hstep + kstep, voffB);
    PG8_WAIT_V(6); PG8_BAR;
    PG8_STAMP();
    for (;;) {
        const bool has_next = S.next(ui + 1, nxt);
        const char* nA = has_next ? (const char*)g.A + (size_t)nxt.pm * tstep : cA; const char* nB = has_next ? (const char*)g.Bt + (size_t)nxt.pn * tstep : cB;
        for (int t = 0; t < nt; t += 2) {
            const bool last = (t == nt - 2);
            const char* a1 = cA + (size_t)(t + 1) * kstep;
            const char* a2 = last ? nA : cA + (size_t)(t + 2) * kstep; const char* b2 = last ? nB : cB + (size_t)(t + 2) * kstep;
            const char* a3 = a2 + kstep; const char* b3 = b2 + kstep;
            if (last && has_next) S.a_ready(nxt);
            PG8_LDB(B0, 0, 0); PG8_SCHED; PG8_LDA(At, 0, 0); PG8_STAGE(PG8_SA(1, 1), a1 + hstep, voffA);
            PG8_WAIT_L(8); PG8_BAR; PG8_WAIT_L(0); PG8_MMA(0, 0, At, B0); PG8_BAR; PG8_SCHED;
            PG8_LDB(B1, 0, 1); PG8_STAGE(PG8_SB(0, 0), b2, voffB);
            PG8_BAR; PG8_WAIT_L(0); PG8_MMA(0, 1, At, B1); PG8_BAR;
            PG8_LDA(At, 0, 1); PG8_STAGE(PG8_SA(0, 0), a2, voffA);
            PG8_BAR; PG8_WAIT_L(0); PG8_MMA(1, 0, At, B0); PG8_BAR; PG8_SCHED;
            PG8_STAGE(PG8_SB(0, 1), b2 + hstep, voffB);
            PG8_WAIT_V(6); PG8_BAR; PG8_MMA(1, 1, At, B1); PG8_BAR;
            PG8_LDB(B0, 1, 0); PG8_SCHED; PG8_LDA(At, 1, 0); PG8_STAGE(PG8_SA(0, 1), a2 + hstep, voffA);
            PG8_WAIT_L(8); PG8_BAR; PG8_WAIT_L(0); PG8_MMA(0, 0, At, B0); PG8_BAR; PG8_SCHED;
            PG8_LDB(B1, 1, 1); PG8_STAGE(PG8_SB(1, 0), b3, voffB);
            PG8_BAR; PG8_WAIT_L(0); PG8_MMA(0, 1, At, B1); PG8_BAR;
            PG8_LDA(At, 1, 1); PG8_STAGE(PG8_SA(1, 0), a3, voffA);
            PG8_BAR; PG8_WAIT_L(0); PG8_MMA(1, 0, At, B0); PG8_BAR; PG8_SCHED;
            PG8_STAGE(PG8_SB(1, 1), b3 + hstep, voffB);
            PG8_WAIT_V(6); PG8_BAR; PG8_MMA(1, 1, At, B1); PG8_BAR;
        }
        PG8_STAMP();
        if constexpr (!Epi::AFTER_DRAIN) { E(acc, cur, wr, wc, fr, fq); S.done(cur); }
        PG8_STAMP();
        if (!has_next) break;
#pragma unroll
        for (int a = 0; a < 2; ++a)
#pragma unroll
            for (int b = 0; b < 2; ++b)
#pragma unroll
                for (int m = 0; m < 4; ++m)
#pragma unroll
                    for (int n = 0; n < 2; ++n) acc[a][b][m][n] = (f32x4){0.f, 0.f, 0.f, 0.f};
        cur = nxt; cA = nA; cB = nB; ++ui;
    }
    PG8_WAIT_V(0);
    if (wr == 0) PG8_BAR;
    PG8_BAR;
    if constexpr (Epi::AFTER_DRAIN) { E.fused(acc, cur, wr, wc, fr, fq, lds, wid, lane); S.done(cur); }
    PG8_STAMP();
    if (STAMP && wid == 0) { stamps[lane] = lane < nts ? (((unsigned long long)(unsigned)ts_hi << 32) | (unsigned)ts_lo) : 0ull;
        if (lane == 62) stamps[62] = rt_entry; if (lane == 63) stamps[63] = (unsigned long long)wall_clock64(); }
#undef PG8_STAMP
#undef PG8_SA
#undef PG8_SB
#undef PG8_STAGE
#undef PG8_LDA
#undef PG8_LDB
#undef PG8_MMA
#undef PG8_WAIT_V
#undef PG8_WAIT_L
#undef PG8_BAR
#undef PG8_SCHED
}
}

#define LAS __attribute__((address_space(3)))
using pg8::bf16_t; using pg8::bf16x8; using pg8::f32x4; using pg8::u32x4; using pg8::cvt_pk_bf16;
typedef unsigned u32x2 __attribute__((ext_vector_type(2)));
typedef float f32x2 __attribute__((ext_vector_type(2)));

constexpr int TP = 16384, TS = 512, TT = 16896, DM = 1024;
constexpr int NHA = 2560, NHB = 3584, DFF = 2816, NUP = 5632;
constexpr float ALPHA = 1.6817928305074292f;
constexpr int LDS_BYTES = 139264;

constexpr size_t WS_WINA = 0;
constexpr size_t WS_WOUTA = WS_WINA + (size_t)2 * NHA * DM * 2;
constexpr size_t WS_WINB = WS_WOUTA + (size_t)2 * DM * DM * 2;
constexpr size_t WS_WOUTB = WS_WINB + (size_t)2 * NHB * DM * 2;
constexpr size_t WS_WKV = WS_WOUTB + (size_t)2 * DM * DM * 2;
constexpr size_t WS_WUP = WS_WKV + (size_t)2048 * DM * 2;
constexpr size_t WS_WDOWN = WS_WUP + (size_t)4 * NUP * DM * 2;
constexpr size_t WS_XF = WS_WDOWN + (size_t)4 * DM * DFF * 2;
constexpr size_t WS_XB = WS_XF + (size_t)TT * DM * 4;
constexpr size_t WS_MEMB = WS_XB + (size_t)TT * DM * 2;
constexpr size_t WS_KB = WS_MEMB + (size_t)2048 * DM * 2;
constexpr size_t WS_VT = WS_KB + (size_t)4 * 8 * 4 * 256 * 64 * 2;
constexpr size_t WS_R = WS_VT + (size_t)4 * 8 * 4 * 256 * 64 * 2;
constexpr size_t WS_H = WS_R;
constexpr size_t WS_CAT = WS_H + (size_t)TT * NHB * 2;
constexpr size_t WS_QKVN = WS_CAT + (size_t)TT * DM * 2;
constexpr size_t WS_GB = WS_QKVN + (size_t)TT * 2304 * 2;
constexpr size_t WS_WC = WS_GB + (size_t)TT * 12 * 4;
constexpr size_t WS_QDC = WS_WC + (size_t)1536 * 16384;
constexpr size_t WS_KDT = WS_QDC + (size_t)1536 * 16384;
constexpr size_t WS_QKC = WS_KDT + (size_t)1536 * 16384;
constexpr size_t WS_UT = WS_QKC + (size_t)1536 * 8192;
constexpr size_t WS_GL = WS_UT + (size_t)1536 * 32768;
constexpr size_t WS_O = WS_GL + (size_t)1536 * 4 + 2048;
constexpr size_t WS_MIX_END = WS_O + (size_t)TT * 768 * 4;
constexpr size_t WS_KT = WS_CAT;
constexpr size_t WS_VTC = WS_XB;
static_assert((size_t)1536 * 16384 <= (size_t)TT * DM * 2, "KT/VT must fit");
constexpr size_t WS_HU = WS_R;
constexpr size_t WS_GACT = WS_HU + (size_t)TT * NUP * 2;
constexpr size_t WS_FFN_END = WS_GACT + (size_t)TT * DFF * 2;
constexpr size_t WS_END = WS_MIX_END > WS_FFN_END ? WS_MIX_END : WS_FFN_END;

constexpr size_t O_Y = 0;
constexpr size_t O_MK = O_Y + (size_t)TT * DM;
constexpr size_t O_MV = O_MK + (size_t)4 * 8 * 256 * 256;
constexpr size_t O_SCP = O_MV + (size_t)4 * 8 * 256 * 256;
constexpr size_t O_GCP = O_SCP + (size_t)2 * 8 * 2 * 768;
constexpr size_t O_GSP = O_GCP + (size_t)2 * 8 * 3 * 2304;
constexpr size_t O_FFP = O_GSP + (size_t)2 * 8 * 6 * 16384;
constexpr size_t O_SCS = O_FFP + (size_t)4 * 8 * 2 * NUP;
constexpr size_t O_GCS = O_SCS + (size_t)2 * 128 * 2 * 768;
constexpr size_t O_GSS = O_GCS + (size_t)2 * 128 * 3 * 2304;
constexpr size_t O_FFS = O_GSS + (size_t)2 * 128 * 6 * 16384;
constexpr size_t O_END = O_FFS + (size_t)4 * 128 * 2 * NUP;

#ifdef DIAG_GDN
constexpr size_t WS_NEED = WS_END + ((size_t)64 << 20);
#else
constexpr size_t WS_NEED = WS_END;
#endif
constexpr size_t WS_BAR = (WS_NEED + 255) / 256 * 256;
constexpr size_t WS_TOTAL = WS_BAR + 16384;
struct Params { const float* in[26]; float* out; unsigned char* ws; };
__device__ __forceinline__ int otid() { int t = threadIdx.x; asm volatile("" : "+v"(t)); return t; }

__device__ __forceinline__ float bflo(unsigned w) { return __uint_as_float(w << 16); }
__device__ __forceinline__ float bfhi(unsigned w) { return __uint_as_float(w & 0xffff0000u); }
__device__ __forceinline__ float bf1(bf16_t v) { return __uint_as_float((unsigned)v << 16); }
__device__ __forceinline__ float silu_f(float x) { return x / (1.f + __expf(-x)); }
__device__ __forceinline__ float wave_sum(float v) {
#pragma unroll
    for (int o = 1; o < 64; o <<= 1) v += __shfl_xor(v, o);
    return v;
}
__device__ __forceinline__ bf16x8 as_bf16x8(u32x4 v) { union { u32x4 u; bf16x8 b; } x; x.u = v; return x.b; }
__device__ __forceinline__ bf16x8 pack8(f32x4 a, f32x4 b) {
    u32x4 w; w.x = cvt_pk_bf16(a[0], a[1]); w.y = cvt_pk_bf16(a[2], a[3]); w.z = cvt_pk_bf16(b[0], b[1]); w.w = cvt_pk_bf16(b[2], b[3]);
    return as_bf16x8(w);
}
__device__ __forceinline__ int invperm32(int a) { return 8 * ((a & 15) >> 2) + (a & 3) + ((a >> 4) << 2); }
__device__ __forceinline__ int perm32k(int p) { const int g = p >> 3, jj = p & 7; return jj < 4 ? 4 * g + jj : 16 + 4 * g + (jj - 4); }

struct EpiStoreBf16 {
    static constexpr bool PERM = true, AFTER_DRAIN = false;
    bf16_t* O; int ldc;
    __device__ __forceinline__ void operator()(const f32x4 (&acc)[2][2][4][2], const pg8::Unit& u, int wr, int wc, int fr, int fq) const {
        const int row0 = u.pm * 256 + wr * 64 + fr, col0 = u.pn * 256 + wc * 32 + 8 * fq;
#pragma unroll
        for (int ai = 0; ai < 2; ++ai)
#pragma unroll
            for (int m = 0; m < 4; ++m) { bf16_t* rowp = O + (size_t)(row0 + ai * 128 + m * 16) * ldc + col0;
#pragma unroll
                for (int bj = 0; bj < 2; ++bj) { const f32x4 v0 = acc[ai][bj][m][0], v1 = acc[ai][bj][m][1];
                    u32x4 w; w.x = cvt_pk_bf16(v0[0], v0[1]); w.y = cvt_pk_bf16(v0[2], v0[3]); w.z = cvt_pk_bf16(v1[0], v1[1]); w.w = cvt_pk_bf16(v1[2], v1[3]);
                    *(u32x4*)(rowp + bj * 128) = w; } }
    }
};
struct EpiResid {
    static constexpr bool PERM = false, AFTER_DRAIN = false;
    float* X; int ldc;
    __device__ __forceinline__ void operator()(const f32x4 (&acc)[2][2][4][2], const pg8::Unit& u, int wr, int wc, int fr, int fq) const {
        const int row0 = u.pm * 256 + wr * 64 + fr, col0 = u.pn * 256 + wc * 32 + 4 * fq;
#pragma unroll
        for (int ai = 0; ai < 2; ++ai)
#pragma unroll
            for (int m = 0; m < 4; ++m) { float* rowp = X + (size_t)(row0 + ai * 128 + m * 16) * ldc + col0;
#pragma unroll
                for (int bj = 0; bj < 2; ++bj)
#pragma unroll
                    for (int n = 0; n < 2; ++n) { f32x4* p = (f32x4*)(rowp + bj * 128 + n * 16); const f32x4 x = *p; *p = x * ALPHA + acc[ai][bj][m][n]; } }
    }
};
struct EpiKV {
    static constexpr bool PERM = false, AFTER_DRAIN = false;
    float* outK; float* outV; bf16_t* Kb; bf16_t* Vt;
    __device__ __forceinline__ void operator()(const f32x4 (&acc)[2][2][4][2], const pg8::Unit& u, int wr, int wc, int fr, int fq) const {
        const int row0 = u.pm * 256 + wr * 64 + fr, col0 = u.pn * 256 + wc * 32 + 4 * fq;
#pragma unroll
        for (int ai = 0; ai < 2; ++ai)
#pragma unroll
            for (int m = 0; m < 4; ++m) { const int row = row0 + ai * 128 + m * 16; const int b = row >> 8, mm = row & 255;
#pragma unroll
                for (int bj = 0; bj < 2; ++bj)
#pragma unroll
                    for (int n = 0; n < 2; ++n) { const int col = col0 + bj * 128 + n * 16; const int l = col >> 9, e = col & 511; const f32x4 v = acc[ai][bj][m][n];
                        if (e < 256) { *(f32x4*)(outK + ((size_t)((l * 8 + b) * 256 + mm)) * 256 + e) = v;
                            u32x2 w; w.x = cvt_pk_bf16(v[0], v[1]); w.y = cvt_pk_bf16(v[2], v[3]);
                            *(u32x2*)(Kb + ((size_t)(((l * 8 + b) * 4 + (e >> 6)) * 256 + mm)) * 64 + (e & 63)) = w; }
                        else { const int e2 = e - 256; *(f32x4*)(outV + ((size_t)((l * 8 + b) * 256 + mm)) * 256 + e2) = v;
                            const unsigned w0 = cvt_pk_bf16(v[0], v[1]), w1 = cvt_pk_bf16(v[2], v[3]);
                            bf16_t* vp = Vt + ((size_t)(((l * 8 + b) * 4 + (e2 >> 6)) * 64 + (e2 & 63))) * 256 + mm;
                            vp[0] = (bf16_t)(w0 & 0xffffu); vp[256] = (bf16_t)(w0 >> 16); vp[512] = (bf16_t)(w1 & 0xffffu); vp[768] = (bf16_t)(w1 >> 16); } } }
    }
};

template <class Epi>
__device__ __forceinline__ void run_gemm(LAS unsigned char* lds, const bf16_t* A, const bf16_t* Bt, int M, int N, int K, const Epi& E, int c) {
    pg8::Gemm g{A, Bt, M, N, K}; pg8::StaticOrder S; S.init(M, N, (int)gridDim.x, c);
    pg8::gemm_phase<Epi, pg8::StaticOrder, false>(lds, g, S, E, nullptr);
}


__device__ __forceinline__ void small_gemm_resid(const bf16_t* A, const bf16_t* Bt, int K, float* X) {
    const int tid_ = otid(); const int lane = tid_ & 63, wave = __builtin_amdgcn_readfirstlane(tid_ >> 6), c16 = lane & 15, g = lane >> 4;
    const int gw = blockIdx.x * 8 + wave, NGW = gridDim.x * 8;
    for (int tile = gw; tile < 2048; tile += NGW) {
        const int rt = tile >> 6, ct = tile & 63;
        const bf16_t* ap = A + (size_t)(TP + rt * 16 + c16) * K + 8 * g;
        const bf16_t* bp = Bt + (size_t)(ct * 16 + c16) * K + 8 * g;
        f32x4 acc = (f32x4){0.f, 0.f, 0.f, 0.f};
#pragma unroll 1
        for (int k = 0; k < K; k += 256) {
            bf16x8 a[8], b[8];
#pragma unroll
            for (int s2 = 0; s2 < 8; ++s2) { a[s2] = *(const bf16x8*)(ap + k + 32 * s2); b[s2] = *(const bf16x8*)(bp + k + 32 * s2); }
#pragma unroll
            for (int s2 = 0; s2 < 8; ++s2) acc = __builtin_amdgcn_mfma_f32_16x16x32_bf16(b[s2], a[s2], acc, 0, 0, 0);
        }
        f32x4* px = (f32x4*)(X + (size_t)(TP + rt * 16 + c16) * DM + ct * 16 + 4 * g);
        const f32x4 x = *px; *px = x * ALPHA + acc;
    }
}
__device__ __forceinline__ void p0_transpose_item(const float* W, int K, int Ns, int Nd, bool remap, bf16_t* WT, LAS float* scr, int item, int lane) {
    const int nblk = Nd / 32, kb = item / nblk, nb = item % nblk, k0 = 64 * kb, n0 = 32 * nb;
    const int n = n0 + (lane & 31); int sn = n;
    if (remap) sn = n < 3072 ? n : (n < 3328 ? n + 12 : (n < 3340 ? n - 256 : -1));
#pragma unroll 8
    for (int i = 0; i < 32; ++i) { const int kk = 2 * i + (lane >> 5); scr[kk * 33 + (lane & 31)] = sn >= 0 ? W[(size_t)(k0 + kk) * Ns + sn] : 0.f; }
    asm volatile("s_waitcnt lgkmcnt(0)" ::: "memory");
    const int c = lane & 7;
#pragma unroll
    for (int j = 0; j < 4; ++j) { const int nn = (lane >> 3) + 8 * j; const LAS float* s = scr + (8 * c) * 33 + nn;
        u32x4 o; o.x = cvt_pk_bf16(s[0 * 33], s[1 * 33]); o.y = cvt_pk_bf16(s[2 * 33], s[3 * 33]); o.z = cvt_pk_bf16(s[4 * 33], s[5 * 33]); o.w = cvt_pk_bf16(s[6 * 33], s[7 * 33]);
        *(u32x4*)(WT + (size_t)(n0 + nn) * K + k0 + 8 * c) = o; }
    asm volatile("s_waitcnt lgkmcnt(0)" ::: "memory");
}

__device__ __forceinline__ void phase_prep(const Params& p, LAS unsigned char* lds) {
    const int tid = otid(), lane = tid & 63, wave = __builtin_amdgcn_readfirstlane(tid >> 6);
    const int gw = blockIdx.x * 8 + wave, NGW = gridDim.x * 8;
    LAS float* scr = (LAS float*)(lds + wave * 16384);
    unsigned char* ws = p.ws;
    constexpr int I_INA = 16 * 80, I_OUT = 16 * 32, I_INB = 16 * 112, I_KV = 16 * 16, I_UP = 16 * 176, I_DN = 44 * 32;
    constexpr int NIT = 2 * I_INA + 2 * I_OUT + 2 * I_INB + 2 * I_OUT + 4 * I_KV + 4 * I_UP + 4 * I_DN;
    for (int it = gw; it < NIT; it += NGW) {
        int r = it;
        if (r < 2 * I_INA) { const int l = r / I_INA; r -= l * I_INA; p0_transpose_item(p.in[9] + (size_t)l * DM * NHA, DM, NHA, NHA, false, (bf16_t*)(ws + WS_WINA) + (size_t)l * NHA * DM, scr, r, lane); continue; } r -= 2 * I_INA;
        if (r < 2 * I_OUT) { const int l = r / I_OUT; r -= l * I_OUT; p0_transpose_item(p.in[11] + (size_t)l * DM * DM, DM, DM, DM, false, (bf16_t*)(ws + WS_WOUTA) + (size_t)l * DM * DM, scr, r, lane); continue; } r -= 2 * I_OUT;
        if (r < 2 * I_INB) { const int l = r / I_INB; r -= l * I_INB; p0_transpose_item(p.in[12] + (size_t)l * DM * 3340, DM, 3340, NHB, true, (bf16_t*)(ws + WS_WINB) + (size_t)l * NHB * DM, scr, r, lane); continue; } r -= 2 * I_INB;
        if (r < 2 * I_OUT) { const int l = r / I_OUT; r -= l * I_OUT; p0_transpose_item(p.in[17] + (size_t)l * DM * DM, DM, DM, DM, false, (bf16_t*)(ws + WS_WOUTB) + (size_t)l * DM * DM, scr, r, lane); continue; } r -= 2 * I_OUT;
        if (r < 4 * I_KV) { const int l = r / I_KV; r -= l * I_KV; p0_transpose_item(p.in[18] + (size_t)l * DM * 512, DM, 512, 512, false, (bf16_t*)(ws + WS_WKV) + (size_t)l * 512 * DM, scr, r, lane); continue; } r -= 4 * I_KV;
        if (r < 4 * I_UP) { const int l = r / I_UP; r -= l * I_UP; p0_transpose_item(p.in[23] + (size_t)l * DM * NUP, DM, NUP, NUP, false, (bf16_t*)(ws + WS_WUP) + (size_t)l * NUP * DM, scr, r, lane); continue; } r -= 4 * I_UP;
        { const int l = r / I_DN; r -= l * I_DN; p0_transpose_item(p.in[25] + (size_t)l * DFF * DM, DFF, DM, DM, false, (bf16_t*)(ws + WS_WDOWN) + (size_t)l * DM * DFF, scr, r, lane); }
    }
    const size_t gt = (size_t)blockIdx.x * 512 + tid, NT = (size_t)gridDim.x * 512;
    float* xf = (float*)(ws + WS_XF); bf16_t* xb = (bf16_t*)(ws + WS_XB); bf16_t* memb = (bf16_t*)(ws + WS_MEMB);
    for (size_t i = gt; i < (size_t)TT * 256; i += NT) {
        const f32x4 v = i < (size_t)TP * 256 ? ((const f32x4*)p.in[0])[i] : ((const f32x4*)p.in[1])[i - (size_t)TP * 256];
        ((f32x4*)xf)[i] = v; u32x2 w; w.x = cvt_pk_bf16(v[0], v[1]); w.y = cvt_pk_bf16(v[2], v[3]); ((u32x2*)xb)[i] = w;
    }
    for (size_t i = gt; i < (size_t)2048 * 256; i += NT) {
        const f32x4 v = ((const f32x4*)p.in[2])[i]; u32x2 w; w.x = cvt_pk_bf16(v[0], v[1]); w.y = cvt_pk_bf16(v[2], v[3]); ((u32x2*)memb)[i] = w;
    }
}

__device__ __forceinline__ void phase_ln(float* xf, bf16_t* xb, const float* gam, const float* bet, float* yout) {
    const int tid_ = otid(); const int lane = tid_ & 63, wave = __builtin_amdgcn_readfirstlane(tid_ >> 6);
    const int gw = blockIdx.x * 8 + wave, NGW = gridDim.x * 8;
    f32x4 gg[4], bb[4];
#pragma unroll
    for (int j = 0; j < 4; ++j) { gg[j] = ((const f32x4*)gam)[lane + 64 * j]; bb[j] = ((const f32x4*)bet)[lane + 64 * j]; }
    for (int row = gw; row < TT; row += NGW) {
        f32x4* xr = (f32x4*)(xf + (size_t)row * DM) + lane;
        f32x4 v[4]; float s = 0.f;
#pragma unroll
        for (int j = 0; j < 4; ++j) { v[j] = xr[64 * j]; s += (v[j][0] + v[j][1]) + (v[j][2] + v[j][3]); }
        const float mean = wave_sum(s) * (1.f / DM); float s2 = 0.f;
#pragma unroll
        for (int j = 0; j < 4; ++j) { v[j] = v[j] - mean; s2 += (v[j][0] * v[j][0] + v[j][1] * v[j][1]) + (v[j][2] * v[j][2] + v[j][3] * v[j][3]); }
        const float rstd = 1.f / sqrtf(wave_sum(s2) * (1.f / DM) + 1e-5f);
#pragma unroll
        for (int j = 0; j < 4; ++j) { const f32x4 o = v[j] * rstd * gg[j] + bb[j];
            if (yout) ((f32x4*)(yout + (size_t)row * DM))[lane + 64 * j] = o;
            else { xr[64 * j] = o; u32x2 w; w.x = cvt_pk_bf16(o[0], o[1]); w.y = cvt_pk_bf16(o[2], o[3]); ((u32x2*)(xb + (size_t)row * DM))[lane + 64 * j] = w; } }
    }
}

__device__ __forceinline__ void attn_prompt_item(LAS unsigned char* lds, const bf16_t* h, int ldh, int qoff, const bf16_t* Kb, const bf16_t* Vt, bf16_t* cat, int layer, int item) {
    const int tid = otid(), lane = tid & 63, wave = __builtin_amdgcn_readfirstlane(tid >> 6), c16 = lane & 15, g = lane >> 4;
    const int qc = item & 7, hd = (item >> 3) & 3, b = item >> 5;
    const size_t kvbase = ((size_t)((layer * 8 + b) * 4 + hd)) * 16384;
    constexpr int VOFF = 256 * 144;
#pragma unroll
    for (int i = 0; i < 4; ++i) { const int q = tid + 512 * i;
        const u32x4 kv = *(const u32x4*)(Kb + kvbase + (size_t)q * 8); *(LAS u32x4*)(lds + (q >> 3) * 144 + (q & 7) * 16) = kv;
        const u32x4 vv = *(const u32x4*)(Vt + kvbase + (size_t)q * 8); *(LAS u32x4*)(lds + VOFF + (q >> 5) * 528 + (q & 31) * 16) = vv; }
    __syncthreads();
#pragma unroll 1
    for (int qt = wave; qt < 16; qt += 8) {
        const int row = b * 2048 + qc * 256 + qt * 16 + c16;
        const bf16_t* qp = h + (size_t)row * ldh + qoff + hd * 64 + g * 8;
        const bf16x8 qf0 = *(const bf16x8*)qp, qf1 = *(const bf16x8*)(qp + 32);
        f32x4 acc[16];
#pragma unroll
        for (int kt = 0; kt < 16; ++kt) { acc[kt] = (f32x4){0.f, 0.f, 0.f, 0.f};
            const LAS unsigned char* kp = lds + (16 * kt + c16) * 144 + g * 16;
            const bf16x8 k0 = *(const LAS bf16x8*)kp, k1 = *(const LAS bf16x8*)(kp + 64);
            acc[kt] = __builtin_amdgcn_mfma_f32_16x16x32_bf16(k0, qf0, acc[kt], 0, 0, 0);
            acc[kt] = __builtin_amdgcn_mfma_f32_16x16x32_bf16(k1, qf1, acc[kt], 0, 0, 0); }
        float mx = -3.0e38f;
#pragma unroll
        for (int kt = 0; kt < 16; ++kt) mx = fmaxf(mx, fmaxf(fmaxf(acc[kt][0], acc[kt][1]), fmaxf(acc[kt][2], acc[kt][3])));
        mx = fmaxf(mx, __shfl_xor(mx, 16)); mx = fmaxf(mx, __shfl_xor(mx, 32));
        const float sc = 0.125f * 1.44269504089f; float sum = 0.f;
#pragma unroll
        for (int kt = 0; kt < 16; ++kt)
#pragma unroll
            for (int r = 0; r < 4; ++r) { const float e = __builtin_amdgcn_exp2f((acc[kt][r] - mx) * sc); acc[kt][r] = e; sum += e; }
        sum += __shfl_xor(sum, 16); sum += __shfl_xor(sum, 32);
        const float inv = 1.f / sum;
        f32x4 o[4];
#pragma unroll
        for (int dt = 0; dt < 4; ++dt) o[dt] = (f32x4){0.f, 0.f, 0.f, 0.f};
#pragma unroll
        for (int s = 0; s < 8; ++s) { const bf16x8 pf = pack8(acc[2 * s], acc[2 * s + 1]);
#pragma unroll
            for (int dt = 0; dt < 4; ++dt) { const LAS unsigned char* vp = lds + VOFF + (16 * dt + c16) * 528 + (32 * s + 4 * g) * 2;
                const u32x2 a0 = *(const LAS u32x2*)vp, a1 = *(const LAS u32x2*)(vp + 32);
                u32x4 av; av.x = a0.x; av.y = a0.y; av.z = a1.x; av.w = a1.y;
                o[dt] = __builtin_amdgcn_mfma_f32_16x16x32_bf16(as_bf16x8(av), pf, o[dt], 0, 0, 0); } }
#pragma unroll
        for (int dt = 0; dt < 4; ++dt) { u32x2 w; w.x = cvt_pk_bf16(o[dt][0] * inv, o[dt][1] * inv); w.y = cvt_pk_bf16(o[dt][2] * inv, o[dt][3] * inv);
            *(u32x2*)(cat + (size_t)row * DM + 768 + hd * 64 + 16 * dt + 4 * g) = w; }
    }
    __syncthreads();
}

__device__ __forceinline__ void attn_prompt_item_naive(LAS unsigned char* lds, const bf16_t* h, int ldh, int qoff, const float* outK, const float* outV, bf16_t* cat, int layer, int item) {
    const int tid = otid();
    const int qc = item & 7, hd = (item >> 3) & 3, b = item >> 5;
    LAS float* Ks = (LAS float*)lds; LAS float* Vs = Ks + 256 * 64;
    for (int i = tid; i < 256 * 64; i += 512) { const int m = i >> 6, d = i & 63; const size_t src = ((size_t)((layer * 8 + b) * 256 + m)) * 256 + hd * 64 + d; Ks[i] = outK[src]; Vs[i] = outV[src]; }
    __syncthreads();
    const int ql = tid & 255, half = tid >> 8;
    const int row = b * 2048 + qc * 256 + ql;
    float q[64];
#pragma unroll
    for (int d = 0; d < 64; ++d) q[d] = bf1(h[(size_t)row * ldh + qoff + hd * 64 + d]);
    float mx = -3.0e38f, l = 0.f; float acc[64];
#pragma unroll
    for (int d = 0; d < 64; ++d) acc[d] = 0.f;
#pragma unroll 1
    for (int m = half * 128; m < half * 128 + 128; ++m) {
        float sdot = 0.f;
#pragma unroll
        for (int d = 0; d < 64; ++d) sdot += q[d] * Ks[m * 64 + d];
        sdot *= 0.125f;
        const float nm = fmaxf(mx, sdot); const float corr = __expf(mx - nm), pe = __expf(sdot - nm);
        l = l * corr + pe;
#pragma unroll
        for (int d = 0; d < 64; ++d) acc[d] = acc[d] * corr + pe * Vs[m * 64 + d];
        mx = nm;
    }
    __syncthreads();
    LAS float* ex = (LAS float*)lds;
    if (half == 1) { ex[ql * 66 + 64] = mx; ex[ql * 66 + 65] = l;
#pragma unroll
        for (int d = 0; d < 64; ++d) ex[ql * 66 + d] = acc[d]; }
    __syncthreads();
    if (half == 0) { const float m2 = ex[ql * 66 + 64], l2 = ex[ql * 66 + 65]; const float nm = fmaxf(mx, m2); const float c1 = __expf(mx - nm), c2 = __expf(m2 - nm); const float inv = 1.f / (l * c1 + l2 * c2);
#pragma unroll
        for (int d = 0; d < 64; ++d) { const float o = (acc[d] * c1 + ex[ql * 66 + d] * c2) * inv; cat[(size_t)row * DM + 768 + hd * 64 + d] = (bf16_t)(cvt_pk_bf16(o, 0.f) & 0xffffu); } }
    __syncthreads();
}
__device__ __forceinline__ void attn_sample_item(LAS unsigned char* lds, const bf16_t* h, int ldh, int qoff, const float* ck, const float* cv, bf16_t* cat, int layer, int item) {
    const int tid = otid(), lane = tid & 63, wave = __builtin_amdgcn_readfirstlane(tid >> 6);
    const int hp = item & 1, sb = item >> 1;
    LAS float* qs = (LAS float*)lds;
    LAS float* scs = qs + 512;
    LAS float* red = scs + 2048;
    { const int t = tid >> 7, hh = (tid >> 6) & 1, d = tid & 63;
      qs[tid] = bf1(h[(size_t)(TP + sb * 4 + t) * ldh + qoff + (2 * hp + hh) * 64 + d]); }
    __syncthreads();
    { const int m = tid & 255, hh = tid >> 8;
      const f32x4* kp = (const f32x4*)(ck + (((size_t)(layer * 128 + sb) * 256 + m) * 4 + (2 * hp + hh)) * 64);
      float a0 = 0.f, a1 = 0.f, a2 = 0.f, a3 = 0.f;
#pragma unroll
      for (int i = 0; i < 16; ++i) { const f32x4 kv = kp[i];
#pragma unroll
          for (int e = 0; e < 4; ++e) { const int d = 4 * i + e; a0 += kv[e] * qs[(0 * 2 + hh) * 64 + d]; a1 += kv[e] * qs[(1 * 2 + hh) * 64 + d]; a2 += kv[e] * qs[(2 * 2 + hh) * 64 + d]; a3 += kv[e] * qs[(3 * 2 + hh) * 64 + d]; } }
      scs[(0 * 2 + hh) * 256 + m] = a0 * 0.125f; scs[(1 * 2 + hh) * 256 + m] = a1 * 0.125f; scs[(2 * 2 + hh) * 256 + m] = a2 * 0.125f; scs[(3 * 2 + hh) * 256 + m] = a3 * 0.125f; }
    __syncthreads();
    { LAS float* sp = scs + wave * 256; float v[4]; float mx = -3.0e38f;
#pragma unroll
      for (int i = 0; i < 4; ++i) { v[i] = sp[lane + 64 * i]; mx = fmaxf(mx, v[i]); }
#pragma unroll
      for (int o = 1; o < 64; o <<= 1) mx = fmaxf(mx, __shfl_xor(mx, o));
      float s = 0.f;
#pragma unroll
      for (int i = 0; i < 4; ++i) { v[i] = __expf(v[i] - mx); s += v[i]; }
      s = wave_sum(s); const float inv = 1.f / s;
#pragma unroll
      for (int i = 0; i < 4; ++i) sp[lane + 64 * i] = v[i] * inv; }
    __syncthreads();
    { const int d = tid & 63, hh = (tid >> 6) & 1, mp = tid >> 7;
      float a0 = 0.f, a1 = 0.f, a2 = 0.f, a3 = 0.f;
      const float* vp = cv + (((size_t)(layer * 128 + sb) * 256 + mp * 64) * 4 + (2 * hp + hh)) * 64 + d;
#pragma unroll 8
      for (int m = 0; m < 64; ++m) { const float vv = vp[(size_t)m * 256]; const int mm = mp * 64 + m;
          a0 += scs[(0 * 2 + hh) * 256 + mm] * vv; a1 += scs[(1 * 2 + hh) * 256 + mm] * vv; a2 += scs[(2 * 2 + hh) * 256 + mm] * vv; a3 += scs[(3 * 2 + hh) * 256 + mm] * vv; }
      red[(mp * 8 + 0 * 2 + hh) * 64 + d] = a0; red[(mp * 8 + 1 * 2 + hh) * 64 + d] = a1; red[(mp * 8 + 2 * 2 + hh) * 64 + d] = a2; red[(mp * 8 + 3 * 2 + hh) * 64 + d] = a3; }
    __syncthreads();
    { const int t = tid >> 7, hh = (tid >> 6) & 1, d = tid & 63; const int idx = (t * 2 + hh) * 64 + d;
      const float o = red[idx] + red[512 + idx] + red[1024 + idx] + red[1536 + idx];
      cat[(size_t)(TP + sb * 4 + t) * DM + 768 + (2 * hp + hh) * 64 + d] = (bf16_t)(cvt_pk_bf16(o, 0.f) & 0xffffu); }
    __syncthreads();
}

__device__ __forceinline__ void load_u8(const bf16_t* h, size_t row, int c, float* u) {
    const u32x4 xi = *(const u32x4*)(h + row * NHA + c), cg = *(const u32x4*)(h + row * NHA + 1536 + c);
#pragma unroll
    for (int i = 0; i < 4; ++i) { u[2 * i] = bflo(xi[i]) * bflo(cg[i]); u[2 * i + 1] = bfhi(xi[i]) * bfhi(cg[i]); }
}
__device__ __forceinline__ void load_f8(const float* src, float* v) {
    const f32x4 a = ((const f32x4*)src)[0], b = ((const f32x4*)src)[1];
#pragma unroll
    for (int i = 0; i < 4; ++i) { v[i] = a[i]; v[4 + i] = b[i]; }
}
__device__ __forceinline__ void phase_mixA_elem(const Params& p, int j) {
    const bf16_t* h = (const bf16_t*)(p.ws + WS_H); bf16_t* cat = (bf16_t*)(p.ws + WS_CAT);
    const float* cw = p.in[10] + (size_t)j * 3 * 768; const float* hist = p.in[5] + (size_t)j * 128 * 2 * 768;
    const int gt = blockIdx.x * 512 + otid(), NT = gridDim.x * 512;
    constexpr int RB = 4, NPB = TP / RB, NIT = (NPB + 128) * 96;
    for (int it = gt; it < NIT; it += NT) {
        const int blk = it / 96, c = (it % 96) * 8;
        const bool smp = blk >= NPB; const int row0 = smp ? TP + (blk - NPB) * 4 : blk * RB; const int t0 = smp ? 0 : (row0 & 2047); const int bb = smp ? blk - NPB : (row0 >> 11);
        float w0[8], w1[8], w2[8];
        load_f8(cw + c, w0); load_f8(cw + 768 + c, w1); load_f8(cw + 1536 + c, w2);
        float u0[8], u1[8], u2[8];
        if (t0 >= 2) { load_u8(h, row0 - 2, c, u0); load_u8(h, row0 - 1, c, u1); }
        else if (smp) { load_f8(hist + ((size_t)bb * 2 + 0) * 768 + c, u0); load_f8(hist + ((size_t)bb * 2 + 1) * 768 + c, u1); }
        else {
#pragma unroll
            for (int i = 0; i < 8; ++i) { u0[i] = 0.f; u1[i] = 0.f; } }
        const int T = smp ? 4 : 2048;
#pragma unroll
        for (int r = 0; r < RB; ++r) {
            const size_t row = (size_t)row0 + r;
            load_u8(h, row, c, u2);
            const u32x4 bg = *(const u32x4*)(h + row * NHA + 768 + c);
            float y[8];
#pragma unroll
            for (int i = 0; i < 8; ++i) { const float bgv = (i & 1) ? bfhi(bg[i >> 1]) : bflo(bg[i >> 1]); y[i] = bgv * (w0[i] * u0[i] + w1[i] * u1[i] + w2[i] * u2[i]); }
            u32x4 w; w.x = cvt_pk_bf16(y[0], y[1]); w.y = cvt_pk_bf16(y[2], y[3]); w.z = cvt_pk_bf16(y[4], y[5]); w.w = cvt_pk_bf16(y[6], y[7]);
            *(u32x4*)(cat + row * DM + c) = w;
            const int t = t0 + r;
            if (t >= T - 2) { float* op = p.out + (smp ? O_SCS : O_SCP) + (((size_t)j * (smp ? 128 : 8) + bb) * 2 + (t - (T - 2))) * 768 + c;
                ((f32x4*)op)[0] = (f32x4){u2[0], u2[1], u2[2], u2[3]}; ((f32x4*)op)[1] = (f32x4){u2[4], u2[5], u2[6], u2[7]}; }
#pragma unroll
            for (int i = 0; i < 8; ++i) { u0[i] = u1[i]; u1[i] = u2[i]; }
        }
    }
}

__device__ __forceinline__ void load_h8(const bf16_t* hu, size_t row, int c, float* v) {
    const u32x4 x = *(const u32x4*)(hu + row * NUP + c);
#pragma unroll
    for (int i = 0; i < 4; ++i) { v[2 * i] = bflo(x[i]); v[2 * i + 1] = bfhi(x[i]); }
}
__device__ __forceinline__ void phase_convgate(const Params& p, int l) {
    const bf16_t* hu = (const bf16_t*)(p.ws + WS_HU); bf16_t* gact = (bf16_t*)(p.ws + WS_GACT);
    const float* cw = p.in[24] + (size_t)l * 3 * NUP; const float* hist = p.in[8] + (size_t)l * 128 * 2 * NUP;
    const int gt = blockIdx.x * 512 + otid(), NT = gridDim.x * 512;
    constexpr int RB = 8, NPB = TP / RB, NIT = (NPB + 128) * 352;
    for (int it = gt; it < NIT; it += NT) {
        const int blk = it / 352, c = (it % 352) * 8;
        const bool smp = blk >= NPB; const int row0 = smp ? TP + (blk - NPB) * 4 : blk * RB; const int t0 = smp ? 0 : (row0 & 2047); const int bb = smp ? blk - NPB : (row0 >> 11);
        const int nr = smp ? 4 : RB; const int T = smp ? 4 : 2048;
        float wg0[8], wg1[8], wg2[8], wu0[8], wu1[8], wu2[8];
        load_f8(cw + c, wg0); load_f8(cw + NUP + c, wg1); load_f8(cw + 2 * NUP + c, wg2);
        load_f8(cw + DFF + c, wu0); load_f8(cw + NUP + DFF + c, wu1); load_f8(cw + 2 * NUP + DFF + c, wu2);
        float g0[8], g1[8], g2[8], a0[8], a1[8], a2[8];
        if (t0 >= 2) { load_h8(hu, row0 - 2, c, g0); load_h8(hu, row0 - 1, c, g1); load_h8(hu, row0 - 2, c + DFF, a0); load_h8(hu, row0 - 1, c + DFF, a1); }
        else if (smp) { load_f8(hist + ((size_t)bb * 2 + 0) * NUP + c, g0); load_f8(hist + ((size_t)bb * 2 + 1) * NUP + c, g1); load_f8(hist + ((size_t)bb * 2 + 0) * NUP + DFF + c, a0); load_f8(hist + ((size_t)bb * 2 + 1) * NUP + DFF + c, a1); }
        else {
#pragma unroll
            for (int i = 0; i < 8; ++i) { g0[i] = 0.f; g1[i] = 0.f; a0[i] = 0.f; a1[i] = 0.f; } }
#pragma unroll
        for (int r = 0; r < RB; ++r) {
            if (r < nr) {
                const size_t row = (size_t)row0 + r;
                load_h8(hu, row, c, g2); load_h8(hu, row, c + DFF, a2);
                float y[8];
#pragma unroll
                for (int i = 0; i < 8; ++i) { const float gg = wg0[i] * g0[i] + wg1[i] * g1[i] + wg2[i] * g2[i], uu = wu0[i] * a0[i] + wu1[i] * a1[i] + wu2[i] * a2[i]; y[i] = silu_f(gg) * uu; }
                u32x4 w; w.x = cvt_pk_bf16(y[0], y[1]); w.y = cvt_pk_bf16(y[2], y[3]); w.z = cvt_pk_bf16(y[4], y[5]); w.w = cvt_pk_bf16(y[6], y[7]);
                *(u32x4*)(gact + row * DFF + c) = w;
                const int t = t0 + r;
                if (t >= T - 2) { float* op = p.out + (smp ? O_FFS : O_FFP) + (((size_t)l * (smp ? 128 : 8) + bb) * 2 + (t - (T - 2))) * NUP + c;
                    ((f32x4*)op)[0] = (f32x4){g2[0], g2[1], g2[2], g2[3]}; ((f32x4*)op)[1] = (f32x4){g2[4], g2[5], g2[6], g2[7]};
                    ((f32x4*)(op + DFF))[0] = (f32x4){a2[0], a2[1], a2[2], a2[3]}; ((f32x4*)(op + DFF))[1] = (f32x4){a2[4], a2[5], a2[6], a2[7]}; }
#pragma unroll
                for (int i = 0; i < 8; ++i) { g0[i] = g1[i]; g1[i] = g2[i]; a0[i] = a1[i]; a1[i] = a2[i]; }
            }
        }
    }
}

__device__ __forceinline__ void phase_gdn_pre(const Params& p, int j) {
    const bf16_t* h = (const bf16_t*)(p.ws + WS_H); bf16_t* qkvn = (bf16_t*)(p.ws + WS_QKVN); float* gb = (float*)(p.ws + WS_GB);
    const float* cw = p.in[13] + (size_t)j * 4 * 2304; const float* hist = p.in[6] + (size_t)j * 128 * 3 * 2304;
    const int tid_ = otid(); const int lane = tid_ & 63, wave = __builtin_amdgcn_readfirstlane(tid_ >> 6);
    const int gw = blockIdx.x * 8 + wave, NGW = gridDim.x * 8;
    constexpr int RB = 8, NPB = TP / RB, NIT = (NPB + 128) * 6;
    for (int it = gw; it < NIT; it += NGW) {
        const int blk = it / 6, hd = it % 6;
        const bool smp = blk >= NPB; const int row0 = smp ? TP + (blk - NPB) * 4 : blk * RB; const int t0 = smp ? 0 : (row0 & 2047); const int bb = smp ? blk - NPB : (row0 >> 11);
        const int nr = smp ? 4 : RB; const int T = smp ? 4 : 2048;
        const float alog = -__expf(p.in[14][j * 6 + hd]), dtb = p.in[15][j * 6 + hd];
        f32x2 wv[3][4], x[3][4];
        float tk0[RB], tk1[RB], tv0[RB], tv1[RB];
#pragma unroll
        for (int r = 0; r < RB; ++r) { tk0[r] = 0.f; tk1[r] = 0.f; tv0[r] = 0.f; tv1[r] = 0.f; }
#pragma unroll
        for (int sec = 0; sec < 3; ++sec) { const int col = sec * 768 + hd * 128 + 2 * lane;
#pragma unroll
            for (int k = 0; k < 4; ++k) wv[sec][k] = *(const f32x2*)(cw + (size_t)k * 2304 + col);
#pragma unroll
            for (int k = 0; k < 3; ++k) {
                if (t0 >= 3) { const unsigned w = *(const unsigned*)(h + (size_t)(row0 - 3 + k) * NHB + col); x[sec][k] = (f32x2){bflo(w), bfhi(w)}; }
                else if (smp) x[sec][k] = *(const f32x2*)(hist + ((size_t)bb * 3 + k) * 2304 + col);
                else x[sec][k] = (f32x2){0.f, 0.f}; } }
#pragma unroll
        for (int r = 0; r < RB; ++r) {
            if (r < nr) {
                const int row = row0 + r, t = t0 + r;
                float val[3][2];
#pragma unroll
                for (int sec = 0; sec < 3; ++sec) { const int col = sec * 768 + hd * 128 + 2 * lane;
                    const unsigned w = *(const unsigned*)(h + (size_t)row * NHB + col); x[sec][3] = (f32x2){bflo(w), bfhi(w)};
                    const f32x2 a = wv[sec][0] * x[sec][0] + wv[sec][1] * x[sec][1] + wv[sec][2] * x[sec][2] + wv[sec][3] * x[sec][3];
                    val[sec][0] = silu_f(a[0]); val[sec][1] = silu_f(a[1]);
                    if (t >= T - 3) { float* op = p.out + (smp ? O_GCS : O_GCP) + (((size_t)j * (smp ? 128 : 8) + bb) * 3 + (t - (T - 3))) * 2304 + col; *(f32x2*)op = x[sec][3]; }
                    x[sec][0] = x[sec][1]; x[sec][1] = x[sec][2]; x[sec][2] = x[sec][3]; }
#pragma unroll
                for (int sec = 0; sec < 2; ++sec) { const float ss = wave_sum(val[sec][0] * val[sec][0] + val[sec][1] * val[sec][1]); const float rr = 1.f / sqrtf(ss + 1e-6f); val[sec][0] *= rr; val[sec][1] *= rr; }
#pragma unroll
                for (int sec = 0; sec < 3; ++sec) *(unsigned*)(qkvn + (size_t)row * 2304 + sec * 768 + hd * 128 + 2 * lane) = cvt_pk_bf16(val[sec][0], val[sec][1]);
                tk0[r] = val[1][0]; tk1[r] = val[1][1]; tv0[r] = val[2][0]; tv1[r] = val[2][1];
                if (lane == 0) {
                    const float bv = bf1(h[(size_t)row * NHB + 3328 + hd]), av = bf1(h[(size_t)row * NHB + 3334 + hd]);
                    const float xx = av + dtb;
                    const float sp = fmaxf(xx, 0.f) + log1pf(__expf(-fabsf(xx)));
                    gb[(size_t)row * 12 + hd] = alog * sp;
                    gb[(size_t)row * 12 + 6 + hd] = 1.f / (1.f + __expf(-bv));
                }
            }
        }
        if (!smp) {
            const int ci = (bb * 6 + hd) * 32 + (t0 >> 6), off = t0 & 63;
            bf16_t* kt = (bf16_t*)(p.ws + WS_KT) + (size_t)ci * 8192 + (size_t)(2 * lane) * 64 + off;
            bf16_t* vt = (bf16_t*)(p.ws + WS_VTC) + (size_t)ci * 8192 + (size_t)(2 * lane) * 64 + off;
            u32x4 w;
            w.x = cvt_pk_bf16(tk0[0], tk0[1]); w.y = cvt_pk_bf16(tk0[2], tk0[3]); w.z = cvt_pk_bf16(tk0[4], tk0[5]); w.w = cvt_pk_bf16(tk0[6], tk0[7]); *(u32x4*)kt = w;
            w.x = cvt_pk_bf16(tk1[0], tk1[1]); w.y = cvt_pk_bf16(tk1[2], tk1[3]); w.z = cvt_pk_bf16(tk1[4], tk1[5]); w.w = cvt_pk_bf16(tk1[6], tk1[7]); *(u32x4*)(kt + 64) = w;
            w.x = cvt_pk_bf16(tv0[0], tv0[1]); w.y = cvt_pk_bf16(tv0[2], tv0[3]); w.z = cvt_pk_bf16(tv0[4], tv0[5]); w.w = cvt_pk_bf16(tv0[6], tv0[7]); *(u32x4*)vt = w;
            w.x = cvt_pk_bf16(tv1[0], tv1[1]); w.y = cvt_pk_bf16(tv1[2], tv1[3]); w.z = cvt_pk_bf16(tv1[4], tv1[5]); w.w = cvt_pk_bf16(tv1[6], tv1[7]); *(u32x4*)(vt + 64) = w;
        }
    }
}

#ifdef OLD_PREP
__device__ __forceinline__ void solve_lds(LAS float* sol, const LAS float* A, int lane) {
#pragma unroll 1
    for (int i = 1; i < 64; ++i) {
        float r0 = sol[i * 64 + lane], r1 = 0.f;
        const int n4 = (i + 3) >> 2;
#pragma unroll 2
        for (int j4 = 0; j4 < n4; ++j4) {
            const f32x4 a = *(const LAS f32x4*)(A + i * 64 + 4 * j4);
            const LAS float* sp = sol + (4 * j4) * 64 + lane;
            r0 -= a[0] * sp[0]; r1 -= a[1] * sp[64]; r0 -= a[2] * sp[128]; r1 -= a[3] * sp[192];
        }
        sol[i * 64 + lane] = r0 + r1;
    }
}
__device__ __forceinline__ void phase_gdn_prep(const Params& p, LAS unsigned char* lds) {
    const bf16_t* qkvn = (const bf16_t*)(p.ws + WS_QKVN); const float* gb = (const float*)(p.ws + WS_GB);
    bf16_t* Wc = (bf16_t*)(p.ws + WS_WC); bf16_t* QDc = (bf16_t*)(p.ws + WS_QDC); bf16_t* KDT = (bf16_t*)(p.ws + WS_KDT); bf16_t* QKc = (bf16_t*)(p.ws + WS_QKC);
    float* UT = (float*)(p.ws + WS_UT); float* GL = (float*)(p.ws + WS_GL);
    const int tid_ = otid(); const int lane0 = tid_ & 63, wave = __builtin_amdgcn_readfirstlane(tid_ >> 6);
    if (wave >= 4) return;
    const int gw = blockIdx.x * 4 + wave, NGW = gridDim.x * 4;
#pragma unroll 1
    for (int ci = gw; ci < 1536; ci += NGW) {
        int lane = lane0; unsigned aoff = (unsigned)wave * 32768u;
        asm volatile("" : "+v"(lane), "+v"(aoff));
        const int c16 = lane & 15, g = lane >> 4;
        LAS float* A = (LAS float*)(lds + aoff);
        const int n = ci & 31, hd = (ci >> 5) % 6, b = ci / 192;
        const int tok0 = b * 2048 + n * 64;
        const float gi = gb[(size_t)(tok0 + lane) * 12 + hd], beta = gb[(size_t)(tok0 + lane) * 12 + 6 + hd];
        float gc = gi;
#pragma unroll
        for (int o = 1; o < 64; o <<= 1) { const float tv = __shfl_up(gc, o); if (lane >= o) gc += tv; }
        const float gl = __shfl(gc, 63);
        const float egc = __expf(gc), edl = __expf(gl - gc);
        if (lane == 0) GL[ci] = __expf(gl);
        {
            bf16x8 kf[4][4];
#pragma unroll
            for (int t = 0; t < 4; ++t)
#pragma unroll
                for (int ks = 0; ks < 4; ++ks) kf[t][ks] = *(const bf16x8*)(qkvn + (size_t)(tok0 + 16 * t + c16) * 2304 + 768 + hd * 128 + 32 * ks + 8 * g);
#pragma unroll
            for (int it = 0; it < 4; ++it)
#pragma unroll
                for (int jt = 0; jt <= it; ++jt) {
                    f32x4 acc = (f32x4){0.f, 0.f, 0.f, 0.f};
#pragma unroll
                    for (int ks = 0; ks < 4; ++ks) acc = __builtin_amdgcn_mfma_f32_16x16x32_bf16(kf[it][ks], kf[jt][ks], acc, 0, 0, 0);
                    const int jj = 16 * jt + c16; const float gcj = __shfl(gc, jj);
#pragma unroll
                    for (int r = 0; r < 4; ++r) { const int ii = 16 * it + 4 * g + r; const float gci = __shfl(gc, ii), bi = __shfl(beta, ii);
                        A[ii * 64 + jj] = ii > jj ? bi * acc[r] * __expf(gci - gcj) : 0.f; }
                }
#pragma unroll
            for (int it = 0; it < 4; ++it) {
                bf16x8 qf[4];
#pragma unroll
                for (int ks = 0; ks < 4; ++ks) qf[ks] = *(const bf16x8*)(qkvn + (size_t)(tok0 + 16 * it + c16) * 2304 + hd * 128 + 32 * ks + 8 * g);
#pragma unroll
                for (int jt = 0; jt < 4; ++jt) {
                    f32x4 acc = (f32x4){0.f, 0.f, 0.f, 0.f};
                    if (jt <= it) {
#pragma unroll
                        for (int ks = 0; ks < 4; ++ks) acc = __builtin_amdgcn_mfma_f32_16x16x32_bf16(qf[ks], kf[jt][ks], acc, 0, 0, 0);
                    }
                    const int jj = 16 * jt + c16; const float gcj = __shfl(gc, jj);
                    const int pos = (jj & 32) + invperm32(jj & 31);
#pragma unroll
                    for (int r = 0; r < 4; ++r) { const int ii = 16 * it + 4 * g + r; const float gci = __shfl(gc, ii);
                        const float v = ii >= jj ? acc[r] * 0.08838834764831845f * __expf(gci - gcj) : 0.f;
                        QKc[(size_t)ci * 4096 + ii * 64 + pos] = (bf16_t)(cvt_pk_bf16(v, 0.f) & 0xffffu); }
                }
            }
        }
        asm volatile("s_waitcnt lgkmcnt(0)" ::: "memory");
        LAS float* sol = A + 4096;
#pragma unroll 1
        for (int pass = 0; pass < 4; ++pass) {
            const int half = pass & 1, isw = pass >> 1;
            const int c = lane + 64 * half; const int posc = (c & ~31) + invperm32(c & 31);
            const bf16_t* src = qkvn + (size_t)tok0 * 2304 + (isw ? 768 : 1536) + hd * 128 + c;
#pragma unroll 8
            for (int i = 0; i < 64; ++i) { float f = __shfl(beta, i); if (isw) f *= __shfl(egc, i); sol[i * 64 + lane] = bf1(src[(size_t)i * 2304]) * f; }
            asm volatile("s_waitcnt lgkmcnt(0)" ::: "memory");
            solve_lds(sol, A, lane);
            asm volatile("s_waitcnt lgkmcnt(0)" ::: "memory");
            if (!isw) { float* up = UT + (size_t)ci * 8192 + (size_t)c * 64;
#pragma unroll 4
                for (int i = 0; i < 64; i += 4) *(f32x4*)(up + i) = (f32x4){sol[i * 64 + lane], sol[(i + 1) * 64 + lane], sol[(i + 2) * 64 + lane], sol[(i + 3) * 64 + lane]}; }
            else {
#pragma unroll 8
                for (int i = 0; i < 64; ++i) Wc[(size_t)ci * 8192 + i * 128 + posc] = (bf16_t)(cvt_pk_bf16(sol[i * 64 + lane], 0.f) & 0xffffu); }
            asm volatile("s_waitcnt lgkmcnt(0)" ::: "memory");
        }
        const int c0 = 2 * lane; const int pos0 = (c0 & ~31) + invperm32(c0 & 31);
#pragma unroll 8
        for (int i = 0; i < 64; ++i) { const unsigned w = *(const unsigned*)(qkvn + (size_t)(tok0 + i) * 2304 + hd * 128 + 2 * lane);
            const float s = __shfl(egc, i) * 0.08838834764831845f;
            *(unsigned*)(QDc + (size_t)ci * 8192 + i * 128 + pos0) = cvt_pk_bf16(bflo(w) * s, bfhi(w) * s); }
        asm volatile("s_waitcnt lgkmcnt(0)" ::: "memory");
        {
            LAS bf16_t* kt = (LAS bf16_t*)A;
#pragma unroll 8
            for (int i = 0; i < 64; ++i) { const unsigned w = *(const unsigned*)(qkvn + (size_t)(tok0 + i) * 2304 + 768 + hd * 128 + 2 * lane);
                *(LAS unsigned*)(kt + i * 128 + 2 * lane) = w; }
            asm volatile("s_waitcnt lgkmcnt(0)" ::: "memory");
#pragma unroll
            for (int hh = 0; hh < 2; ++hh) { const int dk = lane + 64 * hh;
#pragma unroll
                for (int p8 = 0; p8 < 8; ++p8) { float v[8];
#pragma unroll
                    for (int e = 0; e < 8; ++e) { const int pp = p8 * 8 + e; const int c = (pp & 32) + perm32k(pp & 31);
                        v[e] = bf1(kt[c * 128 + dk]) * __uint_as_float((unsigned)__builtin_amdgcn_readlane((int)__float_as_uint(edl), c)); }
                    u32x4 w; w.x = cvt_pk_bf16(v[0], v[1]); w.y = cvt_pk_bf16(v[2], v[3]); w.z = cvt_pk_bf16(v[4], v[5]); w.w = cvt_pk_bf16(v[6], v[7]);
                    *(u32x4*)(KDT + (size_t)ci * 8192 + dk * 64 + p8 * 8) = w; } }
            asm volatile("s_waitcnt lgkmcnt(0)" ::: "memory");
        }
    }
}

#else
__device__ __forceinline__ void phase_gdn_prep(const Params& p, LAS unsigned char* lds) {
    const bf16_t* qkvn = (const bf16_t*)(p.ws + WS_QKVN); const float* gb = (const float*)(p.ws + WS_GB);
    const bf16_t* KT = (const bf16_t*)(p.ws + WS_KT); const bf16_t* VT = (const bf16_t*)(p.ws + WS_VTC);
    bf16_t* Wc = (bf16_t*)(p.ws + WS_WC); bf16_t* QDc = (bf16_t*)(p.ws + WS_QDC); bf16_t* KDT = (bf16_t*)(p.ws + WS_KDT); bf16_t* QKc = (bf16_t*)(p.ws + WS_QKC);
    float* UT = (float*)(p.ws + WS_UT); float* GL = (float*)(p.ws + WS_GL);
    const int tid_ = otid(); const int lane0 = tid_ & 63, wave = __builtin_amdgcn_readfirstlane(tid_ >> 6);
    const int gw = blockIdx.x * 8 + wave, NGW = gridDim.x * 8;
#pragma unroll 1
    for (int ci = gw; ci < 1536; ci += NGW) {
        int lane = lane0; unsigned aoff = (unsigned)wave * 16384u;
        asm volatile("" : "+v"(lane), "+v"(aoff));
        const int c16 = lane & 15, g = lane >> 4;
        LAS float* A = (LAS float*)(lds + aoff);
        const int n = ci & 31, hd = (ci >> 5) % 6, b = ci / 192;
        const int tok0 = b * 2048 + n * 64;
        const float gi = gb[(size_t)(tok0 + lane) * 12 + hd], beta = gb[(size_t)(tok0 + lane) * 12 + 6 + hd];
        float gc = gi;
#pragma unroll
        for (int o = 1; o < 64; o <<= 1) { const float tv = __shfl_up(gc, o); if (lane >= o) gc += tv; }
        const float gl = __shfl(gc, 63);
        const float egc = __expf(gc), edl = __expf(gl - gc);
        if (lane == 0) GL[ci] = __expf(gl);
        {
            bf16x8 kf[4][4];
#pragma unroll
            for (int t = 0; t < 4; ++t)
#pragma unroll
                for (int ks = 0; ks < 4; ++ks) kf[t][ks] = *(const bf16x8*)(qkvn + (size_t)(tok0 + 16 * t + c16) * 2304 + 768 + hd * 128 + 32 * ks + 8 * g);
#pragma unroll
            for (int it = 0; it < 4; ++it)
#pragma unroll
                for (int jt = 0; jt <= it; ++jt) {
                    f32x4 acc = (f32x4){0.f, 0.f, 0.f, 0.f};
#pragma unroll
                    for (int ks = 0; ks < 4; ++ks) acc = __builtin_amdgcn_mfma_f32_16x16x32_bf16(kf[it][ks], kf[jt][ks], acc, 0, 0, 0);
                    const int jj = 16 * jt + c16; const float gcj = __shfl(gc, jj);
#pragma unroll
                    for (int r = 0; r < 4; ++r) { const int ii = 16 * it + 4 * g + r; const float gci = __shfl(gc, ii), bi = __shfl(beta, ii);
                        A[ii * 64 + jj] = ii > jj ? bi * acc[r] * __expf(gci - gcj) : 0.f; }
                }
#pragma unroll
            for (int it = 0; it < 4; ++it) {
                bf16x8 qf[4];
#pragma unroll
                for (int ks = 0; ks < 4; ++ks) qf[ks] = *(const bf16x8*)(qkvn + (size_t)(tok0 + 16 * it + c16) * 2304 + hd * 128 + 32 * ks + 8 * g);
#pragma unroll
                for (int jt = 0; jt < 4; ++jt) {
                    f32x4 acc = (f32x4){0.f, 0.f, 0.f, 0.f};
                    if (jt <= it) {
#pragma unroll
                        for (int ks = 0; ks < 4; ++ks) acc = __builtin_amdgcn_mfma_f32_16x16x32_bf16(qf[ks], kf[jt][ks], acc, 0, 0, 0);
                    }
                    const int jj = 16 * jt + c16; const float gcj = __shfl(gc, jj);
                    const int pos = (jj & 32) + invperm32(jj & 31);
#pragma unroll
                    for (int r = 0; r < 4; ++r) { const int ii = 16 * it + 4 * g + r; const float gci = __shfl(gc, ii);
                        const float v = ii >= jj ? acc[r] * 0.08838834764831845f * __expf(gci - gcj) : 0.f;
                        QKc[(size_t)ci * 4096 + ii * 64 + pos] = (bf16_t)(cvt_pk_bf16(v, 0.f) & 0xffffu); }
                }
            }
        }
#pragma unroll
        for (int it = 0; it < 3; ++it)
#pragma unroll
            for (int r = 0; r < 16; ++r) { if (lane >= 16 * (it + 1)) A[(16 * it + r) * 64 + lane] = 0.f; }
        asm volatile("s_waitcnt lgkmcnt(0)" ::: "memory");
        A[lane] = lane == 0 ? 1.f : 0.f;
#pragma unroll 1
        for (int i = 1; i < 64; ++i) {
            float r0 = lane == i ? 1.f : 0.f, r1 = 0.f;
            const int n4 = (i + 3) >> 2;
#pragma unroll 2
            for (int j4 = 0; j4 < n4; ++j4) {
                const f32x4 a = *(const LAS f32x4*)(A + i * 64 + 4 * j4);
                const LAS float* sp = A + (4 * j4) * 64 + lane;
                r0 -= a[0] * sp[0]; r1 -= a[1] * sp[64]; r0 -= a[2] * sp[128]; r1 -= a[3] * sp[192];
            }
            A[i * 64 + lane] = r0 + r1;
        }
        asm volatile("s_waitcnt lgkmcnt(0)" ::: "memory");
        {
            bf16x8 TU[4][2], TW[4][2];
            const float bw = beta * egc;
#pragma unroll
            for (int ks = 0; ks < 2; ++ks) {
                float fu[8], fw[8];
#pragma unroll
                for (int e = 0; e < 8; ++e) { fu[e] = __shfl(beta, 32 * ks + 8 * g + e); fw[e] = __shfl(bw, 32 * ks + 8 * g + e); }
#pragma unroll
                for (int it = 0; it < 4; ++it) {
                    const LAS f32x4* tp = (const LAS f32x4*)(A + (16 * it + c16) * 64 + 32 * ks + 8 * g);
                    const f32x4 t0 = tp[0], t1 = tp[1];
                    TU[it][ks] = pack8((f32x4){t0[0] * fu[0], t0[1] * fu[1], t0[2] * fu[2], t0[3] * fu[3]}, (f32x4){t1[0] * fu[4], t1[1] * fu[5], t1[2] * fu[6], t1[3] * fu[7]});
                    TW[it][ks] = pack8((f32x4){t0[0] * fw[0], t0[1] * fw[1], t0[2] * fw[2], t0[3] * fw[3]}, (f32x4){t1[0] * fw[4], t1[1] * fw[5], t1[2] * fw[6], t1[3] * fw[7]});
                }
            }
#pragma unroll 2
            for (int nt = 0; nt < 8; ++nt) {
                const bf16x8 v0 = *(const bf16x8*)(VT + (size_t)ci * 8192 + (size_t)(16 * nt + c16) * 64 + 8 * g), v1 = *(const bf16x8*)(VT + (size_t)ci * 8192 + (size_t)(16 * nt + c16) * 64 + 32 + 8 * g);
                const bf16x8 k0 = *(const bf16x8*)(KT + (size_t)ci * 8192 + (size_t)(16 * nt + c16) * 64 + 8 * g), k1 = *(const bf16x8*)(KT + (size_t)ci * 8192 + (size_t)(16 * nt + c16) * 64 + 32 + 8 * g);
                const int posn = ((16 * nt + 4 * g) & ~31) + invperm32((16 * nt + 4 * g) & 31);
#pragma unroll
                for (int it = 0; it < 4; ++it) {
                    f32x4 au = (f32x4){0.f, 0.f, 0.f, 0.f}, aw = (f32x4){0.f, 0.f, 0.f, 0.f};
                    au = __builtin_amdgcn_mfma_f32_16x16x32_bf16(TU[it][0], v0, au, 0, 0, 0); au = __builtin_amdgcn_mfma_f32_16x16x32_bf16(TU[it][1], v1, au, 0, 0, 0);
                    aw = __builtin_amdgcn_mfma_f32_16x16x32_bf16(k0, TW[it][0], aw, 0, 0, 0); aw = __builtin_amdgcn_mfma_f32_16x16x32_bf16(k1, TW[it][1], aw, 0, 0, 0);
                    *(f32x4*)(UT + (size_t)ci * 8192 + (size_t)(16 * nt + c16) * 64 + 16 * it + 4 * g) = au;
                    u32x2 w; w.x = pg8::cvt_pk_safe(aw[0], aw[1]); w.y = pg8::cvt_pk_safe(aw[2], aw[3]);
                    *(u32x2*)(Wc + (size_t)ci * 8192 + (16 * it + c16) * 128 + posn) = w;
                }
            }
        }
        const int c0 = 2 * lane; const int pos0 = (c0 & ~31) + invperm32(c0 & 31);
#pragma unroll 8
        for (int i = 0; i < 64; ++i) { const unsigned w = *(const unsigned*)(qkvn + (size_t)(tok0 + i) * 2304 + hd * 128 + 2 * lane);
            const float s = __shfl(egc, i) * 0.08838834764831845f;
            *(unsigned*)(QDc + (size_t)ci * 8192 + i * 128 + pos0) = cvt_pk_bf16(bflo(w) * s, bfhi(w) * s); }
#pragma unroll 1
        for (int hh = 0; hh < 2; ++hh) { const int dk = lane + 64 * hh;
            u32x4 kr[8];
#pragma unroll
            for (int q = 0; q < 8; ++q) kr[q] = *(const u32x4*)(KT + (size_t)ci * 8192 + (size_t)dk * 64 + 8 * q);
#pragma unroll
            for (int p8 = 0; p8 < 8; ++p8) { float v[8];
#pragma unroll
                for (int e = 0; e < 8; ++e) { const int pp = p8 * 8 + e; const int c = (pp & 32) + perm32k(pp & 31);
                    const unsigned wd = kr[c >> 3][(c & 7) >> 1]; const float kv = (c & 1) ? bfhi(wd) : bflo(wd);
                    v[e] = kv * __uint_as_float((unsigned)__builtin_amdgcn_readlane((int)__float_as_uint(edl), c)); }
                u32x4 w; w.x = cvt_pk_bf16(v[0], v[1]); w.y = cvt_pk_bf16(v[2], v[3]); w.z = cvt_pk_bf16(v[4], v[5]); w.w = cvt_pk_bf16(v[6], v[7]);
                *(u32x4*)(KDT + (size_t)ci * 8192 + dk * 64 + p8 * 8) = w; } }
        asm volatile("s_waitcnt lgkmcnt(0)" ::: "memory");
    }
}

#endif
constexpr int RB_W = 0, RB_QD = 17408, RB_KD = 34816, RB_QK = 34816 + 18432, RB_SZ = 62464;
__device__ __forceinline__ void rec_load(u32x4 (&r)[7], const bf16_t* Wc, const bf16_t* QDc, const bf16_t* KDT, const bf16_t* QKc, int ci, int tid) {
    r[0] = *(const u32x4*)(Wc + (size_t)ci * 8192 + (size_t)tid * 8); r[1] = *(const u32x4*)(Wc + (size_t)ci * 8192 + (size_t)(512 + tid) * 8);
    r[2] = *(const u32x4*)(QDc + (size_t)ci * 8192 + (size_t)tid * 8); r[3] = *(const u32x4*)(QDc + (size_t)ci * 8192 + (size_t)(512 + tid) * 8);
    r[4] = *(const u32x4*)(KDT + (size_t)ci * 8192 + (size_t)tid * 8); r[5] = *(const u32x4*)(KDT + (size_t)ci * 8192 + (size_t)(512 + tid) * 8);
    r[6] = *(const u32x4*)(QKc + (size_t)ci * 4096 + (size_t)tid * 8);
}
__device__ __forceinline__ void rec_store(const u32x4 (&r)[7], LAS unsigned char* buf, int tid) {
#pragma unroll
    for (int k = 0; k < 2; ++k) { const int q = tid + 512 * k;
        *(LAS u32x4*)(buf + RB_W + (q >> 4) * 272 + (q & 15) * 16) = r[k];
        *(LAS u32x4*)(buf + RB_QD + (q >> 4) * 272 + (q & 15) * 16) = r[2 + k];
        *(LAS u32x4*)(buf + RB_KD + (q >> 3) * 144 + (q & 7) * 16) = r[4 + k]; }
    *(LAS u32x4*)(buf + RB_QK + (tid >> 3) * 144 + (tid & 7) * 16) = r[6];
}
__device__ __forceinline__ void gdn_recur_prompt(const Params& p, LAS unsigned char* lds, int j, int bh, float* ob, float* gsbase) {
    const bf16_t* Wc = (const bf16_t*)(p.ws + WS_WC); const bf16_t* QDc = (const bf16_t*)(p.ws + WS_QDC); const bf16_t* KDT = (const bf16_t*)(p.ws + WS_KDT); const bf16_t* QKc = (const bf16_t*)(p.ws + WS_QKC);
    const float* UT = (const float*)(p.ws + WS_UT); const float* GL = (const float*)(p.ws + WS_GL);
    const int tid = otid(), lane = tid & 63, wave = __builtin_amdgcn_readfirstlane(tid >> 6), c16 = lane & 15, g = lane >> 4;
    const int b = bh / 6, hd = bh % 6, dv0 = wave * 16;
    f32x4 S[8];
#pragma unroll
    for (int i = 0; i < 8; ++i) S[i] = (f32x4){0.f, 0.f, 0.f, 0.f};
    u32x4 rg[7];
    rec_load(rg, Wc, QDc, KDT, QKc, bh * 32, tid);
    rec_store(rg, lds, tid);
    f32x4 un[4]; float egln;
#pragma unroll
    for (int ct = 0; ct < 4; ++ct) un[ct] = *(const f32x4*)(UT + (size_t)(bh * 32) * 8192 + (size_t)(dv0 + c16) * 64 + 16 * ct + 4 * g);
    egln = GL[bh * 32];
    __syncthreads();
#pragma unroll 1
    for (int n = 0; n < 32; ++n) {
        const int ci = bh * 32 + n;
        LAS unsigned char* buf = lds + (n & 1) * RB_SZ;
        if (n + 1 < 32) rec_load(rg, Wc, QDc, KDT, QKc, ci + 1, tid);
        f32x4 u[4];
#pragma unroll
        for (int ct = 0; ct < 4; ++ct) u[ct] = un[ct];
        const float egl = egln;
        { const int cn = (n + 1 < 32) ? ci + 1 : ci;
#pragma unroll
          for (int ct = 0; ct < 4; ++ct) un[ct] = *(const f32x4*)(UT + (size_t)cn * 8192 + (size_t)(dv0 + c16) * 64 + 16 * ct + 4 * g);
          egln = GL[cn]; }
        bf16x8 bS[4];
#pragma unroll
        for (int ks = 0; ks < 4; ++ks) bS[ks] = pack8(S[2 * ks], S[2 * ks + 1]);
        f32x4 vn[4], o[4];
#pragma unroll
        for (int ct = 0; ct < 4; ++ct) {
            f32x4 ws = (f32x4){0.f, 0.f, 0.f, 0.f}, oo = (f32x4){0.f, 0.f, 0.f, 0.f};
#pragma unroll
            for (int ks = 0; ks < 4; ++ks) {
                const bf16x8 wf = *(const LAS bf16x8*)(buf + RB_W + (16 * ct + c16) * 272 + ks * 64 + g * 16);
                const bf16x8 qf = *(const LAS bf16x8*)(buf + RB_QD + (16 * ct + c16) * 272 + ks * 64 + g * 16);
                ws = __builtin_amdgcn_mfma_f32_16x16x32_bf16(wf, bS[ks], ws, 0, 0, 0);
                oo = __builtin_amdgcn_mfma_f32_16x16x32_bf16(qf, bS[ks], oo, 0, 0, 0);
            }
            vn[ct] = u[ct] - ws; o[ct] = oo;
        }
        bf16x8 bV[2];
#pragma unroll
        for (int k2 = 0; k2 < 2; ++k2) bV[k2] = pack8(vn[2 * k2], vn[2 * k2 + 1]);
#pragma unroll
        for (int ct = 0; ct < 4; ++ct) {
#pragma unroll
            for (int k2 = 0; k2 < 2; ++k2) { const bf16x8 af = *(const LAS bf16x8*)(buf + RB_QK + (16 * ct + c16) * 144 + k2 * 64 + g * 16);
                o[ct] = __builtin_amdgcn_mfma_f32_16x16x32_bf16(af, bV[k2], o[ct], 0, 0, 0); }
#pragma unroll
            for (int r = 0; r < 4; ++r) ob[(size_t)(b * 2048 + n * 64 + 16 * ct + 4 * g + r) * 768 + hd * 128 + dv0 + c16] = o[ct][r];
        }
#pragma unroll
        for (int dt = 0; dt < 8; ++dt) { f32x4 s = S[dt] * egl;
#pragma unroll
            for (int k2 = 0; k2 < 2; ++k2) { const bf16x8 af = *(const LAS bf16x8*)(buf + RB_KD + (16 * dt + c16) * 144 + k2 * 64 + g * 16);
                s = __builtin_amdgcn_mfma_f32_16x16x32_bf16(af, bV[k2], s, 0, 0, 0); }
            S[dt] = s; }
        if (n + 1 < 32) rec_store(rg, lds + ((n + 1) & 1) * RB_SZ, tid);
        asm volatile("s_waitcnt lgkmcnt(0)" ::: "memory"); __builtin_amdgcn_s_barrier(); asm volatile("" ::: "memory");
    }
    float* so = gsbase + ((size_t)(j * 8 + b) * 6 + hd) * 16384;
#pragma unroll
    for (int dt = 0; dt < 8; ++dt)
#pragma unroll
        for (int r = 0; r < 4; ++r) so[(size_t)(16 * dt + 4 * g + r) * 128 + dv0 + c16] = S[dt][r];
}
__device__ __forceinline__ void gdn_naive_item(const Params& p, LAS unsigned char* lds, int row0, int T, int hd, const float* s0, float* sout, float* ob) {
    const bf16_t* qkvn = (const bf16_t*)(p.ws + WS_QKVN); const float* gb = (const float*)(p.ws + WS_GB);
    const int tid = otid(), e = tid & 127, part = tid >> 7;
    LAS float* kq = (LAS float*)lds;
    LAS float* red = kq + 1024;
    LAS float* red2 = red + 512;
    float S[32];
#pragma unroll
    for (int i = 0; i < 32; ++i) S[i] = s0 ? s0[(size_t)(part * 32 + i) * 128 + e] : 0.f;
#pragma unroll 1
    for (int tb = 0; tb < T; tb += 4) {
        __syncthreads();
        for (int i = tid; i < 1024; i += 512) { const int t = i >> 8, s = (i >> 7) & 1, d = i & 127;
            kq[i] = bf1(qkvn[(size_t)(row0 + tb + t) * 2304 + (s == 0 ? 768 : 0) + hd * 128 + d]); }
        __syncthreads();
#pragma unroll 1
        for (int t = 0; t < 4; ++t) {
            const int row = row0 + tb + t;
            const float a = __expf(gb[(size_t)row * 12 + hd]), bt = gb[(size_t)row * 12 + 6 + hd];
            const float v = bf1(qkvn[(size_t)row * 2304 + 1536 + hd * 128 + e]);
            float ps = 0.f;
#pragma unroll
            for (int i = 0; i < 32; ++i) ps += S[i] * kq[(t * 2 + 0) * 128 + part * 32 + i];
            red[part * 128 + e] = ps;
            __syncthreads();
            const float kS = red[e] + red[128 + e] + red[256 + e] + red[384 + e];
            const float vnew = bt * (v - a * kS);
            float po = 0.f;
#pragma unroll
            for (int i = 0; i < 32; ++i) { S[i] = a * S[i] + kq[(t * 2 + 0) * 128 + part * 32 + i] * vnew; po += S[i] * kq[(t * 2 + 1) * 128 + part * 32 + i]; }
            red2[part * 128 + e] = po;
            __syncthreads();
            if (part == 0) ob[(size_t)row * 768 + hd * 128 + e] = (red2[e] + red2[128 + e] + red2[256 + e] + red2[384 + e]) * 0.08838834764831845f;
        }
    }
#pragma unroll
    for (int i = 0; i < 32; ++i) sout[(size_t)(part * 32 + i) * 128 + e] = S[i];
    __syncthreads();
}
__device__ __forceinline__ void gdn_sample_item(const Params& p, LAS unsigned char* lds, int j, int item) {
    const int sb = item / 6, hd = item % 6;
    gdn_naive_item(p, lds, TP + sb * 4, 4, hd, p.in[7] + ((size_t)(j * 128 + sb) * 6 + hd) * 16384, p.out + O_GSS + ((size_t)(j * 128 + sb) * 6 + hd) * 16384, (float*)(p.ws + WS_O));
}
__device__ __forceinline__ void phase_gdn_post(const Params& p, int j) {
    const bf16_t* h = (const bf16_t*)(p.ws + WS_H); const float* ob = (const float*)(p.ws + WS_O); bf16_t* cat = (bf16_t*)(p.ws + WS_CAT);
    const int tid_ = otid(); const int lane = tid_ & 63, wave = __builtin_amdgcn_readfirstlane(tid_ >> 6);
    const int gw = blockIdx.x * 8 + wave, NGW = gridDim.x * 8;
    const f32x2 nw = *(const f32x2*)(p.in[16] + j * 128 + 2 * lane);
    for (int it = gw; it < TT * 6; it += NGW) {
        const int row = it / 6, hd = it % 6;
        const f32x2 o = *(const f32x2*)(ob + (size_t)row * 768 + hd * 128 + 2 * lane);
        const float ss = wave_sum(o[0] * o[0] + o[1] * o[1]);
        const float r = 1.f / sqrtf(ss * (1.f / 128.f) + 1e-6f);
        const unsigned zw = *(const unsigned*)(h + (size_t)row * NHB + 2304 + hd * 128 + 2 * lane);
        const float y0 = o[0] * r * nw[0] * silu_f(bflo(zw)), y1 = o[1] * r * nw[1] * silu_f(bfhi(zw));
        *(unsigned*)(cat + (size_t)row * DM + hd * 128 + 2 * lane) = cvt_pk_bf16(y0, y1);
    }
}


#ifdef DIAG_GDN
constexpr size_t WS_DBG = WS_END;
constexpr size_t WS_OB2 = WS_END + 4096;
constexpr size_t WS_GS2 = WS_OB2 + (size_t)TT * 768 * 4;
constexpr size_t WS_DIAG_END = WS_GS2 + (size_t)2 * 8 * 6 * 16384 * 4;
__device__ __forceinline__ void diag_compare(const Params& p, int j) {
    const float* ob = (const float*)(p.ws + WS_O); const float* ob2 = (const float*)(p.ws + WS_OB2);
    const float* gs = p.out + O_GSP + (size_t)j * 8 * 6 * 16384; const float* gs2 = (const float*)(p.ws + WS_GS2) + (size_t)j * 8 * 6 * 16384;
    float* dbg = (float*)(p.ws + WS_DBG);
    const size_t gt = (size_t)blockIdx.x * 512 + otid(), NT = (size_t)gridDim.x * 512;
    float n1 = 0.f, d1 = 0.f, n3 = 0.f, d3 = 0.f, n2 = 0.f, d2 = 0.f, n4 = 0.f, d4 = 0.f;
    for (size_t i = gt; i < (size_t)TP * 768; i += NT) { const int row = (int)(i / 768); const float a = ob[i], b = ob2[i]; const float e = (a - b) * (a - b);
        n3 += e; d3 += a * a; if ((row & 2047) < 64) { n1 += e; d1 += a * a; } else if ((row & 2047) < 128) { n4 += e; d4 += a * a; } }
    for (size_t i = gt; i < (size_t)8 * 6 * 16384; i += NT) { const float a = gs[i], b = gs2[i]; n2 += (a - b) * (a - b); d2 += a * a; }
    n1 = wave_sum(n1); d1 = wave_sum(d1); n2 = wave_sum(n2); d2 = wave_sum(d2); n3 = wave_sum(n3); d3 = wave_sum(d3); n4 = wave_sum(n4); d4 = wave_sum(d4);
    if ((otid() & 63) == 0) { atomicAdd(dbg + 0, n1); atomicAdd(dbg + 1, d1); atomicAdd(dbg + 2, n2); atomicAdd(dbg + 3, d2); atomicAdd(dbg + 4, n3); atomicAdd(dbg + 5, d3); atomicAdd(dbg + 6, n4); atomicAdd(dbg + 7, d4); }
}
__device__ __forceinline__ void diag_compare2(const Params& p) {
    const bf16_t* qkvn = (const bf16_t*)(p.ws + WS_QKVN); const float* gb = (const float*)(p.ws + WS_GB);
    const bf16_t* Wc = (const bf16_t*)(p.ws + WS_WC); const float* UT = (const float*)(p.ws + WS_UT);
    float* dbg = (float*)(p.ws + WS_DBG);
    const int tid_ = otid(); const int lane = tid_ & 63, wave = __builtin_amdgcn_readfirstlane(tid_ >> 6);
    const int gw = blockIdx.x * 8 + wave, NGW = gridDim.x * 8;
    float n8 = 0.f, d8 = 0.f, n12 = 0.f, d12 = 0.f;
    for (int cs = gw; cs < 192; cs += NGW) {
        const int ci = cs * 8 + (cs % 7);
        const int n = ci & 31, hd = (ci >> 5) % 6, b = ci / 192; const int tok0 = b * 2048 + n * 64;
        float gcs = 0.f, mygc = 0.f;
        for (int t = 0; t < 64; ++t) { gcs += gb[(size_t)(tok0 + t) * 12 + hd]; if (t == lane) mygc = gcs; }
        const float mybeta = gb[(size_t)(tok0 + lane) * 12 + 6 + hd];
        const int pos0 = (lane & ~31) + invperm32(lane & 31), pos1 = 64 + pos0;
        for (int i = 0; i < 64; ++i) {
            const float gci = __shfl(mygc, i), bi = __shfl(mybeta, i);
            const float ki0 = bf1(qkvn[(size_t)(tok0 + i) * 2304 + 768 + hd * 128 + lane]), ki1 = bf1(qkvn[(size_t)(tok0 + i) * 2304 + 768 + hd * 128 + 64 + lane]);
            float lw0 = bf1(Wc[(size_t)ci * 8192 + i * 128 + pos0]), lw1 = bf1(Wc[(size_t)ci * 8192 + i * 128 + pos1]);
            float lu0 = UT[(size_t)ci * 8192 + (size_t)lane * 64 + i], lu1 = UT[(size_t)ci * 8192 + (size_t)(lane + 64) * 64 + i];
            for (int j = 0; j < i; ++j) {
                const float kj0 = bf1(qkvn[(size_t)(tok0 + j) * 2304 + 768 + hd * 128 + lane]), kj1 = bf1(qkvn[(size_t)(tok0 + j) * 2304 + 768 + hd * 128 + 64 + lane]);
                const float dot = wave_sum(ki0 * kj0 + ki1 * kj1);
                const float aij = bi * dot * __expf(gci - __shfl(mygc, j));
                lw0 += aij * bf1(Wc[(size_t)ci * 8192 + j * 128 + pos0]); lw1 += aij * bf1(Wc[(size_t)ci * 8192 + j * 128 + pos1]);
                lu0 += aij * UT[(size_t)ci * 8192 + (size_t)lane * 64 + j]; lu1 += aij * UT[(size_t)ci * 8192 + (size_t)(lane + 64) * 64 + j];
            }
            const float rw0 = bi * __expf(gci) * ki0, rw1 = bi * __expf(gci) * ki1;
            const float vi0 = bf1(qkvn[(size_t)(tok0 + i) * 2304 + 1536 + hd * 128 + lane]), vi1 = bf1(qkvn[(size_t)(tok0 + i) * 2304 + 1536 + hd * 128 + 64 + lane]);
            const float ru0 = bi * vi0, ru1 = bi * vi1;
            n12 += (lw0 - rw0) * (lw0 - rw0) + (lw1 - rw1) * (lw1 - rw1); d12 += rw0 * rw0 + rw1 * rw1;
            n8 += (lu0 - ru0) * (lu0 - ru0) + (lu1 - ru1) * (lu1 - ru1); d8 += ru0 * ru0 + ru1 * ru1;
        }
    }
    n8 = wave_sum(n8); d8 = wave_sum(d8); n12 = wave_sum(n12); d12 = wave_sum(d12);
    if (lane == 0) { atomicAdd(dbg + 8, n8); atomicAdd(dbg + 9, d8); atomicAdd(dbg + 12, n12); atomicAdd(dbg + 13, d12); }
}
__device__ __forceinline__ int diag_class(float n, float d) { const float r = n / (d + 1e-30f); return r < 4e-4f ? 0 : (r < 0.09f ? 1 : 2); }
#endif
#define XB_TMO      128
#define XB_XCNT(j)  (256  + 64 * (j))
#define XB_XSUB(j)  (1280 + 64 * (j))
#define XB_XGEN(j)  (2304 + 64 * (j))
#define XB_TOP      3328
#define XB_TOPGEN   3392
#define XCD_BAR_WORDS 3456
#define XB_SPIN_CAP (1u << 18)

__device__ __forceinline__ unsigned xb_ld(unsigned* p)              { return __hip_atomic_load(p, __ATOMIC_RELAXED, __HIP_MEMORY_SCOPE_AGENT); }
__device__ __forceinline__ unsigned xb_add(unsigned* p, unsigned v) { return __hip_atomic_fetch_add(p, v, __ATOMIC_RELAXED, __HIP_MEMORY_SCOPE_AGENT); }
__device__ __forceinline__ unsigned xb_xcc_id() { return (unsigned)__builtin_amdgcn_s_getreg((3 << 11) | 20) & 0xFu; }
#define XB_SPIN(cond, bar) do { unsigned _sp = 0; while (cond) { __builtin_amdgcn_s_sleep(1); \
    if ((++_sp & 255u) == 0u) { if (xb_ld(&(bar)[XB_TMO])) break; if (_sp > XB_SPIN_CAP) { atomicAdd(&(bar)[XB_TMO], 1u); break; } } } } while (0)

struct XcdBarrier {
    unsigned* bar; unsigned x;
    volatile LAS unsigned* st;
};

__device__ __forceinline__ XcdBarrier xcd_barrier_post(unsigned* bar, volatile LAS unsigned* st) {
    XcdBarrier b; b.bar = bar; b.x = xb_xcc_id(); b.st = st;
    if (threadIdx.x == 0) (void)xb_add(&bar[XB_XCNT(b.x)], 1u);
    return b;
}
__device__ __forceinline__ void xcd_barrier_complete(unsigned* bar, unsigned x, unsigned& nloc, unsigned& nx) {
    const unsigned G = gridDim.x * gridDim.y * gridDim.z;
    unsigned sum, cnt, mine, sp = 0u;
    for (;;) {
        sum = 0u; cnt = 0u; mine = 0u;
#pragma unroll
        for (unsigned j = 0; j < 16; ++j) { const unsigned c = xb_ld(&bar[XB_XCNT(j)]); sum += c; cnt += (c > 0u) ? 1u : 0u; mine = (j == x) ? c : mine; }
        if (sum == G) break;
        __builtin_amdgcn_s_sleep(1);
        if ((++sp & 255u) == 0u) { if (xb_ld(&bar[XB_TMO])) break; if (sp > XB_SPIN_CAP) { atomicAdd(&bar[XB_TMO], 1u); break; } }
    }
    nloc = mine > 0u ? mine : 1u; nx = cnt > 0u ? cnt : 1u;
}

__device__ __forceinline__ void xcd_barrier(const XcdBarrier& b) {
    asm volatile("s_waitcnt vmcnt(0)" ::: "memory");
    __syncthreads();
    if (threadIdx.x == 0) {
        unsigned* bar = b.bar;
        __builtin_amdgcn_s_waitcnt(0);
        unsigned nloc = b.st[0], nx = b.st[1];
        if (nloc == 0u) { xcd_barrier_complete(bar, b.x, nloc, nx); b.st[0] = nloc; b.st[1] = nx; }
        const unsigned old = xb_add(&bar[XB_XSUB(b.x)], 1u);
        const unsigned gen = old / nloc;
        if (old + 1u == (gen + 1u) * nloc) {
            __builtin_amdgcn_fence(__ATOMIC_RELEASE, "agent");
            asm volatile("s_waitcnt vmcnt(0)" ::: "memory");
            const unsigned og = xb_add(&bar[XB_TOP], 1u);
            const unsigned tg = og / nx;
            if (og + 1u == (tg + 1u) * nx) xb_add(&bar[XB_TOPGEN], 1u);
            else XB_SPIN(xb_ld(&bar[XB_TOPGEN]) == tg, bar);
            __builtin_amdgcn_fence(__ATOMIC_ACQUIRE, "agent");
            xb_add(&bar[XB_XGEN(b.x)], 1u);
            asm volatile("s_waitcnt vmcnt(0)" ::: "memory");
        } else {
            XB_SPIN(xb_ld(&bar[XB_XGEN(b.x)]) == gen, bar);
            __builtin_amdgcn_fence(__ATOMIC_ACQUIRE, "agent");
            asm volatile("s_waitcnt vmcnt(0)" ::: "memory");
        }
    }
    __syncthreads();
}


#ifdef EXP_SYNC2
#define GSYNC() do { xcd_barrier(xbar); xcd_barrier(xbar); } while (0)
#else
#define GSYNC() xcd_barrier(xbar)
#endif
#ifdef EXP_ELEM2
#define ELEM2(x) do { x; x; } while (0)
#else
#define ELEM2(x) do { x; } while (0)
#endif
#ifdef EXP_GEMM2
#define GEMM2(x) do { x; x; } while (0)
#else
#define GEMM2(x) do { x; } while (0)
#endif
#ifdef EXP_GDNPREP2
#define GDNP2(x) do { x; x; } while (0)
#else
#define GDNP2(x) do { x; } while (0)
#endif
#ifdef EXP_GDN2
#define GDN2(x) do { x; x; } while (0)
#else
#define GDN2(x) do { x; } while (0)
#endif
__global__ void __launch_bounds__(512, 2) fwd_megakernel(Params p) {
    extern __shared__ __attribute__((aligned(16))) unsigned char lds_raw[];
    LAS unsigned char* lds = (LAS unsigned char*)lds_raw;
    cg::grid_group grid = cg::this_grid();
    unsigned char* ws = p.ws;
    float* xf = (float*)(ws + WS_XF); bf16_t* xb = (bf16_t*)(ws + WS_XB);
    bf16_t* hbuf = (bf16_t*)(ws + WS_H); bf16_t* cat = (bf16_t*)(ws + WS_CAT);
    bf16_t* hu = (bf16_t*)(ws + WS_HU); bf16_t* gact = (bf16_t*)(ws + WS_GACT);
    const bf16_t* Kb = (const bf16_t*)(ws + WS_KB); const bf16_t* Vt = (const bf16_t*)(ws + WS_VT);
    const int bid = blockIdx.x, G = gridDim.x;
    volatile LAS unsigned* xst = (volatile LAS unsigned*)(lds + LDS_BYTES - 16);
    if (threadIdx.x < 4) xst[threadIdx.x] = 0u;
    __syncthreads();
    XcdBarrier xbar = xcd_barrier_post((unsigned*)(ws + WS_BAR), xst);

#ifdef DIAG_GDN
    if (bid == 0 && threadIdx.x < 64) ((float*)(ws + WS_DBG))[threadIdx.x] = 0.f;
#endif
#ifdef EXP_PREP2
    phase_prep(p, lds);
#endif
    phase_prep(p, lds);
    grid.sync();
    {
        EpiKV E{p.out + O_MK, p.out + O_MV, (bf16_t*)(ws + WS_KB), (bf16_t*)(ws + WS_VT)};
        run_gemm(lds, (const bf16_t*)(ws + WS_MEMB), (const bf16_t*)(ws + WS_WKV), 2048, 2048, DM, E, (bid + 64) % G);
    }
#pragma unroll 1
    for (int l = 0; l < 4; ++l) {
        const int j = l >> 1; const bool isB = (l & 1) != 0;
        if (!isB) {
            { EpiStoreBf16 E{hbuf, NHA}; GEMM2(run_gemm(lds, xb, (const bf16_t*)(ws + WS_WINA) + (size_t)j * NHA * DM, TT, NHA, DM, E, bid)); }
            GSYNC();
            ELEM2(phase_mixA_elem(p, j));
#ifdef NAIVE_ATTN
            for (int it = bid; it < 256; it += G) attn_prompt_item_naive(lds, hbuf, NHA, 2304, p.out + O_MK, p.out + O_MV, cat, l, it);
#else
            for (int it = bid; it < 256; it += G) attn_prompt_item(lds, hbuf, NHA, 2304, Kb, Vt, cat, l, it);
#endif
            for (int it = bid; it < 256; it += G) attn_sample_item(lds, hbuf, NHA, 2304, p.in[3], p.in[4], cat, l, it);
            GSYNC();
            { EpiResid E{xf, DM}; const bf16_t* W = (const bf16_t*)(ws + WS_WOUTA) + (size_t)j * DM * DM; small_gemm_resid(cat, W, DM, xf); run_gemm(lds, cat, W, TP, DM, DM, E, bid); }
        } else {
            { EpiStoreBf16 E{hbuf, NHB}; GEMM2(run_gemm(lds, xb, (const bf16_t*)(ws + WS_WINB) + (size_t)j * NHB * DM, TT, NHB, DM, E, bid)); }
            GSYNC();
            ELEM2(phase_gdn_pre(p, j));
            GSYNC();
#ifndef NAIVE_GDN
            GDNP2(phase_gdn_prep(p, lds));
            GSYNC();
#endif
#ifdef NAIVE_GDN
            if (bid < 48) gdn_naive_item(p, lds, (bid / 6) * 2048, 2048, bid % 6, nullptr, p.out + O_GSP + ((size_t)(j * 8 + bid / 6) * 6 + bid % 6) * 16384, (float*)(ws + WS_O));
#else
            if (bid < 48) { GDN2(gdn_recur_prompt(p, lds, j, bid, (float*)(ws + WS_O), p.out + O_GSP)); }
#endif
            else {
                const int nb = G - 48;
                for (int it = bid - 48; it < 768; it += nb) gdn_sample_item(p, lds, j, it);
#ifdef NAIVE_ATTN
                for (int it = bid - 48; it < 256; it += nb) attn_prompt_item_naive(lds, hbuf, NHB, 3072, p.out + O_MK, p.out + O_MV, cat, l, it);
#else
                for (int it = bid - 48; it < 256; it += nb) attn_prompt_item(lds, hbuf, NHB, 3072, Kb, Vt, cat, l, it);
#endif
                for (int it = bid - 48; it < 256; it += nb) attn_sample_item(lds, hbuf, NHB, 3072, p.in[3], p.in[4], cat, l, it);
            }
            GSYNC();
#ifdef DIAG_GDN
            if (l == 1) {
                if (bid < 48) gdn_naive_item(p, lds, (bid / 6) * 2048, 2048, bid % 6, nullptr, (float*)(ws + WS_GS2) + ((size_t)(j * 8 + bid / 6) * 6 + bid % 6) * 16384, (float*)(ws + WS_OB2));
                GSYNC();
                diag_compare(p, j);
                diag_compare2(p);
                GSYNC();
            }
#endif
            ELEM2(phase_gdn_post(p, j));
            GSYNC();
            { EpiResid E{xf, DM}; const bf16_t* W = (const bf16_t*)(ws + WS_WOUTB) + (size_t)j * DM * DM; small_gemm_resid(cat, W, DM, xf); run_gemm(lds, cat, W, TP, DM, DM, E, bid); }
        }
        GSYNC();
#ifdef EXP_LN2
        phase_ln(xf, xb, p.in[19] + l * DM, p.in[20] + l * DM, (float*)(ws + WS_HU));
#endif
        phase_ln(xf, xb, p.in[19] + l * DM, p.in[20] + l * DM, nullptr);
        GSYNC();
        { EpiStoreBf16 E{hu, NUP}; GEMM2(run_gemm(lds, xb, (const bf16_t*)(ws + WS_WUP) + (size_t)l * NUP * DM, TT, NUP, DM, E, bid)); }
        GSYNC();
        ELEM2(phase_convgate(p, l));
        GSYNC();
        { EpiResid E{xf, DM}; const bf16_t* W = (const bf16_t*)(ws + WS_WDOWN) + (size_t)l * DM * DFF; small_gemm_resid(gact, W, DFF, xf); run_gemm(lds, gact, W, TP, DM, DFF, E, bid); }
        GSYNC();
#ifdef EXP_LN2
        phase_ln(xf, xb, p.in[21] + l * DM, p.in[22] + l * DM, (float*)(ws + WS_H));
#endif
        phase_ln(xf, xb, p.in[21] + l * DM, p.in[22] + l * DM, l == 3 ? p.out + O_Y : nullptr);
        if (l < 3) GSYNC();
    }
#ifdef DIAG_GDN
    GSYNC();
    if (bid == 0 && threadIdx.x == 0) { const float* dbg = (const float*)(ws + WS_DBG);
        const int code = 27 * diag_class(dbg[6], dbg[7]) + 9 * diag_class(dbg[8], dbg[9]) + 3 * diag_class(dbg[2], dbg[3]) + diag_class(dbg[12], dbg[13]);
        float v = 1.0e4f; for (int i = 0; i < code; ++i) v *= 1.25f;
        p.out[0] = v; }
#endif
}

extern "C" void kernel_launch(void* const* d_in, const int* in_sizes, int n_in, void* d_out, int out_size, void* d_ws, size_t ws_size, hipStream_t stream) {
    static int grid_blocks = 0;
    if (grid_blocks == 0) {
        if (n_in != 26 || (size_t)out_size != O_END || ws_size < WS_TOTAL) { fprintf(stderr, "kernel_launch: unexpected shapes n_in %d out %d (want %zu) ws %zu (need %zu)\n", n_in, out_size, (size_t)O_END, ws_size, (size_t)WS_END); grid_blocks = -1; return; }
        int dev = 0, cus = 0, per_cu = 0;
        hipGetDevice(&dev);
        hipDeviceGetAttribute(&cus, hipDeviceAttributeMultiprocessorCount, dev);
        if (hipFuncSetAttribute((const void*)fwd_megakernel, hipFuncAttributeMaxDynamicSharedMemorySize, LDS_BYTES) != hipSuccess) { fprintf(stderr, "kernel_launch: hipFuncSetAttribute failed\n"); grid_blocks = -1; return; }
        hipOccupancyMaxActiveBlocksPerMultiprocessor(&per_cu, (const void*)fwd_megakernel, 512, LDS_BYTES);
        if (per_cu < 1) { fprintf(stderr, "kernel_launch: occupancy query says %d blocks/CU\n", per_cu); grid_blocks = -1; return; }
        grid_blocks = cus;
        if (grid_blocks > 256) grid_blocks = 256;
    }
    if (grid_blocks < 0) return;
    if (hipMemsetAsync((char*)d_ws + WS_BAR, 0, 16384, stream) != hipSuccess) { fprintf(stderr, "kernel_launch: memset of barrier words failed\n"); return; }
    Params p{};
    for (int i = 0; i < 26; ++i) p.in[i] = (const float*)d_in[i];
    p.out = (float*)d_out; p.ws = (unsigned char*)d_ws;
    void* args[] = {&p};
    hipError_t e = hipLaunchCooperativeKernel((const void*)fwd_megakernel, dim3(grid_blocks), dim3(512), args, LDS_BYTES, stream);
    if (e != hipSuccess) fprintf(stderr, "cooperative launch failed: %s (grid %d)\n", hipGetErrorString(e), grid_blocks);
}
```

```cpp
#include <hip/hip_runtime.h>
#include <hip/hip_cooperative_groups.h>
#include <cstdio>
namespace cg = cooperative_groups;
namespace pg8 {
#define PG8_LAS __attribute__((address_space(3)))
typedef unsigned short bf16_t;
typedef short bf16x8 __attribute__((ext_vector_type(8)));
typedef float f32x4 __attribute__((ext_vector_type(4)));
typedef unsigned u32x4 __attribute__((ext_vector_type(4)));
constexpr int BM = 256, BK = 64, HALF = 128, HTB = HALF * BK * 2  , STAGE_BYTES = 8 * HTB, NXCD = 8, WGM = 8;

__host__ __device__ __forceinline__ int lds_byte(int r, int c) { const int st = (r >> 4) * 2 + (c >> 5), rr = r & 15, cc = c & 31, ob = rr * 64 + cc * 2; return st * 1024 + (ob ^ (((ob >> 9) & 1) << 5)); }
__host__ __device__ __forceinline__ void stage_rc(int b, int& R, int& C) { const int st = b / 1024, sb = b % 1024, swz = sb ^ (((sb >> 9) & 1) << 5); R = (st >> 1) * 16 + swz / 64; C = (st & 1) * 32 + (swz % 64) / 2; }
__host__ __device__ __forceinline__ int perm32(int rho) { const int n = rho >> 4, i = rho & 15; return 8 * (i >> 2) + 4 * n + (i & 3); }

struct Unit { int pm, pn; };
struct Gemm { const bf16_t* A; const bf16_t* Bt; int M, N, K; };

struct StaticOrder {
    int nM, nN, nwg, G, c;
    __host__ __device__ void init(int M, int N, int G_, int c_) { nM = M / BM; nN = N / BM; nwg = nM * nN; G = G_; c = c_; }
    __host__ __device__ bool next(int i, Unit& u) const {
        const long L = (long)i * G + c; if (L >= nwg) return false;
        int wgid = (int)L; { const int q = nwg / NXCD, r = nwg % NXCD, xcd = wgid % NXCD, off = wgid / NXCD; wgid = (xcd < r ? xcd * (q + 1) : r * (q + 1) + (xcd - r) * q) + off; }
        const int nig = WGM * nN, gid = wgid / nig, fm = gid * WGM, gsz = (nM - fm) < WGM ? (nM - fm) : WGM;
        u.pm = fm + ((wgid % nig) % gsz); u.pn = (wgid % nig) / gsz; return true;
    }
    __device__ __forceinline__ void a_ready(const Unit&) const {}
    __device__ __forceinline__ void done(const Unit&) const {}
};
__device__ __forceinline__ unsigned cvt_pk_bf16(float lo, float hi) { unsigned r; asm volatile("v_cvt_pk_bf16_f32 %0, %1, %2" : "=v"(r) : "v"(lo), "v"(hi)); return r; }
typedef float f32x2cv __attribute__((ext_vector_type(2))); typedef __bf16 bf16x2cv __attribute__((ext_vector_type(2)));
__device__ __forceinline__ unsigned cvt_pk_safe(float lo, float hi) { const f32x2cv v = {lo, hi}; union { bf16x2cv b; unsigned u; } x; x.b = __builtin_convertvector(v, bf16x2cv); return x.u; }
typedef float f32x2 __attribute__((ext_vector_type(2)));
template <class Epi, class Sched, bool STAMP = false>
__device__ __forceinline__ void gemm_phase(PG8_LAS unsigned char* lds, const Gemm g, const Sched& S, const Epi& E, unsigned long long* stamps) {
    int tid = threadIdx.x; asm volatile("" : "+v"(tid)); const int wid = __builtin_amdgcn_readfirstlane(tid >> 6), lane = tid & 63, wr = wid >> 2, wc = wid & 3, fr = lane & 15, fq = lane >> 4;
    const int K = g.K, nt = K / BK;
    int ts_lo = 0, ts_hi = 0, nts = 0; const unsigned long long rt_entry = STAMP ? (unsigned long long)wall_clock64() : 0ull;
#define PG8_STAMP() do { if (STAMP && wid == 0 && nts < 64) { const unsigned long long _c = (unsigned long long)clock64(); \
        ts_lo = (lane == nts) ? (int)(unsigned)_c : ts_lo; ts_hi = (lane == nts) ? (int)(unsigned)(_c >> 32) : ts_hi; ++nts; } } while (0)
    PG8_STAMP();
    unsigned voffA[2], voffB[2];
#pragma unroll
    for (int i = 0; i < 2; ++i) { int R, C; stage_rc(tid * 16 + i * 8192, R, C); const int Rb = Epi::PERM ? ((R & ~31) + perm32(R & 31)) : R;
        voffA[i] = (unsigned)(R * K + C) * 2u; voffB[i] = (unsigned)(Rb * K + C) * 2u; }
    const size_t kstep = (size_t)(BK * 2);
    const size_t hstep = (size_t)HALF * K * 2;
    const size_t tstep = 2 * hstep;
    const unsigned ldsw = (unsigned)wid * 1024u;
    const int aoff = lds_byte(wr * 64 + fr, fq * 8), boff = lds_byte(wc * 32 + fr, fq * 8);
#define PG8_SA(b, h) (((b) * 2 + (h)) * HTB)
#define PG8_SB(b, h) ((4 + (b) * 2 + (h)) * HTB)
#define PG8_STAGE(bufoff, gbase, voff) do { _Pragma("unroll") for (int _i = 0; _i < 2; ++_i) \
        __builtin_amdgcn_global_load_lds((const unsigned*)((const char*)(gbase) + (voff)[_i]), (PG8_LAS unsigned*)(lds + (bufoff) + ldsw + _i * 8192), 16, 0, 0); } while (0)
#define PG8_LDA(dst, b, h) do { _Pragma("unroll") for (int m = 0; m < 4; ++m) _Pragma("unroll") for (int k = 0; k < 2; ++k) dst[m][k] = *(const PG8_LAS bf16x8*)(lds + PG8_SA(b, h) + aoff + m * 2048 + k * 1024); } while (0)
#define PG8_LDB(dst, b, h) do { _Pragma("unroll") for (int n = 0; n < 2; ++n) _Pragma("unroll") for (int k = 0; k < 2; ++k) dst[n][k] = *(const PG8_LAS bf16x8*)(lds + PG8_SB(b, h) + boff + n * 2048 + k * 1024); } while (0)
#define PG8_MMA(ai, bj, At, Bt) do { __builtin_amdgcn_s_setprio(1); _Pragma("unroll") for (int m = 0; m < 4; ++m) _Pragma("unroll") for (int n = 0; n < 2; ++n) _Pragma("unroll") for (int k = 0; k < 2; ++k) \
        acc[ai][bj][m][n] = __builtin_amdgcn_mfma_f32_16x16x32_bf16(Bt[n][k], At[m][k], acc[ai][bj][m][n], 0, 0, 0); __builtin_amdgcn_s_setprio(0); } while (0)
#define PG8_WAIT_V(n) asm volatile("s_waitcnt vmcnt(" #n ")" ::: "memory")
#define PG8_WAIT_L(n) asm volatile("s_waitcnt lgkmcnt(" #n ")" ::: "memory")
#define PG8_BAR __builtin_amdgcn_s_barrier()
#define PG8_SCHED __builtin_amdgcn_sched_barrier(0)
    Unit cur, nxt; int ui = 0;
    if (!S.next(0, cur)) return;
    f32x4 acc[2][2][4][2];
#pragma unroll
    for (int a = 0; a < 2; ++a)
#pragma unroll
        for (int b = 0; b < 2; ++b)
#pragma unroll
            for (int m = 0; m < 4; ++m)
#pragma unroll
                for (int n = 0; n < 2; ++n) acc[a][b][m][n] = (f32x4){0.f, 0.f, 0.f, 0.f};
    bf16x8 At[4][2], B0[2][2], B1[2][2];
    const char* cA = (const char*)g.A + (size_t)cur.pm * tstep; const char* cB = (const char*)g.Bt + (size_t)cur.pn * tstep;
    S.a_ready(cur);
    PG8_STAGE(PG8_SB(0, 0), cB, voffB); PG8_STAGE(PG8_SA(0, 0), cA, voffA); PG8_STAGE(PG8_SB(0, 1), cB + hstep, voffB); PG8_STAGE(PG8_SA(0, 1), cA + hstep, voffA);
    if (wr == 1) PG8_BAR;
    PG8_WAIT_V(4); PG8_BAR;
    PG8_STAGE(PG8_SB(1, 0), cB + kstep, voffB); PG8_STAGE(PG8_SA(1, 0), cA + kstep, voffA); PG8_STAGE(PG8_SB(1, 1), cB + hstep + kstep, voffB);
    PG8_WAIT_V(6); PG8_BAR;
    PG8_STAMP();
    for (;;) {
        const bool has_next = S.next(ui + 1, nxt);
        const char* nA = has_next ? (const char*)g.A + (size_t)nxt.pm * tstep : cA; const char* nB = has_next ? (const char*)g.Bt + (size_t)nxt.pn * tstep : cB;
        for (int t = 0; t < nt; t += 2) {
            const bool last = (t == nt - 2);
            const char* a1 = cA + (size_t)(t + 1) * kstep;
            const char* a2 = last ? nA : cA + (size_t)(t + 2) * kstep; const char* b2 = last ? nB : cB + (size_t)(t + 2) * kstep;
            const char* a3 = a2 + kstep; const char* b3 = b2 + kstep;
            if (last && has_next) S.a_ready(nxt);
            PG8_LDB(B0, 0, 0); PG8_SCHED; PG8_LDA(At, 0, 0); PG8_STAGE(PG8_SA(1, 1), a1 + hstep, voffA);
            PG8_WAIT_L(8); PG8_BAR; PG8_WAIT_L(0); PG8_MMA(0, 0, At, B0); PG8_BAR; PG8_SCHED;
            PG8_LDB(B1, 0, 1); PG8_STAGE(PG8_SB(0, 0), b2, voffB);
            PG8_BAR; PG8_WAIT_L(0); PG8_MMA(0, 1, At, B1); PG8_BAR;
            PG8_LDA(At, 0, 1); PG8_STAGE(PG8_SA(0, 0), a2, voffA);
            PG8_BAR; PG8_WAIT_L(0); PG8_MMA(1, 0, At, B0); PG8_BAR; PG8_SCHED;
            PG8_STAGE(PG8_SB(0, 1), b2 + hstep, voffB);
            PG8_WAIT_V(6); PG8_BAR; PG8_MMA(1, 1, At, B1); PG8_BAR;
            PG8_LDB(B0, 1, 0); PG8_SCHED; PG8_LDA(At, 1, 0); PG8_STAGE(PG8_SA(0, 1), a2 + hstep, voffA);
            PG8_WAIT_L(8); PG8_BAR; PG8_WAIT_L(0); PG8_MMA(0, 0, At, B0); PG8_BAR; PG8_SCHED;
            PG8_LDB(B1, 1, 1); PG8_STAGE(PG8_SB(1, 0), b3, voffB);
            PG8_BAR; PG8_WAIT_L(0); PG8_MMA(0, 1, At, B1); PG8_BAR;
            PG8_LDA(At, 1, 1); PG8_STAGE(PG8_SA(1, 0), a3, voffA);
            PG8_BAR; PG8_WAIT_L(0); PG8_MMA(1, 0, At, B0); PG8_BAR; PG8_SCHED;
            PG8_STAGE(PG8_SB(1, 1), b3 + hstep, voffB);
            PG8_WAIT_V(6); PG8_BAR; PG8_MMA(1, 1, At, B1); PG8_BAR;
        }
        PG8_STAMP();
        if constexpr (!Epi::AFTER_DRAIN) { E(acc, cur, wr, wc, fr, fq); S.done(cur); }
        PG8_STAMP();
        if (!has_next) break;
#pragma unroll
        for (int a = 0; a < 2; ++a)
#pragma unroll
            for (int b = 0; b < 2; ++b)
#pragma unroll
                for (int m = 0; m < 4; ++m)
#pragma unroll
                    for (int n = 0; n < 2; ++n) acc[a][b][m][n] = (f32x4){0.f, 0.f, 0.f, 0.f};
        cur = nxt; cA = nA; cB = nB; ++ui;
    }
    PG8_WAIT_V(0);
    if (wr == 0) PG8_BAR;
    PG8_BAR;
    if constexpr (Epi::AFTER_DRAIN) { E.fused(acc, cur, wr, wc, fr, fq, lds, wid, lane); S.done(cur); }
    PG8_STAMP();
    if (STAMP && wid == 0) { stamps[lane] = lane < nts ? (((unsigned long long)(unsigned)ts_hi << 32) | (unsigned)ts_lo) : 0ull;
        if (lane == 62) stamps[62] = rt_entry; if (lane == 63) stamps[63] = (unsigned long long)wall_clock64(); }
#undef PG8_STAMP
#undef PG8_SA
#undef PG8_SB
#undef PG8_STAGE
#undef PG8_LDA
#undef PG8_LDB
#undef PG8_MMA
#undef PG8_WAIT_V
#undef PG8_WAIT_L
#undef PG8_BAR
#undef PG8_SCHED
}
}

#define LAS __attribute__((address_space(3)))
using pg8::bf16_t; using pg8::bf16x8; using pg8::f32x4; using pg8::u32x4; using pg8::cvt_pk_bf16;
typedef unsigned u32x2 __attribute__((ext_vector_type(2)));
typedef float f32x2 __attribute__((ext_vector_type(2)));

constexpr int TP = 16384, TS = 512, TT = 16896, DM = 1024;
constexpr int NHA = 2560, NHB = 3584, DFF = 2816, NUP = 5632;
constexpr float ALPHA = 1.6817928305074292f;
constexpr int LDS_BYTES = 139264;

constexpr size_t WS_WINA = 0;
constexpr size_t WS_WOUTA = WS_WINA + (size_t)2 * NHA * DM * 2;
constexpr size_t WS_WINB = WS_WOUTA + (size_t)2 * DM * DM * 2;
constexpr size_t WS_WOUTB = WS_WINB + (size_t)2 * NHB * DM * 2;
constexpr size_t WS_WKV = WS_WOUTB + (size_t)2 * DM * DM * 2;
constexpr size_t WS_WUP = WS_WKV + (size_t)2048 * DM * 2;
constexpr size_t WS_WDOWN = WS_WUP + (size_t)4 * NUP * DM * 2;
constexpr size_t WS_XF = WS_WDOWN + (size_t)4 * DM * DFF * 2;
constexpr size_t WS_XB = WS_XF + (size_t)TT * DM * 4;
constexpr size_t WS_MEMB = WS_XB + (size_t)TT * DM * 2;
constexpr size_t WS_KB = WS_MEMB + (size_t)2048 * DM * 2;
constexpr size_t WS_VT = WS_KB + (size_t)4 * 8 * 4 * 256 * 64 * 2;
constexpr size_t WS_R = WS_VT + (size_t)4 * 8 * 4 * 256 * 64 * 2;
constexpr size_t WS_H = WS_R;
constexpr size_t WS_CAT = WS_H + (size_t)TT * NHB * 2;
constexpr size_t WS_QKVN = WS_CAT + (size_t)TT * DM * 2;
constexpr size_t WS_GB = WS_QKVN + (size_t)TT * 2304 * 2;
constexpr size_t WS_WC = WS_GB + (size_t)TT * 12 * 4;
constexpr size_t WS_QDC = WS_WC + (size_t)1536 * 16384;
constexpr size_t WS_KDT = WS_QDC + (size_t)1536 * 16384;
constexpr size_t WS_QKC = WS_KDT + (size_t)1536 * 16384;
constexpr size_t WS_UT = WS_QKC + (size_t)1536 * 8192;
constexpr size_t WS_GL = WS_UT + (size_t)1536 * 32768;
constexpr size_t WS_O = WS_GL + (size_t)1536 * 4 + 2048;
constexpr size_t WS_MIX_END = WS_O + (size_t)TT * 768 * 4;
constexpr size_t WS_KT = WS_CAT;
constexpr size_t WS_VTC = WS_XB;
static_assert((size_t)1536 * 16384 <= (size_t)TT * DM * 2, "KT/VT must fit");
constexpr size_t WS_HU = WS_R;
constexpr size_t WS_GACT = WS_HU + (size_t)TT * NUP * 2;
constexpr size_t WS_FFN_END = WS_GACT + (size_t)TT * DFF * 2;
constexpr size_t WS_END = WS_MIX_END > WS_FFN_END ? WS_MIX_END : WS_FFN_END;

constexpr size_t O_Y = 0;
constexpr size_t O_MK = O_Y + (size_t)TT * DM;
constexpr size_t O_MV = O_MK + (size_t)4 * 8 * 256 * 256;
constexpr size_t O_SCP = O_MV + (size_t)4 * 8 * 256 * 256;
constexpr size_t O_GCP = O_SCP + (size_t)2 * 8 * 2 * 768;
constexpr size_t O_GSP = O_GCP + (size_t)2 * 8 * 3 * 2304;
constexpr size_t O_FFP = O_GSP + (size_t)2 * 8 * 6 * 16384;
constexpr size_t O_SCS = O_FFP + (size_t)4 * 8 * 2 * NUP;
constexpr size_t O_GCS = O_SCS + (size_t)2 * 128 * 2 * 768;
constexpr size_t O_GSS = O_GCS + (size_t)2 * 128 * 3 * 2304;
constexpr size_t O_FFS = O_GSS + (size_t)2 * 128 * 6 * 16384;
constexpr size_t O_END = O_FFS + (size_t)4 * 128 * 2 * NUP;

#ifdef DIAG_GDN
constexpr size_t WS_NEED = WS_END + ((size_t)64 << 20);
#else
constexpr size_t WS_NEED = WS_END;
#endif
constexpr size_t WS_BAR = (WS_NEED + 255) / 256 * 256;
constexpr size_t WS_TOTAL = WS_BAR + 16384;
struct Params { const float* in[26]; float* out; unsigned char* ws; };
__device__ __forceinline__ int otid() { int t = threadIdx.x; asm volatile("" : "+v"(t)); return t; }

__device__ __forceinline__ float bflo(unsigned w) { return __uint_as_float(w << 16); }
__device__ __forceinline__ float bfhi(unsigned w) { return __uint_as_float(w & 0xffff0000u); }
__device__ __forceinline__ float bf1(bf16_t v) { return __uint_as_float((unsigned)v << 16); }
__device__ __forceinline__ float silu_f(float x) { return x * __builtin_amdgcn_rcpf(1.f + __expf(-x)); }
__device__ __forceinline__ float wave_sum(float v) {
#pragma unroll
    for (int o = 1; o < 64; o <<= 1) v += __shfl_xor(v, o);
    return v;
}
__device__ __forceinline__ bf16x8 as_bf16x8(u32x4 v) { union { u32x4 u; bf16x8 b; } x; x.u = v; return x.b; }
__device__ __forceinline__ bf16x8 pack8(f32x4 a, f32x4 b) {
    u32x4 w; w.x = cvt_pk_bf16(a[0], a[1]); w.y = cvt_pk_bf16(a[2], a[3]); w.z = cvt_pk_bf16(b[0], b[1]); w.w = cvt_pk_bf16(b[2], b[3]);
    return as_bf16x8(w);
}
__device__ __forceinline__ int invperm32(int a) { return 8 * ((a & 15) >> 2) + (a & 3) + ((a >> 4) << 2); }
__device__ __forceinline__ int perm32k(int p) { const int g = p >> 3, jj = p & 7; return jj < 4 ? 4 * g + jj : 16 + 4 * g + (jj - 4); }

struct EpiStoreBf16 {
    static constexpr bool PERM = true, AFTER_DRAIN = false;
    bf16_t* O; int ldc;
    __device__ __forceinline__ void operator()(const f32x4 (&acc)[2][2][4][2], const pg8::Unit& u, int wr, int wc, int fr, int fq) const {
        const int row0 = u.pm * 256 + wr * 64 + fr, col0 = u.pn * 256 + wc * 32 + 8 * fq;
#pragma unroll
        for (int ai = 0; ai < 2; ++ai)
#pragma unroll
            for (int m = 0; m < 4; ++m) { bf16_t* rowp = O + (size_t)(row0 + ai * 128 + m * 16) * ldc + col0;
#pragma unroll
                for (int bj = 0; bj < 2; ++bj) { const f32x4 v0 = acc[ai][bj][m][0], v1 = acc[ai][bj][m][1];
                    u32x4 w; w.x = cvt_pk_bf16(v0[0], v0[1]); w.y = cvt_pk_bf16(v0[2], v0[3]); w.z = cvt_pk_bf16(v1[0], v1[1]); w.w = cvt_pk_bf16(v1[2], v1[3]);
                    *(u32x4*)(rowp + bj * 128) = w; } }
    }
};
struct EpiResid {
    static constexpr bool PERM = false, AFTER_DRAIN = false;
    float* X; int ldc;
    __device__ __forceinline__ void operator()(const f32x4 (&acc)[2][2][4][2], const pg8::Unit& u, int wr, int wc, int fr, int fq) const {
        const int row0 = u.pm * 256 + wr * 64 + fr, col0 = u.pn * 256 + wc * 32 + 4 * fq;
#pragma unroll
        for (int ai = 0; ai < 2; ++ai)
#pragma unroll
            for (int m = 0; m < 4; ++m) { float* rowp = X + (size_t)(row0 + ai * 128 + m * 16) * ldc + col0;
#pragma unroll
                for (int bj = 0; bj < 2; ++bj)
#pragma unroll
                    for (int n = 0; n < 2; ++n) { f32x4* p = (f32x4*)(rowp + bj * 128 + n * 16); const f32x4 x = *p; *p = x * ALPHA + acc[ai][bj][m][n]; } }
    }
};
struct EpiKV {
    static constexpr bool PERM = false, AFTER_DRAIN = false;
    float* outK; float* outV; bf16_t* Kb; bf16_t* Vt;
    __device__ __forceinline__ void operator()(const f32x4 (&acc)[2][2][4][2], const pg8::Unit& u, int wr, int wc, int fr, int fq) const {
        const int row0 = u.pm * 256 + wr * 64 + fr, col0 = u.pn * 256 + wc * 32 + 4 * fq;
#pragma unroll
        for (int ai = 0; ai < 2; ++ai)
#pragma unroll
            for (int m = 0; m < 4; ++m) { const int row = row0 + ai * 128 + m * 16; const int b = row >> 8, mm = row & 255;
#pragma unroll
                for (int bj = 0; bj < 2; ++bj)
#pragma unroll
                    for (int n = 0; n < 2; ++n) { const int col = col0 + bj * 128 + n * 16; const int l = col >> 9, e = col & 511; const f32x4 v = acc[ai][bj][m][n];
                        if (e < 256) { *(f32x4*)(outK + ((size_t)((l * 8 + b) * 256 + mm)) * 256 + e) = v;
                            u32x2 w; w.x = cvt_pk_bf16(v[0], v[1]); w.y = cvt_pk_bf16(v[2], v[3]);
                            *(u32x2*)(Kb + ((size_t)(((l * 8 + b) * 4 + (e >> 6)) * 256 + mm)) * 64 + (e & 63)) = w; }
                        else { const int e2 = e - 256; *(f32x4*)(outV + ((size_t)((l * 8 + b) * 256 + mm)) * 256 + e2) = v;
                            const unsigned w0 = cvt_pk_bf16(v[0], v[1]), w1 = cvt_pk_bf16(v[2], v[3]);
                            bf16_t* vp = Vt + ((size_t)(((l * 8 + b) * 4 + (e2 >> 6)) * 64 + (e2 & 63))) * 256 + mm;
                            vp[0] = (bf16_t)(w0 & 0xffffu); vp[256] = (bf16_t)(w0 >> 16); vp[512] = (bf16_t)(w1 & 0xffffu); vp[768] = (bf16_t)(w1 >> 16); } } }
    }
};

template <class Epi>
__device__ __forceinline__ void run_gemm(LAS unsigned char* lds, const bf16_t* A, const bf16_t* Bt, int M, int N, int K, const Epi& E, int c) {
    pg8::Gemm g{A, Bt, M, N, K}; pg8::StaticOrder S; S.init(M, N, (int)gridDim.x, c);
    pg8::gemm_phase<Epi, pg8::StaticOrder, false>(lds, g, S, E, nullptr);
}


__device__ __forceinline__ void small_gemm_resid(const bf16_t* A, const bf16_t* Bt, int K, float* X) {
    const int tid_ = otid(); const int lane = tid_ & 63, wave = __builtin_amdgcn_readfirstlane(tid_ >> 6), c16 = lane & 15, g = lane >> 4;
    const int gw = blockIdx.x * 8 + wave, NGW = gridDim.x * 8;
    for (int tile = gw; tile < 2048; tile += NGW) {
        const int rt = tile >> 6, ct = tile & 63;
        const bf16_t* ap = A + (size_t)(TP + rt * 16 + c16) * K + 8 * g;
        const bf16_t* bp = Bt + (size_t)(ct * 16 + c16) * K + 8 * g;
        f32x4 acc = (f32x4){0.f, 0.f, 0.f, 0.f};
#pragma unroll 1
        for (int k = 0; k < K; k += 256) {
            bf16x8 a[8], b[8];
#pragma unroll
            for (int s2 = 0; s2 < 8; ++s2) { a[s2] = *(const bf16x8*)(ap + k + 32 * s2); b[s2] = *(const bf16x8*)(bp + k + 32 * s2); }
#pragma unroll
            for (int s2 = 0; s2 < 8; ++s2) acc = __builtin_amdgcn_mfma_f32_16x16x32_bf16(b[s2], a[s2], acc, 0, 0, 0);
        }
        f32x4* px = (f32x4*)(X + (size_t)(TP + rt * 16 + c16) * DM + ct * 16 + 4 * g);
        const f32x4 x = *px; *px = x * ALPHA + acc;
    }
}
__device__ __forceinline__ void p0_transpose_item(const float* W, int K, int Ns, int Nd, bool remap, bf16_t* WT, LAS float* scr, int item, int lane) {
    const int nblk = Nd / 32, kb = item / nblk, nb = item % nblk, k0 = 64 * kb, n0 = 32 * nb;
    const int n = n0 + (lane & 31); int sn = n;
    if (remap) sn = n < 3072 ? n : (n < 3328 ? n + 12 : (n < 3340 ? n - 256 : -1));
#pragma unroll 8
    for (int i = 0; i < 32; ++i) { const int kk = 2 * i + (lane >> 5); scr[kk * 33 + (lane & 31)] = sn >= 0 ? W[(size_t)(k0 + kk) * Ns + sn] : 0.f; }
    asm volatile("s_waitcnt lgkmcnt(0)" ::: "memory");
    const int c = lane & 7;
#pragma unroll
    for (int j = 0; j < 4; ++j) { const int nn = (lane >> 3) + 8 * j; const LAS float* s = scr + (8 * c) * 33 + nn;
        u32x4 o; o.x = cvt_pk_bf16(s[0 * 33], s[1 * 33]); o.y = cvt_pk_bf16(s[2 * 33], s[3 * 33]); o.z = cvt_pk_bf16(s[4 * 33], s[5 * 33]); o.w = cvt_pk_bf16(s[6 * 33], s[7 * 33]);
        *(u32x4*)(WT + (size_t)(n0 + nn) * K + k0 + 8 * c) = o; }
    asm volatile("s_waitcnt lgkmcnt(0)" ::: "memory");
}

__device__ __forceinline__ void phase_prep(const Params& p, LAS unsigned char* lds) {
    const int tid = otid(), lane = tid & 63, wave = __builtin_amdgcn_readfirstlane(tid >> 6);
    const int gw = blockIdx.x * 8 + wave, NGW = gridDim.x * 8;
    LAS float* scr = (LAS float*)(lds + wave * 16384);
    unsigned char* ws = p.ws;
    constexpr int I_INA = 16 * 80, I_OUT = 16 * 32, I_INB = 16 * 112, I_KV = 16 * 16, I_UP = 16 * 176, I_DN = 44 * 32;
    constexpr int NIT = 2 * I_INA + 2 * I_OUT + 2 * I_INB + 2 * I_OUT + 4 * I_KV + 4 * I_UP + 4 * I_DN;
    for (int it = gw; it < NIT; it += NGW) {
        int r = it;
        if (r < 2 * I_INA) { const int l = r / I_INA; r -= l * I_INA; p0_transpose_item(p.in[9] + (size_t)l * DM * NHA, DM, NHA, NHA, false, (bf16_t*)(ws + WS_WINA) + (size_t)l * NHA * DM, scr, r, lane); continue; } r -= 2 * I_INA;
        if (r < 2 * I_OUT) { const int l = r / I_OUT; r -= l * I_OUT; p0_transpose_item(p.in[11] + (size_t)l * DM * DM, DM, DM, DM, false, (bf16_t*)(ws + WS_WOUTA) + (size_t)l * DM * DM, scr, r, lane); continue; } r -= 2 * I_OUT;
        if (r < 2 * I_INB) { const int l = r / I_INB; r -= l * I_INB; p0_transpose_item(p.in[12] + (size_t)l * DM * 3340, DM, 3340, NHB, true, (bf16_t*)(ws + WS_WINB) + (size_t)l * NHB * DM, scr, r, lane); continue; } r -= 2 * I_INB;
        if (r < 2 * I_OUT) { const int l = r / I_OUT; r -= l * I_OUT; p0_transpose_item(p.in[17] + (size_t)l * DM * DM, DM, DM, DM, false, (bf16_t*)(ws + WS_WOUTB) + (size_t)l * DM * DM, scr, r, lane); continue; } r -= 2 * I_OUT;
        if (r < 4 * I_KV) { const int l = r / I_KV; r -= l * I_KV; p0_transpose_item(p.in[18] + (size_t)l * DM * 512, DM, 512, 512, false, (bf16_t*)(ws + WS_WKV) + (size_t)l * 512 * DM, scr, r, lane); continue; } r -= 4 * I_KV;
        if (r < 4 * I_UP) { const int l = r / I_UP; r -= l * I_UP; p0_transpose_item(p.in[23] + (size_t)l * DM * NUP, DM, NUP, NUP, false, (bf16_t*)(ws + WS_WUP) + (size_t)l * NUP * DM, scr, r, lane); continue; } r -= 4 * I_UP;
        { const int l = r / I_DN; r -= l * I_DN; p0_transpose_item(p.in[25] + (size_t)l * DFF * DM, DFF, DM, DM, false, (bf16_t*)(ws + WS_WDOWN) + (size_t)l * DM * DFF, scr, r, lane); }
    }
    const size_t gt = (size_t)blockIdx.x * 512 + tid, NT = (size_t)gridDim.x * 512;
    float* xf = (float*)(ws + WS_XF); bf16_t* xb = (bf16_t*)(ws + WS_XB); bf16_t* memb = (bf16_t*)(ws + WS_MEMB);
    for (size_t i = gt; i < (size_t)TT * 256; i += NT) {
        const f32x4 v = i < (size_t)TP * 256 ? ((const f32x4*)p.in[0])[i] : ((const f32x4*)p.in[1])[i - (size_t)TP * 256];
        ((f32x4*)xf)[i] = v; u32x2 w; w.x = cvt_pk_bf16(v[0], v[1]); w.y = cvt_pk_bf16(v[2], v[3]); ((u32x2*)xb)[i] = w;
    }
    for (size_t i = gt; i < (size_t)2048 * 256; i += NT) {
        const f32x4 v = ((const f32x4*)p.in[2])[i]; u32x2 w; w.x = cvt_pk_bf16(v[0], v[1]); w.y = cvt_pk_bf16(v[2], v[3]); ((u32x2*)memb)[i] = w;
    }
}

__device__ __forceinline__ void phase_ln(float* xf, bf16_t* xb, const float* gam, const float* bet, float* yout) {
    const int tid_ = otid(); const int lane = tid_ & 63, wave = __builtin_amdgcn_readfirstlane(tid_ >> 6);
    const int gw = blockIdx.x * 8 + wave, NGW = gridDim.x * 8;
    f32x4 gg[4], bb[4];
#pragma unroll
    for (int j = 0; j < 4; ++j) { gg[j] = ((const f32x4*)gam)[lane + 64 * j]; bb[j] = ((const f32x4*)bet)[lane + 64 * j]; }
    f32x4 nx[4];
    if (gw < TT) {
#pragma unroll
        for (int j = 0; j < 4; ++j) nx[j] = ((const f32x4*)(xf + (size_t)gw * DM))[lane + 64 * j]; }
    for (int row = gw; row < TT; row += NGW) {
        f32x4* xr = (f32x4*)(xf + (size_t)row * DM) + lane;
        f32x4 v[4]; float s = 0.f;
#pragma unroll
        for (int j = 0; j < 4; ++j) { v[j] = nx[j]; s += (v[j][0] + v[j][1]) + (v[j][2] + v[j][3]); }
        if (row + NGW < TT) {
#pragma unroll
            for (int j = 0; j < 4; ++j) nx[j] = ((const f32x4*)(xf + (size_t)(row + NGW) * DM))[lane + 64 * j]; }
        const float mean = wave_sum(s) * (1.f / DM); float s2 = 0.f;
#pragma unroll
        for (int j = 0; j < 4; ++j) { v[j] = v[j] - mean; s2 += (v[j][0] * v[j][0] + v[j][1] * v[j][1]) + (v[j][2] * v[j][2] + v[j][3] * v[j][3]); }
        const float rstd = 1.f / sqrtf(wave_sum(s2) * (1.f / DM) + 1e-5f);
#pragma unroll
        for (int j = 0; j < 4; ++j) { const f32x4 o = v[j] * rstd * gg[j] + bb[j];
            if (yout) ((f32x4*)(yout + (size_t)row * DM))[lane + 64 * j] = o;
            else { xr[64 * j] = o; u32x2 w; w.x = cvt_pk_bf16(o[0], o[1]); w.y = cvt_pk_bf16(o[2], o[3]); ((u32x2*)(xb + (size_t)row * DM))[lane + 64 * j] = w; } }
    }
}

__device__ __forceinline__ void attn_prompt_item(LAS unsigned char* lds, const bf16_t* h, int ldh, int qoff, const bf16_t* Kb, const bf16_t* Vt, bf16_t* cat, int layer, int item) {
    const int tid = otid(), lane = tid & 63, wave = __builtin_amdgcn_readfirstlane(tid >> 6), c16 = lane & 15, g = lane >> 4;
    const int qc = item & 7, hd = (item >> 3) & 3, b = item >> 5;
    const size_t kvbase = ((size_t)((layer * 8 + b) * 4 + hd)) * 16384;
    constexpr int VOFF = 256 * 144;
#pragma unroll
    for (int i = 0; i < 4; ++i) { const int q = tid + 512 * i;
        const u32x4 kv = *(const u32x4*)(Kb + kvbase + (size_t)q * 8); *(LAS u32x4*)(lds + (q >> 3) * 144 + (q & 7) * 16) = kv;
        const u32x4 vv = *(const u32x4*)(Vt + kvbase + (size_t)q * 8); *(LAS u32x4*)(lds + VOFF + (q >> 5) * 528 + (q & 31) * 16) = vv; }
    __syncthreads();
#pragma unroll 1
    for (int qt = wave; qt < 16; qt += 8) {
        const int row = b * 2048 + qc * 256 + qt * 16 + c16;
        const bf16_t* qp = h + (size_t)row * ldh + qoff + hd * 64 + g * 8;
        const bf16x8 qf0 = *(const bf16x8*)qp, qf1 = *(const bf16x8*)(qp + 32);
        f32x4 acc[16];
#pragma unroll
        for (int kt = 0; kt < 16; ++kt) { acc[kt] = (f32x4){0.f, 0.f, 0.f, 0.f};
            const LAS unsigned char* kp = lds + (16 * kt + c16) * 144 + g * 16;
            const bf16x8 k0 = *(const LAS bf16x8*)kp, k1 = *(const LAS bf16x8*)(kp + 64);
            acc[kt] = __builtin_amdgcn_mfma_f32_16x16x32_bf16(k0, qf0, acc[kt], 0, 0, 0);
            acc[kt] = __builtin_amdgcn_mfma_f32_16x16x32_bf16(k1, qf1, acc[kt], 0, 0, 0); }
        float mx = -3.0e38f;
#pragma unroll
        for (int kt = 0; kt < 16; ++kt) mx = fmaxf(mx, fmaxf(fmaxf(acc[kt][0], acc[kt][1]), fmaxf(acc[kt][2], acc[kt][3])));
        mx = fmaxf(mx, __shfl_xor(mx, 16)); mx = fmaxf(mx, __shfl_xor(mx, 32));
        const float sc = 0.125f * 1.44269504089f; float sum = 0.f;
#pragma unroll
        for (int kt = 0; kt < 16; ++kt)
#pragma unroll
            for (int r = 0; r < 4; ++r) { const float e = __builtin_amdgcn_exp2f((acc[kt][r] - mx) * sc); acc[kt][r] = e; sum += e; }
        sum += __shfl_xor(sum, 16); sum += __shfl_xor(sum, 32);
        const float inv = 1.f / sum;
        f32x4 o[4];
#pragma unroll
        for (int dt = 0; dt < 4; ++dt) o[dt] = (f32x4){0.f, 0.f, 0.f, 0.f};
#pragma unroll
        for (int s = 0; s < 8; ++s) { const bf16x8 pf = pack8(acc[2 * s], acc[2 * s + 1]);
#pragma unroll
            for (int dt = 0; dt < 4; ++dt) { const LAS unsigned char* vp = lds + VOFF + (16 * dt + c16) * 528 + (32 * s + 4 * g) * 2;
                const u32x2 a0 = *(const LAS u32x2*)vp, a1 = *(const LAS u32x2*)(vp + 32);
                u32x4 av; av.x = a0.x; av.y = a0.y; av.z = a1.x; av.w = a1.y;
                o[dt] = __builtin_amdgcn_mfma_f32_16x16x32_bf16(as_bf16x8(av), pf, o[dt], 0, 0, 0); } }
#pragma unroll
        for (int dt = 0; dt < 4; ++dt) { u32x2 w; w.x = cvt_pk_bf16(o[dt][0] * inv, o[dt][1] * inv); w.y = cvt_pk_bf16(o[dt][2] * inv, o[dt][3] * inv);
            *(u32x2*)(cat + (size_t)row * DM + 768 + hd * 64 + 16 * dt + 4 * g) = w; }
    }
    __syncthreads();
}

__device__ __forceinline__ void attn_prompt_item_naive(LAS unsigned char* lds, const bf16_t* h, int ldh, int qoff, const float* outK, const float* outV, bf16_t* cat, int layer, int item) {
    const int tid = otid();
    const int qc = item & 7, hd = (item >> 3) & 3, b = item >> 5;
    LAS float* Ks = (LAS float*)lds; LAS float* Vs = Ks + 256 * 64;
    for (int i = tid; i < 256 * 64; i += 512) { const int m = i >> 6, d = i & 63; const size_t src = ((size_t)((layer * 8 + b) * 256 + m)) * 256 + hd * 64 + d; Ks[i] = outK[src]; Vs[i] = outV[src]; }
    __syncthreads();
    const int ql = tid & 255, half = tid >> 8;
    const int row = b * 2048 + qc * 256 + ql;
    float q[64];
#pragma unroll
    for (int d = 0; d < 64; ++d) q[d] = bf1(h[(size_t)row * ldh + qoff + hd * 64 + d]);
    float mx = -3.0e38f, l = 0.f; float acc[64];
#pragma unroll
    for (int d = 0; d < 64; ++d) acc[d] = 0.f;
#pragma unroll 1
    for (int m = half * 128; m < half * 128 + 128; ++m) {
        float sdot = 0.f;
#pragma unroll
        for (int d = 0; d < 64; ++d) sdot += q[d] * Ks[m * 64 + d];
        sdot *= 0.125f;
        const float nm = fmaxf(mx, sdot); const float corr = __expf(mx - nm), pe = __expf(sdot - nm);
        l = l * corr + pe;
#pragma unroll
        for (int d = 0; d < 64; ++d) acc[d] = acc[d] * corr + pe * Vs[m * 64 + d];
        mx = nm;
    }
    __syncthreads();
    LAS float* ex = (LAS float*)lds;
    if (half == 1) { ex[ql * 66 + 64] = mx; ex[ql * 66 + 65] = l;
#pragma unroll
        for (int d = 0; d < 64; ++d) ex[ql * 66 + d] = acc[d]; }
    __syncthreads();
    if (half == 0) { const float m2 = ex[ql * 66 + 64], l2 = ex[ql * 66 + 65]; const float nm = fmaxf(mx, m2); const float c1 = __expf(mx - nm), c2 = __expf(m2 - nm); const float inv = 1.f / (l * c1 + l2 * c2);
#pragma unroll
        for (int d = 0; d < 64; ++d) { const float o = (acc[d] * c1 + ex[ql * 66 + d] * c2) * inv; cat[(size_t)row * DM + 768 + hd * 64 + d] = (bf16_t)(cvt_pk_bf16(o, 0.f) & 0xffffu); } }
    __syncthreads();
}
__device__ __forceinline__ void attn_sample_item(LAS unsigned char* lds, const bf16_t* h, int ldh, int qoff, const float* ck, const float* cv, bf16_t* cat, int layer, int item) {
    const int tid = otid(), lane = tid & 63, wave = __builtin_amdgcn_readfirstlane(tid >> 6);
    const int hp = item & 1, sb = item >> 1;
    LAS float* qs = (LAS float*)lds;
    LAS float* scs = qs + 512;
    LAS float* red = scs + 2048;
    { const int t = tid >> 7, hh = (tid >> 6) & 1, d = tid & 63;
      qs[tid] = bf1(h[(size_t)(TP + sb * 4 + t) * ldh + qoff + (2 * hp + hh) * 64 + d]); }
    __syncthreads();
    { const int m = tid & 255, hh = tid >> 8;
      const f32x4* kp = (const f32x4*)(ck + (((size_t)(layer * 128 + sb) * 256 + m) * 4 + (2 * hp + hh)) * 64);
      float a0 = 0.f, a1 = 0.f, a2 = 0.f, a3 = 0.f;
#pragma unroll
      for (int i = 0; i < 16; ++i) { const f32x4 kv = kp[i];
#pragma unroll
          for (int e = 0; e < 4; ++e) { const int d = 4 * i + e; a0 += kv[e] * qs[(0 * 2 + hh) * 64 + d]; a1 += kv[e] * qs[(1 * 2 + hh) * 64 + d]; a2 += kv[e] * qs[(2 * 2 + hh) * 64 + d]; a3 += kv[e] * qs[(3 * 2 + hh) * 64 + d]; } }
      scs[(0 * 2 + hh) * 256 + m] = a0 * 0.125f; scs[(1 * 2 + hh) * 256 + m] = a1 * 0.125f; scs[(2 * 2 + hh) * 256 + m] = a2 * 0.125f; scs[(3 * 2 + hh) * 256 + m] = a3 * 0.125f; }
    __syncthreads();
    { LAS float* sp = scs + wave * 256; float v[4]; float mx = -3.0e38f;
#pragma unroll
      for (int i = 0; i < 4; ++i) { v[i] = sp[lane + 64 * i]; mx = fmaxf(mx, v[i]); }
#pragma unroll
      for (int o = 1; o < 64; o <<= 1) mx = fmaxf(mx, __shfl_xor(mx, o));
      float s = 0.f;
#pragma unroll
      for (int i = 0; i < 4; ++i) { v[i] = __expf(v[i] - mx); s += v[i]; }
      s = wave_sum(s); const float inv = 1.f / s;
#pragma unroll
      for (int i = 0; i < 4; ++i) sp[lane + 64 * i] = v[i] * inv; }
    __syncthreads();
    { const int d = tid & 63, hh = (tid >> 6) & 1, mp = tid >> 7;
      float a0 = 0.f, a1 = 0.f, a2 = 0.f, a3 = 0.f;
      const float* vp = cv + (((size_t)(layer * 128 + sb) * 256 + mp * 64) * 4 + (2 * hp + hh)) * 64 + d;
#pragma unroll 8
      for (int m = 0; m < 64; ++m) { const float vv = vp[(size_t)m * 256]; const int mm = mp * 64 + m;
          a0 += scs[(0 * 2 + hh) * 256 + mm] * vv; a1 += scs[(1 * 2 + hh) * 256 + mm] * vv; a2 += scs[(2 * 2 + hh) * 256 + mm] * vv; a3 += scs[(3 * 2 + hh) * 256 + mm] * vv; }
      red[(mp * 8 + 0 * 2 + hh) * 64 + d] = a0; red[(mp * 8 + 1 * 2 + hh) * 64 + d] = a1; red[(mp * 8 + 2 * 2 + hh) * 64 + d] = a2; red[(mp * 8 + 3 * 2 + hh) * 64 + d] = a3; }
    __syncthreads();
    { const int t = tid >> 7, hh = (tid >> 6) & 1, d = tid & 63; const int idx = (t * 2 + hh) * 64 + d;
      const float o = red[idx] + red[512 + idx] + red[1024 + idx] + red[1536 + idx];
      cat[(size_t)(TP + sb * 4 + t) * DM + 768 + (2 * hp + hh) * 64 + d] = (bf16_t)(cvt_pk_bf16(o, 0.f) & 0xffffu); }
    __syncthreads();
}

__device__ __forceinline__ void load_u8(const bf16_t* h, size_t row, int c, float* u) {
    const u32x4 xi = *(const u32x4*)(h + row * NHA + c), cg = *(const u32x4*)(h + row * NHA + 1536 + c);
#pragma unroll
    for (int i = 0; i < 4; ++i) { u[2 * i] = bflo(xi[i]) * bflo(cg[i]); u[2 * i + 1] = bfhi(xi[i]) * bfhi(cg[i]); }
}
__device__ __forceinline__ void load_f8(const float* src, float* v) {
    const f32x4 a = ((const f32x4*)src)[0], b = ((const f32x4*)src)[1];
#pragma unroll
    for (int i = 0; i < 4; ++i) { v[i] = a[i]; v[4 + i] = b[i]; }
}
__device__ __forceinline__ void phase_mixA_elem(const Params& p, int j) {
    const bf16_t* h = (const bf16_t*)(p.ws + WS_H); bf16_t* cat = (bf16_t*)(p.ws + WS_CAT);
    const float* cw = p.in[10] + (size_t)j * 3 * 768; const float* hist = p.in[5] + (size_t)j * 128 * 2 * 768;
    const int gt = blockIdx.x * 512 + otid(), NT = gridDim.x * 512;
    constexpr int RB = 4, NPB = TP / RB, NIT = (NPB + 128) * 96;
    for (int it = gt; it < NIT; it += NT) {
        const int blk = it / 96, c = (it % 96) * 8;
        const bool smp = blk >= NPB; const int row0 = smp ? TP + (blk - NPB) * 4 : blk * RB; const int t0 = smp ? 0 : (row0 & 2047); const int bb = smp ? blk - NPB : (row0 >> 11);
        float w0[8], w1[8], w2[8];
        load_f8(cw + c, w0); load_f8(cw + 768 + c, w1); load_f8(cw + 1536 + c, w2);
        float u0[8], u1[8], u2[8];
        if (t0 >= 2) { load_u8(h, row0 - 2, c, u0); load_u8(h, row0 - 1, c, u1); }
        else if (smp) { load_f8(hist + ((size_t)bb * 2 + 0) * 768 + c, u0); load_f8(hist + ((size_t)bb * 2 + 1) * 768 + c, u1); }
        else {
#pragma unroll
            for (int i = 0; i < 8; ++i) { u0[i] = 0.f; u1[i] = 0.f; } }
        const int T = smp ? 4 : 2048;
#pragma unroll
        for (int r = 0; r < RB; ++r) {
            const size_t row = (size_t)row0 + r;
            load_u8(h, row, c, u2);
            const u32x4 bg = *(const u32x4*)(h + row * NHA + 768 + c);
            float y[8];
#pragma unroll
            for (int i = 0; i < 8; ++i) { const float bgv = (i & 1) ? bfhi(bg[i >> 1]) : bflo(bg[i >> 1]); y[i] = bgv * (w0[i] * u0[i] + w1[i] * u1[i] + w2[i] * u2[i]); }
            u32x4 w; w.x = cvt_pk_bf16(y[0], y[1]); w.y = cvt_pk_bf16(y[2], y[3]); w.z = cvt_pk_bf16(y[4], y[5]); w.w = cvt_pk_bf16(y[6], y[7]);
            *(u32x4*)(cat + row * DM + c) = w;
            const int t = t0 + r;
            if (t >= T - 2) { float* op = p.out + (smp ? O_SCS : O_SCP) + (((size_t)j * (smp ? 128 : 8) + bb) * 2 + (t - (T - 2))) * 768 + c;
                ((f32x4*)op)[0] = (f32x4){u2[0], u2[1], u2[2], u2[3]}; ((f32x4*)op)[1] = (f32x4){u2[4], u2[5], u2[6], u2[7]}; }
#pragma unroll
            for (int i = 0; i < 8; ++i) { u0[i] = u1[i]; u1[i] = u2[i]; }
        }
    }
}

__device__ __forceinline__ void load_h8(const bf16_t* hu, size_t row, int c, float* v) {
    const u32x4 x = *(const u32x4*)(hu + row * NUP + c);
#pragma unroll
    for (int i = 0; i < 4; ++i) { v[2 * i] = bflo(x[i]); v[2 * i + 1] = bfhi(x[i]); }
}
__device__ __forceinline__ void unpk8(const u32x4 x, float* v) {
#pragma unroll
    for (int i = 0; i < 4; ++i) { v[2 * i] = bflo(x[i]); v[2 * i + 1] = bfhi(x[i]); }
}
__device__ __forceinline__ void phase_convgate(const Params& p, int l) {
    const bf16_t* hu = (const bf16_t*)(p.ws + WS_HU); bf16_t* gact = (bf16_t*)(p.ws + WS_GACT);
    const float* cw = p.in[24] + (size_t)l * 3 * NUP; const float* hist = p.in[8] + (size_t)l * 128 * 2 * NUP;
    const int gt = blockIdx.x * 512 + otid(), NT = gridDim.x * 512;
    constexpr int RB = 8, NPB = TP / RB, NITP = NPB * 352, NIT = NITP + 128 * 352;
    for (int it = gt; it < NIT; it += NT) {
        const bool smp = it >= NITP;
        const int blk = smp ? (it - NITP) / 352 : it / 352, c = (smp ? (it - NITP) % 352 : it % 352) * 8;
        const int row0 = smp ? TP + blk * 4 : blk * RB; const int t0 = smp ? 0 : (row0 & 2047); const int bb = smp ? blk : (row0 >> 11);
        const int nr = smp ? 4 : RB; const int T = smp ? 4 : 2048;
        u32x4 rg[RB + 2], ra[RB + 2];
        const bool hal = t0 >= 2;
#pragma unroll
        for (int r = 0; r < RB + 2; ++r) { const int rr = r - 2;
            if ((rr >= 0 && rr < nr) || (rr < 0 && hal)) { rg[r] = *(const u32x4*)(hu + (size_t)(row0 + rr) * NUP + c); ra[r] = *(const u32x4*)(hu + (size_t)(row0 + rr) * NUP + DFF + c); }
            else { rg[r] = (u32x4){0u, 0u, 0u, 0u}; ra[r] = (u32x4){0u, 0u, 0u, 0u}; } }
        float wg0[8], wg1[8], wg2[8], wu0[8], wu1[8], wu2[8];
        load_f8(cw + c, wg0); load_f8(cw + NUP + c, wg1); load_f8(cw + 2 * NUP + c, wg2);
        load_f8(cw + DFF + c, wu0); load_f8(cw + NUP + DFF + c, wu1); load_f8(cw + 2 * NUP + DFF + c, wu2);
        float g0[8], g1[8], g2[8], a0[8], a1[8], a2[8];
        if (smp) { load_f8(hist + ((size_t)bb * 2 + 0) * NUP + c, g0); load_f8(hist + ((size_t)bb * 2 + 1) * NUP + c, g1); load_f8(hist + ((size_t)bb * 2 + 0) * NUP + DFF + c, a0); load_f8(hist + ((size_t)bb * 2 + 1) * NUP + DFF + c, a1); }
        else { unpk8(rg[0], g0); unpk8(rg[1], g1); unpk8(ra[0], a0); unpk8(ra[1], a1); }
#pragma unroll
        for (int r = 0; r < RB; ++r) {
            if (r < nr) {
                const size_t row = (size_t)row0 + r;
                unpk8(rg[r + 2], g2); unpk8(ra[r + 2], a2);
                float y[8];
#pragma unroll
                for (int i = 0; i < 8; ++i) { const float gg = wg0[i] * g0[i] + wg1[i] * g1[i] + wg2[i] * g2[i], uu = wu0[i] * a0[i] + wu1[i] * a1[i] + wu2[i] * a2[i]; y[i] = silu_f(gg) * uu; }
                u32x4 w; w.x = cvt_pk_bf16(y[0], y[1]); w.y = cvt_pk_bf16(y[2], y[3]); w.z = cvt_pk_bf16(y[4], y[5]); w.w = cvt_pk_bf16(y[6], y[7]);
                *(u32x4*)(gact + row * DFF + c) = w;
                const int t = t0 + r;
                if (t >= T - 2) { float* op = p.out + (smp ? O_FFS : O_FFP) + (((size_t)l * (smp ? 128 : 8) + bb) * 2 + (t - (T - 2))) * NUP + c;
                    ((f32x4*)op)[0] = (f32x4){g2[0], g2[1], g2[2], g2[3]}; ((f32x4*)op)[1] = (f32x4){g2[4], g2[5], g2[6], g2[7]};
                    ((f32x4*)(op + DFF))[0] = (f32x4){a2[0], a2[1], a2[2], a2[3]}; ((f32x4*)(op + DFF))[1] = (f32x4){a2[4], a2[5], a2[6], a2[7]}; }
#pragma unroll
                for (int i = 0; i < 8; ++i) { g0[i] = g1[i]; g1[i] = g2[i]; a0[i] = a1[i]; a1[i] = a2[i]; }
            }
        }
    }
}

__device__ __forceinline__ void phase_gdn_pre(const Params& p, int j) {
    const bf16_t* h = (const bf16_t*)(p.ws + WS_H); bf16_t* qkvn = (bf16_t*)(p.ws + WS_QKVN); float* gb = (float*)(p.ws + WS_GB);
    const float* cw = p.in[13] + (size_t)j * 4 * 2304; const float* hist = p.in[6] + (size_t)j * 128 * 3 * 2304;
    const int tid_ = otid(); const int lane = tid_ & 63, wave = __builtin_amdgcn_readfirstlane(tid_ >> 6);
    const int gw = blockIdx.x * 8 + wave, NGW = gridDim.x * 8;
    constexpr int RB = 8, NPB = TP / RB, NIT = (NPB + 128) * 6;
    for (int it = gw; it < NIT; it += NGW) {
        const int blk = it / 6, hd = it % 6;
        const bool smp = blk >= NPB; const int row0 = smp ? TP + (blk - NPB) * 4 : blk * RB; const int t0 = smp ? 0 : (row0 & 2047); const int bb = smp ? blk - NPB : (row0 >> 11);
        const int nr = smp ? 4 : RB; const int T = smp ? 4 : 2048;
        const float alog = -__expf(p.in[14][j * 6 + hd]), dtb = p.in[15][j * 6 + hd];
        f32x2 wv[3][4], x[3][4];
        float tk0[RB], tk1[RB], tv0[RB], tv1[RB];
#pragma unroll
        for (int r = 0; r < RB; ++r) { tk0[r] = 0.f; tk1[r] = 0.f; tv0[r] = 0.f; tv1[r] = 0.f; }
#pragma unroll
        for (int sec = 0; sec < 3; ++sec) { const int col = sec * 768 + hd * 128 + 2 * lane;
#pragma unroll
            for (int k = 0; k < 4; ++k) wv[sec][k] = *(const f32x2*)(cw + (size_t)k * 2304 + col);
#pragma unroll
            for (int k = 0; k < 3; ++k) {
                if (t0 >= 3) { const unsigned w = *(const unsigned*)(h + (size_t)(row0 - 3 + k) * NHB + col); x[sec][k] = (f32x2){bflo(w), bfhi(w)}; }
                else if (smp) x[sec][k] = *(const f32x2*)(hist + ((size_t)bb * 3 + k) * 2304 + col);
                else x[sec][k] = (f32x2){0.f, 0.f}; } }
        unsigned raw[3][RB];
#pragma unroll
        for (int r = 0; r < RB; ++r)
#pragma unroll
            for (int sec = 0; sec < 3; ++sec) raw[sec][r] = r < nr ? *(const unsigned*)(h + (size_t)(row0 + r) * NHB + sec * 768 + hd * 128 + 2 * lane) : 0u;
#pragma unroll
        for (int r = 0; r < RB; ++r) {
            if (r < nr) {
                const int row = row0 + r, t = t0 + r;
                float val[3][2];
#pragma unroll
                for (int sec = 0; sec < 3; ++sec) { const int col = sec * 768 + hd * 128 + 2 * lane;
                    const unsigned w = raw[sec][r]; x[sec][3] = (f32x2){bflo(w), bfhi(w)};
                    const f32x2 a = wv[sec][0] * x[sec][0] + wv[sec][1] * x[sec][1] + wv[sec][2] * x[sec][2] + wv[sec][3] * x[sec][3];
                    val[sec][0] = silu_f(a[0]); val[sec][1] = silu_f(a[1]);
                    if (t >= T - 3) { float* op = p.out + (smp ? O_GCS : O_GCP) + (((size_t)j * (smp ? 128 : 8) + bb) * 3 + (t - (T - 3))) * 2304 + col; *(f32x2*)op = x[sec][3]; }
                    x[sec][0] = x[sec][1]; x[sec][1] = x[sec][2]; x[sec][2] = x[sec][3]; }
#pragma unroll
                for (int sec = 0; sec < 2; ++sec) { const float ss = wave_sum(val[sec][0] * val[sec][0] + val[sec][1] * val[sec][1]); const float rr = 1.f / sqrtf(ss + 1e-6f); val[sec][0] *= rr; val[sec][1] *= rr; }
#pragma unroll
                for (int sec = 0; sec < 3; ++sec) *(unsigned*)(qkvn + (size_t)row * 2304 + sec * 768 + hd * 128 + 2 * lane) = cvt_pk_bf16(val[sec][0], val[sec][1]);
                tk0[r] = val[1][0]; tk1[r] = val[1][1]; tv0[r] = val[2][0]; tv1[r] = val[2][1];
                if (lane == 0) {
                    const float bv = bf1(h[(size_t)row * NHB + 3328 + hd]), av = bf1(h[(size_t)row * NHB + 3334 + hd]);
                    const float xx = av + dtb;
                    const float sp = fmaxf(xx, 0.f) + log1pf(__expf(-fabsf(xx)));
                    gb[(size_t)row * 12 + hd] = alog * sp;
                    gb[(size_t)row * 12 + 6 + hd] = 1.f / (1.f + __expf(-bv));
                }
            }
        }
        if (!smp) {
            const int ci = (bb * 6 + hd) * 32 + (t0 >> 6), off = t0 & 63;
            bf16_t* kt = (bf16_t*)(p.ws + WS_KT) + (size_t)ci * 8192 + (size_t)(2 * lane) * 64 + off;
            bf16_t* vt = (bf16_t*)(p.ws + WS_VTC) + (size_t)ci * 8192 + (size_t)(2 * lane) * 64 + off;
            u32x4 w;
            w.x = cvt_pk_bf16(tk0[0], tk0[1]); w.y = cvt_pk_bf16(tk0[2], tk0[3]); w.z = cvt_pk_bf16(tk0[4], tk0[5]); w.w = cvt_pk_bf16(tk0[6], tk0[7]); *(u32x4*)kt = w;
            w.x = cvt_pk_bf16(tk1[0], tk1[1]); w.y = cvt_pk_bf16(tk1[2], tk1[3]); w.z = cvt_pk_bf16(tk1[4], tk1[5]); w.w = cvt_pk_bf16(tk1[6], tk1[7]); *(u32x4*)(kt + 64) = w;
            w.x = cvt_pk_bf16(tv0[0], tv0[1]); w.y = cvt_pk_bf16(tv0[2], tv0[3]); w.z = cvt_pk_bf16(tv0[4], tv0[5]); w.w = cvt_pk_bf16(tv0[6], tv0[7]); *(u32x4*)vt = w;
            w.x = cvt_pk_bf16(tv1[0], tv1[1]); w.y = cvt_pk_bf16(tv1[2], tv1[3]); w.z = cvt_pk_bf16(tv1[4], tv1[5]); w.w = cvt_pk_bf16(tv1[6], tv1[7]); *(u32x4*)(vt + 64) = w;
        }
    }
}

#ifdef OLD_PREP
__device__ __forceinline__ void solve_lds(LAS float* sol, const LAS float* A, int lane) {
#pragma unroll 1
    for (int i = 1; i < 64; ++i) {
        float r0 = sol[i * 64 + lane], r1 = 0.f;
        const int n4 = (i + 3) >> 2;
#pragma unroll 2
        for (int j4 = 0; j4 < n4; ++j4) {
            const f32x4 a = *(const LAS f32x4*)(A + i * 64 + 4 * j4);
            const LAS float* sp = sol + (4 * j4) * 64 + lane;
            r0 -= a[0] * sp[0]; r1 -= a[1] * sp[64]; r0 -= a[2] * sp[128]; r1 -= a[3] * sp[192];
        }
        sol[i * 64 + lane] = r0 + r1;
    }
}
__device__ __forceinline__ void phase_gdn_prep(const Params& p, LAS unsigned char* lds) {
    const bf16_t* qkvn = (const bf16_t*)(p.ws + WS_QKVN); const float* gb = (const float*)(p.ws + WS_GB);
    bf16_t* Wc = (bf16_t*)(p.ws + WS_WC); bf16_t* QDc = (bf16_t*)(p.ws + WS_QDC); bf16_t* KDT = (bf16_t*)(p.ws + WS_KDT); bf16_t* QKc = (bf16_t*)(p.ws + WS_QKC);
    float* UT = (float*)(p.ws + WS_UT); float* GL = (float*)(p.ws + WS_GL);
    const int tid_ = otid(); const int lane0 = tid_ & 63, wave = __builtin_amdgcn_readfirstlane(tid_ >> 6);
    if (wave >= 4) return;
    const int gw = blockIdx.x * 4 + wave, NGW = gridDim.x * 4;
#pragma unroll 1
    for (int ci = gw; ci < 1536; ci += NGW) {
        int lane = lane0; unsigned aoff = (unsigned)wave * 32768u;
        asm volatile("" : "+v"(lane), "+v"(aoff));
        const int c16 = lane & 15, g = lane >> 4;
        LAS float* A = (LAS float*)(lds + aoff);
        const int n = ci & 31, hd = (ci >> 5) % 6, b = ci / 192;
        const int tok0 = b * 2048 + n * 64;
        const float gi = gb[(size_t)(tok0 + lane) * 12 + hd], beta = gb[(size_t)(tok0 + lane) * 12 + 6 + hd];
        float gc = gi;
#pragma unroll
        for (int o = 1; o < 64; o <<= 1) { const float tv = __shfl_up(gc, o); if (lane >= o) gc += tv; }
        const float gl = __shfl(gc, 63);
        const float egc = __expf(gc), edl = __expf(gl - gc);
        if (lane == 0) GL[ci] = __expf(gl);
        {
            bf16x8 kf[4][4];
#pragma unroll
            for (int t = 0; t < 4; ++t)
#pragma unroll
                for (int ks = 0; ks < 4; ++ks) kf[t][ks] = *(const bf16x8*)(qkvn + (size_t)(tok0 + 16 * t + c16) * 2304 + 768 + hd * 128 + 32 * ks + 8 * g);
#pragma unroll
            for (int it = 0; it < 4; ++it)
#pragma unroll
                for (int jt = 0; jt <= it; ++jt) {
                    f32x4 acc = (f32x4){0.f, 0.f, 0.f, 0.f};
#pragma unroll
                    for (int ks = 0; ks < 4; ++ks) acc = __builtin_amdgcn_mfma_f32_16x16x32_bf16(kf[it][ks], kf[jt][ks], acc, 0, 0, 0);
                    const int jj = 16 * jt + c16; const float gcj = __shfl(gc, jj);
#pragma unroll
                    for (int r = 0; r < 4; ++r) { const int ii = 16 * it + 4 * g + r; const float gci = __shfl(gc, ii), bi = __shfl(beta, ii);
                        A[ii * 64 + jj] = ii > jj ? bi * acc[r] * __expf(gci - gcj) : 0.f; }
                }
#pragma unroll
            for (int it = 0; it < 4; ++it) {
                bf16x8 qf[4];
#pragma unroll
                for (int ks = 0; ks < 4; ++ks) qf[ks] = *(const bf16x8*)(qkvn + (size_t)(tok0 + 16 * it + c16) * 2304 + hd * 128 + 32 * ks + 8 * g);
#pragma unroll
                for (int jt = 0; jt < 4; ++jt) {
                    f32x4 acc = (f32x4){0.f, 0.f, 0.f, 0.f};
                    if (jt <= it) {
#pragma unroll
                        for (int ks = 0; ks < 4; ++ks) acc = __builtin_amdgcn_mfma_f32_16x16x32_bf16(qf[ks], kf[jt][ks], acc, 0, 0, 0);
                    }
                    const int jj = 16 * jt + c16; const float gcj = __shfl(gc, jj);
                    const int pos = (jj & 32) + invperm32(jj & 31);
#pragma unroll
                    for (int r = 0; r < 4; ++r) { const int ii = 16 * it + 4 * g + r; const float gci = __shfl(gc, ii);
                        const float v = ii >= jj ? acc[r] * 0.08838834764831845f * __expf(gci - gcj) : 0.f;
                        QKc[(size_t)ci * 4096 + ii * 64 + pos] = (bf16_t)(cvt_pk_bf16(v, 0.f) & 0xffffu); }
                }
            }
        }
        asm volatile("s_waitcnt lgkmcnt(0)" ::: "memory");
        LAS float* sol = A + 4096;
#pragma unroll 1
        for (int pass = 0; pass < 4; ++pass) {
            const int half = pass & 1, isw = pass >> 1;
            const int c = lane + 64 * half; const int posc = (c & ~31) + invperm32(c & 31);
            const bf16_t* src = qkvn + (size_t)tok0 * 2304 + (isw ? 768 : 1536) + hd * 128 + c;
#pragma unroll 8
            for (int i = 0; i < 64; ++i) { float f = __shfl(beta, i); if (isw) f *= __shfl(egc, i); sol[i * 64 + lane] = bf1(src[(size_t)i * 2304]) * f; }
            asm volatile("s_waitcnt lgkmcnt(0)" ::: "memory");
            solve_lds(sol, A, lane);
            asm volatile("s_waitcnt lgkmcnt(0)" ::: "memory");
            if (!isw) { float* up = UT + (size_t)ci * 8192 + (size_t)c * 64;
#pragma unroll 4
                for (int i = 0; i < 64; i += 4) *(f32x4*)(up + i) = (f32x4){sol[i * 64 + lane], sol[(i + 1) * 64 + lane], sol[(i + 2) * 64 + lane], sol[(i + 3) * 64 + lane]}; }
            else {
#pragma unroll 8
                for (int i = 0; i < 64; ++i) Wc[(size_t)ci * 8192 + i * 128 + posc] = (bf16_t)(cvt_pk_bf16(sol[i * 64 + lane], 0.f) & 0xffffu); }
            asm volatile("s_waitcnt lgkmcnt(0)" ::: "memory");
        }
        const int c0 = 2 * lane; const int pos0 = (c0 & ~31) + invperm32(c0 & 31);
#pragma unroll 8
        for (int i = 0; i < 64; ++i) { const unsigned w = *(const unsigned*)(qkvn + (size_t)(tok0 + i) * 2304 + hd * 128 + 2 * lane);
            const float s = __shfl(egc, i) * 0.08838834764831845f;
            *(unsigned*)(QDc + (size_t)ci * 8192 + i * 128 + pos0) = cvt_pk_bf16(bflo(w) * s, bfhi(w) * s); }
        asm volatile("s_waitcnt lgkmcnt(0)" ::: "memory");
        {
            LAS bf16_t* kt = (LAS bf16_t*)A;
#pragma unroll 8
            for (int i = 0; i < 64; ++i) { const unsigned w = *(const unsigned*)(qkvn + (size_t)(tok0 + i) * 2304 + 768 + hd * 128 + 2 * lane);
                *(LAS unsigned*)(kt + i * 128 + 2 * lane) = w; }
            asm volatile("s_waitcnt lgkmcnt(0)" ::: "memory");
#pragma unroll
            for (int hh = 0; hh < 2; ++hh) { const int dk = lane + 64 * hh;
#pragma unroll
                for (int p8 = 0; p8 < 8; ++p8) { float v[8];
#pragma unroll
                    for (int e = 0; e < 8; ++e) { const int pp = p8 * 8 + e; const int c = (pp & 32) + perm32k(pp & 31);
                        v[e] = bf1(kt[c * 128 + dk]) * __uint_as_float((unsigned)__builtin_amdgcn_readlane((int)__float_as_uint(edl), c)); }
                    u32x4 w; w.x = cvt_pk_bf16(v[0], v[1]); w.y = cvt_pk_bf16(v[2], v[3]); w.z = cvt_pk_bf16(v[4], v[5]); w.w = cvt_pk_bf16(v[6], v[7]);
                    *(u32x4*)(KDT + (size_t)ci * 8192 + dk * 64 + p8 * 8) = w; } }
            asm volatile("s_waitcnt lgkmcnt(0)" ::: "memory");
        }
    }
}

#else
__device__ __forceinline__ void phase_gdn_prep(const Params& p, LAS unsigned char* lds) {
    const bf16_t* qkvn = (const bf16_t*)(p.ws + WS_QKVN); const float* gb = (const float*)(p.ws + WS_GB);
    const bf16_t* KT = (const bf16_t*)(p.ws + WS_KT); const bf16_t* VT = (const bf16_t*)(p.ws + WS_VTC);
    bf16_t* Wc = (bf16_t*)(p.ws + WS_WC); bf16_t* QDc = (bf16_t*)(p.ws + WS_QDC); bf16_t* KDT = (bf16_t*)(p.ws + WS_KDT); bf16_t* QKc = (bf16_t*)(p.ws + WS_QKC);
    float* UT = (float*)(p.ws + WS_UT); float* GL = (float*)(p.ws + WS_GL);
    const int tid_ = otid(); const int lane0 = tid_ & 63, wave = __builtin_amdgcn_readfirstlane(tid_ >> 6);
    const int gw = blockIdx.x * 8 + wave, NGW = gridDim.x * 8;
#pragma unroll 1
    for (int ci = gw; ci < 1536; ci += NGW) {
        int lane = lane0; unsigned aoff = (unsigned)wave * 16384u;
        asm volatile("" : "+v"(lane), "+v"(aoff));
        const int c16 = lane & 15, g = lane >> 4;
        LAS float* A = (LAS float*)(lds + aoff);
        const int n = ci & 31, hd = (ci >> 5) % 6, b = ci / 192;
        const int tok0 = b * 2048 + n * 64;
        const float gi = gb[(size_t)(tok0 + lane) * 12 + hd], beta = gb[(size_t)(tok0 + lane) * 12 + 6 + hd];
        float gc = gi;
#pragma unroll
        for (int o = 1; o < 64; o <<= 1) { const float tv = __shfl_up(gc, o); if (lane >= o) gc += tv; }
        const float gl = __shfl(gc, 63);
        const float egc = __expf(gc), edl = __expf(gl - gc);
        if (lane == 0) GL[ci] = __expf(gl);
        {
            bf16x8 kf[4][4];
#pragma unroll
            for (int t = 0; t < 4; ++t)
#pragma unroll
                for (int ks = 0; ks < 4; ++ks) kf[t][ks] = *(const bf16x8*)(qkvn + (size_t)(tok0 + 16 * t + c16) * 2304 + 768 + hd * 128 + 32 * ks + 8 * g);
#pragma unroll
            for (int it = 0; it < 4; ++it)
#pragma unroll
                for (int jt = 0; jt <= it; ++jt) {
                    f32x4 acc = (f32x4){0.f, 0.f, 0.f, 0.f};
#pragma unroll
                    for (int ks = 0; ks < 4; ++ks) acc = __builtin_amdgcn_mfma_f32_16x16x32_bf16(kf[it][ks], kf[jt][ks], acc, 0, 0, 0);
                    const int jj = 16 * jt + c16; const float gcj = __shfl(gc, jj);
#pragma unroll
                    for (int r = 0; r < 4; ++r) { const int ii = 16 * it + 4 * g + r; const float gci = __shfl(gc, ii), bi = __shfl(beta, ii);
                        A[ii * 64 + jj] = ii > jj ? bi * acc[r] * __expf(gci - gcj) : 0.f; }
                }
#pragma unroll
            for (int it = 0; it < 4; ++it) {
                bf16x8 qf[4];
#pragma unroll
                for (int ks = 0; ks < 4; ++ks) qf[ks] = *(const bf16x8*)(qkvn + (size_t)(tok0 + 16 * it + c16) * 2304 + hd * 128 + 32 * ks + 8 * g);
#pragma unroll
                for (int jt = 0; jt < 4; ++jt) {
                    f32x4 acc = (f32x4){0.f, 0.f, 0.f, 0.f};
                    if (jt <= it) {
#pragma unroll
                        for (int ks = 0; ks < 4; ++ks) acc = __builtin_amdgcn_mfma_f32_16x16x32_bf16(qf[ks], kf[jt][ks], acc, 0, 0, 0);
                    }
                    const int jj = 16 * jt + c16; const float gcj = __shfl(gc, jj);
                    const int pos = (jj & 32) + invperm32(jj & 31);
#pragma unroll
                    for (int r = 0; r < 4; ++r) { const int ii = 16 * it + 4 * g + r; const float gci = __shfl(gc, ii);
                        const float v = ii >= jj ? acc[r] * 0.08838834764831845f * __expf(gci - gcj) : 0.f;
                        QKc[(size_t)ci * 4096 + ii * 64 + pos] = (bf16_t)(cvt_pk_bf16(v, 0.f) & 0xffffu); }
                }
            }
        }
#pragma unroll
        for (int it = 0; it < 3; ++it)
#pragma unroll
            for (int r = 0; r < 16; ++r) { if (lane >= 16 * (it + 1)) A[(16 * it + r) * 64 + lane] = 0.f; }
        asm volatile("s_waitcnt lgkmcnt(0)" ::: "memory");
        A[lane] = lane == 0 ? 1.f : 0.f;
#pragma unroll 1
        for (int i = 1; i < 64; ++i) {
            float r0 = lane == i ? 1.f : 0.f, r1 = 0.f;
            const int n4 = (i + 3) >> 2;
#pragma unroll 2
            for (int j4 = 0; j4 < n4; ++j4) {
                const f32x4 a = *(const LAS f32x4*)(A + i * 64 + 4 * j4);
                const LAS float* sp = A + (4 * j4) * 64 + lane;
                r0 -= a[0] * sp[0]; r1 -= a[1] * sp[64]; r0 -= a[2] * sp[128]; r1 -= a[3] * sp[192];
            }
            A[i * 64 + lane] = r0 + r1;
        }
        asm volatile("s_waitcnt lgkmcnt(0)" ::: "memory");
        {
            bf16x8 TU[4][2], TW[4][2];
            const float bw = beta * egc;
#pragma unroll
            for (int ks = 0; ks < 2; ++ks) {
                float fu[8], fw[8];
#pragma unroll
                for (int e = 0; e < 8; ++e) { fu[e] = __shfl(beta, 32 * ks + 8 * g + e); fw[e] = __shfl(bw, 32 * ks + 8 * g + e); }
#pragma unroll
                for (int it = 0; it < 4; ++it) {
                    const LAS f32x4* tp = (const LAS f32x4*)(A + (16 * it + c16) * 64 + 32 * ks + 8 * g);
                    const f32x4 t0 = tp[0], t1 = tp[1];
                    TU[it][ks] = pack8((f32x4){t0[0] * fu[0], t0[1] * fu[1], t0[2] * fu[2], t0[3] * fu[3]}, (f32x4){t1[0] * fu[4], t1[1] * fu[5], t1[2] * fu[6], t1[3] * fu[7]});
                    TW[it][ks] = pack8((f32x4){t0[0] * fw[0], t0[1] * fw[1], t0[2] * fw[2], t0[3] * fw[3]}, (f32x4){t1[0] * fw[4], t1[1] * fw[5], t1[2] * fw[6], t1[3] * fw[7]});
                }
            }
#pragma unroll 2
            for (int nt = 0; nt < 8; ++nt) {
                const bf16x8 v0 = *(const bf16x8*)(VT + (size_t)ci * 8192 + (size_t)(16 * nt + c16) * 64 + 8 * g), v1 = *(const bf16x8*)(VT + (size_t)ci * 8192 + (size_t)(16 * nt + c16) * 64 + 32 + 8 * g);
                const bf16x8 k0 = *(const bf16x8*)(KT + (size_t)ci * 8192 + (size_t)(16 * nt + c16) * 64 + 8 * g), k1 = *(const bf16x8*)(KT + (size_t)ci * 8192 + (size_t)(16 * nt + c16) * 64 + 32 + 8 * g);
                const int posn = ((16 * nt + 4 * g) & ~31) + invperm32((16 * nt + 4 * g) & 31);
#pragma unroll
                for (int it = 0; it < 4; ++it) {
                    f32x4 au = (f32x4){0.f, 0.f, 0.f, 0.f}, aw = (f32x4){0.f, 0.f, 0.f, 0.f};
                    au = __builtin_amdgcn_mfma_f32_16x16x32_bf16(TU[it][0], v0, au, 0, 0, 0); au = __builtin_amdgcn_mfma_f32_16x16x32_bf16(TU[it][1], v1, au, 0, 0, 0);
                    aw = __builtin_amdgcn_mfma_f32_16x16x32_bf16(k0, TW[it][0], aw, 0, 0, 0); aw = __builtin_amdgcn_mfma_f32_16x16x32_bf16(k1, TW[it][1], aw, 0, 0, 0);
                    *(f32x4*)(UT + (size_t)ci * 8192 + (size_t)(16 * nt + c16) * 64 + 16 * it + 4 * g) = au;
                    u32x2 w; w.x = pg8::cvt_pk_safe(aw[0], aw[1]); w.y = pg8::cvt_pk_safe(aw[2], aw[3]);
                    *(u32x2*)(Wc + (size_t)ci * 8192 + (16 * it + c16) * 128 + posn) = w;
                }
            }
        }
        const int c0 = 2 * lane; const int pos0 = (c0 & ~31) + invperm32(c0 & 31);
#pragma unroll 8
        for (int i = 0; i < 64; ++i) { const unsigned w = *(const unsigned*)(qkvn + (size_t)(tok0 + i) * 2304 + hd * 128 + 2 * lane);
            const float s = __shfl(egc, i) * 0.08838834764831845f;
            *(unsigned*)(QDc + (size_t)ci * 8192 + i * 128 + pos0) = cvt_pk_bf16(bflo(w) * s, bfhi(w) * s); }
#pragma unroll 1
        for (int hh = 0; hh < 2; ++hh) { const int dk = lane + 64 * hh;
            u32x4 kr[8];
#pragma unroll
            for (int q = 0; q < 8; ++q) kr[q] = *(const u32x4*)(KT + (size_t)ci * 8192 + (size_t)dk * 64 + 8 * q);
#pragma unroll
            for (int p8 = 0; p8 < 8; ++p8) { float v[8];
#pragma unroll
                for (int e = 0; e < 8; ++e) { const int pp = p8 * 8 + e; const int c = (pp & 32) + perm32k(pp & 31);
                    const unsigned wd = kr[c >> 3][(c & 7) >> 1]; const float kv = (c & 1) ? bfhi(wd) : bflo(wd);
                    v[e] = kv * __uint_as_float((unsigned)__builtin_amdgcn_readlane((int)__float_as_uint(edl), c)); }
                u32x4 w; w.x = cvt_pk_bf16(v[0], v[1]); w.y = cvt_pk_bf16(v[2], v[3]); w.z = cvt_pk_bf16(v[4], v[5]); w.w = cvt_pk_bf16(v[6], v[7]);
                *(u32x4*)(KDT + (size_t)ci * 8192 + dk * 64 + p8 * 8) = w; } }
        asm volatile("s_waitcnt lgkmcnt(0)" ::: "memory");
    }
}

#endif
constexpr int RB_W = 0, RB_QD = 17408, RB_KD = 34816, RB_QK = 34816 + 18432, RB_SZ = 62464;
__device__ __forceinline__ void rec_load(u32x4 (&r)[7], const bf16_t* Wc, const bf16_t* QDc, const bf16_t* KDT, const bf16_t* QKc, int ci, int tid) {
    r[0] = *(const u32x4*)(Wc + (size_t)ci * 8192 + (size_t)tid * 8); r[1] = *(const u32x4*)(Wc + (size_t)ci * 8192 + (size_t)(512 + tid) * 8);
    r[2] = *(const u32x4*)(QDc + (size_t)ci * 8192 + (size_t)tid * 8); r[3] = *(const u32x4*)(QDc + (size_t)ci * 8192 + (size_t)(512 + tid) * 8);
    r[4] = *(const u32x4*)(KDT + (size_t)ci * 8192 + (size_t)tid * 8); r[5] = *(const u32x4*)(KDT + (size_t)ci * 8192 + (size_t)(512 + tid) * 8);
    r[6] = *(const u32x4*)(QKc + (size_t)ci * 4096 + (size_t)tid * 8);
}
__device__ __forceinline__ void rec_store(const u32x4 (&r)[7], LAS unsigned char* buf, int tid) {
#pragma unroll
    for (int k = 0; k < 2; ++k) { const int q = tid + 512 * k;
        *(LAS u32x4*)(buf + RB_W + (q >> 4) * 272 + (q & 15) * 16) = r[k];
        *(LAS u32x4*)(buf + RB_QD + (q >> 4) * 272 + (q & 15) * 16) = r[2 + k];
        *(LAS u32x4*)(buf + RB_KD + (q >> 3) * 144 + (q & 7) * 16) = r[4 + k]; }
    *(LAS u32x4*)(buf + RB_QK + (tid >> 3) * 144 + (tid & 7) * 16) = r[6];
}
__device__ __forceinline__ void gdn_recur_prompt(const Params& p, LAS unsigned char* lds, int j, int bh, float* ob, float* gsbase) {
    const bf16_t* Wc = (const bf16_t*)(p.ws + WS_WC); const bf16_t* QDc = (const bf16_t*)(p.ws + WS_QDC); const bf16_t* KDT = (const bf16_t*)(p.ws + WS_KDT); const bf16_t* QKc = (const bf16_t*)(p.ws + WS_QKC);
    const float* UT = (const float*)(p.ws + WS_UT); const float* GL = (const float*)(p.ws + WS_GL);
    const int tid = otid(), lane = tid & 63, wave = __builtin_amdgcn_readfirstlane(tid >> 6), c16 = lane & 15, g = lane >> 4;
    const int b = bh / 6, hd = bh % 6, dv0 = wave * 16;
    f32x4 S[8];
#pragma unroll
    for (int i = 0; i < 8; ++i) S[i] = (f32x4){0.f, 0.f, 0.f, 0.f};
    u32x4 rg[7];
    rec_load(rg, Wc, QDc, KDT, QKc, bh * 32, tid);
    rec_store(rg, lds, tid);
    f32x4 un[4]; float egln;
#pragma unroll
    for (int ct = 0; ct < 4; ++ct) un[ct] = *(const f32x4*)(UT + (size_t)(bh * 32) * 8192 + (size_t)(dv0 + c16) * 64 + 16 * ct + 4 * g);
    egln = GL[bh * 32];
    __syncthreads();
#pragma unroll 1
    for (int n = 0; n < 32; ++n) {
        const int ci = bh * 32 + n;
        LAS unsigned char* buf = lds + (n & 1) * RB_SZ;
        if (n + 1 < 32) rec_load(rg, Wc, QDc, KDT, QKc, ci + 1, tid);
        f32x4 u[4];
#pragma unroll
        for (int ct = 0; ct < 4; ++ct) u[ct] = un[ct];
        const float egl = egln;
        { const int cn = (n + 1 < 32) ? ci + 1 : ci;
#pragma unroll
          for (int ct = 0; ct < 4; ++ct) un[ct] = *(const f32x4*)(UT + (size_t)cn * 8192 + (size_t)(dv0 + c16) * 64 + 16 * ct + 4 * g);
          egln = GL[cn]; }
        bf16x8 bS[4];
#pragma unroll
        for (int ks = 0; ks < 4; ++ks) bS[ks] = pack8(S[2 * ks], S[2 * ks + 1]);
        f32x4 vn[4], o[4];
#pragma unroll
        for (int ct = 0; ct < 4; ++ct) {
            f32x4 ws = (f32x4){0.f, 0.f, 0.f, 0.f}, oo = (f32x4){0.f, 0.f, 0.f, 0.f};
#pragma unroll
            for (int ks = 0; ks < 4; ++ks) {
                const bf16x8 wf = *(const LAS bf16x8*)(buf + RB_W + (16 * ct + c16) * 272 + ks * 64 + g * 16);
                const bf16x8 qf = *(const LAS bf16x8*)(buf + RB_QD + (16 * ct + c16) * 272 + ks * 64 + g * 16);
                ws = __builtin_amdgcn_mfma_f32_16x16x32_bf16(wf, bS[ks], ws, 0, 0, 0);
                oo = __builtin_amdgcn_mfma_f32_16x16x32_bf16(qf, bS[ks], oo, 0, 0, 0);
            }
            vn[ct] = u[ct] - ws; o[ct] = oo;
        }
        bf16x8 bV[2];
#pragma unroll
        for (int k2 = 0; k2 < 2; ++k2) bV[k2] = pack8(vn[2 * k2], vn[2 * k2 + 1]);
#pragma unroll
        for (int ct = 0; ct < 4; ++ct) {
#pragma unroll
            for (int k2 = 0; k2 < 2; ++k2) { const bf16x8 af = *(const LAS bf16x8*)(buf + RB_QK + (16 * ct + c16) * 144 + k2 * 64 + g * 16);
                o[ct] = __builtin_amdgcn_mfma_f32_16x16x32_bf16(af, bV[k2], o[ct], 0, 0, 0); }
#pragma unroll
            for (int r = 0; r < 4; ++r) ob[(size_t)(b * 2048 + n * 64 + 16 * ct + 4 * g + r) * 768 + hd * 128 + dv0 + c16] = o[ct][r];
        }
#pragma unroll
        for (int dt = 0; dt < 8; ++dt) { f32x4 s = S[dt] * egl;
#pragma unroll
            for (int k2 = 0; k2 < 2; ++k2) { const bf16x8 af = *(const LAS bf16x8*)(buf + RB_KD + (16 * dt + c16) * 144 + k2 * 64 + g * 16);
                s = __builtin_amdgcn_mfma_f32_16x16x32_bf16(af, bV[k2], s, 0, 0, 0); }
            S[dt] = s; }
        if (n + 1 < 32) rec_store(rg, lds + ((n + 1) & 1) * RB_SZ, tid);
        asm volatile("s_waitcnt lgkmcnt(0)" ::: "memory"); __builtin_amdgcn_s_barrier(); asm volatile("" ::: "memory");
    }
    float* so = gsbase + ((size_t)(j * 8 + b) * 6 + hd) * 16384;
#pragma unroll
    for (int dt = 0; dt < 8; ++dt)
#pragma unroll
        for (int r = 0; r < 4; ++r) so[(size_t)(16 * dt + 4 * g + r) * 128 + dv0 + c16] = S[dt][r];
}
__device__ __forceinline__ void gdn_naive_item(const Params& p, LAS unsigned char* lds, int row0, int T, int hd, const float* s0, float* sout, float* ob) {
    const bf16_t* qkvn = (const bf16_t*)(p.ws + WS_QKVN); const float* gb = (const float*)(p.ws + WS_GB);
    const int tid = otid(), e = tid & 127, part = tid >> 7;
    LAS float* kq = (LAS float*)lds;
    LAS float* red = kq + 1024;
    LAS float* red2 = red + 512;
    float S[32];
#pragma unroll
    for (int i = 0; i < 32; ++i) S[i] = s0 ? s0[(size_t)(part * 32 + i) * 128 + e] : 0.f;
#pragma unroll 1
    for (int tb = 0; tb < T; tb += 4) {
        __syncthreads();
        for (int i = tid; i < 1024; i += 512) { const int t = i >> 8, s = (i >> 7) & 1, d = i & 127;
            kq[i] = bf1(qkvn[(size_t)(row0 + tb + t) * 2304 + (s == 0 ? 768 : 0) + hd * 128 + d]); }
        __syncthreads();
#pragma unroll 1
        for (int t = 0; t < 4; ++t) {
            const int row = row0 + tb + t;
            const float a = __expf(gb[(size_t)row * 12 + hd]), bt = gb[(size_t)row * 12 + 6 + hd];
            const float v = bf1(qkvn[(size_t)row * 2304 + 1536 + hd * 128 + e]);
            float ps = 0.f;
#pragma unroll
            for (int i = 0; i < 32; ++i) ps += S[i] * kq[(t * 2 + 0) * 128 + part * 32 + i];
            red[part * 128 + e] = ps;
            __syncthreads();
            const float kS = red[e] + red[128 + e] + red[256 + e] + red[384 + e];
            const float vnew = bt * (v - a * kS);
            float po = 0.f;
#pragma unroll
            for (int i = 0; i < 32; ++i) { S[i] = a * S[i] + kq[(t * 2 + 0) * 128 + part * 32 + i] * vnew; po += S[i] * kq[(t * 2 + 1) * 128 + part * 32 + i]; }
            red2[part * 128 + e] = po;
            __syncthreads();
            if (part == 0) ob[(size_t)row * 768 + hd * 128 + e] = (red2[e] + red2[128 + e] + red2[256 + e] + red2[384 + e]) * 0.08838834764831845f;
        }
    }
#pragma unroll
    for (int i = 0; i < 32; ++i) sout[(size_t)(part * 32 + i) * 128 + e] = S[i];
    __syncthreads();
}
__device__ __forceinline__ void gdn_sample_item(const Params& p, LAS unsigned char* lds, int j, int item) {
    const int sb = item / 6, hd = item % 6;
    gdn_naive_item(p, lds, TP + sb * 4, 4, hd, p.in[7] + ((size_t)(j * 128 + sb) * 6 + hd) * 16384, p.out + O_GSS + ((size_t)(j * 128 + sb) * 6 + hd) * 16384, (float*)(p.ws + WS_O));
}
__device__ __forceinline__ void phase_gdn_post(const Params& p, int j) {
    const bf16_t* h = (const bf16_t*)(p.ws + WS_H); const float* ob = (const float*)(p.ws + WS_O); bf16_t* cat = (bf16_t*)(p.ws + WS_CAT);
    const int tid_ = otid(); const int lane = tid_ & 63, wave = __builtin_amdgcn_readfirstlane(tid_ >> 6);
    const int gw = blockIdx.x * 8 + wave, NGW = gridDim.x * 8;
    const f32x2 nw = *(const f32x2*)(p.in[16] + j * 128 + 2 * lane);
    for (int it = gw; it < TT * 6; it += NGW) {
        const int row = it / 6, hd = it % 6;
        const f32x2 o = *(const f32x2*)(ob + (size_t)row * 768 + hd * 128 + 2 * lane);
        const float ss = wave_sum(o[0] * o[0] + o[1] * o[1]);
        const float r = 1.f / sqrtf(ss * (1.f / 128.f) + 1e-6f);
        const unsigned zw = *(const unsigned*)(h + (size_t)row * NHB + 2304 + hd * 128 + 2 * lane);
        const float y0 = o[0] * r * nw[0] * silu_f(bflo(zw)), y1 = o[1] * r * nw[1] * silu_f(bfhi(zw));
        *(unsigned*)(cat + (size_t)row * DM + hd * 128 + 2 * lane) = cvt_pk_bf16(y0, y1);
    }
}


#ifdef DIAG_GDN
constexpr size_t WS_DBG = WS_END;
constexpr size_t WS_OB2 = WS_END + 4096;
constexpr size_t WS_GS2 = WS_OB2 + (size_t)TT * 768 * 4;
constexpr size_t WS_DIAG_END = WS_GS2 + (size_t)2 * 8 * 6 * 16384 * 4;
__device__ __forceinline__ void diag_compare(const Params& p, int j) {
    const float* ob = (const float*)(p.ws + WS_O); const float* ob2 = (const float*)(p.ws + WS_OB2);
    const float* gs = p.out + O_GSP + (size_t)j * 8 * 6 * 16384; const float* gs2 = (const float*)(p.ws + WS_GS2) + (size_t)j * 8 * 6 * 16384;
    float* dbg = (float*)(p.ws + WS_DBG);
    const size_t gt = (size_t)blockIdx.x * 512 + otid(), NT = (size_t)gridDim.x * 512;
    float n1 = 0.f, d1 = 0.f, n3 = 0.f, d3 = 0.f, n2 = 0.f, d2 = 0.f, n4 = 0.f, d4 = 0.f;
    for (size_t i = gt; i < (size_t)TP * 768; i += NT) { const int row = (int)(i / 768); const float a = ob[i], b = ob2[i]; const float e = (a - b) * (a - b);
        n3 += e; d3 += a * a; if ((row & 2047) < 64) { n1 += e; d1 += a * a; } else if ((row & 2047) < 128) { n4 += e; d4 += a * a; } }
    for (size_t i = gt; i < (size_t)8 * 6 * 16384; i += NT) { const float a = gs[i], b = gs2[i]; n2 += (a - b) * (a - b); d2 += a * a; }
    n1 = wave_sum(n1); d1 = wave_sum(d1); n2 = wave_sum(n2); d2 = wave_sum(d2); n3 = wave_sum(n3); d3 = wave_sum(d3); n4 = wave_sum(n4); d4 = wave_sum(d4);
    if ((otid() & 63) == 0) { atomicAdd(dbg + 0, n1); atomicAdd(dbg + 1, d1); atomicAdd(dbg + 2, n2); atomicAdd(dbg + 3, d2); atomicAdd(dbg + 4, n3); atomicAdd(dbg + 5, d3); atomicAdd(dbg + 6, n4); atomicAdd(dbg + 7, d4); }
}
__device__ __forceinline__ void diag_compare2(const Params& p) {
    const bf16_t* qkvn = (const bf16_t*)(p.ws + WS_QKVN); const float* gb = (const float*)(p.ws + WS_GB);
    const bf16_t* Wc = (const bf16_t*)(p.ws + WS_WC); const float* UT = (const float*)(p.ws + WS_UT);
    float* dbg = (float*)(p.ws + WS_DBG);
    const int tid_ = otid(); const int lane = tid_ & 63, wave = __builtin_amdgcn_readfirstlane(tid_ >> 6);
    const int gw = blockIdx.x * 8 + wave, NGW = gridDim.x * 8;
    float n8 = 0.f, d8 = 0.f, n12 = 0.f, d12 = 0.f;
    for (int cs = gw; cs < 192; cs += NGW) {
        const int ci = cs * 8 + (cs % 7);
        const int n = ci & 31, hd = (ci >> 5) % 6, b = ci / 192; const int tok0 = b * 2048 + n * 64;
        float gcs = 0.f, mygc = 0.f;
        for (int t = 0; t < 64; ++t) { gcs += gb[(size_t)(tok0 + t) * 12 + hd]; if (t == lane) mygc = gcs; }
        const float mybeta = gb[(size_t)(tok0 + lane) * 12 + 6 + hd];
        const int pos0 = (lane & ~31) + invperm32(lane & 31), pos1 = 64 + pos0;
        for (int i = 0; i < 64; ++i) {
            const float gci = __shfl(mygc, i), bi = __shfl(mybeta, i);
            const float ki0 = bf1(qkvn[(size_t)(tok0 + i) * 2304 + 768 + hd * 128 + lane]), ki1 = bf1(qkvn[(size_t)(tok0 + i) * 2304 + 768 + hd * 128 + 64 + lane]);
            float lw0 = bf1(Wc[(size_t)ci * 8192 + i * 128 + pos0]), lw1 = bf1(Wc[(size_t)ci * 8192 + i * 128 + pos1]);
            float lu0 = UT[(size_t)ci * 8192 + (size_t)lane * 64 + i], lu1 = UT[(size_t)ci * 8192 + (size_t)(lane + 64) * 64 + i];
            for (int j = 0; j < i; ++j) {
                const float kj0 = bf1(qkvn[(size_t)(tok0 + j) * 2304 + 768 + hd * 128 + lane]), kj1 = bf1(qkvn[(size_t)(tok0 + j) * 2304 + 768 + hd * 128 + 64 + lane]);
                const float dot = wave_sum(ki0 * kj0 + ki1 * kj1);
                const float aij = bi * dot * __expf(gci - __shfl(mygc, j));
                lw0 += aij * bf1(Wc[(size_t)ci * 8192 + j * 128 + pos0]); lw1 += aij * bf1(Wc[(size_t)ci * 8192 + j * 128 + pos1]);
                lu0 += aij * UT[(size_t)ci * 8192 + (size_t)lane * 64 + j]; lu1 += aij * UT[(size_t)ci * 8192 + (size_t)(lane + 64) * 64 + j];
            }
            const float rw0 = bi * __expf(gci) * ki0, rw1 = bi * __expf(gci) * ki1;
            const float vi0 = bf1(qkvn[(size_t)(tok0 + i) * 2304 + 1536 + hd * 128 + lane]), vi1 = bf1(qkvn[(size_t)(tok0 + i) * 2304 + 1536 + hd * 128 + 64 + lane]);
            const float ru0 = bi * vi0, ru1 = bi * vi1;
            n12 += (lw0 - rw0) * (lw0 - rw0) + (lw1 - rw1) * (lw1 - rw1); d12 += rw0 * rw0 + rw1 * rw1;
            n8 += (lu0 - ru0) * (lu0 - ru0) + (lu1 - ru1) * (lu1 - ru1); d8 += ru0 * ru0 + ru1 * ru1;
        }
    }
    n8 = wave_sum(n8); d8 = wave_sum(d8); n12 = wave_sum(n12); d12 = wave_sum(d12);
    if (lane == 0) { atomicAdd(dbg + 8, n8); atomicAdd(dbg + 9, d8); atomicAdd(dbg + 12, n12); atomicAdd(dbg + 13, d12); }
}
__device__ __forceinline__ int diag_class(float n, float d) { const float r = n / (d + 1e-30f); return r < 4e-4f ? 0 : (r < 0.09f ? 1 : 2); }
#endif
#define XB_TMO      128
#define XB_XCNT(j)  (256  + 64 * (j))
#define XB_XSUB(j)  (1280 + 64 * (j))
#define XB_XGEN(j)  (2304 + 64 * (j))
#define XB_TOP      3328
#define XB_TOPGEN   3392
#define XCD_BAR_WORDS 3456
#define XB_SPIN_CAP (1u << 18)

__device__ __forceinline__ unsigned xb_ld(unsigned* p)              { return __hip_atomic_load(p, __ATOMIC_RELAXED, __HIP_MEMORY_SCOPE_AGENT); }
__device__ __forceinline__ unsigned xb_add(unsigned* p, unsigned v) { return __hip_atomic_fetch_add(p, v, __ATOMIC_RELAXED, __HIP_MEMORY_SCOPE_AGENT); }
__device__ __forceinline__ unsigned xb_xcc_id() { return (unsigned)__builtin_amdgcn_s_getreg((3 << 11) | 20) & 0xFu; }
#define XB_SPIN(cond, bar) do { unsigned _sp = 0; while (cond) { __builtin_amdgcn_s_sleep(1); \
    if ((++_sp & 255u) == 0u) { if (xb_ld(&(bar)[XB_TMO])) break; if (_sp > XB_SPIN_CAP) { atomicAdd(&(bar)[XB_TMO], 1u); break; } } } } while (0)

struct XcdBarrier {
    unsigned* bar; unsigned x;
    volatile LAS unsigned* st;
};

__device__ __forceinline__ XcdBarrier xcd_barrier_post(unsigned* bar, volatile LAS unsigned* st) {
    XcdBarrier b; b.bar = bar; b.x = xb_xcc_id(); b.st = st;
    if (threadIdx.x == 0) (void)xb_add(&bar[XB_XCNT(b.x)], 1u);
    return b;
}
__device__ __forceinline__ void xcd_barrier_complete(unsigned* bar, unsigned x, unsigned& nloc, unsigned& nx) {
    const unsigned G = gridDim.x * gridDim.y * gridDim.z;
    unsigned sum, cnt, mine, sp = 0u;
    for (;;) {
        sum = 0u; cnt = 0u; mine = 0u;
#pragma unroll
        for (unsigned j = 0; j < 16; ++j) { const unsigned c = xb_ld(&bar[XB_XCNT(j)]); sum += c; cnt += (c > 0u) ? 1u : 0u; mine = (j == x) ? c : mine; }
        if (sum == G) break;
        __builtin_amdgcn_s_sleep(1);
        if ((++sp & 255u) == 0u) { if (xb_ld(&bar[XB_TMO])) break; if (sp > XB_SPIN_CAP) { atomicAdd(&bar[XB_TMO], 1u); break; } }
    }
    nloc = mine > 0u ? mine : 1u; nx = cnt > 0u ? cnt : 1u;
}

__device__ __forceinline__ void xcd_barrier(const XcdBarrier& b) {
    asm volatile("s_waitcnt vmcnt(0)" ::: "memory");
    __syncthreads();
    if (threadIdx.x == 0) {
        unsigned* bar = b.bar;
        __builtin_amdgcn_s_waitcnt(0);
        unsigned nloc = b.st[0], nx = b.st[1];
        if (nloc == 0u) { xcd_barrier_complete(bar, b.x, nloc, nx); b.st[0] = nloc; b.st[1] = nx; }
        const unsigned old = xb_add(&bar[XB_XSUB(b.x)], 1u);
        const unsigned gen = old / nloc;
        if (old + 1u == (gen + 1u) * nloc) {
            __builtin_amdgcn_fence(__ATOMIC_RELEASE, "agent");
            asm volatile("s_waitcnt vmcnt(0)" ::: "memory");
            const unsigned og = xb_add(&bar[XB_TOP], 1u);
            const unsigned tg = og / nx;
            if (og + 1u == (tg + 1u) * nx) xb_add(&bar[XB_TOPGEN], 1u);
            else XB_SPIN(xb_ld(&bar[XB_TOPGEN]) == tg, bar);
            __builtin_amdgcn_fence(__ATOMIC_ACQUIRE, "agent");
            xb_add(&bar[XB_XGEN(b.x)], 1u);
            asm volatile("s_waitcnt vmcnt(0)" ::: "memory");
        } else {
            XB_SPIN(xb_ld(&bar[XB_XGEN(b.x)]) == gen, bar);
            __builtin_amdgcn_fence(__ATOMIC_ACQUIRE, "agent");
            asm volatile("s_waitcnt vmcnt(0)" ::: "memory");
        }
    }
    __syncthreads();
}


#ifdef EXP_SYNC2
#define GSYNC() do { xcd_barrier(xbar); xcd_barrier(xbar); } while (0)
#else
#define GSYNC() xcd_barrier(xbar)
#endif
#ifdef EXP_ELEM2
#define ELEM2(x) do { x; x; } while (0)
#else
#define ELEM2(x) do { x; } while (0)
#endif
#ifdef EXP_GEMM2
#define GEMM2(x) do { x; x; } while (0)
#else
#define GEMM2(x) do { x; } while (0)
#endif
#ifdef EXP_GDNPREP2
#define GDNP2(x) do { x; x; } while (0)
#else
#define GDNP2(x) do { x; } while (0)
#endif
#ifdef EXP_ATTN2
#define ATTN_REP 2
#else
#define ATTN_REP 1
#endif
#ifdef EXP_ATTNS2
#define ATTNS_REP 2
#else
#define ATTNS_REP 1
#endif
#ifdef EXP_GEMM3
#define GEMM3(x) do { x; x; } while (0)
#else
#define GEMM3(x) do { x; } while (0)
#endif
#ifdef EXP_GDN2
#define GDN2(x) do { x; x; } while (0)
#else
#define GDN2(x) do { x; } while (0)
#endif
__global__ void __launch_bounds__(512, 2) fwd_megakernel(Params p) {
    extern __shared__ __attribute__((aligned(16))) unsigned char lds_raw[];
    LAS unsigned char* lds = (LAS unsigned char*)lds_raw;
    cg::grid_group grid = cg::this_grid();
    unsigned char* ws = p.ws;
    float* xf = (float*)(ws + WS_XF); bf16_t* xb = (bf16_t*)(ws + WS_XB);
    bf16_t* hbuf = (bf16_t*)(ws + WS_H); bf16_t* cat = (bf16_t*)(ws + WS_CAT);
    bf16_t* hu = (bf16_t*)(ws + WS_HU); bf16_t* gact = (bf16_t*)(ws + WS_GACT);
    const bf16_t* Kb = (const bf16_t*)(ws + WS_KB); const bf16_t* Vt = (const bf16_t*)(ws + WS_VT);
    const int bid = blockIdx.x, G = gridDim.x;
    volatile LAS unsigned* xst = (volatile LAS unsigned*)(lds + LDS_BYTES - 16);
    if (threadIdx.x < 4) xst[threadIdx.x] = 0u;
    __syncthreads();
    XcdBarrier xbar = xcd_barrier_post((unsigned*)(ws + WS_BAR), xst);

#ifdef DIAG_GDN
    if (bid == 0 && threadIdx.x < 64) ((float*)(ws + WS_DBG))[threadIdx.x] = 0.f;
#endif
#ifdef EXP_PREP2
    phase_prep(p, lds);
#endif
    phase_prep(p, lds);
    grid.sync();
    {
        EpiKV E{p.out + O_MK, p.out + O_MV, (bf16_t*)(ws + WS_KB), (bf16_t*)(ws + WS_VT)};
        run_gemm(lds, (const bf16_t*)(ws + WS_MEMB), (const bf16_t*)(ws + WS_WKV), 2048, 2048, DM, E, (bid + 64) % G);
    }
#pragma unroll 1
    for (int l = 0; l < 4; ++l) {
        const int j = l >> 1; const bool isB = (l & 1) != 0;
        if (!isB) {
            { EpiStoreBf16 E{hbuf, NHA}; GEMM3(run_gemm(lds, xb, (const bf16_t*)(ws + WS_WINA) + (size_t)j * NHA * DM, TT, NHA, DM, E, bid)); }
            GSYNC();
            ELEM2(phase_mixA_elem(p, j));
#ifdef NAIVE_ATTN
            for (int it = bid; it < 256; it += G) attn_prompt_item_naive(lds, hbuf, NHA, 2304, p.out + O_MK, p.out + O_MV, cat, l, it);
#else
            for (int rep = 0; rep < ATTN_REP; ++rep) for (int it = bid; it < 256; it += G) attn_prompt_item(lds, hbuf, NHA, 2304, Kb, Vt, cat, l, it);
#endif
            for (int rep = 0; rep < ATTNS_REP; ++rep) for (int it = bid; it < 256; it += G) attn_sample_item(lds, hbuf, NHA, 2304, p.in[3], p.in[4], cat, l, it);
            GSYNC();
            { EpiResid E{xf, DM}; const bf16_t* W = (const bf16_t*)(ws + WS_WOUTA) + (size_t)j * DM * DM; small_gemm_resid(cat, W, DM, xf); run_gemm(lds, cat, W, TP, DM, DM, E, bid); }
        } else {
            { EpiStoreBf16 E{hbuf, NHB}; GEMM3(run_gemm(lds, xb, (const bf16_t*)(ws + WS_WINB) + (size_t)j * NHB * DM, TT, NHB, DM, E, bid)); }
            GSYNC();
            ELEM2(phase_gdn_pre(p, j));
            GSYNC();
#ifndef NAIVE_GDN
            GDNP2(phase_gdn_prep(p, lds));
            GSYNC();
#endif
#ifdef NAIVE_GDN
            if (bid < 48) gdn_naive_item(p, lds, (bid / 6) * 2048, 2048, bid % 6, nullptr, p.out + O_GSP + ((size_t)(j * 8 + bid / 6) * 6 + bid % 6) * 16384, (float*)(ws + WS_O));
#else
            if (bid < 48) { GDN2(gdn_recur_prompt(p, lds, j, bid, (float*)(ws + WS_O), p.out + O_GSP)); }
#endif
            else {
                const int nb = G - 48;
                for (int it = bid - 48; it < 768; it += nb) gdn_sample_item(p, lds, j, it);
#ifdef NAIVE_ATTN
                for (int it = bid - 48; it < 256; it += nb) attn_prompt_item_naive(lds, hbuf, NHB, 3072, p.out + O_MK, p.out + O_MV, cat, l, it);
#else
                for (int it = bid - 48; it < 256; it += nb) attn_prompt_item(lds, hbuf, NHB, 3072, Kb, Vt, cat, l, it);
#endif
                for (int it = bid - 48; it < 256; it += nb) attn_sample_item(lds, hbuf, NHB, 3072, p.in[3], p.in[4], cat, l, it);
            }
            GSYNC();
#ifdef DIAG_GDN
            if (l == 1) {
                if (bid < 48) gdn_naive_item(p, lds, (bid / 6) * 2048, 2048, bid % 6, nullptr, (float*)(ws + WS_GS2) + ((size_t)(j * 8 + bid / 6) * 6 + bid % 6) * 16384, (float*)(ws + WS_OB2));
                GSYNC();
                diag_compare(p, j);
                diag_compare2(p);
                GSYNC();
            }
#endif
            ELEM2(phase_gdn_post(p, j));
            GSYNC();
            { EpiResid E{xf, DM}; const bf16_t* W = (const bf16_t*)(ws + WS_WOUTB) + (size_t)j * DM * DM; small_gemm_resid(cat, W, DM, xf); run_gemm(lds, cat, W, TP, DM, DM, E, bid); }
        }
        GSYNC();
#ifdef EXP_LN2
        phase_ln(xf, xb, p.in[19] + l * DM, p.in[20] + l * DM, (float*)(ws + WS_HU));
#endif
        phase_ln(xf, xb, p.in[19] + l * DM, p.in[20] + l * DM, nullptr);
        GSYNC();
        { EpiStoreBf16 E{hu, NUP}; GEMM2(run_gemm(lds, xb, (const bf16_t*)(ws + WS_WUP) + (size_t)l * NUP * DM, TT, NUP, DM, E, bid)); }
        GSYNC();
        ELEM2(phase_convgate(p, l));
        GSYNC();
        { EpiResid E{xf, DM}; const bf16_t* W = (const bf16_t*)(ws + WS_WDOWN) + (size_t)l * DM * DFF; small_gemm_resid(gact, W, DFF, xf); run_gemm(lds, gact, W, TP, DM, DFF, E, bid); }
        GSYNC();
#ifdef EXP_LN2
        phase_ln(xf, xb, p.in[21] + l * DM, p.in[22] + l * DM, (float*)(ws + WS_H));
#endif
        phase_ln(xf, xb, p.in[21] + l * DM, p.in[22] + l * DM, l == 3 ? p.out + O_Y : nullptr);
        if (l < 3) GSYNC();
    }
#ifdef DIAG_GDN
    GSYNC();
    if (bid == 0 && threadIdx.x == 0) { const float* dbg = (const float*)(ws + WS_DBG);
        const int code = 27 * diag_class(dbg[6], dbg[7]) + 9 * diag_class(dbg[8], dbg[9]) + 3 * diag_class(dbg[2], dbg[3]) + diag_class(dbg[12], dbg[13]);
        float v = 1.0e4f; for (int i = 0; i < code; ++i) v *= 1.25f;
        p.out[0] = v; }
#endif
}

extern "C" void kernel_launch(void* const* d_in, const int* in_sizes, int n_in, void* d_out, int out_size, void* d_ws, size_t ws_size, hipStream_t stream) {
    static int grid_blocks = 0;
    if (grid_blocks == 0) {
        if (n_in != 26 || (size_t)out_size != O_END || ws_size < WS_TOTAL) { fprintf(stderr, "kernel_launch: unexpected shapes n_in %d out %d (want %zu) ws %zu (need %zu)\n", n_in, out_size, (size_t)O_END, ws_size, (size_t)WS_END); grid_blocks = -1; return; }
        int dev = 0, cus = 0, per_cu = 0;
        hipGetDevice(&dev);
        hipDeviceGetAttribute(&cus, hipDeviceAttributeMultiprocessorCount, dev);
        if (hipFuncSetAttribute((const void*)fwd_megakernel, hipFuncAttributeMaxDynamicSharedMemorySize, LDS_BYTES) != hipSuccess) { fprintf(stderr, "kernel_launch: hipFuncSetAttribute failed\n"); grid_blocks = -1; return; }
        hipOccupancyMaxActiveBlocksPerMultiprocessor(&per_cu, (const void*)fwd_megakernel, 512, LDS_BYTES);
        if (per_cu < 1) { fprintf(stderr, "kernel_launch: occupancy query says %d blocks/CU\n", per_cu); grid_blocks = -1; return; }
        grid_blocks = cus;
        if (grid_blocks > 256) grid_blocks = 256;
    }
    if (grid_blocks < 0) return;
    if (hipMemsetAsync((char*)d_ws + WS_BAR, 0, 16384, stream) != hipSuccess) { fprintf(stderr, "kernel_launch: memset of barrier words failed\n"); return; }
    Params p{};
    for (int i = 0; i < 26; ++i) p.in[i] = (const float*)d_in[i];
    p.out = (float*)d_out; p.ws = (unsigned char*)d_ws;
    void* args[] = {&p};
    hipError_t e = hipLaunchCooperativeKernel((const void*)fwd_megakernel, dim3(grid_blocks), dim3(512), args, LDS_BYTES, stream);
    if (e != hipSuccess) fprintf(stderr, "cooperative launch failed: %s (grid %d)\n", hipGetErrorString(e), grid_blocks);
}
```
